# Optimizing an MI355X kernel written in HIP

```python
import jax, jax.numpy as jnp
from jax import lax
import numpy as np

D_MODEL = 1024
BATCH = 8
SEQ = 2048
DEPTH = 1
DEC_BATCH = 128
DEC_SEQ = 8
PAST_LEN = 16384
PAGE_SIZE = 128

MIX_WIDTH = D_MODEL
CONV_DIM = MIX_WIDTH // 2
CONV_GROUPS = 8
CONV_K = 3
HEADS_B = 8
HEAD_DIM_B = (MIX_WIDTH - CONV_DIM) // HEADS_B
CHUNK_DIM = HEADS_B * HEAD_DIM_B
CHUNK = 128
D_FF = ((8 * D_MODEL // 3 + 127) // 128) * 128
PLE_DIM = 256
IN_COLS = 3 * CONV_DIM + 2 * CHUNK_DIM
EPS = 1e-6

kernel_name = "hymba_conv_gmlp_macaron_step"


def rmsnorm(x, g):
    xf = x.astype(jnp.float32)
    y = xf * lax.rsqrt(jnp.mean(xf * xf, axis=-1, keepdims=True) + EPS)
    return (y * g.astype(jnp.float32)).astype(x.dtype)


def swiglu(x, w_gate, w_up, w_down):
    return (jax.nn.silu(x @ w_gate) * (x @ w_up)) @ w_down


def causal_dwconv(prev, z, w):
    L = z.shape[1]
    full = jnp.concatenate([prev, z], axis=1)
    y = sum(w[k] * full[:, k:k + L] for k in range(CONV_K))
    return y, full[:, full.shape[1] - (CONV_K - 1):]


def chunk_spatial_mix(v, w_s, b_s):
    B, L, H, D = v.shape
    n_chunks = -(-L // CHUNK)
    pad = n_chunks * CHUNK - L
    vp = jnp.pad(v, ((0, 0), (0, pad), (0, 0), (0, 0))).reshape(B, n_chunks, CHUNK, H, D)
    causal = jnp.tril(jnp.ones((CHUNK, CHUNK), dtype=bool))
    wm = jnp.where(causal[None], w_s, jnp.zeros_like(w_s))
    out = jnp.einsum('hts,bcshd->bcthd', wm, vp) + b_s.T[None, None, :, :, None]
    return out.reshape(B, n_chunks * CHUNK, H, D)[:, :L]


def layer(x, p_emb, conv_prev,
          ffn1_pre_g, ffn1_post_g, ffn1_w_gate, ffn1_w_up, ffn1_w_down,
          mix_pre_g, mix_post_g, w_in, conv_w, v_norm_g, w_s, b_s, out_g_a, out_g_b, w_out,
          ffn2_pre_g, ffn2_post_g, ffn2_w_gate, ffn2_w_up, ffn2_w_down,
          ple_w_gate, ple_w_proj, ple_post_g):
    B, L, _ = x.shape
    h = x + 0.5 * rmsnorm(swiglu(rmsnorm(x, ffn1_pre_g), ffn1_w_gate, ffn1_w_up, ffn1_w_down), ffn1_post_g)
    n = rmsnorm(h, mix_pre_g)
    proj = n @ w_in
    o = 0
    b_a = proj[..., o:o + CONV_DIM]; o += CONV_DIM
    c_a = proj[..., o:o + CONV_DIM]; o += CONV_DIM
    h_a = proj[..., o:o + CONV_DIM]; o += CONV_DIM
    u = proj[..., o:o + CHUNK_DIM]; o += CHUNK_DIM
    v = proj[..., o:o + CHUNK_DIM]
    conv_out, new_conv = causal_dwconv(conv_prev, c_a * h_a, conv_w)
    y_a = b_a * conv_out
    v_n = rmsnorm(v.reshape(B, L, HEADS_B, HEAD_DIM_B), v_norm_g)
    mixed = chunk_spatial_mix(v_n, w_s, b_s)
    y_b = (u.reshape(B, L, HEADS_B, HEAD_DIM_B) * mixed).reshape(B, L, CHUNK_DIM)
    n_cur = ((L - 1) % CHUNK) + 1
    v_cur = v_n[:, L - n_cur:]
    y = jnp.concatenate([rmsnorm(y_a, out_g_a), rmsnorm(y_b, out_g_b)], axis=-1) @ w_out
    h = h + rmsnorm(y, mix_post_g)
    h = h + 0.5 * rmsnorm(swiglu(rmsnorm(h, ffn2_pre_g), ffn2_w_gate, ffn2_w_up, ffn2_w_down), ffn2_post_g)
    gate = jax.nn.sigmoid(h @ ple_w_gate)
    h = h + rmsnorm(gate * (p_emb @ ple_w_proj), ple_post_g)
    return h, new_conv, v_cur


def setup_inputs(seed: int = 0) -> dict:
    key = jax.random.key(seed)
    ks = iter(jax.random.split(key, 40))
    f32 = jnp.float32

    def nrm(shape, scale):
        return jax.random.normal(next(ks), shape, f32) * scale

    def gain(shape):
        return 1.0 + 0.05 * jax.random.normal(next(ks), shape, f32)

    d = {}
    d["x_prompt"] = nrm((BATCH, SEQ, D_MODEL), 1.0)
    d["x_sample"] = nrm((DEC_BATCH, DEC_SEQ, D_MODEL), 1.0)
    d["p_prompt"] = nrm((DEPTH, BATCH, SEQ, PLE_DIM), 1.0)
    d["p_sample"] = nrm((DEPTH, DEC_BATCH, DEC_SEQ, PLE_DIM), 1.0)
    d["state_conv"] = nrm((DEPTH, DEC_BATCH, CONV_K - 1, CONV_DIM), 1.0)
    d["ffn1_pre_g"] = gain((DEPTH, D_MODEL))
    d["ffn1_post_g"] = gain((DEPTH, D_MODEL))
    d["ffn1_w_gate"] = nrm((DEPTH, D_MODEL, D_FF), D_MODEL ** -0.5)
    d["ffn1_w_up"] = nrm((DEPTH, D_MODEL, D_FF), D_MODEL ** -0.5)
    d["ffn1_w_down"] = nrm((DEPTH, D_FF, D_MODEL), D_FF ** -0.5)
    d["mix_pre_g"] = gain((DEPTH, D_MODEL))
    d["mix_post_g"] = gain((DEPTH, D_MODEL))
    d["w_in"] = nrm((DEPTH, D_MODEL, IN_COLS), D_MODEL ** -0.5)
    d["conv_w"] = nrm((DEPTH, CONV_K, CONV_DIM), CONV_K ** -0.5)
    d["v_norm_g"] = gain((DEPTH, HEADS_B, HEAD_DIM_B))
    d["w_s"] = nrm((DEPTH, HEADS_B, CHUNK, CHUNK), CHUNK ** -0.5)
    d["b_s"] = 1.0 + nrm((DEPTH, HEADS_B, CHUNK), 0.1)
    d["out_g_a"] = gain((DEPTH, CONV_DIM))
    d["out_g_b"] = gain((DEPTH, CHUNK_DIM))
    d["w_out"] = nrm((DEPTH, MIX_WIDTH, D_MODEL), MIX_WIDTH ** -0.5)
    d["ffn2_pre_g"] = gain((DEPTH, D_MODEL))
    d["ffn2_post_g"] = gain((DEPTH, D_MODEL))
    d["ffn2_w_gate"] = nrm((DEPTH, D_MODEL, D_FF), D_MODEL ** -0.5)
    d["ffn2_w_up"] = nrm((DEPTH, D_MODEL, D_FF), D_MODEL ** -0.5)
    d["ffn2_w_down"] = nrm((DEPTH, D_FF, D_MODEL), D_FF ** -0.5)
    d["ple_w_gate"] = nrm((DEPTH, D_MODEL, D_MODEL), D_MODEL ** -0.5)
    d["ple_w_proj"] = nrm((DEPTH, PLE_DIM, D_MODEL), PLE_DIM ** -0.5)
    d["ple_post_g"] = gain((DEPTH, D_MODEL))
    return d


def reference(x_prompt, x_sample, p_prompt, p_sample, state_conv,
              ffn1_pre_g, ffn1_post_g, ffn1_w_gate, ffn1_w_up, ffn1_w_down,
              mix_pre_g, mix_post_g, w_in, conv_w, v_norm_g, w_s, b_s, out_g_a, out_g_b, w_out,
              ffn2_pre_g, ffn2_post_g, ffn2_w_gate, ffn2_w_up, ffn2_w_down,
              ple_w_gate, ple_w_proj, ple_post_g):
    hp, hs = x_prompt, x_sample
    conv_p_list, conv_s_list, vp_list, vs_list = [], [], [], []
    for i in range(DEPTH):
        w = (ffn1_pre_g[i], ffn1_post_g[i], ffn1_w_gate[i], ffn1_w_up[i], ffn1_w_down[i],
             mix_pre_g[i], mix_post_g[i], w_in[i], conv_w[i], v_norm_g[i], w_s[i], b_s[i],
             out_g_a[i], out_g_b[i], w_out[i],
             ffn2_pre_g[i], ffn2_post_g[i], ffn2_w_gate[i], ffn2_w_up[i], ffn2_w_down[i],
             ple_w_gate[i], ple_w_proj[i], ple_post_g[i])
        zeros_prev = jnp.zeros((hp.shape[0], CONV_K - 1, CONV_DIM), hp.dtype)
        hp, conv_p, v_p = layer(hp, p_prompt[i], zeros_prev, *w)
        hs, conv_s, v_s = layer(hs, p_sample[i], state_conv[i].astype(hs.dtype), *w)
        conv_p_list.append(conv_p)
        conv_s_list.append(conv_s)
        vp_list.append(v_p)
        vs_list.append(v_s)
    new_conv_prompt = jnp.stack(conv_p_list)
    new_conv_sample = jnp.stack(conv_s_list)
    chunk_v_prompt = jnp.stack(vp_list)
    chunk_v_sample = jnp.stack(vs_list)
    return (hp, hs, new_conv_prompt, new_conv_sample, chunk_v_prompt, chunk_v_sample)
```

```cpp
#include <hip/hip_runtime.h>
#include <hip/hip_cooperative_groups.h>
#include <cstdio>
#include <cstdint>
namespace cg = cooperative_groups;
namespace pg8 {
#define PG8_LAS __attribute__((address_space(3)))
typedef unsigned short bf16_t;
typedef short bf16x8 __attribute__((ext_vector_type(8)));
typedef float f32x4 __attribute__((ext_vector_type(4)));
typedef unsigned u32x4 __attribute__((ext_vector_type(4)));
constexpr int BM = 256, BK = 64, HALF = 128, HTB = HALF * BK * 2  , STAGE_BYTES = 8 * HTB, NXCD = 8, WGM = 8;

__host__ __device__ __forceinline__ int lds_byte(int r, int c) { const int st = (r >> 4) * 2 + (c >> 5), rr = r & 15, cc = c & 31, ob = rr * 64 + cc * 2; return st * 1024 + (ob ^ (((ob >> 9) & 1) << 5)); }
__host__ __device__ __forceinline__ void stage_rc(int b, int& R, int& C) { const int st = b / 1024, sb = b % 1024, swz = sb ^ (((sb >> 9) & 1) << 5); R = (st >> 1) * 16 + swz / 64; C = (st & 1) * 32 + (swz % 64) / 2; }
__host__ __device__ __forceinline__ int perm32(int rho) { const int n = rho >> 4, i = rho & 15; return 8 * (i >> 2) + 4 * n + (i & 3); }

struct Unit { int pm, pn; };
struct Gemm { const bf16_t* A; const bf16_t* Bt; int M, N, K; };

struct StaticOrder {
    int nM, nN, nwg, G, c;
    __host__ __device__ void init(int M, int N, int G_, int c_) { nM = M / BM; nN = N / BM; nwg = nM * nN; G = G_; c = c_; }
    __host__ __device__ bool next(int i, Unit& u) const {
        const long L = (long)i * G + c; if (L >= nwg) return false;
        int wgid = (int)L; { const int q = nwg / NXCD, r = nwg % NXCD, xcd = wgid % NXCD, off = wgid / NXCD; wgid = (xcd < r ? xcd * (q + 1) : r * (q + 1) + (xcd - r) * q) + off; }
        const int nig = WGM * nN, gid = wgid / nig, fm = gid * WGM, gsz = (nM - fm) < WGM ? (nM - fm) : WGM;
        u.pm = fm + ((wgid % nig) % gsz); u.pn = (wgid % nig) / gsz; return true;
    }
    __device__ __forceinline__ void a_ready(const Unit&) const {}
    __device__ __forceinline__ void done(const Unit&) const {}
};
typedef unsigned u32x2 __attribute__((ext_vector_type(2)));

__device__ __forceinline__ unsigned cvt_pk_bf16(float lo, float hi) { unsigned r; asm("v_cvt_pk_bf16_f32 %0, %1, %2" : "=v"(r) : "v"(lo), "v"(hi)); return r; }
__device__ __forceinline__ float sigmoid_f(float x) { return __builtin_amdgcn_rcpf(1.0f + __builtin_amdgcn_exp2f(x * -1.44269504089f)); }

struct EpiF32 {
    static constexpr bool PERM = false, AFTER_DRAIN = false;
    float* C; int ldc;
    __device__ __forceinline__ void operator()(const f32x4 (&acc)[2][2][4][2], const Unit& u, int wr, int wc, int fr, int fq) const {
        const int row0 = u.pm * BM + wr * 64 + fr, col0 = u.pn * BM + wc * 32 + 4 * fq;
#pragma unroll
        for (int ai = 0; ai < 2; ++ai)
#pragma unroll
            for (int m = 0; m < 4; ++m) { float* rowp = C + (size_t)(row0 + ai * HALF + m * 16) * ldc + col0;
#pragma unroll
                for (int bj = 0; bj < 2; ++bj)
#pragma unroll
                    for (int n = 0; n < 2; ++n) *(f32x4*)(rowp + bj * HALF + n * 16) = acc[ai][bj][m][n]; }
    }
};
struct EpiPle {
    static constexpr bool PERM = false, AFTER_DRAIN = false;
    float* C; const float* P; int ldc;
    __device__ __forceinline__ void operator()(const f32x4 (&acc)[2][2][4][2], const Unit& u, int wr, int wc, int fr, int fq) const {
        const int row0 = u.pm * BM + wr * 64 + fr, col0 = u.pn * BM + wc * 32 + 4 * fq;
#pragma unroll
        for (int ai = 0; ai < 2; ++ai)
#pragma unroll
            for (int m = 0; m < 4; ++m) { const size_t off = (size_t)(row0 + ai * HALF + m * 16) * ldc + col0;
#pragma unroll
                for (int bj = 0; bj < 2; ++bj)
#pragma unroll
                    for (int n = 0; n < 2; ++n) { const f32x4 p = *(const f32x4*)(P + off + bj * HALF + n * 16); const f32x4 a = acc[ai][bj][m][n];
                        f32x4 o; o.x = sigmoid_f(a.x) * p.x; o.y = sigmoid_f(a.y) * p.y; o.z = sigmoid_f(a.z) * p.z; o.w = sigmoid_f(a.w) * p.w;
                        *(f32x4*)(C + off + bj * HALF + n * 16) = o; } }
    }
};
struct EpiBf16 {
    static constexpr bool PERM = true, AFTER_DRAIN = false;
    bf16_t* O; int ldc;
    __device__ __forceinline__ void operator()(const f32x4 (&acc)[2][2][4][2], const Unit& u, int wr, int wc, int fr, int fq) const {
        const int row0 = u.pm * BM + wr * 64 + fr, col0 = u.pn * BM + wc * 32 + 8 * fq;
#pragma unroll
        for (int ai = 0; ai < 2; ++ai)
#pragma unroll
            for (int m = 0; m < 4; ++m) { bf16_t* rowp = O + (size_t)(row0 + ai * HALF + m * 16) * ldc + col0;
#pragma unroll
                for (int bj = 0; bj < 2; ++bj) { const f32x4 v0 = acc[ai][bj][m][0], v1 = acc[ai][bj][m][1];
                    u32x4 w; w.x = cvt_pk_bf16(v0[0], v0[1]); w.y = cvt_pk_bf16(v0[2], v0[3]); w.z = cvt_pk_bf16(v1[0], v1[1]); w.w = cvt_pk_bf16(v1[2], v1[3]);
                    *(u32x4*)(rowp + bj * HALF) = w; } }
    }
};
struct EpiSwiglu {
    static constexpr bool PERM = true, AFTER_DRAIN = false;
    bf16_t* O; int ldc;
    __device__ __forceinline__ void operator()(const f32x4 (&acc)[2][2][4][2], const Unit& u, int wr, int wc, int fr, int fq) const {
        const int row0 = u.pm * BM + wr * 64 + fr, col0 = u.pn * HALF + wc * 32 + 8 * fq;
#pragma unroll
        for (int ai = 0; ai < 2; ++ai)
#pragma unroll
            for (int m = 0; m < 4; ++m) { bf16_t* rowp = O + (size_t)(row0 + ai * HALF + m * 16) * ldc + col0;
                const f32x4 g0 = acc[ai][0][m][0], g1 = acc[ai][0][m][1], u0 = acc[ai][1][m][0], u1 = acc[ai][1][m][1];
                f32x4 v0, v1;
#pragma unroll
                for (int j = 0; j < 4; ++j) { v0[j] = g0[j] * sigmoid_f(g0[j]) * u0[j]; v1[j] = g1[j] * sigmoid_f(g1[j]) * u1[j]; }
                u32x4 w; w.x = cvt_pk_bf16(v0[0], v0[1]); w.y = cvt_pk_bf16(v0[2], v0[3]); w.z = cvt_pk_bf16(v1[0], v1[1]); w.w = cvt_pk_bf16(v1[2], v1[3]);
                *(u32x4*)rowp = w; }
    }
};

template <class Epi, class Sched, bool ALIGN_EPI = false, bool SP2 = false>
__device__ __forceinline__ void gemm_phase(PG8_LAS unsigned char* lds, const Gemm g, const Sched& S, const Epi& E) {
    const int tid = threadIdx.x, wid = __builtin_amdgcn_readfirstlane(tid >> 6), lane = tid & 63, wr = wid >> 2, wc = wid & 3, fr = lane & 15, fq = lane >> 4;
    const int K = g.K, nt = K / BK;
    unsigned voffA[2], voffB[2];
#pragma unroll
    for (int i = 0; i < 2; ++i) { int R, C; stage_rc(tid * 16 + i * 8192, R, C); const int Rb = Epi::PERM ? ((R & ~31) + perm32(R & 31)) : R;
        voffA[i] = (unsigned)(R * K + C) * 2u; voffB[i] = (unsigned)(Rb * K + C) * 2u; }
    const size_t kstep = (size_t)(BK * 2);
    const size_t hstep = (size_t)HALF * K * 2;
    const size_t tstep = 2 * hstep;
    const unsigned ldsw = (unsigned)wid * 1024u;
    const int aoff = lds_byte(wr * 64 + fr, fq * 8), boff = lds_byte(wc * 32 + fr, fq * 8);
#define PG8_SA(b, h) (((b) * 2 + (h)) * HTB)
#define PG8_SB(b, h) ((4 + (b) * 2 + (h)) * HTB)
#define PG8_STAGE(bufoff, gbase, voff) do { _Pragma("unroll") for (int _i = 0; _i < 2; ++_i) \
        __builtin_amdgcn_global_load_lds((const unsigned*)((const char*)(gbase) + (voff)[_i]), (PG8_LAS unsigned*)(lds + (bufoff) + ldsw + _i * 8192), 16, 0, 0); } while (0)
#define PG8_LDA(dst, b, h) do { _Pragma("unroll") for (int m = 0; m < 4; ++m) _Pragma("unroll") for (int k = 0; k < 2; ++k) dst[m][k] = *(const PG8_LAS bf16x8*)(lds + PG8_SA(b, h) + aoff + m * 2048 + k * 1024); } while (0)
#define PG8_LDB(dst, b, h) do { _Pragma("unroll") for (int n = 0; n < 2; ++n) _Pragma("unroll") for (int k = 0; k < 2; ++k) dst[n][k] = *(const PG8_LAS bf16x8*)(lds + PG8_SB(b, h) + boff + n * 2048 + k * 1024); } while (0)
#define PG8_MMA(ai, bj, At, Bt) do { __builtin_amdgcn_s_setprio(1); _Pragma("unroll") for (int m = 0; m < 4; ++m) _Pragma("unroll") for (int n = 0; n < 2; ++n) _Pragma("unroll") for (int k = 0; k < 2; ++k) \
        acc[ai][bj][m][n] = __builtin_amdgcn_mfma_f32_16x16x32_bf16(Bt[n][k], At[m][k], acc[ai][bj][m][n], 0, 0, 0); __builtin_amdgcn_s_setprio(0); } while (0)
#define PG8_WAIT_V(n) asm volatile("s_waitcnt vmcnt(" #n ")" ::: "memory")
#define PG8_WAIT_L(n) asm volatile("s_waitcnt lgkmcnt(" #n ")" ::: "memory")
#define PG8_BAR __builtin_amdgcn_s_barrier()
#define PG8_SCHED __builtin_amdgcn_sched_barrier(0)
    Unit cur, nxt; int ui = 0;
    if (!S.next(0, cur)) return;
    f32x4 acc[2][2][4][2];
#pragma unroll
    for (int a = 0; a < 2; ++a)
#pragma unroll
        for (int b = 0; b < 2; ++b)
#pragma unroll
            for (int m = 0; m < 4; ++m)
#pragma unroll
                for (int n = 0; n < 2; ++n) acc[a][b][m][n] = (f32x4){0.f, 0.f, 0.f, 0.f};
    bf16x8 At[4][2], B0[2][2], B1[2][2];
    const char* cA = (const char*)g.A + (size_t)cur.pm * tstep; const char* cB = (const char*)g.Bt + (size_t)cur.pn * tstep;
    S.a_ready(cur);
    if constexpr (SP2) {
        PG8_STAGE(PG8_SB(0, 0), cB, voffB); PG8_STAGE(PG8_SB(0, 1), cB + hstep, voffB); PG8_STAGE(PG8_SA(0, 0), cA, voffA); PG8_STAGE(PG8_SA(0, 1), cA + hstep, voffA);
        if (wr == 1) PG8_BAR;
        PG8_WAIT_V(2); PG8_BAR;
        PG8_STAGE(PG8_SB(1, 0), cB + kstep, voffB); PG8_STAGE(PG8_SA(1, 0), cA + kstep, voffA); PG8_STAGE(PG8_SB(1, 1), cB + hstep + kstep, voffB);
        PG8_WAIT_V(6); PG8_BAR;
    } else {
        PG8_STAGE(PG8_SB(0, 0), cB, voffB); PG8_STAGE(PG8_SA(0, 0), cA, voffA); PG8_STAGE(PG8_SB(0, 1), cB + hstep, voffB); PG8_STAGE(PG8_SA(0, 1), cA + hstep, voffA);
        if (wr == 1) PG8_BAR;
        PG8_WAIT_V(4); PG8_BAR;
        PG8_STAGE(PG8_SB(1, 0), cB + kstep, voffB); PG8_STAGE(PG8_SA(1, 0), cA + kstep, voffA); PG8_STAGE(PG8_SB(1, 1), cB + hstep + kstep, voffB);
        PG8_WAIT_V(6); PG8_BAR;
    }
    for (;;) {
        const bool has_next = S.next(ui + 1, nxt);
        const char* nA = has_next ? (const char*)g.A + (size_t)nxt.pm * tstep : cA; const char* nB = has_next ? (const char*)g.Bt + (size_t)nxt.pn * tstep : cB;
        for (int t = 0; t < nt; t += 2) {
            const bool last = (t == nt - 2);
            const char* a1 = cA + (size_t)(t + 1) * kstep;
            const char* a2 = last ? nA : cA + (size_t)(t + 2) * kstep; const char* b2 = last ? nB : cB + (size_t)(t + 2) * kstep;
            const char* a3 = a2 + kstep; const char* b3 = b2 + kstep;
            if (last && has_next) S.a_ready(nxt);
            if constexpr (SP2) {
            PG8_LDB(B0, 0, 0); PG8_LDB(B1, 0, 1); PG8_SCHED; PG8_LDA(At, 0, 0); PG8_STAGE(PG8_SA(1, 1), a1 + hstep, voffA);
            PG8_WAIT_V(8); PG8_WAIT_L(0); PG8_BAR; PG8_MMA(0, 0, At, B0); PG8_MMA(0, 1, At, B1); PG8_BAR; PG8_SCHED;
            PG8_LDA(At, 0, 1); PG8_STAGE(PG8_SB(0, 0), b2, voffB); PG8_STAGE(PG8_SB(0, 1), b2 + hstep, voffB); PG8_STAGE(PG8_SA(0, 0), a2, voffA);
            PG8_WAIT_V(8); PG8_WAIT_L(0); PG8_BAR; PG8_MMA(1, 0, At, B0); PG8_MMA(1, 1, At, B1); PG8_BAR; PG8_SCHED;
            PG8_LDB(B0, 1, 0); PG8_LDB(B1, 1, 1); PG8_SCHED; PG8_LDA(At, 1, 0); PG8_STAGE(PG8_SA(0, 1), a2 + hstep, voffA);
            PG8_WAIT_V(8); PG8_WAIT_L(0); PG8_BAR; PG8_MMA(0, 0, At, B0); PG8_MMA(0, 1, At, B1); PG8_BAR; PG8_SCHED;
            PG8_LDA(At, 1, 1); PG8_STAGE(PG8_SB(1, 0), b3, voffB); PG8_STAGE(PG8_SB(1, 1), b3 + hstep, voffB); PG8_STAGE(PG8_SA(1, 0), a3, voffA);
            PG8_WAIT_V(8); PG8_WAIT_L(0); PG8_BAR; PG8_MMA(1, 0, At, B0); PG8_MMA(1, 1, At, B1); PG8_BAR; PG8_SCHED;
            } else {
            PG8_LDB(B0, 0, 0); PG8_SCHED; PG8_LDA(At, 0, 0); PG8_STAGE(PG8_SA(1, 1), a1 + hstep, voffA);
            PG8_WAIT_L(8); PG8_BAR; PG8_WAIT_L(0); PG8_MMA(0, 0, At, B0); PG8_BAR; PG8_SCHED;
            PG8_LDB(B1, 0, 1); PG8_STAGE(PG8_SB(0, 0), b2, voffB);
            PG8_BAR; PG8_WAIT_L(0); PG8_MMA(0, 1, At, B1); PG8_BAR;
            PG8_LDA(At, 0, 1); PG8_STAGE(PG8_SA(0, 0), a2, voffA);
            PG8_BAR; PG8_WAIT_L(0); PG8_MMA(1, 0, At, B0); PG8_BAR; PG8_SCHED;
            PG8_STAGE(PG8_SB(0, 1), b2 + hstep, voffB);
            PG8_WAIT_V(6); PG8_BAR; PG8_MMA(1, 1, At, B1); PG8_BAR;
            PG8_LDB(B0, 1, 0); PG8_SCHED; PG8_LDA(At, 1, 0); PG8_STAGE(PG8_SA(0, 1), a2 + hstep, voffA);
            PG8_WAIT_L(8); PG8_BAR; PG8_WAIT_L(0); PG8_MMA(0, 0, At, B0); PG8_BAR; PG8_SCHED;
            PG8_LDB(B1, 1, 1); PG8_STAGE(PG8_SB(1, 0), b3, voffB);
            PG8_BAR; PG8_WAIT_L(0); PG8_MMA(0, 1, At, B1); PG8_BAR;
            PG8_LDA(At, 1, 1); PG8_STAGE(PG8_SA(1, 0), a3, voffA);
            PG8_BAR; PG8_WAIT_L(0); PG8_MMA(1, 0, At, B0); PG8_BAR; PG8_SCHED;
            PG8_STAGE(PG8_SB(1, 1), b3 + hstep, voffB);
            PG8_WAIT_V(6); PG8_BAR; PG8_MMA(1, 1, At, B1); PG8_BAR;
            }
        }
        if constexpr (ALIGN_EPI) { if (wr == 0) PG8_BAR; }
        if constexpr (!Epi::AFTER_DRAIN) { E(acc, cur, wr, wc, fr, fq); S.done(cur); }
        if (!has_next) break;
#pragma unroll
        for (int a = 0; a < 2; ++a)
#pragma unroll
            for (int b = 0; b < 2; ++b)
#pragma unroll
                for (int m = 0; m < 4; ++m)
#pragma unroll
                    for (int n = 0; n < 2; ++n) acc[a][b][m][n] = (f32x4){0.f, 0.f, 0.f, 0.f};
        cur = nxt; cA = nA; cB = nB; ++ui;
        if constexpr (ALIGN_EPI) { if (wr == 1) PG8_BAR; }
    }
    PG8_WAIT_V(0);
    if constexpr (!ALIGN_EPI) { if (wr == 0) PG8_BAR; }
    PG8_BAR;
    if constexpr (Epi::AFTER_DRAIN) { E.fused(acc, cur, wr, wc, fr, fq, lds, wid, lane); S.done(cur); }
#undef PG8_SA
#undef PG8_SB
#undef PG8_STAGE
#undef PG8_LDA
#undef PG8_LDB
#undef PG8_MMA
#undef PG8_WAIT_V
#undef PG8_WAIT_L
#undef PG8_BAR
#undef PG8_SCHED
}
}

using pg8::bf16_t; using pg8::bf16x8; using pg8::f32x4; using pg8::u32x4; using pg8::u32x2; using pg8::cvt_pk_bf16;
#define LAS __attribute__((address_space(3)))
#ifndef MK_COOP
#define MK_COOP 1
#endif
constexpr int M_ = 17408, MP_ = 16384, DM = 1024, FF = 2816, NGU = 5632, NIN = 2560, PLE = 256;
constexpr float EPS_ = 1e-6f;
constexpr int LDS_BYTES = 147456;
constexpr int NPHASE = 14;
constexpr size_t WS_WGU1 = 0;
constexpr size_t WS_WD1 = WS_WGU1 + (size_t)NGU * DM * 2;
constexpr size_t WS_WIN = WS_WD1 + (size_t)DM * FF * 2;
constexpr size_t WS_WOUT = WS_WIN + (size_t)NIN * DM * 2;
constexpr size_t WS_WGU2 = WS_WOUT + (size_t)DM * DM * 2;
constexpr size_t WS_WD2 = WS_WGU2 + (size_t)NGU * DM * 2;
constexpr size_t WS_WPG = WS_WD2 + (size_t)DM * FF * 2;
constexpr size_t WS_WPP = WS_WPG + (size_t)DM * DM * 2;
constexpr size_t WS_XN = WS_WPP + (size_t)DM * PLE * 2;
constexpr size_t WS_ACT = WS_XN + (size_t)M_ * DM * 2;
constexpr size_t WS_D = WS_ACT + (size_t)M_ * FF * 2;
constexpr size_t WS_END = WS_D + (size_t)M_ * DM * 4;
constexpr size_t WS_PROJ = WS_ACT;
constexpr size_t WS_PP = WS_ACT;
constexpr size_t WS_PB = WS_ACT + (size_t)M_ * DM * 4;
static_assert(WS_PB + (size_t)M_ * PLE * 2 <= WS_D, "aliases fit");
constexpr size_t OUT_NCP = 17825792, OUT_NCS = 17833984, OUT_CVP = 17965056, OUT_CVS = 18489344;

struct Args { const float* in[28]; float* out; unsigned char* ws; int ph_lo, ph_hi; };

__device__ __forceinline__ float wave_sum(float v) {
#pragma unroll
    for (int o = 1; o < 64; o <<= 1) v += __shfl_xor(v, o);
    return v;
}
__device__ __forceinline__ float bf_lo(unsigned w) { return __uint_as_float(w << 16); }
__device__ __forceinline__ float bf_hi(unsigned w) { return __uint_as_float(w & 0xffff0000u); }
__device__ __forceinline__ float dot4(f32x4 a) { return (a.x * a.x + a.y * a.y) + (a.z * a.z + a.w * a.w); }
#define LDS_WAIT() asm volatile("s_waitcnt lgkmcnt(0)" ::: "memory")

__device__ __forceinline__ void transpose_item(const float* __restrict__ W, int K, int N, bf16_t* __restrict__ WT, int k0, int n0, int drow0, LAS float* scr, int lane) {
#pragma unroll 8
    for (int i = 0; i < 32; ++i) { const int kk = 2 * i + (lane >> 5); scr[kk * 33 + (lane & 31)] = W[(size_t)(k0 + kk) * N + n0 + (lane & 31)]; }
    LDS_WAIT();
    const int c = lane & 7;
#pragma unroll
    for (int j = 0; j < 4; ++j) { const int n = (lane >> 3) + 8 * j; const LAS float* s = scr + (8 * c) * 33 + n;
        u32x4 o; o.x = cvt_pk_bf16(s[0 * 33], s[1 * 33]); o.y = cvt_pk_bf16(s[2 * 33], s[3 * 33]); o.z = cvt_pk_bf16(s[4 * 33], s[5 * 33]); o.w = cvt_pk_bf16(s[6 * 33], s[7 * 33]);
        *(u32x4*)(WT + (size_t)(drow0 + n) * K + k0 + 8 * c) = o; }
    LDS_WAIT();
}

template <int MODE>
__device__ __forceinline__ void rowpass(const float* __restrict__ dbuf, const float* resP, const float* resS, float* hout, bf16_t* __restrict__ xn,
                                        const float* __restrict__ gpost, float sc, const float* __restrict__ gnext, int gw, int NGW, int lane) {
    f32x4 gp[4], gn[4];
#pragma unroll
    for (int j = 0; j < 4; ++j) { gp[j] = (MODE & 1) ? ((const f32x4*)gpost)[lane + 64 * j] : (f32x4){0.f, 0.f, 0.f, 0.f}; gn[j] = (MODE & 4) ? ((const f32x4*)gnext)[lane + 64 * j] : (f32x4){0.f, 0.f, 0.f, 0.f}; }
    for (int m = gw; m < M_; m += NGW) {
        const float* rrow = (m < MP_) ? resP + (size_t)m * DM : resS + (size_t)(m - MP_) * DM;
        f32x4 h[4];
#pragma unroll
        for (int j = 0; j < 4; ++j) h[j] = ((const f32x4*)rrow)[lane + 64 * j];
        if (MODE & 1) {
            const f32x4* dr = (const f32x4*)(dbuf + (size_t)m * DM) + lane;
            f32x4 d[4]; float ss = 0.f;
#pragma unroll
            for (int j = 0; j < 4; ++j) { d[j] = dr[64 * j]; ss += dot4(d[j]); }
            const float rs = sc * rsqrtf(wave_sum(ss) * (1.0f / DM) + EPS_);
#pragma unroll
            for (int j = 0; j < 4; ++j) h[j] += d[j] * rs * gp[j];
        }
        if (MODE & 2) { f32x4* ho = (f32x4*)(hout + (size_t)m * DM) + lane;
#pragma unroll
            for (int j = 0; j < 4; ++j) ho[64 * j] = h[j]; }
        if (MODE & 4) {
            float s2 = 0.f;
#pragma unroll
            for (int j = 0; j < 4; ++j) s2 += dot4(h[j]);
            const float rs2 = rsqrtf(wave_sum(s2) * (1.0f / DM) + EPS_);
            u32x2* o = (u32x2*)(xn + (size_t)m * DM) + lane;
#pragma unroll
            for (int j = 0; j < 4; ++j) { const f32x4 v = h[j] * rs2 * gn[j]; u32x2 w; w.x = cvt_pk_bf16(v.x, v.y); w.y = cvt_pk_bf16(v.z, v.w); o[64 * j] = w; }
        } else if (MODE & 8) {
            u32x2* o = (u32x2*)(xn + (size_t)m * DM) + lane;
#pragma unroll
            for (int j = 0; j < 4; ++j) { const f32x4 v = h[j]; u32x2 w; w.x = cvt_pk_bf16(v.x, v.y); w.y = cvt_pk_bf16(v.z, v.w); o[64 * j] = w; }
        }
    }
}

__device__ __forceinline__ f32x4 bf4(unsigned a, unsigned b) { return (f32x4){bf_lo(a), bf_hi(a), bf_lo(b), bf_hi(b)}; }

__device__ __forceinline__ void mixer_phase(const Args& a, LAS unsigned char* lds, const bf16_t* __restrict__ PROJ, bf16_t* __restrict__ YC, int wave, int lane) {
    constexpr int VP = 272;
    LAS float* part = (LAS float*)(lds + 512 * VP);
    const int fr = lane & 15, fq = lane >> 4;
    const float* __restrict__ wsm = a.in[15]; const float* __restrict__ bsm = a.in[16];
    float* out = a.out;
    for (int u = blockIdx.x; u < 272; u += gridDim.x) {
        const bool samp = (u >= 256);
        const int R0 = u * 64;
        int s0 = 0, t0 = 0;
        if (!samp) { s0 = (u & 31) * 64; t0 = s0 & 127; }
        const int CB = R0 - t0, kext = t0 + 64;
        {
            const f32x4 vg0 = *(const f32x4*)(a.in[14] + lane * 8), vg1 = *(const f32x4*)(a.in[14] + lane * 8 + 4);
            for (int s = wave; s < kext; s += 8) {
                const int row = CB + s;
                const u32x4 raw = *(const u32x4*)(PROJ + (size_t)row * NIN + 2048 + lane * 8);
                f32x4 v0 = bf4(raw.x, raw.y), v1 = bf4(raw.z, raw.w);
                float ss = dot4(v0) + dot4(v1);
                ss += __shfl_xor(ss, 1); ss += __shfl_xor(ss, 2); ss += __shfl_xor(ss, 4);
                const float rs = rsqrtf(ss * (1.0f / 64.0f) + EPS_);
                v0 = v0 * rs * vg0; v1 = v1 * rs * vg1;
                LAS bf16_t* dst = (LAS bf16_t*)(lds + (lane * 8) * VP + s * 2);
                const unsigned p0 = cvt_pk_bf16(v0.x, v0.y), p1 = cvt_pk_bf16(v0.z, v0.w), p2 = cvt_pk_bf16(v1.x, v1.y), p3 = cvt_pk_bf16(v1.z, v1.w);
                dst[0 * (VP / 2)] = (bf16_t)(p0 & 0xffffu); dst[1 * (VP / 2)] = (bf16_t)(p0 >> 16);
                dst[2 * (VP / 2)] = (bf16_t)(p1 & 0xffffu); dst[3 * (VP / 2)] = (bf16_t)(p1 >> 16);
                dst[4 * (VP / 2)] = (bf16_t)(p2 & 0xffffu); dst[5 * (VP / 2)] = (bf16_t)(p2 >> 16);
                dst[6 * (VP / 2)] = (bf16_t)(p3 & 0xffffu); dst[7 * (VP / 2)] = (bf16_t)(p3 >> 16);
                if (s >= t0) {
                    if (samp) { float* o = out + OUT_CVS + (size_t)(row - MP_) * 512 + lane * 8; *(f32x4*)o = v0; *(f32x4*)(o + 4) = v1; }
                    else if (s0 - t0 == 1920) { float* o = out + OUT_CVP + (size_t)((u >> 5) * 128 + s) * 512 + lane * 8; *(f32x4*)o = v0; *(f32x4*)(o + 4) = v1; }
                }
            }
        }
        __syncthreads();
        const int h = wave;
        f32x4 acc[4][4];
#pragma unroll
        for (int i = 0; i < 4; ++i)
#pragma unroll
            for (int j = 0; j < 4; ++j) acc[i][j] = (f32x4){0.f, 0.f, 0.f, 0.f};
        const int nkb = kext >> 5;
        for (int kb = 0; kb < nkb; ++kb) {
            bf16x8 af[4];
#pragma unroll
            for (int tb = 0; tb < 4; ++tb) {
                f32x4 w0, w1; int lim;
                if (!samp) { const int tt = t0 + tb * 16 + fr, sb = kb * 32 + fq * 8; const float* wp = wsm + (size_t)(h * 128 + tt) * 128 + sb;
                    w0 = *(const f32x4*)wp; w1 = *(const f32x4*)(wp + 4); lim = tt - sb; }
                else { const int tt = fr & 7; const float* wp = wsm + (size_t)(h * 128 + tt) * 128;
                    w0 = *(const f32x4*)wp; w1 = *(const f32x4*)(wp + 4); lim = ((kb * 4 + fq) == (tb * 2 + (fr >> 3))) ? tt : -1; }
                w0.x = (0 <= lim) ? w0.x : 0.f; w0.y = (1 <= lim) ? w0.y : 0.f; w0.z = (2 <= lim) ? w0.z : 0.f; w0.w = (3 <= lim) ? w0.w : 0.f;
                w1.x = (4 <= lim) ? w1.x : 0.f; w1.y = (5 <= lim) ? w1.y : 0.f; w1.z = (6 <= lim) ? w1.z : 0.f; w1.w = (7 <= lim) ? w1.w : 0.f;
                u32x4 pk; pk.x = cvt_pk_bf16(w0.x, w0.y); pk.y = cvt_pk_bf16(w0.z, w0.w); pk.z = cvt_pk_bf16(w1.x, w1.y); pk.w = cvt_pk_bf16(w1.z, w1.w);
                af[tb] = __builtin_bit_cast(bf16x8, pk);
            }
#pragma unroll
            for (int db = 0; db < 4; ++db) {
                const bf16x8 bfv = *(const LAS bf16x8*)(lds + (h * 64 + db * 16 + fr) * VP + (kb * 32 + fq * 8) * 2);
#pragma unroll
                for (int tb = 0; tb < 4; ++tb) acc[tb][db] = __builtin_amdgcn_mfma_f32_16x16x32_bf16(bfv, af[tb], acc[tb][db], 0, 0, 0);
            }
        }
#pragma unroll
        for (int tb = 0; tb < 4; ++tb) {
            const int t = tb * 16 + fr; const int tt = samp ? (fr & 7) : (t0 + t); const float bias = bsm[h * 128 + tt];
            const bf16_t* up = PROJ + (size_t)(R0 + t) * NIN + 1536 + h * 64 + fq * 4;
            float s = 0.f;
#pragma unroll
            for (int db = 0; db < 4; ++db) { const u32x2 ur = *(const u32x2*)(up + db * 16); const f32x4 uu = bf4(ur.x, ur.y);
                const f32x4 y = uu * (acc[tb][db] + bias); acc[tb][db] = y; s += dot4(y); }
            s += __shfl_xor(s, 16); s += __shfl_xor(s, 32);
            if (fq == 0) part[h * 64 + t] = s;
        }
        __syncthreads();
#pragma unroll
        for (int tb = 0; tb < 4; ++tb) {
            const int t = tb * 16 + fr; float tot = 0.f;
#pragma unroll
            for (int hh = 0; hh < 8; ++hh) tot += part[hh * 64 + t];
            const float rs = rsqrtf(tot * (1.0f / 512.0f) + EPS_);
            bf16_t* yp = YC + (size_t)(R0 + t) * DM + 512 + h * 64 + fq * 4;
#pragma unroll
            for (int db = 0; db < 4; ++db) { const f32x4 gb = *(const f32x4*)(a.in[18] + h * 64 + db * 16 + fq * 4); const f32x4 y = acc[tb][db] * rs * gb;
                u32x2 w; w.x = cvt_pk_bf16(y.x, y.y); w.y = cvt_pk_bf16(y.z, y.w); *(u32x2*)(yp + db * 16) = w; }
        }
        {
            const int c0 = lane * 8; const float* cw = a.in[13];
            const f32x4 w0a = *(const f32x4*)(cw + c0), w0b = *(const f32x4*)(cw + c0 + 4), w1a = *(const f32x4*)(cw + 512 + c0), w1b = *(const f32x4*)(cw + 512 + c0 + 4),
                        w2a = *(const f32x4*)(cw + 1024 + c0), w2b = *(const f32x4*)(cw + 1024 + c0 + 4);
            const f32x4 gaa = *(const f32x4*)(a.in[17] + c0), gab = *(const f32x4*)(a.in[17] + c0 + 4);
            f32x4 zp2a = {0.f, 0.f, 0.f, 0.f}, zp2b = zp2a, zp1a = zp2a, zp1b = zp2a;
            const int rb = R0 + wave * 8; const int sb_ = (u - 256) * 8 + wave;
            if (samp) { const float* st = a.in[4] + (size_t)sb_ * 1024 + c0; zp2a = *(const f32x4*)st; zp2b = *(const f32x4*)(st + 4); zp1a = *(const f32x4*)(st + 512); zp1b = *(const f32x4*)(st + 516); }
            else if (s0 + wave * 8 > 0) {
                const bf16_t* p2 = PROJ + (size_t)(rb - 2) * NIN + c0; const bf16_t* p1 = p2 + NIN;
                const u32x4 c2 = *(const u32x4*)(p2 + 512), h2 = *(const u32x4*)(p2 + 1024), c1 = *(const u32x4*)(p1 + 512), h1 = *(const u32x4*)(p1 + 1024);
                zp2a = bf4(c2.x, c2.y) * bf4(h2.x, h2.y); zp2b = bf4(c2.z, c2.w) * bf4(h2.z, h2.w); zp1a = bf4(c1.x, c1.y) * bf4(h1.x, h1.y); zp1b = bf4(c1.z, c1.w) * bf4(h1.z, h1.w);
            }
            f32x4 ya[8], yb[8]; float ss[8];
#pragma unroll
            for (int i = 0; i < 8; ++i) {
                const bf16_t* pr = PROJ + (size_t)(rb + i) * NIN + c0;
                const u32x4 braw = *(const u32x4*)pr, craw = *(const u32x4*)(pr + 512), hraw = *(const u32x4*)(pr + 1024);
                const f32x4 za = bf4(craw.x, craw.y) * bf4(hraw.x, hraw.y), zb = bf4(craw.z, craw.w) * bf4(hraw.z, hraw.w);
                const f32x4 ca = w0a * zp2a + w1a * zp1a + w2a * za, cb = w0b * zp2b + w1b * zp1b + w2b * zb;
                ya[i] = bf4(braw.x, braw.y) * ca; yb[i] = bf4(braw.z, braw.w) * cb;
                ss[i] = wave_sum(dot4(ya[i]) + dot4(yb[i]));
                if (i >= 6) {
                    if (samp) { float* o = out + OUT_NCS + ((size_t)sb_ * 2 + (i - 6)) * 512 + c0; *(f32x4*)o = za; *(f32x4*)(o + 4) = zb; }
                    else if ((u & 31) == 31 && wave == 7) { float* o = out + OUT_NCP + ((size_t)(u >> 5) * 2 + (i - 6)) * 512 + c0; *(f32x4*)o = za; *(f32x4*)(o + 4) = zb; }
                }
                zp2a = zp1a; zp2b = zp1b; zp1a = za; zp1b = zb;
            }
#pragma unroll
            for (int i = 0; i < 8; ++i) {
                const float rs = rsqrtf(ss[i] * (1.0f / 512.0f) + EPS_);
                const f32x4 y0 = ya[i] * rs * gaa, y1 = yb[i] * rs * gab;
                u32x4 w; w.x = cvt_pk_bf16(y0.x, y0.y); w.y = cvt_pk_bf16(y0.z, y0.w); w.z = cvt_pk_bf16(y1.x, y1.y); w.w = cvt_pk_bf16(y1.z, y1.w);
                *(u32x4*)(YC + (size_t)(rb + i) * DM + c0) = w;
            }
        }
        __syncthreads();
    }
}

template <bool COOP>
__global__ void __launch_bounds__(512, 2) fwd_kernel(Args a) {
    extern __shared__ __attribute__((aligned(16))) unsigned char lds_raw[];
    LAS unsigned char* lds = (LAS unsigned char*)lds_raw;
    const int tid = threadIdx.x, lane = tid & 63, wave = __builtin_amdgcn_readfirstlane(tid >> 6);
    const int G = gridDim.x, gw = blockIdx.x * 8 + wave, NGW = G * 8;
    unsigned char* ws = a.ws;
    bf16_t* WGU1 = (bf16_t*)(ws + WS_WGU1); bf16_t* WD1 = (bf16_t*)(ws + WS_WD1); bf16_t* WIN = (bf16_t*)(ws + WS_WIN); bf16_t* WOUT = (bf16_t*)(ws + WS_WOUT);
    bf16_t* WGU2 = (bf16_t*)(ws + WS_WGU2); bf16_t* WD2 = (bf16_t*)(ws + WS_WD2); bf16_t* WPG = (bf16_t*)(ws + WS_WPG); bf16_t* WPP = (bf16_t*)(ws + WS_WPP);
    bf16_t* XN = (bf16_t*)(ws + WS_XN); bf16_t* ACT = (bf16_t*)(ws + WS_ACT); bf16_t* PROJ = (bf16_t*)(ws + WS_PROJ); bf16_t* PB = (bf16_t*)(ws + WS_PB);
    float* DB = (float*)(ws + WS_D); float* PP = (float*)(ws + WS_PP);
    float* H = a.out;
#define IN(k) (a.ph_lo <= (k) && (k) < a.ph_hi)
#define SEAM(k) do { if (COOP && IN(k) && IN((k) + 1)) cg::this_grid().sync(); } while (0)

    if (IN(0)) {
        LAS float* scr = (LAS float*)(lds + wave * 8448);
        constexpr int I_G = (DM / 64) * (FF / 32), I_D = (FF / 64) * (DM / 32), I_IN = (DM / 64) * (NIN / 32), I_O = (DM / 64) * (DM / 32), I_PP = (PLE / 64) * (DM / 32);
        constexpr int NITEMS = 4 * I_G + 2 * I_D + I_IN + 2 * I_O + I_PP;
        for (int it = gw; it < NITEMS; it += NGW) {
            int r = it; const float* W; int K, N; bf16_t* WT; int mode = 0;
            if (r < I_G) { W = a.in[7]; K = DM; N = FF; WT = WGU1; mode = 1; }
            else if ((r -= I_G) < I_G) { W = a.in[8]; K = DM; N = FF; WT = WGU1; mode = 2; }
            else if ((r -= I_G) < I_G) { W = a.in[22]; K = DM; N = FF; WT = WGU2; mode = 1; }
            else if ((r -= I_G) < I_G) { W = a.in[23]; K = DM; N = FF; WT = WGU2; mode = 2; }
            else if ((r -= I_G) < I_D) { W = a.in[9]; K = FF; N = DM; WT = WD1; }
            else if ((r -= I_D) < I_D) { W = a.in[24]; K = FF; N = DM; WT = WD2; }
            else if ((r -= I_D) < I_IN) { W = a.in[12]; K = DM; N = NIN; WT = WIN; }
            else if ((r -= I_IN) < I_O) { W = a.in[19]; K = DM; N = DM; WT = WOUT; }
            else if ((r -= I_O) < I_O) { W = a.in[25]; K = DM; N = DM; WT = WPG; }
            else { r -= I_O; W = a.in[26]; K = PLE; N = DM; WT = WPP; }
            const int nblk = N / 32, kb = r / nblk, nb = r % nblk, k0 = 64 * kb, n0 = 32 * nb;
            int drow0 = n0; if (mode) drow0 = (n0 >> 7) * 256 + (n0 & 127) + (mode == 2 ? 128 : 0);
            transpose_item(W, K, N, WT, k0, n0, drow0, scr, lane);
        }
        rowpass<4>(nullptr, a.in[0], a.in[1], nullptr, XN, nullptr, 0.f, a.in[5], gw, NGW, lane);
    }
    SEAM(0);
    if (IN(1)) { pg8::Gemm g{XN, WGU1, M_, NGU, DM}; pg8::StaticOrder S; S.init(M_, NGU, G, (int)blockIdx.x); pg8::EpiSwiglu E{ACT, FF};
        pg8::gemm_phase<pg8::EpiSwiglu, pg8::StaticOrder, true, true>(lds, g, S, E); }
    SEAM(1);
    if (IN(2)) { pg8::Gemm g{ACT, WD1, M_, DM, FF}; pg8::StaticOrder S; S.init(M_, DM, G, (int)blockIdx.x); pg8::EpiF32 E{DB, DM};
        pg8::gemm_phase<pg8::EpiF32, pg8::StaticOrder, true, true>(lds, g, S, E); }
    SEAM(2);
    if (IN(3)) rowpass<1 | 2 | 4>(DB, a.in[0], a.in[1], H, XN, a.in[6], 0.5f, a.in[10], gw, NGW, lane);
    SEAM(3);
    if (IN(4)) { pg8::Gemm g{XN, WIN, M_, NIN, DM}; pg8::StaticOrder S; S.init(M_, NIN, G, (int)blockIdx.x); pg8::EpiBf16 E{PROJ, NIN};
        pg8::gemm_phase<pg8::EpiBf16, pg8::StaticOrder, true, true>(lds, g, S, E); }
    SEAM(4);
    if (IN(5)) mixer_phase(a, lds, PROJ, XN, wave, lane);
    SEAM(5);
    if (IN(6)) { pg8::Gemm g{XN, WOUT, M_, DM, DM}; pg8::StaticOrder S; S.init(M_, DM, G, (int)blockIdx.x); pg8::EpiF32 E{DB, DM};
        pg8::gemm_phase<pg8::EpiF32, pg8::StaticOrder, true, true>(lds, g, S, E); }
    SEAM(6);
    if (IN(7)) rowpass<1 | 2 | 4>(DB, H, H + (size_t)MP_ * DM, H, XN, a.in[11], 1.0f, a.in[20], gw, NGW, lane);
    SEAM(7);
    if (IN(8)) { pg8::Gemm g{XN, WGU2, M_, NGU, DM}; pg8::StaticOrder S; S.init(M_, NGU, G, (int)blockIdx.x); pg8::EpiSwiglu E{ACT, FF};
        pg8::gemm_phase<pg8::EpiSwiglu, pg8::StaticOrder, true, true>(lds, g, S, E); }
    SEAM(8);
    if (IN(9)) { pg8::Gemm g{ACT, WD2, M_, DM, FF}; pg8::StaticOrder S; S.init(M_, DM, G, (int)blockIdx.x); pg8::EpiF32 E{DB, DM};
        pg8::gemm_phase<pg8::EpiF32, pg8::StaticOrder, true, true>(lds, g, S, E); }
    SEAM(9);
    if (IN(10)) {
        rowpass<1 | 2 | 8>(DB, H, H + (size_t)MP_ * DM, H, XN, a.in[21], 0.5f, nullptr, gw, NGW, lane);
        for (int m = gw; m < M_; m += NGW) { const float* pr = (m < MP_) ? a.in[2] + (size_t)m * PLE : a.in[3] + (size_t)(m - MP_) * PLE;
            const f32x4 v = ((const f32x4*)pr)[lane]; u32x2 w; w.x = cvt_pk_bf16(v.x, v.y); w.y = cvt_pk_bf16(v.z, v.w); ((u32x2*)(PB + (size_t)m * PLE))[lane] = w; }
    }
    SEAM(10);
    if (IN(11)) { pg8::Gemm g{PB, WPP, M_, DM, PLE}; pg8::StaticOrder S; S.init(M_, DM, G, (int)blockIdx.x); pg8::EpiF32 E{PP, DM};
        pg8::gemm_phase<pg8::EpiF32, pg8::StaticOrder, true, true>(lds, g, S, E); }
    if (IN(12)) { pg8::Gemm g{XN, WPG, M_, DM, DM}; pg8::StaticOrder S; S.init(M_, DM, G, (int)blockIdx.x); pg8::EpiPle E{DB, PP, DM};
        pg8::gemm_phase<pg8::EpiPle, pg8::StaticOrder, true, true>(lds, g, S, E); }
    SEAM(12);
    if (IN(13)) rowpass<1 | 2>(DB, H, H + (size_t)MP_ * DM, H, nullptr, a.in[27], 1.0f, nullptr, gw, NGW, lane);
#undef IN
#undef SEAM
}

extern "C" void kernel_launch(void* const* d_in, const int* in_sizes, int n_in, void* d_out, int out_size, void* d_ws, size_t ws_size, hipStream_t stream) {
    static int grid = 0;
    if (grid == 0) {
        if (n_in != 28 || out_size != 19013632 || ws_size < WS_END) { fprintf(stderr, "kernel_launch: unexpected shapes: n_in %d out %d ws %zu (need %zu)\n", n_in, out_size, ws_size, (size_t)WS_END); grid = -1; return; }
        int dev = 0, cus = 0, per_cu = 0;
        if (hipGetDevice(&dev) != hipSuccess || hipDeviceGetAttribute(&cus, hipDeviceAttributeMultiprocessorCount, dev) != hipSuccess) { fprintf(stderr, "kernel_launch: device query failed\n"); grid = -1; return; }
        if (hipFuncSetAttribute((const void*)fwd_kernel<true>, hipFuncAttributeMaxDynamicSharedMemorySize, LDS_BYTES) != hipSuccess ||
            hipFuncSetAttribute((const void*)fwd_kernel<false>, hipFuncAttributeMaxDynamicSharedMemorySize, LDS_BYTES) != hipSuccess) { fprintf(stderr, "kernel_launch: hipFuncSetAttribute failed\n"); grid = -1; return; }
        if (hipOccupancyMaxActiveBlocksPerMultiprocessor(&per_cu, (const void*)fwd_kernel<true>, 512, LDS_BYTES) != hipSuccess || per_cu < 1) { fprintf(stderr, "kernel_launch: occupancy query says %d blocks per CU\n", per_cu); per_cu = 1; }
        (void)hipGetLastError();
        grid = cus * per_cu;
        fprintf(stderr, "kernel_launch: grid %d (cus %d x %d)\n", grid, cus, per_cu);
    }
    if (grid < 0) return;
    Args a{};
    for (int i = 0; i < 28; ++i) a.in[i] = (const float*)d_in[i];
    a.out = (float*)d_out; a.ws = (unsigned char*)d_ws;
#if MK_COOP
    a.ph_lo = 0; a.ph_hi = NPHASE;
    void* args[] = {&a};
    const hipError_t e = hipLaunchCooperativeKernel((const void*)fwd_kernel<true>, dim3(grid), dim3(512), args, LDS_BYTES, stream);
    if (e != hipSuccess) fprintf(stderr, "kernel_launch: cooperative launch failed: %s (grid %d)\n", hipGetErrorString(e), grid);
#else
    for (int p = 0; p < NPHASE; ++p) { a.ph_lo = p; a.ph_hi = p + 1; hipLaunchKernelGGL(fwd_kernel<false>, dim3(grid), dim3(512), LDS_BYTES, stream, a); }
#endif
}
```

```cpp
#include <hip/hip_runtime.h>
#include <hip/hip_cooperative_groups.h>
#include <cstdio>
#include <cstdint>
namespace cg = cooperative_groups;
namespace pg8 {
#define PG8_LAS __attribute__((address_space(3)))
typedef unsigned short bf16_t;
typedef short bf16x8 __attribute__((ext_vector_type(8)));
typedef float f32x4 __attribute__((ext_vector_type(4)));
typedef unsigned u32x4 __attribute__((ext_vector_type(4)));
constexpr int BM = 256, BK = 64, HALF = 128, HTB = HALF * BK * 2  , STAGE_BYTES = 8 * HTB, NXCD = 8, WGM = 8;

__host__ __device__ __forceinline__ int lds_byte(int r, int c) { const int st = (r >> 4) * 2 + (c >> 5), rr = r & 15, cc = c & 31, ob = rr * 64 + cc * 2; return st * 1024 + (ob ^ (((ob >> 9) & 1) << 5)); }
__host__ __device__ __forceinline__ void stage_rc(int b, int& R, int& C) { const int st = b / 1024, sb = b % 1024, swz = sb ^ (((sb >> 9) & 1) << 5); R = (st >> 1) * 16 + swz / 64; C = (st & 1) * 32 + (swz % 64) / 2; }
__host__ __device__ __forceinline__ int perm32(int rho) { const int n = rho >> 4, i = rho & 15; return 8 * (i >> 2) + 4 * n + (i & 3); }

struct Unit { int pm, pn; };
struct Gemm { const bf16_t* A; const bf16_t* Bt; int M, N, K; };

struct StaticOrder {
    int nM, nN, nwg, G, c;
    __host__ __device__ void init(int M, int N, int G_, int c_) { nM = M / BM; nN = N / BM; nwg = nM * nN; G = G_; c = c_; }
    __host__ __device__ bool next(int i, Unit& u) const {
        const long L = (long)i * G + c; if (L >= nwg) return false;
        int wgid = (int)L; { const int q = nwg / NXCD, r = nwg % NXCD, xcd = wgid % NXCD, off = wgid / NXCD; wgid = (xcd < r ? xcd * (q + 1) : r * (q + 1) + (xcd - r) * q) + off; }
        const int nig = WGM * nN, gid = wgid / nig, fm = gid * WGM, gsz = (nM - fm) < WGM ? (nM - fm) : WGM;
        u.pm = fm + ((wgid % nig) % gsz); u.pn = (wgid % nig) / gsz; return true;
    }
    __device__ __forceinline__ void a_ready(const Unit&) const {}
    __device__ __forceinline__ void done(const Unit&) const {}
};
typedef unsigned u32x2 __attribute__((ext_vector_type(2)));

__device__ __forceinline__ unsigned cvt_pk_bf16(float lo, float hi) { unsigned r; asm("v_cvt_pk_bf16_f32 %0, %1, %2" : "=v"(r) : "v"(lo), "v"(hi)); return r; }
__device__ __forceinline__ float sigmoid_f(float x) { return __builtin_amdgcn_rcpf(1.0f + __builtin_amdgcn_exp2f(x * -1.44269504089f)); }

struct EpiF32 {
    static constexpr bool PERM = false, AFTER_DRAIN = false;
    float* C; int ldc;
    __device__ __forceinline__ void operator()(const f32x4 (&acc)[2][2][4][2], const Unit& u, int wr, int wc, int fr, int fq) const {
        const int row0 = u.pm * BM + wr * 64 + fr, col0 = u.pn * BM + wc * 32 + 4 * fq;
#pragma unroll
        for (int ai = 0; ai < 2; ++ai)
#pragma unroll
            for (int m = 0; m < 4; ++m) { float* rowp = C + (size_t)(row0 + ai * HALF + m * 16) * ldc + col0;
#pragma unroll
                for (int bj = 0; bj < 2; ++bj)
#pragma unroll
                    for (int n = 0; n < 2; ++n) *(f32x4*)(rowp + bj * HALF + n * 16) = acc[ai][bj][m][n]; }
    }
};
struct EpiPle {
    static constexpr bool PERM = false, AFTER_DRAIN = false;
    float* C; const float* P; int ldc;
    __device__ __forceinline__ void operator()(const f32x4 (&acc)[2][2][4][2], const Unit& u, int wr, int wc, int fr, int fq) const {
        const int row0 = u.pm * BM + wr * 64 + fr, col0 = u.pn * BM + wc * 32 + 4 * fq;
#pragma unroll
        for (int ai = 0; ai < 2; ++ai)
#pragma unroll
            for (int m = 0; m < 4; ++m) { const size_t off = (size_t)(row0 + ai * HALF + m * 16) * ldc + col0;
#pragma unroll
                for (int bj = 0; bj < 2; ++bj)
#pragma unroll
                    for (int n = 0; n < 2; ++n) { const f32x4 p = *(const f32x4*)(P + off + bj * HALF + n * 16); const f32x4 a = acc[ai][bj][m][n];
                        f32x4 o; o.x = sigmoid_f(a.x) * p.x; o.y = sigmoid_f(a.y) * p.y; o.z = sigmoid_f(a.z) * p.z; o.w = sigmoid_f(a.w) * p.w;
                        *(f32x4*)(C + off + bj * HALF + n * 16) = o; } }
    }
};
struct EpiBf16 {
    static constexpr bool PERM = true, AFTER_DRAIN = false;
    bf16_t* O; int ldc;
    __device__ __forceinline__ void operator()(const f32x4 (&acc)[2][2][4][2], const Unit& u, int wr, int wc, int fr, int fq) const {
        const int row0 = u.pm * BM + wr * 64 + fr, col0 = u.pn * BM + wc * 32 + 8 * fq;
#pragma unroll
        for (int ai = 0; ai < 2; ++ai)
#pragma unroll
            for (int m = 0; m < 4; ++m) { bf16_t* rowp = O + (size_t)(row0 + ai * HALF + m * 16) * ldc + col0;
#pragma unroll
                for (int bj = 0; bj < 2; ++bj) { const f32x4 v0 = acc[ai][bj][m][0], v1 = acc[ai][bj][m][1];
                    u32x4 w; w.x = cvt_pk_bf16(v0[0], v0[1]); w.y = cvt_pk_bf16(v0[2], v0[3]); w.z = cvt_pk_bf16(v1[0], v1[1]); w.w = cvt_pk_bf16(v1[2], v1[3]);
                    *(u32x4*)(rowp + bj * HALF) = w; } }
    }
};
struct EpiSwiglu {
    static constexpr bool PERM = true, AFTER_DRAIN = false;
    bf16_t* O; int ldc;
    __device__ __forceinline__ void operator()(const f32x4 (&acc)[2][2][4][2], const Unit& u, int wr, int wc, int fr, int fq) const {
        const int row0 = u.pm * BM + wr * 64 + fr, col0 = u.pn * HALF + wc * 32 + 8 * fq;
#pragma unroll
        for (int ai = 0; ai < 2; ++ai)
#pragma unroll
            for (int m = 0; m < 4; ++m) { bf16_t* rowp = O + (size_t)(row0 + ai * HALF + m * 16) * ldc + col0;
                const f32x4 g0 = acc[ai][0][m][0], g1 = acc[ai][0][m][1], u0 = acc[ai][1][m][0], u1 = acc[ai][1][m][1];
                f32x4 v0, v1;
#pragma unroll
                for (int j = 0; j < 4; ++j) { v0[j] = g0[j] * sigmoid_f(g0[j]) * u0[j]; v1[j] = g1[j] * sigmoid_f(g1[j]) * u1[j]; }
                u32x4 w; w.x = cvt_pk_bf16(v0[0], v0[1]); w.y = cvt_pk_bf16(v0[2], v0[3]); w.z = cvt_pk_bf16(v1[0], v1[1]); w.w = cvt_pk_bf16(v1[2], v1[3]);
                *(u32x4*)rowp = w; }
    }
};

template <class Epi, class Sched, bool ALIGN_EPI = false, bool SP2 = false>
__device__ __forceinline__ void gemm_phase(PG8_LAS unsigned char* lds, const Gemm g, const Sched& S, const Epi& E) {
    const int tid = threadIdx.x, wid = __builtin_amdgcn_readfirstlane(tid >> 6), lane = tid & 63, wr = wid >> 2, wc = wid & 3, fr = lane & 15, fq = lane >> 4;
    const int K = g.K, nt = K / BK;
    unsigned voffA[2], voffB[2];
#pragma unroll
    for (int i = 0; i < 2; ++i) { int R, C; stage_rc(tid * 16 + i * 8192, R, C); const int Rb = Epi::PERM ? ((R & ~31) + perm32(R & 31)) : R;
        voffA[i] = (unsigned)(R * K + C) * 2u; voffB[i] = (unsigned)(Rb * K + C) * 2u; }
    const size_t kstep = (size_t)(BK * 2);
    const size_t hstep = (size_t)HALF * K * 2;
    const size_t tstep = 2 * hstep;
    const unsigned ldsw = (unsigned)wid * 1024u;
    const int aoff = lds_byte(wr * 64 + fr, fq * 8), boff = lds_byte(wc * 32 + fr, fq * 8);
#define PG8_SA(b, h) (((b) * 2 + (h)) * HTB)
#define PG8_SB(b, h) ((4 + (b) * 2 + (h)) * HTB)
#define PG8_STAGE(bufoff, gbase, voff) do { _Pragma("unroll") for (int _i = 0; _i < 2; ++_i) \
        __builtin_amdgcn_global_load_lds((const unsigned*)((const char*)(gbase) + (voff)[_i]), (PG8_LAS unsigned*)(lds + (bufoff) + ldsw + _i * 8192), 16, 0, 0); } while (0)
#define PG8_LDA(dst, b, h) do { _Pragma("unroll") for (int m = 0; m < 4; ++m) _Pragma("unroll") for (int k = 0; k < 2; ++k) dst[m][k] = *(const PG8_LAS bf16x8*)(lds + PG8_SA(b, h) + aoff + m * 2048 + k * 1024); } while (0)
#define PG8_LDB(dst, b, h) do { _Pragma("unroll") for (int n = 0; n < 2; ++n) _Pragma("unroll") for (int k = 0; k < 2; ++k) dst[n][k] = *(const PG8_LAS bf16x8*)(lds + PG8_SB(b, h) + boff + n * 2048 + k * 1024); } while (0)
#define PG8_MMA(ai, bj, At, Bt) do { __builtin_amdgcn_s_setprio(1); _Pragma("unroll") for (int m = 0; m < 4; ++m) _Pragma("unroll") for (int n = 0; n < 2; ++n) _Pragma("unroll") for (int k = 0; k < 2; ++k) \
        acc[ai][bj][m][n] = __builtin_amdgcn_mfma_f32_16x16x32_bf16(Bt[n][k], At[m][k], acc[ai][bj][m][n], 0, 0, 0); __builtin_amdgcn_s_setprio(0); } while (0)
#define PG8_WAIT_V(n) asm volatile("s_waitcnt vmcnt(" #n ")" ::: "memory")
#define PG8_WAIT_L(n) asm volatile("s_waitcnt lgkmcnt(" #n ")" ::: "memory")
#define PG8_BAR __builtin_amdgcn_s_barrier()
#define PG8_SCHED __builtin_amdgcn_sched_barrier(0)
    Unit cur, nxt; int ui = 0;
    if (!S.next(0, cur)) return;
    f32x4 acc[2][2][4][2];
#pragma unroll
    for (int a = 0; a < 2; ++a)
#pragma unroll
        for (int b = 0; b < 2; ++b)
#pragma unroll
            for (int m = 0; m < 4; ++m)
#pragma unroll
                for (int n = 0; n < 2; ++n) acc[a][b][m][n] = (f32x4){0.f, 0.f, 0.f, 0.f};
    bf16x8 At[4][2], B0[2][2], B1[2][2];
    const char* cA = (const char*)g.A + (size_t)cur.pm * tstep; const char* cB = (const char*)g.Bt + (size_t)cur.pn * tstep;
    S.a_ready(cur);
    if constexpr (SP2) {
        PG8_STAGE(PG8_SB(0, 0), cB, voffB); PG8_STAGE(PG8_SB(0, 1), cB + hstep, voffB); PG8_STAGE(PG8_SA(0, 0), cA, voffA); PG8_STAGE(PG8_SA(0, 1), cA + hstep, voffA);
        if (wr == 1) PG8_BAR;
        PG8_WAIT_V(2); PG8_BAR;
        PG8_STAGE(PG8_SB(1, 0), cB + kstep, voffB); PG8_STAGE(PG8_SA(1, 0), cA + kstep, voffA); PG8_STAGE(PG8_SB(1, 1), cB + hstep + kstep, voffB);
        PG8_WAIT_V(6); PG8_BAR;
    } else {
        PG8_STAGE(PG8_SB(0, 0), cB, voffB); PG8_STAGE(PG8_SA(0, 0), cA, voffA); PG8_STAGE(PG8_SB(0, 1), cB + hstep, voffB); PG8_STAGE(PG8_SA(0, 1), cA + hstep, voffA);
        if (wr == 1) PG8_BAR;
        PG8_WAIT_V(4); PG8_BAR;
        PG8_STAGE(PG8_SB(1, 0), cB + kstep, voffB); PG8_STAGE(PG8_SA(1, 0), cA + kstep, voffA); PG8_STAGE(PG8_SB(1, 1), cB + hstep + kstep, voffB);
        PG8_WAIT_V(6); PG8_BAR;
    }
    for (;;) {
        const bool has_next = S.next(ui + 1, nxt);
        const char* nA = has_next ? (const char*)g.A + (size_t)nxt.pm * tstep : cA; const char* nB = has_next ? (const char*)g.Bt + (size_t)nxt.pn * tstep : cB;
        for (int t = 0; t < nt; t += 2) {
            const bool last = (t == nt - 2);
            const char* a1 = cA + (size_t)(t + 1) * kstep;
            const char* a2 = last ? nA : cA + (size_t)(t + 2) * kstep; const char* b2 = last ? nB : cB + (size_t)(t + 2) * kstep;
            const char* a3 = a2 + kstep; const char* b3 = b2 + kstep;
            if (last && has_next) S.a_ready(nxt);
            if constexpr (SP2) {
            PG8_LDB(B0, 0, 0); PG8_LDB(B1, 0, 1); PG8_SCHED; PG8_LDA(At, 0, 0); PG8_STAGE(PG8_SA(1, 1), a1 + hstep, voffA);
            PG8_WAIT_V(8); PG8_WAIT_L(0); PG8_BAR; PG8_MMA(0, 0, At, B0); PG8_MMA(0, 1, At, B1); PG8_BAR; PG8_SCHED;
            PG8_LDA(At, 0, 1); PG8_STAGE(PG8_SB(0, 0), b2, voffB); PG8_STAGE(PG8_SB(0, 1), b2 + hstep, voffB); PG8_STAGE(PG8_SA(0, 0), a2, voffA);
            PG8_WAIT_V(8); PG8_WAIT_L(0); PG8_BAR; PG8_MMA(1, 0, At, B0); PG8_MMA(1, 1, At, B1); PG8_BAR; PG8_SCHED;
            PG8_LDB(B0, 1, 0); PG8_LDB(B1, 1, 1); PG8_SCHED; PG8_LDA(At, 1, 0); PG8_STAGE(PG8_SA(0, 1), a2 + hstep, voffA);
            PG8_WAIT_V(8); PG8_WAIT_L(0); PG8_BAR; PG8_MMA(0, 0, At, B0); PG8_MMA(0, 1, At, B1); PG8_BAR; PG8_SCHED;
            PG8_LDA(At, 1, 1); PG8_STAGE(PG8_SB(1, 0), b3, voffB); PG8_STAGE(PG8_SB(1, 1), b3 + hstep, voffB); PG8_STAGE(PG8_SA(1, 0), a3, voffA);
            PG8_WAIT_V(8); PG8_WAIT_L(0); PG8_BAR; PG8_MMA(1, 0, At, B0); PG8_MMA(1, 1, At, B1); PG8_BAR; PG8_SCHED;
            } else {
            PG8_LDB(B0, 0, 0); PG8_SCHED; PG8_LDA(At, 0, 0); PG8_STAGE(PG8_SA(1, 1), a1 + hstep, voffA);
            PG8_WAIT_L(8); PG8_BAR; PG8_WAIT_L(0); PG8_MMA(0, 0, At, B0); PG8_BAR; PG8_SCHED;
            PG8_LDB(B1, 0, 1); PG8_STAGE(PG8_SB(0, 0), b2, voffB);
            PG8_BAR; PG8_WAIT_L(0); PG8_MMA(0, 1, At, B1); PG8_BAR;
            PG8_LDA(At, 0, 1); PG8_STAGE(PG8_SA(0, 0), a2, voffA);
            PG8_BAR; PG8_WAIT_L(0); PG8_MMA(1, 0, At, B0); PG8_BAR; PG8_SCHED;
            PG8_STAGE(PG8_SB(0, 1), b2 + hstep, voffB);
            PG8_WAIT_V(6); PG8_BAR; PG8_MMA(1, 1, At, B1); PG8_BAR;
            PG8_LDB(B0, 1, 0); PG8_SCHED; PG8_LDA(At, 1, 0); PG8_STAGE(PG8_SA(0, 1), a2 + hstep, voffA);
            PG8_WAIT_L(8); PG8_BAR; PG8_WAIT_L(0); PG8_MMA(0, 0, At, B0); PG8_BAR; PG8_SCHED;
            PG8_LDB(B1, 1, 1); PG8_STAGE(PG8_SB(1, 0), b3, voffB);
            PG8_BAR; PG8_WAIT_L(0); PG8_MMA(0, 1, At, B1); PG8_BAR;
            PG8_LDA(At, 1, 1); PG8_STAGE(PG8_SA(1, 0), a3, voffA);
            PG8_BAR; PG8_WAIT_L(0); PG8_MMA(1, 0, At, B0); PG8_BAR; PG8_SCHED;
            PG8_STAGE(PG8_SB(1, 1), b3 + hstep, voffB);
            PG8_WAIT_V(6); PG8_BAR; PG8_MMA(1, 1, At, B1); PG8_BAR;
            }
        }
        if constexpr (ALIGN_EPI) { if (wr == 0) PG8_BAR; }
        if constexpr (!Epi::AFTER_DRAIN) { E(acc, cur, wr, wc, fr, fq); S.done(cur); }
        if (!has_next) break;
#pragma unroll
        for (int a = 0; a < 2; ++a)
#pragma unroll
            for (int b = 0; b < 2; ++b)
#pragma unroll
                for (int m = 0; m < 4; ++m)
#pragma unroll
                    for (int n = 0; n < 2; ++n) acc[a][b][m][n] = (f32x4){0.f, 0.f, 0.f, 0.f};
        cur = nxt; cA = nA; cB = nB; ++ui;
        if constexpr (ALIGN_EPI) { if (wr == 1) PG8_BAR; }
    }
    PG8_WAIT_V(0);
    if constexpr (!ALIGN_EPI) { if (wr == 0) PG8_BAR; }
    PG8_BAR;
    if constexpr (Epi::AFTER_DRAIN) { E.fused(acc, cur, wr, wc, fr, fq, lds, wid, lane); S.done(cur); }
#undef PG8_SA
#undef PG8_SB
#undef PG8_STAGE
#undef PG8_LDA
#undef PG8_LDB
#undef PG8_MMA
#undef PG8_WAIT_V
#undef PG8_WAIT_L
#undef PG8_BAR
#undef PG8_SCHED
}
}

using pg8::bf16_t; using pg8::bf16x8; using pg8::f32x4; using pg8::u32x4; using pg8::u32x2; using pg8::cvt_pk_bf16;
#define LAS __attribute__((address_space(3)))
#define XB_TMO      128
#define XB_XCNT(j)  (256  + 64 * (j))
#define XB_XSUB(j)  (1280 + 64 * (j))
#define XB_XGEN(j)  (2304 + 64 * (j))
#define XB_TOP      3328
#define XB_TOPGEN   3392
#define XCD_BAR_WORDS 3456
#define XB_SPIN_CAP (1u << 18)

__device__ __forceinline__ unsigned xb_ld(unsigned* p)              { return __hip_atomic_load(p, __ATOMIC_RELAXED, __HIP_MEMORY_SCOPE_AGENT); }
__device__ __forceinline__ unsigned xb_add(unsigned* p, unsigned v) { return __hip_atomic_fetch_add(p, v, __ATOMIC_RELAXED, __HIP_MEMORY_SCOPE_AGENT); }
__device__ __forceinline__ unsigned xb_xcc_id() { return (unsigned)__builtin_amdgcn_s_getreg((3 << 11) | 20) & 0xFu; }
#define XB_SPIN(cond, bar) do { unsigned _sp = 0; while (cond) { __builtin_amdgcn_s_sleep(1); \
    if ((++_sp & 255u) == 0u) { if (xb_ld(&(bar)[XB_TMO])) break; if (_sp > XB_SPIN_CAP) { atomicAdd(&(bar)[XB_TMO], 1u); break; } } } } while (0)

struct XcdBarrier {
    unsigned* bar; unsigned x;
    volatile LAS unsigned* st;
};

__device__ __forceinline__ XcdBarrier xcd_barrier_post(unsigned* bar, volatile LAS unsigned* st) {
    XcdBarrier b; b.bar = bar; b.x = xb_xcc_id(); b.st = st;
    if (threadIdx.x == 0) (void)xb_add(&bar[XB_XCNT(b.x)], 1u);
    return b;
}
__device__ __forceinline__ void xcd_barrier_complete(unsigned* bar, unsigned x, unsigned& nloc, unsigned& nx) {
    const unsigned G = gridDim.x * gridDim.y * gridDim.z;
    unsigned sum, cnt, mine, sp = 0u;
    for (;;) {
        sum = 0u; cnt = 0u; mine = 0u;
#pragma unroll
        for (unsigned j = 0; j < 16; ++j) { const unsigned c = xb_ld(&bar[XB_XCNT(j)]); sum += c; cnt += (c > 0u) ? 1u : 0u; mine = (j == x) ? c : mine; }
        if (sum == G) break;
        __builtin_amdgcn_s_sleep(1);
        if ((++sp & 255u) == 0u) { if (xb_ld(&bar[XB_TMO])) break; if (sp > XB_SPIN_CAP) { atomicAdd(&bar[XB_TMO], 1u); break; } }
    }
    nloc = mine > 0u ? mine : 1u; nx = cnt > 0u ? cnt : 1u;
}

__device__ __forceinline__ void xcd_barrier(const XcdBarrier& b) {
    asm volatile("s_waitcnt vmcnt(0)" ::: "memory");
    __syncthreads();
    if (threadIdx.x == 0) {
        unsigned* bar = b.bar;
        __builtin_amdgcn_s_waitcnt(0);
        unsigned nloc = b.st[0], nx = b.st[1];
        if (nloc == 0u) { xcd_barrier_complete(bar, b.x, nloc, nx); b.st[0] = nloc; b.st[1] = nx; }
        const unsigned old = xb_add(&bar[XB_XSUB(b.x)], 1u);
        const unsigned gen = old / nloc;
        if (old + 1u == (gen + 1u) * nloc) {
            __builtin_amdgcn_fence(__ATOMIC_RELEASE, "agent");
            asm volatile("s_waitcnt vmcnt(0)" ::: "memory");
            const unsigned og = xb_add(&bar[XB_TOP], 1u);
            const unsigned tg = og / nx;
            if (og + 1u == (tg + 1u) * nx) xb_add(&bar[XB_TOPGEN], 1u);
            else XB_SPIN(xb_ld(&bar[XB_TOPGEN]) == tg, bar);
            __builtin_amdgcn_fence(__ATOMIC_ACQUIRE, "agent");
            xb_add(&bar[XB_XGEN(b.x)], 1u);
            asm volatile("s_waitcnt vmcnt(0)" ::: "memory");
        } else {
            XB_SPIN(xb_ld(&bar[XB_XGEN(b.x)]) == gen, bar);
            __builtin_amdgcn_fence(__ATOMIC_ACQUIRE, "agent");
            asm volatile("s_waitcnt vmcnt(0)" ::: "memory");
        }
    }
    __syncthreads();
}


#ifndef MK_COOP
#define MK_COOP 1
#endif
constexpr int M_ = 17408, MP_ = 16384, DM = 1024, FF = 2816, NGU = 5632, NIN = 2560, PLE = 256;
constexpr float EPS_ = 1e-6f;
constexpr int LDS_BYTES = 147456;
constexpr int NPHASE = 14;
constexpr size_t WS_WGU1 = 0;
constexpr size_t WS_WD1 = WS_WGU1 + (size_t)NGU * DM * 2;
constexpr size_t WS_WIN = WS_WD1 + (size_t)DM * FF * 2;
constexpr size_t WS_WOUT = WS_WIN + (size_t)NIN * DM * 2;
constexpr size_t WS_WGU2 = WS_WOUT + (size_t)DM * DM * 2;
constexpr size_t WS_WD2 = WS_WGU2 + (size_t)NGU * DM * 2;
constexpr size_t WS_WPG = WS_WD2 + (size_t)DM * FF * 2;
constexpr size_t WS_WPP = WS_WPG + (size_t)DM * DM * 2;
constexpr size_t WS_XN = WS_WPP + (size_t)DM * PLE * 2;
constexpr size_t WS_ACT = WS_XN + (size_t)M_ * DM * 2;
constexpr size_t WS_D = WS_ACT + (size_t)M_ * FF * 2;
constexpr size_t WS_END = WS_D + (size_t)M_ * DM * 4;
constexpr size_t WS_BAR = WS_END;
constexpr size_t WS_TOTAL = WS_BAR + (size_t)XCD_BAR_WORDS * 4;
constexpr size_t WS_PROJ = WS_ACT;
constexpr size_t WS_PP = WS_ACT;
constexpr size_t WS_PB = WS_ACT + (size_t)M_ * DM * 4;
static_assert(WS_PB + (size_t)M_ * PLE * 2 <= WS_D, "aliases fit");
constexpr size_t OUT_NCP = 17825792, OUT_NCS = 17833984, OUT_CVP = 17965056, OUT_CVS = 18489344;

struct Args { const float* in[28]; float* out; unsigned char* ws; int ph_lo, ph_hi; };

__device__ __forceinline__ float wave_sum(float v) {
#pragma unroll
    for (int o = 1; o < 64; o <<= 1) v += __shfl_xor(v, o);
    return v;
}
__device__ __forceinline__ float bf_lo(unsigned w) { return __uint_as_float(w << 16); }
__device__ __forceinline__ float bf_hi(unsigned w) { return __uint_as_float(w & 0xffff0000u); }
__device__ __forceinline__ float dot4(f32x4 a) { return (a.x * a.x + a.y * a.y) + (a.z * a.z + a.w * a.w); }
#define LDS_WAIT() asm volatile("s_waitcnt lgkmcnt(0)" ::: "memory")

__device__ __forceinline__ void transpose_item(const float* __restrict__ W, int K, int N, bf16_t* __restrict__ WT, int k0, int n0, int drow0, LAS float* scr, int lane) {
#pragma unroll 8
    for (int i = 0; i < 32; ++i) { const int kk = 2 * i + (lane >> 5); scr[kk * 33 + (lane & 31)] = W[(size_t)(k0 + kk) * N + n0 + (lane & 31)]; }
    LDS_WAIT();
    const int c = lane & 7;
#pragma unroll
    for (int j = 0; j < 4; ++j) { const int n = (lane >> 3) + 8 * j; const LAS float* s = scr + (8 * c) * 33 + n;
        u32x4 o; o.x = cvt_pk_bf16(s[0 * 33], s[1 * 33]); o.y = cvt_pk_bf16(s[2 * 33], s[3 * 33]); o.z = cvt_pk_bf16(s[4 * 33], s[5 * 33]); o.w = cvt_pk_bf16(s[6 * 33], s[7 * 33]);
        *(u32x4*)(WT + (size_t)(drow0 + n) * K + k0 + 8 * c) = o; }
    LDS_WAIT();
}

template <int MODE>
__device__ __forceinline__ void rowpass(const float* __restrict__ dbuf, const float* resP, const float* resS, float* hout, bf16_t* __restrict__ xn,
                                        const float* __restrict__ gpost, float sc, const float* __restrict__ gnext, int gw, int NGW, int lane) {
    f32x4 gp[4], gn[4];
#pragma unroll
    for (int j = 0; j < 4; ++j) { gp[j] = (MODE & 1) ? ((const f32x4*)gpost)[lane + 64 * j] : (f32x4){0.f, 0.f, 0.f, 0.f}; gn[j] = (MODE & 4) ? ((const f32x4*)gnext)[lane + 64 * j] : (f32x4){0.f, 0.f, 0.f, 0.f}; }
    for (int m = gw; m < M_; m += NGW) {
        const float* rrow = (m < MP_) ? resP + (size_t)m * DM : resS + (size_t)(m - MP_) * DM;
        f32x4 h[4];
#pragma unroll
        for (int j = 0; j < 4; ++j) h[j] = ((const f32x4*)rrow)[lane + 64 * j];
        if (MODE & 1) {
            const f32x4* dr = (const f32x4*)(dbuf + (size_t)m * DM) + lane;
            f32x4 d[4]; float ss = 0.f;
#pragma unroll
            for (int j = 0; j < 4; ++j) { d[j] = dr[64 * j]; ss += dot4(d[j]); }
            const float rs = sc * rsqrtf(wave_sum(ss) * (1.0f / DM) + EPS_);
#pragma unroll
            for (int j = 0; j < 4; ++j) h[j] += d[j] * rs * gp[j];
        }
        if (MODE & 2) { f32x4* ho = (f32x4*)(hout + (size_t)m * DM) + lane;
#pragma unroll
            for (int j = 0; j < 4; ++j) ho[64 * j] = h[j]; }
        if (MODE & 4) {
            float s2 = 0.f;
#pragma unroll
            for (int j = 0; j < 4; ++j) s2 += dot4(h[j]);
            const float rs2 = rsqrtf(wave_sum(s2) * (1.0f / DM) + EPS_);
            u32x2* o = (u32x2*)(xn + (size_t)m * DM) + lane;
#pragma unroll
            for (int j = 0; j < 4; ++j) { const f32x4 v = h[j] * rs2 * gn[j]; u32x2 w; w.x = cvt_pk_bf16(v.x, v.y); w.y = cvt_pk_bf16(v.z, v.w); o[64 * j] = w; }
        } else if (MODE & 8) {
            u32x2* o = (u32x2*)(xn + (size_t)m * DM) + lane;
#pragma unroll
            for (int j = 0; j < 4; ++j) { const f32x4 v = h[j]; u32x2 w; w.x = cvt_pk_bf16(v.x, v.y); w.y = cvt_pk_bf16(v.z, v.w); o[64 * j] = w; }
        }
    }
}

__device__ __forceinline__ f32x4 bf4(unsigned a, unsigned b) { return (f32x4){bf_lo(a), bf_hi(a), bf_lo(b), bf_hi(b)}; }

__device__ __forceinline__ void mixer_phase(const Args& a, LAS unsigned char* lds, const bf16_t* __restrict__ PROJ, bf16_t* __restrict__ YC, int wave, int lane) {
    constexpr int VP = 272;
    LAS float* part = (LAS float*)(lds + 512 * VP);
    const int fr = lane & 15, fq = lane >> 4;
    const float* __restrict__ wsm = a.in[15]; const float* __restrict__ bsm = a.in[16];
    float* out = a.out;
    for (int u = blockIdx.x; u < 272; u += gridDim.x) {
        const bool samp = (u >= 256);
        const int R0 = u * 64;
        int s0 = 0, t0 = 0;
        if (!samp) { s0 = (u & 31) * 64; t0 = s0 & 127; }
        const int CB = R0 - t0, kext = t0 + 64;
        {
            const f32x4 vg0 = *(const f32x4*)(a.in[14] + lane * 8), vg1 = *(const f32x4*)(a.in[14] + lane * 8 + 4);
            for (int s = wave; s < kext; s += 8) {
                const int row = CB + s;
                const u32x4 raw = *(const u32x4*)(PROJ + (size_t)row * NIN + 2048 + lane * 8);
                f32x4 v0 = bf4(raw.x, raw.y), v1 = bf4(raw.z, raw.w);
                float ss = dot4(v0) + dot4(v1);
                ss += __shfl_xor(ss, 1); ss += __shfl_xor(ss, 2); ss += __shfl_xor(ss, 4);
                const float rs = rsqrtf(ss * (1.0f / 64.0f) + EPS_);
                v0 = v0 * rs * vg0; v1 = v1 * rs * vg1;
                LAS bf16_t* dst = (LAS bf16_t*)(lds + (lane * 8) * VP + s * 2);
                const unsigned p0 = cvt_pk_bf16(v0.x, v0.y), p1 = cvt_pk_bf16(v0.z, v0.w), p2 = cvt_pk_bf16(v1.x, v1.y), p3 = cvt_pk_bf16(v1.z, v1.w);
                dst[0 * (VP / 2)] = (bf16_t)(p0 & 0xffffu); dst[1 * (VP / 2)] = (bf16_t)(p0 >> 16);
                dst[2 * (VP / 2)] = (bf16_t)(p1 & 0xffffu); dst[3 * (VP / 2)] = (bf16_t)(p1 >> 16);
                dst[4 * (VP / 2)] = (bf16_t)(p2 & 0xffffu); dst[5 * (VP / 2)] = (bf16_t)(p2 >> 16);
                dst[6 * (VP / 2)] = (bf16_t)(p3 & 0xffffu); dst[7 * (VP / 2)] = (bf16_t)(p3 >> 16);
                if (s >= t0) {
                    if (samp) { float* o = out + OUT_CVS + (size_t)(row - MP_) * 512 + lane * 8; *(f32x4*)o = v0; *(f32x4*)(o + 4) = v1; }
                    else if (s0 - t0 == 1920) { float* o = out + OUT_CVP + (size_t)((u >> 5) * 128 + s) * 512 + lane * 8; *(f32x4*)o = v0; *(f32x4*)(o + 4) = v1; }
                }
            }
        }
        __syncthreads();
        const int h = wave;
        f32x4 acc[4][4];
#pragma unroll
        for (int i = 0; i < 4; ++i)
#pragma unroll
            for (int j = 0; j < 4; ++j) acc[i][j] = (f32x4){0.f, 0.f, 0.f, 0.f};
        const int nkb = kext >> 5;
        for (int kb = 0; kb < nkb; ++kb) {
            bf16x8 af[4];
#pragma unroll
            for (int tb = 0; tb < 4; ++tb) {
                f32x4 w0, w1; int lim;
                if (!samp) { const int tt = t0 + tb * 16 + fr, sb = kb * 32 + fq * 8; const float* wp = wsm + (size_t)(h * 128 + tt) * 128 + sb;
                    w0 = *(const f32x4*)wp; w1 = *(const f32x4*)(wp + 4); lim = tt - sb; }
                else { const int tt = fr & 7; const float* wp = wsm + (size_t)(h * 128 + tt) * 128;
                    w0 = *(const f32x4*)wp; w1 = *(const f32x4*)(wp + 4); lim = ((kb * 4 + fq) == (tb * 2 + (fr >> 3))) ? tt : -1; }
                w0.x = (0 <= lim) ? w0.x : 0.f; w0.y = (1 <= lim) ? w0.y : 0.f; w0.z = (2 <= lim) ? w0.z : 0.f; w0.w = (3 <= lim) ? w0.w : 0.f;
                w1.x = (4 <= lim) ? w1.x : 0.f; w1.y = (5 <= lim) ? w1.y : 0.f; w1.z = (6 <= lim) ? w1.z : 0.f; w1.w = (7 <= lim) ? w1.w : 0.f;
                u32x4 pk; pk.x = cvt_pk_bf16(w0.x, w0.y); pk.y = cvt_pk_bf16(w0.z, w0.w); pk.z = cvt_pk_bf16(w1.x, w1.y); pk.w = cvt_pk_bf16(w1.z, w1.w);
                af[tb] = __builtin_bit_cast(bf16x8, pk);
            }
#pragma unroll
            for (int db = 0; db < 4; ++db) {
                const bf16x8 bfv = *(const LAS bf16x8*)(lds + (h * 64 + db * 16 + fr) * VP + (kb * 32 + fq * 8) * 2);
#pragma unroll
                for (int tb = 0; tb < 4; ++tb) acc[tb][db] = __builtin_amdgcn_mfma_f32_16x16x32_bf16(bfv, af[tb], acc[tb][db], 0, 0, 0);
            }
        }
#pragma unroll
        for (int tb = 0; tb < 4; ++tb) {
            const int t = tb * 16 + fr; const int tt = samp ? (fr & 7) : (t0 + t); const float bias = bsm[h * 128 + tt];
            const bf16_t* up = PROJ + (size_t)(R0 + t) * NIN + 1536 + h * 64 + fq * 4;
            float s = 0.f;
#pragma unroll
            for (int db = 0; db < 4; ++db) { const u32x2 ur = *(const u32x2*)(up + db * 16); const f32x4 uu = bf4(ur.x, ur.y);
                const f32x4 y = uu * (acc[tb][db] + bias); acc[tb][db] = y; s += dot4(y); }
            s += __shfl_xor(s, 16); s += __shfl_xor(s, 32);
            if (fq == 0) part[h * 64 + t] = s;
        }
        __syncthreads();
#pragma unroll
        for (int tb = 0; tb < 4; ++tb) {
            const int t = tb * 16 + fr; float tot = 0.f;
#pragma unroll
            for (int hh = 0; hh < 8; ++hh) tot += part[hh * 64 + t];
            const float rs = rsqrtf(tot * (1.0f / 512.0f) + EPS_);
            bf16_t* yp = YC + (size_t)(R0 + t) * DM + 512 + h * 64 + fq * 4;
#pragma unroll
            for (int db = 0; db < 4; ++db) { const f32x4 gb = *(const f32x4*)(a.in[18] + h * 64 + db * 16 + fq * 4); const f32x4 y = acc[tb][db] * rs * gb;
                u32x2 w; w.x = cvt_pk_bf16(y.x, y.y); w.y = cvt_pk_bf16(y.z, y.w); *(u32x2*)(yp + db * 16) = w; }
        }
        {
            const int c0 = lane * 8; const float* cw = a.in[13];
            const f32x4 w0a = *(const f32x4*)(cw + c0), w0b = *(const f32x4*)(cw + c0 + 4), w1a = *(const f32x4*)(cw + 512 + c0), w1b = *(const f32x4*)(cw + 512 + c0 + 4),
                        w2a = *(const f32x4*)(cw + 1024 + c0), w2b = *(const f32x4*)(cw + 1024 + c0 + 4);
            const f32x4 gaa = *(const f32x4*)(a.in[17] + c0), gab = *(const f32x4*)(a.in[17] + c0 + 4);
            f32x4 zp2a = {0.f, 0.f, 0.f, 0.f}, zp2b = zp2a, zp1a = zp2a, zp1b = zp2a;
            const int rb = R0 + wave * 8; const int sb_ = (u - 256) * 8 + wave;
            if (samp) { const float* st = a.in[4] + (size_t)sb_ * 1024 + c0; zp2a = *(const f32x4*)st; zp2b = *(const f32x4*)(st + 4); zp1a = *(const f32x4*)(st + 512); zp1b = *(const f32x4*)(st + 516); }
            else if (s0 + wave * 8 > 0) {
                const bf16_t* p2 = PROJ + (size_t)(rb - 2) * NIN + c0; const bf16_t* p1 = p2 + NIN;
                const u32x4 c2 = *(const u32x4*)(p2 + 512), h2 = *(const u32x4*)(p2 + 1024), c1 = *(const u32x4*)(p1 + 512), h1 = *(const u32x4*)(p1 + 1024);
                zp2a = bf4(c2.x, c2.y) * bf4(h2.x, h2.y); zp2b = bf4(c2.z, c2.w) * bf4(h2.z, h2.w); zp1a = bf4(c1.x, c1.y) * bf4(h1.x, h1.y); zp1b = bf4(c1.z, c1.w) * bf4(h1.z, h1.w);
            }
            f32x4 ya[8], yb[8]; float ss[8];
#pragma unroll
            for (int i = 0; i < 8; ++i) {
                const bf16_t* pr = PROJ + (size_t)(rb + i) * NIN + c0;
                const u32x4 braw = *(const u32x4*)pr, craw = *(const u32x4*)(pr + 512), hraw = *(const u32x4*)(pr + 1024);
                const f32x4 za = bf4(craw.x, craw.y) * bf4(hraw.x, hraw.y), zb = bf4(craw.z, craw.w) * bf4(hraw.z, hraw.w);
                const f32x4 ca = w0a * zp2a + w1a * zp1a + w2a * za, cb = w0b * zp2b + w1b * zp1b + w2b * zb;
                ya[i] = bf4(braw.x, braw.y) * ca; yb[i] = bf4(braw.z, braw.w) * cb;
                ss[i] = wave_sum(dot4(ya[i]) + dot4(yb[i]));
                if (i >= 6) {
                    if (samp) { float* o = out + OUT_NCS + ((size_t)sb_ * 2 + (i - 6)) * 512 + c0; *(f32x4*)o = za; *(f32x4*)(o + 4) = zb; }
                    else if ((u & 31) == 31 && wave == 7) { float* o = out + OUT_NCP + ((size_t)(u >> 5) * 2 + (i - 6)) * 512 + c0; *(f32x4*)o = za; *(f32x4*)(o + 4) = zb; }
                }
                zp2a = zp1a; zp2b = zp1b; zp1a = za; zp1b = zb;
            }
#pragma unroll
            for (int i = 0; i < 8; ++i) {
                const float rs = rsqrtf(ss[i] * (1.0f / 512.0f) + EPS_);
                const f32x4 y0 = ya[i] * rs * gaa, y1 = yb[i] * rs * gab;
                u32x4 w; w.x = cvt_pk_bf16(y0.x, y0.y); w.y = cvt_pk_bf16(y0.z, y0.w); w.z = cvt_pk_bf16(y1.x, y1.y); w.w = cvt_pk_bf16(y1.z, y1.w);
                *(u32x4*)(YC + (size_t)(rb + i) * DM + c0) = w;
            }
        }
        __syncthreads();
    }
}

template <bool COOP>
__global__ void __launch_bounds__(512, 2) fwd_kernel(Args a) {
    extern __shared__ __attribute__((aligned(16))) unsigned char lds_raw[];
    LAS unsigned char* lds = (LAS unsigned char*)lds_raw;
    const int tid = threadIdx.x, lane = tid & 63, wave = __builtin_amdgcn_readfirstlane(tid >> 6);
    const int G = gridDim.x, gw = blockIdx.x * 8 + wave, NGW = G * 8;
    unsigned char* ws = a.ws;
    bf16_t* WGU1 = (bf16_t*)(ws + WS_WGU1); bf16_t* WD1 = (bf16_t*)(ws + WS_WD1); bf16_t* WIN = (bf16_t*)(ws + WS_WIN); bf16_t* WOUT = (bf16_t*)(ws + WS_WOUT);
    bf16_t* WGU2 = (bf16_t*)(ws + WS_WGU2); bf16_t* WD2 = (bf16_t*)(ws + WS_WD2); bf16_t* WPG = (bf16_t*)(ws + WS_WPG); bf16_t* WPP = (bf16_t*)(ws + WS_WPP);
    bf16_t* XN = (bf16_t*)(ws + WS_XN); bf16_t* ACT = (bf16_t*)(ws + WS_ACT); bf16_t* PROJ = (bf16_t*)(ws + WS_PROJ); bf16_t* PB = (bf16_t*)(ws + WS_PB);
    float* DB = (float*)(ws + WS_D); float* PP = (float*)(ws + WS_PP);
    float* H = a.out;
#define IN(k) (a.ph_lo <= (k) && (k) < a.ph_hi)
    XcdBarrier bar; bar.bar = (unsigned*)(ws + WS_BAR); bar.x = 0; bar.st = nullptr;
    if (COOP) {
        volatile LAS unsigned* st = (volatile LAS unsigned*)(lds + LDS_BYTES - 16);
        if (tid < 4) st[tid] = 0u;
        __syncthreads();
        bar = xcd_barrier_post((unsigned*)(ws + WS_BAR), st);
        if (a.ph_lo < 0) cg::this_grid().sync();
    }
#define SEAM(k) do { if (COOP && IN(k) && IN((k) + 1)) xcd_barrier(bar); } while (0)

    if (IN(0)) {
        LAS float* scr = (LAS float*)(lds + wave * 8448);
        constexpr int I_G = (DM / 64) * (FF / 32), I_D = (FF / 64) * (DM / 32), I_IN = (DM / 64) * (NIN / 32), I_O = (DM / 64) * (DM / 32), I_PP = (PLE / 64) * (DM / 32);
        constexpr int NITEMS = 4 * I_G + 2 * I_D + I_IN + 2 * I_O + I_PP;
        for (int it = gw; it < NITEMS; it += NGW) {
            int r = it; const float* W; int K, N; bf16_t* WT; int mode = 0;
            if (r < I_G) { W = a.in[7]; K = DM; N = FF; WT = WGU1; mode = 1; }
            else if ((r -= I_G) < I_G) { W = a.in[8]; K = DM; N = FF; WT = WGU1; mode = 2; }
            else if ((r -= I_G) < I_G) { W = a.in[22]; K = DM; N = FF; WT = WGU2; mode = 1; }
            else if ((r -= I_G) < I_G) { W = a.in[23]; K = DM; N = FF; WT = WGU2; mode = 2; }
            else if ((r -= I_G) < I_D) { W = a.in[9]; K = FF; N = DM; WT = WD1; }
            else if ((r -= I_D) < I_D) { W = a.in[24]; K = FF; N = DM; WT = WD2; }
            else if ((r -= I_D) < I_IN) { W = a.in[12]; K = DM; N = NIN; WT = WIN; }
            else if ((r -= I_IN) < I_O) { W = a.in[19]; K = DM; N = DM; WT = WOUT; }
            else if ((r -= I_O) < I_O) { W = a.in[25]; K = DM; N = DM; WT = WPG; }
            else { r -= I_O; W = a.in[26]; K = PLE; N = DM; WT = WPP; }
            const int nblk = N / 32, kb = r / nblk, nb = r % nblk, k0 = 64 * kb, n0 = 32 * nb;
            int drow0 = n0; if (mode) drow0 = (n0 >> 7) * 256 + (n0 & 127) + (mode == 2 ? 128 : 0);
            transpose_item(W, K, N, WT, k0, n0, drow0, scr, lane);
        }
        rowpass<4>(nullptr, a.in[0], a.in[1], nullptr, XN, nullptr, 0.f, a.in[5], gw, NGW, lane);
    }
    SEAM(0);
    if (IN(1)) { pg8::Gemm g{XN, WGU1, M_, NGU, DM}; pg8::StaticOrder S; S.init(M_, NGU, G, (int)blockIdx.x); pg8::EpiSwiglu E{ACT, FF};
        pg8::gemm_phase<pg8::EpiSwiglu, pg8::StaticOrder, true, true>(lds, g, S, E); }
    SEAM(1);
    if (IN(2)) { pg8::Gemm g{ACT, WD1, M_, DM, FF}; pg8::StaticOrder S; S.init(M_, DM, G, (int)blockIdx.x); pg8::EpiF32 E{DB, DM};
        pg8::gemm_phase<pg8::EpiF32, pg8::StaticOrder, true, true>(lds, g, S, E); }
    SEAM(2);
    if (IN(3)) rowpass<1 | 2 | 4>(DB, a.in[0], a.in[1], H, XN, a.in[6], 0.5f, a.in[10], gw, NGW, lane);
    SEAM(3);
    if (IN(4)) { pg8::Gemm g{XN, WIN, M_, NIN, DM}; pg8::StaticOrder S; S.init(M_, NIN, G, (int)blockIdx.x); pg8::EpiBf16 E{PROJ, NIN};
        pg8::gemm_phase<pg8::EpiBf16, pg8::StaticOrder, true, true>(lds, g, S, E); }
    SEAM(4);
    if (IN(5)) mixer_phase(a, lds, PROJ, XN, wave, lane);
    SEAM(5);
    if (IN(6)) { pg8::Gemm g{XN, WOUT, M_, DM, DM}; pg8::StaticOrder S; S.init(M_, DM, G, (int)blockIdx.x); pg8::EpiF32 E{DB, DM};
        pg8::gemm_phase<pg8::EpiF32, pg8::StaticOrder, true, true>(lds, g, S, E); }
    SEAM(6);
    if (IN(7)) rowpass<1 | 2 | 4>(DB, H, H + (size_t)MP_ * DM, H, XN, a.in[11], 1.0f, a.in[20], gw, NGW, lane);
    SEAM(7);
    if (IN(8)) { pg8::Gemm g{XN, WGU2, M_, NGU, DM}; pg8::StaticOrder S; S.init(M_, NGU, G, (int)blockIdx.x); pg8::EpiSwiglu E{ACT, FF};
        pg8::gemm_phase<pg8::EpiSwiglu, pg8::StaticOrder, true, true>(lds, g, S, E); }
    SEAM(8);
    if (IN(9)) { pg8::Gemm g{ACT, WD2, M_, DM, FF}; pg8::StaticOrder S; S.init(M_, DM, G, (int)blockIdx.x); pg8::EpiF32 E{DB, DM};
        pg8::gemm_phase<pg8::EpiF32, pg8::StaticOrder, true, true>(lds, g, S, E); }
    SEAM(9);
    if (IN(10)) {
        rowpass<1 | 2 | 8>(DB, H, H + (size_t)MP_ * DM, H, XN, a.in[21], 0.5f, nullptr, gw, NGW, lane);
        for (int m = gw; m < M_; m += NGW) { const float* pr = (m < MP_) ? a.in[2] + (size_t)m * PLE : a.in[3] + (size_t)(m - MP_) * PLE;
            const f32x4 v = ((const f32x4*)pr)[lane]; u32x2 w; w.x = cvt_pk_bf16(v.x, v.y); w.y = cvt_pk_bf16(v.z, v.w); ((u32x2*)(PB + (size_t)m * PLE))[lane] = w; }
    }
    SEAM(10);
    if (IN(11)) { pg8::Gemm g{PB, WPP, M_, DM, PLE}; pg8::StaticOrder S; S.init(M_, DM, G, (int)blockIdx.x); pg8::EpiF32 E{PP, DM};
        pg8::gemm_phase<pg8::EpiF32, pg8::StaticOrder, true, true>(lds, g, S, E); }
    if (IN(12)) { pg8::Gemm g{XN, WPG, M_, DM, DM}; pg8::StaticOrder S; S.init(M_, DM, G, (int)blockIdx.x); pg8::EpiPle E{DB, PP, DM};
        pg8::gemm_phase<pg8::EpiPle, pg8::StaticOrder, true, true>(lds, g, S, E); }
    SEAM(12);
    if (IN(13)) rowpass<1 | 2>(DB, H, H + (size_t)MP_ * DM, H, nullptr, a.in[27], 1.0f, nullptr, gw, NGW, lane);
#undef IN
#undef SEAM
}

extern "C" void kernel_launch(void* const* d_in, const int* in_sizes, int n_in, void* d_out, int out_size, void* d_ws, size_t ws_size, hipStream_t stream) {
    static int grid = 0;
    if (grid == 0) {
        if (n_in != 28 || out_size != 19013632 || ws_size < WS_TOTAL) { fprintf(stderr, "kernel_launch: unexpected shapes: n_in %d out %d ws %zu (need %zu)\n", n_in, out_size, ws_size, (size_t)WS_TOTAL); grid = -1; return; }
        int dev = 0, cus = 0, per_cu = 0;
        if (hipGetDevice(&dev) != hipSuccess || hipDeviceGetAttribute(&cus, hipDeviceAttributeMultiprocessorCount, dev) != hipSuccess) { fprintf(stderr, "kernel_launch: device query failed\n"); grid = -1; return; }
        if (hipFuncSetAttribute((const void*)fwd_kernel<true>, hipFuncAttributeMaxDynamicSharedMemorySize, LDS_BYTES) != hipSuccess ||
            hipFuncSetAttribute((const void*)fwd_kernel<false>, hipFuncAttributeMaxDynamicSharedMemorySize, LDS_BYTES) != hipSuccess) { fprintf(stderr, "kernel_launch: hipFuncSetAttribute failed\n"); grid = -1; return; }
        if (hipOccupancyMaxActiveBlocksPerMultiprocessor(&per_cu, (const void*)fwd_kernel<true>, 512, LDS_BYTES) != hipSuccess || per_cu < 1) { fprintf(stderr, "kernel_launch: occupancy query says %d blocks per CU\n", per_cu); per_cu = 1; }
        (void)hipGetLastError();
        grid = cus * per_cu;
        fprintf(stderr, "kernel_launch: grid %d (cus %d x %d)\n", grid, cus, per_cu);
    }
    if (grid < 0) return;
    Args a{};
    for (int i = 0; i < 28; ++i) a.in[i] = (const float*)d_in[i];
    a.out = (float*)d_out; a.ws = (unsigned char*)d_ws;
#if MK_COOP
    if (hipMemsetAsync((char*)d_ws + WS_BAR, 0, (size_t)XCD_BAR_WORDS * 4, stream) != hipSuccess) { fprintf(stderr, "kernel_launch: memset of the barrier words failed\n"); return; }
    a.ph_lo = 0; a.ph_hi = NPHASE;
    void* args[] = {&a};
    const hipError_t e = hipLaunchCooperativeKernel((const void*)fwd_kernel<true>, dim3(grid), dim3(512), args, LDS_BYTES, stream);
    if (e != hipSuccess) fprintf(stderr, "kernel_launch: cooperative launch failed: %s (grid %d)\n", hipGetErrorString(e), grid);
#else
    for (int p = 0; p < NPHASE; ++p) { a.ph_lo = p; a.ph_hi = p + 1; hipLaunchKernelGGL(fwd_kernel<false>, dim3(grid), dim3(512), LDS_BYTES, stream, a); }
#endif
}
```

```cpp
#include <hip/hip_runtime.h>
#include <hip/hip_cooperative_groups.h>
#include <cstdio>
#include <cstdint>
namespace cg = cooperative_groups;
#define MK_DUP 0u
namespace pg8 {
#define PG8_LAS __attribute__((address_space(3)))
typedef unsigned short bf16_t;
typedef short bf16x8 __attribute__((ext_vector_type(8)));
typedef float f32x4 __attribute__((ext_vector_type(4)));
typedef unsigned u32x4 __attribute__((ext_vector_type(4)));
constexpr int BM = 256, BK = 64, HALF = 128, HTB = HALF * BK * 2  , STAGE_BYTES = 8 * HTB, NXCD = 8, WGM = 8;

__host__ __device__ __forceinline__ int lds_byte(int r, int c) { const int st = (r >> 4) * 2 + (c >> 5), rr = r & 15, cc = c & 31, ob = rr * 64 + cc * 2; return st * 1024 + (ob ^ (((ob >> 9) & 1) << 5)); }
__host__ __device__ __forceinline__ void stage_rc(int b, int& R, int& C) { const int st = b / 1024, sb = b % 1024, swz = sb ^ (((sb >> 9) & 1) << 5); R = (st >> 1) * 16 + swz / 64; C = (st & 1) * 32 + (swz % 64) / 2; }
__host__ __device__ __forceinline__ int perm32(int rho) { const int n = rho >> 4, i = rho & 15; return 8 * (i >> 2) + 4 * n + (i & 3); }

struct Unit { int pm, pn, ks; };
struct Gemm { const bf16_t* A; const bf16_t* Bt; int ld, K; };

struct StaticOrder {
    int nM, nN, nwg, G, c;
    __host__ __device__ void init(int M, int N, int G_, int c_) { nM = M / BM; nN = N / BM; nwg = nM * nN; G = G_; c = c_; }
    __host__ __device__ bool next(int i, Unit& u) const {
        const long L = (long)i * G + c; if (L >= nwg) return false;
        int wgid = (int)L; { const int q = nwg / NXCD, r = nwg % NXCD, xcd = wgid % NXCD, off = wgid / NXCD; wgid = (xcd < r ? xcd * (q + 1) : r * (q + 1) + (xcd - r) * q) + off; }
        const int nig = WGM * nN, gid = wgid / nig, fm = gid * WGM, gsz = (nM - fm) < WGM ? (nM - fm) : WGM;
        u.pm = fm + ((wgid % nig) % gsz); u.pn = (wgid % nig) / gsz; u.ks = 0; return true;
    }
    __device__ __forceinline__ void a_ready(const Unit&) const {}
    __device__ __forceinline__ void done(const Unit&) const {}
};
struct SubOrder {
    int pm0, npm, nN, nsl, G, c;
    __host__ __device__ bool next(int i, Unit& u) const {
        const int L = i * G + c; if (c < 0 || L >= npm * nN * nsl) return false;
        const int t = L / nsl; u.ks = L - t * nsl; u.pn = t % nN; u.pm = pm0 + t / nN; return true;
    }
    __device__ __forceinline__ void a_ready(const Unit&) const {}
    __device__ __forceinline__ void done(const Unit&) const {}
};
typedef unsigned u32x2 __attribute__((ext_vector_type(2)));

__device__ __forceinline__ unsigned cvt_pk_bf16(float lo, float hi) { unsigned r; asm("v_cvt_pk_bf16_f32 %0, %1, %2" : "=v"(r) : "v"(lo), "v"(hi)); return r; }
__device__ __forceinline__ float sigmoid_f(float x) { return __builtin_amdgcn_rcpf(1.0f + __builtin_amdgcn_exp2f(x * -1.44269504089f)); }

struct EpiF32 {
    static constexpr bool PERM = false, AFTER_DRAIN = false;
    float* C; int ldc;
    __device__ __forceinline__ void operator()(const f32x4 (&acc)[2][2][4][2], const Unit& u, int wr, int wc, int fr, int fq) const {
        const int row0 = u.pm * BM + wr * 64 + fr, col0 = u.pn * BM + wc * 32 + 4 * fq;
#pragma unroll
        for (int ai = 0; ai < 2; ++ai)
#pragma unroll
            for (int m = 0; m < 4; ++m) { float* rowp = C + (size_t)(row0 + ai * HALF + m * 16) * ldc + col0;
#pragma unroll
                for (int bj = 0; bj < 2; ++bj)
#pragma unroll
                    for (int n = 0; n < 2; ++n) *(f32x4*)(rowp + bj * HALF + n * 16) = acc[ai][bj][m][n]; }
    }
};
struct EpiPle {
    static constexpr bool PERM = false, AFTER_DRAIN = false;
    bf16_t* T; const float* P; int ldc;
    __device__ __forceinline__ void operator()(const f32x4 (&acc)[2][2][4][2], const Unit& u, int wr, int wc, int fr, int fq) const {
        const int row0 = u.pm * BM + wr * 64 + fr, col0 = u.pn * BM + wc * 32 + 4 * fq;
#pragma unroll
        for (int ai = 0; ai < 2; ++ai)
#pragma unroll
            for (int m = 0; m < 4; ++m) { const size_t off = (size_t)(row0 + ai * HALF + m * 16) * ldc + col0;
#pragma unroll
                for (int bj = 0; bj < 2; ++bj)
#pragma unroll
                    for (int n = 0; n < 2; ++n) { const f32x4 p = *(const f32x4*)(P + off + bj * HALF + n * 16); const f32x4 a = acc[ai][bj][m][n];
                        u32x2 w; w.x = cvt_pk_bf16(sigmoid_f(a.x) * p.x, sigmoid_f(a.y) * p.y); w.y = cvt_pk_bf16(sigmoid_f(a.z) * p.z, sigmoid_f(a.w) * p.w);
                        *(u32x2*)(T + off + bj * HALF + n * 16) = w; } }
    }
};
struct EpiF32Slab {
    static constexpr bool PERM = false, AFTER_DRAIN = false;
    float* base; int pm0;
    __device__ __forceinline__ void operator()(const f32x4 (&acc)[2][2][4][2], const Unit& u, int wr, int wc, int fr, int fq) const {
        const int row0 = (u.pm - pm0) * BM + wr * 64 + fr, col0 = u.pn * BM + wc * 32 + 4 * fq;
        float* C = base + ((size_t)u.ks << 20);
#pragma unroll
        for (int ai = 0; ai < 2; ++ai)
#pragma unroll
            for (int m = 0; m < 4; ++m) { float* rowp = C + (size_t)(row0 + ai * HALF + m * 16) * 1024 + col0;
#pragma unroll
                for (int bj = 0; bj < 2; ++bj)
#pragma unroll
                    for (int n = 0; n < 2; ++n) *(f32x4*)(rowp + bj * HALF + n * 16) = acc[ai][bj][m][n]; }
    }
};
struct EpiBf16 {
    static constexpr bool PERM = true, AFTER_DRAIN = false;
    bf16_t* O; int ldc;
    __device__ __forceinline__ void operator()(const f32x4 (&acc)[2][2][4][2], const Unit& u, int wr, int wc, int fr, int fq) const {
        const int row0 = u.pm * BM + wr * 64 + fr, col0 = u.pn * BM + wc * 32 + 8 * fq;
#pragma unroll
        for (int ai = 0; ai < 2; ++ai)
#pragma unroll
            for (int m = 0; m < 4; ++m) { bf16_t* rowp = O + (size_t)(row0 + ai * HALF + m * 16) * ldc + col0;
#pragma unroll
                for (int bj = 0; bj < 2; ++bj) { const f32x4 v0 = acc[ai][bj][m][0], v1 = acc[ai][bj][m][1];
                    u32x4 w; w.x = cvt_pk_bf16(v0[0], v0[1]); w.y = cvt_pk_bf16(v0[2], v0[3]); w.z = cvt_pk_bf16(v1[0], v1[1]); w.w = cvt_pk_bf16(v1[2], v1[3]);
                    *(u32x4*)(rowp + bj * HALF) = w; } }
    }
};
struct EpiSwiglu {
    static constexpr bool PERM = true, AFTER_DRAIN = false;
    bf16_t* O; int ldc;
    __device__ __forceinline__ void operator()(const f32x4 (&acc)[2][2][4][2], const Unit& u, int wr, int wc, int fr, int fq) const {
        const int row0 = u.pm * BM + wr * 64 + fr, col0 = u.pn * HALF + wc * 32 + 8 * fq;
#pragma unroll
        for (int ai = 0; ai < 2; ++ai)
#pragma unroll
            for (int m = 0; m < 4; ++m) { bf16_t* rowp = O + (size_t)(row0 + ai * HALF + m * 16) * ldc + col0;
                const f32x4 g0 = acc[ai][0][m][0], g1 = acc[ai][0][m][1], u0 = acc[ai][1][m][0], u1 = acc[ai][1][m][1];
                f32x4 v0, v1;
#pragma unroll
                for (int j = 0; j < 4; ++j) { v0[j] = g0[j] * sigmoid_f(g0[j]) * u0[j]; v1[j] = g1[j] * sigmoid_f(g1[j]) * u1[j]; }
                u32x4 w; w.x = cvt_pk_bf16(v0[0], v0[1]); w.y = cvt_pk_bf16(v0[2], v0[3]); w.z = cvt_pk_bf16(v1[0], v1[1]); w.w = cvt_pk_bf16(v1[2], v1[3]);
                *(u32x4*)rowp = w; }
    }
};

template <class Epi, class Sched, bool ALIGN_EPI = false, bool SP2 = false>
__device__ __forceinline__ void gemm_phase(PG8_LAS unsigned char* lds, const Gemm g, const Sched& S, const Epi& E) {
    const int tid = threadIdx.x, wid = __builtin_amdgcn_readfirstlane(tid >> 6), lane = tid & 63, wr = wid >> 2, wc = wid & 3, fr = lane & 15, fq = lane >> 4;
    const int K = g.K, nt = K / BK;
    unsigned voffA[2], voffB[2];
#pragma unroll
    for (int i = 0; i < 2; ++i) { int R, C; stage_rc(tid * 16 + i * 8192, R, C); const int Rb = Epi::PERM ? ((R & ~31) + perm32(R & 31)) : R;
        voffA[i] = (unsigned)(R * g.ld + C) * 2u; voffB[i] = (unsigned)(Rb * g.ld + C) * 2u; }
    const size_t kstep = (size_t)(BK * 2);
    const size_t hstepA = (size_t)HALF * g.ld * 2, hstepB = hstepA;
    const size_t kslice = (size_t)K * 2;
    const unsigned ldsw = (unsigned)wid * 1024u;
    const int aoff = lds_byte(wr * 64 + fr, fq * 8), boff = lds_byte(wc * 32 + fr, fq * 8);
#define PG8_SA(b, h) (((b) * 2 + (h)) * HTB)
#define PG8_SB(b, h) ((4 + (b) * 2 + (h)) * HTB)
#define PG8_STAGE(bufoff, gbase, voff) do { _Pragma("unroll") for (int _i = 0; _i < 2; ++_i) \
        __builtin_amdgcn_global_load_lds((const unsigned*)((const char*)(gbase) + (voff)[_i]), (PG8_LAS unsigned*)(lds + (bufoff) + ldsw + _i * 8192), 16, 0, 0); } while (0)
#define PG8_LDA(dst, b, h) do { _Pragma("unroll") for (int m = 0; m < 4; ++m) _Pragma("unroll") for (int k = 0; k < 2; ++k) dst[m][k] = *(const PG8_LAS bf16x8*)(lds + PG8_SA(b, h) + aoff + m * 2048 + k * 1024); } while (0)
#define PG8_LDB(dst, b, h) do { _Pragma("unroll") for (int n = 0; n < 2; ++n) _Pragma("unroll") for (int k = 0; k < 2; ++k) dst[n][k] = *(const PG8_LAS bf16x8*)(lds + PG8_SB(b, h) + boff + n * 2048 + k * 1024); } while (0)
#define PG8_MMA(ai, bj, At, Bt) do { __builtin_amdgcn_s_setprio(1); _Pragma("unroll") for (int m = 0; m < 4; ++m) _Pragma("unroll") for (int n = 0; n < 2; ++n) _Pragma("unroll") for (int k = 0; k < 2; ++k) \
        acc[ai][bj][m][n] = __builtin_amdgcn_mfma_f32_16x16x32_bf16(Bt[n][k], At[m][k], acc[ai][bj][m][n], 0, 0, 0); __builtin_amdgcn_s_setprio(0); } while (0)
#define PG8_WAIT_V(n) asm volatile("s_waitcnt vmcnt(" #n ")" ::: "memory")
#define PG8_WAIT_L(n) asm volatile("s_waitcnt lgkmcnt(" #n ")" ::: "memory")
#define PG8_BAR __builtin_amdgcn_s_barrier()
#define PG8_SCHED __builtin_amdgcn_sched_barrier(0)
    Unit cur, nxt; int ui = 0;
    if (!S.next(0, cur)) return;
    f32x4 acc[2][2][4][2];
#pragma unroll
    for (int a = 0; a < 2; ++a)
#pragma unroll
        for (int b = 0; b < 2; ++b)
#pragma unroll
            for (int m = 0; m < 4; ++m)
#pragma unroll
                for (int n = 0; n < 2; ++n) acc[a][b][m][n] = (f32x4){0.f, 0.f, 0.f, 0.f};
    bf16x8 At[4][2], B0[2][2], B1[2][2];
    const char* cA = (const char*)g.A + (size_t)cur.pm * 2 * hstepA + (size_t)cur.ks * kslice; const char* cB = (const char*)g.Bt + (size_t)cur.pn * 2 * hstepB + (size_t)cur.ks * kslice;
    S.a_ready(cur);
    if constexpr (SP2) {
        PG8_STAGE(PG8_SB(0, 0), cB, voffB); PG8_STAGE(PG8_SB(0, 1), cB + hstepB, voffB); PG8_STAGE(PG8_SA(0, 0), cA, voffA); PG8_STAGE(PG8_SA(0, 1), cA + hstepA, voffA);
        if (wr == 1) PG8_BAR;
        PG8_WAIT_V(2); PG8_BAR;
        PG8_STAGE(PG8_SB(1, 0), cB + kstep, voffB); PG8_STAGE(PG8_SA(1, 0), cA + kstep, voffA); PG8_STAGE(PG8_SB(1, 1), cB + hstepB + kstep, voffB);
        PG8_WAIT_V(6); PG8_BAR;
    } else {
        PG8_STAGE(PG8_SB(0, 0), cB, voffB); PG8_STAGE(PG8_SA(0, 0), cA, voffA); PG8_STAGE(PG8_SB(0, 1), cB + hstepB, voffB); PG8_STAGE(PG8_SA(0, 1), cA + hstepA, voffA);
        if (wr == 1) PG8_BAR;
        PG8_WAIT_V(4); PG8_BAR;
        PG8_STAGE(PG8_SB(1, 0), cB + kstep, voffB); PG8_STAGE(PG8_SA(1, 0), cA + kstep, voffA); PG8_STAGE(PG8_SB(1, 1), cB + hstepB + kstep, voffB);
        PG8_WAIT_V(6); PG8_BAR;
    }
    for (;;) {
        const bool has_next = S.next(ui + 1, nxt);
        const char* nA = has_next ? (const char*)g.A + (size_t)nxt.pm * 2 * hstepA + (size_t)nxt.ks * kslice : cA; const char* nB = has_next ? (const char*)g.Bt + (size_t)nxt.pn * 2 * hstepB + (size_t)nxt.ks * kslice : cB;
        for (int t = 0; t < nt; t += 2) {
            const bool last = (t == nt - 2);
            const char* a1 = cA + (size_t)(t + 1) * kstep;
            const char* a2 = last ? nA : cA + (size_t)(t + 2) * kstep; const char* b2 = last ? nB : cB + (size_t)(t + 2) * kstep;
            const char* a3 = a2 + kstep; const char* b3 = b2 + kstep;
            if (last && has_next) S.a_ready(nxt);
            if constexpr (SP2) {
            PG8_LDB(B0, 0, 0); PG8_LDB(B1, 0, 1); PG8_SCHED; PG8_LDA(At, 0, 0); PG8_STAGE(PG8_SA(1, 1), a1 + hstepA, voffA);
            PG8_WAIT_V(8); PG8_WAIT_L(0); PG8_BAR; PG8_MMA(0, 0, At, B0); PG8_MMA(0, 1, At, B1); PG8_BAR; PG8_SCHED;
            PG8_LDA(At, 0, 1); PG8_STAGE(PG8_SB(0, 0), b2, voffB); PG8_STAGE(PG8_SB(0, 1), b2 + hstepB, voffB); PG8_STAGE(PG8_SA(0, 0), a2, voffA);
            PG8_WAIT_V(8); PG8_WAIT_L(0); PG8_BAR; PG8_MMA(1, 0, At, B0); PG8_MMA(1, 1, At, B1); PG8_BAR; PG8_SCHED;
            PG8_LDB(B0, 1, 0); PG8_LDB(B1, 1, 1); PG8_SCHED; PG8_LDA(At, 1, 0); PG8_STAGE(PG8_SA(0, 1), a2 + hstepA, voffA);
            PG8_WAIT_V(8); PG8_WAIT_L(0); PG8_BAR; PG8_MMA(0, 0, At, B0); PG8_MMA(0, 1, At, B1); PG8_BAR; PG8_SCHED;
            PG8_LDA(At, 1, 1); PG8_STAGE(PG8_SB(1, 0), b3, voffB); PG8_STAGE(PG8_SB(1, 1), b3 + hstepB, voffB); PG8_STAGE(PG8_SA(1, 0), a3, voffA);
            PG8_WAIT_V(8); PG8_WAIT_L(0); PG8_BAR; PG8_MMA(1, 0, At, B0); PG8_MMA(1, 1, At, B1); PG8_BAR; PG8_SCHED;
            } else {
            PG8_LDB(B0, 0, 0); PG8_SCHED; PG8_LDA(At, 0, 0); PG8_STAGE(PG8_SA(1, 1), a1 + hstepA, voffA);
            PG8_WAIT_L(8); PG8_BAR; PG8_WAIT_L(0); PG8_MMA(0, 0, At, B0); PG8_BAR; PG8_SCHED;
            PG8_LDB(B1, 0, 1); PG8_STAGE(PG8_SB(0, 0), b2, voffB);
            PG8_BAR; PG8_WAIT_L(0); PG8_MMA(0, 1, At, B1); PG8_BAR;
            PG8_LDA(At, 0, 1); PG8_STAGE(PG8_SA(0, 0), a2, voffA);
            PG8_BAR; PG8_WAIT_L(0); PG8_MMA(1, 0, At, B0); PG8_BAR; PG8_SCHED;
            PG8_STAGE(PG8_SB(0, 1), b2 + hstepB, voffB);
            PG8_WAIT_V(6); PG8_BAR; PG8_MMA(1, 1, At, B1); PG8_BAR;
            PG8_LDB(B0, 1, 0); PG8_SCHED; PG8_LDA(At, 1, 0); PG8_STAGE(PG8_SA(0, 1), a2 + hstepA, voffA);
            PG8_WAIT_L(8); PG8_BAR; PG8_WAIT_L(0); PG8_MMA(0, 0, At, B0); PG8_BAR; PG8_SCHED;
            PG8_LDB(B1, 1, 1); PG8_STAGE(PG8_SB(1, 0), b3, voffB);
            PG8_BAR; PG8_WAIT_L(0); PG8_MMA(0, 1, At, B1); PG8_BAR;
            PG8_LDA(At, 1, 1); PG8_STAGE(PG8_SA(1, 0), a3, voffA);
            PG8_BAR; PG8_WAIT_L(0); PG8_MMA(1, 0, At, B0); PG8_BAR; PG8_SCHED;
            PG8_STAGE(PG8_SB(1, 1), b3 + hstepB, voffB);
            PG8_WAIT_V(6); PG8_BAR; PG8_MMA(1, 1, At, B1); PG8_BAR;
            }
        }
        if constexpr (ALIGN_EPI) { if (wr == 0) PG8_BAR; }
        if constexpr (!Epi::AFTER_DRAIN) { E(acc, cur, wr, wc, fr, fq); S.done(cur); }
        if (!has_next) break;
#pragma unroll
        for (int a = 0; a < 2; ++a)
#pragma unroll
            for (int b = 0; b < 2; ++b)
#pragma unroll
                for (int m = 0; m < 4; ++m)
#pragma unroll
                    for (int n = 0; n < 2; ++n) acc[a][b][m][n] = (f32x4){0.f, 0.f, 0.f, 0.f};
        cur = nxt; cA = nA; cB = nB; ++ui;
        if constexpr (ALIGN_EPI) { if (wr == 1) PG8_BAR; }
    }
    PG8_WAIT_V(0);
    if constexpr (!ALIGN_EPI) { if (wr == 0) PG8_BAR; }
    PG8_BAR;
    if constexpr (Epi::AFTER_DRAIN) { E.fused(acc, cur, wr, wc, fr, fq, lds, wid, lane); S.done(cur); }
#undef PG8_SA
#undef PG8_SB
#undef PG8_STAGE
#undef PG8_LDA
#undef PG8_LDB
#undef PG8_MMA
#undef PG8_WAIT_V
#undef PG8_WAIT_L
#undef PG8_BAR
#undef PG8_SCHED
}
}

using pg8::bf16_t; using pg8::bf16x8; using pg8::f32x4; using pg8::u32x4; using pg8::u32x2; using pg8::cvt_pk_bf16;
#define LAS __attribute__((address_space(3)))
#define XB_TMO      128
#define XB_XCNT(j)  (256  + 64 * (j))
#define XB_XSUB(j)  (1280 + 64 * (j))
#define XB_XGEN(j)  (2304 + 64 * (j))
#define XB_TOP      3328
#define XB_TOPGEN   3392
#define XCD_BAR_WORDS 3456
#define XB_SPIN_CAP (1u << 18)

__device__ __forceinline__ unsigned xb_ld(unsigned* p)              { return __hip_atomic_load(p, __ATOMIC_RELAXED, __HIP_MEMORY_SCOPE_AGENT); }
__device__ __forceinline__ unsigned xb_add(unsigned* p, unsigned v) { return __hip_atomic_fetch_add(p, v, __ATOMIC_RELAXED, __HIP_MEMORY_SCOPE_AGENT); }
__device__ __forceinline__ unsigned xb_xcc_id() { return (unsigned)__builtin_amdgcn_s_getreg((3 << 11) | 20) & 0xFu; }
#define XB_SPIN(cond, bar) do { unsigned _sp = 0; while (cond) { __builtin_amdgcn_s_sleep(1); \
    if ((++_sp & 255u) == 0u) { if (xb_ld(&(bar)[XB_TMO])) break; if (_sp > XB_SPIN_CAP) { atomicAdd(&(bar)[XB_TMO], 1u); break; } } } } while (0)

struct XcdBarrier {
    unsigned* bar; unsigned x;
    volatile LAS unsigned* st;
};

__device__ __forceinline__ XcdBarrier xcd_barrier_post(unsigned* bar, volatile LAS unsigned* st) {
    XcdBarrier b; b.bar = bar; b.x = xb_xcc_id(); b.st = st;
    if (threadIdx.x == 0) (void)xb_add(&bar[XB_XCNT(b.x)], 1u);
    return b;
}
__device__ __forceinline__ void xcd_barrier_complete(unsigned* bar, unsigned x, unsigned& nloc, unsigned& nx) {
    const unsigned G = gridDim.x * gridDim.y * gridDim.z;
    unsigned sum, cnt, mine, sp = 0u;
    for (;;) {
        sum = 0u; cnt = 0u; mine = 0u;
#pragma unroll
        for (unsigned j = 0; j < 16; ++j) { const unsigned c = xb_ld(&bar[XB_XCNT(j)]); sum += c; cnt += (c > 0u) ? 1u : 0u; mine = (j == x) ? c : mine; }
        if (sum == G) break;
        __builtin_amdgcn_s_sleep(1);
        if ((++sp & 255u) == 0u) { if (xb_ld(&bar[XB_TMO])) break; if (sp > XB_SPIN_CAP) { atomicAdd(&bar[XB_TMO], 1u); break; } }
    }
    nloc = mine > 0u ? mine : 1u; nx = cnt > 0u ? cnt : 1u;
}

__device__ __forceinline__ void xcd_barrier(const XcdBarrier& b) {
    asm volatile("s_waitcnt vmcnt(0)" ::: "memory");
    __syncthreads();
    if (threadIdx.x == 0) {
        unsigned* bar = b.bar;
        __builtin_amdgcn_s_waitcnt(0);
        unsigned nloc = b.st[0], nx = b.st[1];
        if (nloc == 0u) { xcd_barrier_complete(bar, b.x, nloc, nx); b.st[0] = nloc; b.st[1] = nx; }
        const unsigned old = xb_add(&bar[XB_XSUB(b.x)], 1u);
        const unsigned gen = old / nloc;
        if (old + 1u == (gen + 1u) * nloc) {
            __builtin_amdgcn_fence(__ATOMIC_RELEASE, "agent");
            asm volatile("s_waitcnt vmcnt(0)" ::: "memory");
            const unsigned og = xb_add(&bar[XB_TOP], 1u);
            const unsigned tg = og / nx;
            if (og + 1u == (tg + 1u) * nx) xb_add(&bar[XB_TOPGEN], 1u);
            else XB_SPIN(xb_ld(&bar[XB_TOPGEN]) == tg, bar);
            __builtin_amdgcn_fence(__ATOMIC_ACQUIRE, "agent");
            xb_add(&bar[XB_XGEN(b.x)], 1u);
            asm volatile("s_waitcnt vmcnt(0)" ::: "memory");
        } else {
            XB_SPIN(xb_ld(&bar[XB_XGEN(b.x)]) == gen, bar);
            __builtin_amdgcn_fence(__ATOMIC_ACQUIRE, "agent");
            asm volatile("s_waitcnt vmcnt(0)" ::: "memory");
        }
    }
    __syncthreads();
}


#ifndef MK_DUP
#define MK_DUP 0u
#endif
#ifndef MK_COOP
#define MK_COOP 1
#endif
constexpr int M_ = 17408, MP_ = 16384, DM = 1024, FF = 2816, NGU = 5632, NIN = 2560, PLE = 256;
constexpr float EPS_ = 1e-6f;
constexpr int LDS_BYTES = 147456;
constexpr int NPHASE = 14;
constexpr size_t WS_WGU1 = 0;
constexpr size_t WS_WD1 = WS_WGU1 + (size_t)NGU * DM * 2;
constexpr size_t WS_WIN = WS_WD1 + (size_t)DM * FF * 2;
constexpr size_t WS_WOUT = WS_WIN + (size_t)NIN * DM * 2;
constexpr size_t WS_WGU2 = WS_WOUT + (size_t)DM * DM * 2;
constexpr size_t WS_WD2 = WS_WGU2 + (size_t)NGU * DM * 2;
constexpr size_t WS_WPG = WS_WD2 + (size_t)DM * FF * 2;
constexpr size_t WS_WPP = WS_WPG + (size_t)DM * DM * 2;
constexpr size_t WS_XN = WS_WPP + (size_t)DM * PLE * 2;
constexpr size_t WS_ACT = WS_XN + (size_t)M_ * DM * 2;
constexpr size_t WS_D = WS_ACT + (size_t)M_ * FF * 2;
constexpr size_t WS_SLAB = WS_D + (size_t)M_ * DM * 2;
constexpr size_t WS_END = WS_SLAB + (size_t)11 * 1024 * 1024 * 4;
constexpr size_t WS_BAR = WS_END;
constexpr size_t WS_TOTAL = WS_BAR + (size_t)XCD_BAR_WORDS * 4;
constexpr size_t WS_PROJ = WS_ACT;
constexpr size_t WS_PP = WS_ACT;
constexpr size_t WS_PB = WS_ACT + (size_t)M_ * DM * 4;
static_assert(WS_PB + (size_t)M_ * PLE * 2 <= WS_D, "aliases fit");
constexpr size_t OUT_NCP = 17825792, OUT_NCS = 17833984, OUT_CVP = 17965056, OUT_CVS = 18489344;

struct Args { const float* in[28]; float* out; unsigned char* ws; int ph_lo, ph_hi; };

__device__ __forceinline__ float wave_sum(float v) {
#pragma unroll
    for (int o = 1; o < 64; o <<= 1) v += __shfl_xor(v, o);
    return v;
}
__device__ __forceinline__ float bf_lo(unsigned w) { return __uint_as_float(w << 16); }
__device__ __forceinline__ float bf_hi(unsigned w) { return __uint_as_float(w & 0xffff0000u); }
__device__ __forceinline__ float dot4(f32x4 a) { return (a.x * a.x + a.y * a.y) + (a.z * a.z + a.w * a.w); }
#define LDS_WAIT() asm volatile("s_waitcnt lgkmcnt(0)" ::: "memory")

__device__ __forceinline__ void transpose_item(const float* __restrict__ W, int K, int N, bf16_t* __restrict__ WT, int k0, int n0, int drow0, LAS float* scr, int lane) {
#pragma unroll 8
    for (int i = 0; i < 32; ++i) { const int kk = 2 * i + (lane >> 5); scr[kk * 33 + (lane & 31)] = W[(size_t)(k0 + kk) * N + n0 + (lane & 31)]; }
    LDS_WAIT();
    const int c = lane & 7;
#pragma unroll
    for (int j = 0; j < 4; ++j) { const int n = (lane >> 3) + 8 * j; const LAS float* s = scr + (8 * c) * 33 + n;
        u32x4 o; o.x = cvt_pk_bf16(s[0 * 33], s[1 * 33]); o.y = cvt_pk_bf16(s[2 * 33], s[3 * 33]); o.z = cvt_pk_bf16(s[4 * 33], s[5 * 33]); o.w = cvt_pk_bf16(s[6 * 33], s[7 * 33]);
        *(u32x4*)(WT + (size_t)(drow0 + n) * K + k0 + 8 * c) = o; }
    LDS_WAIT();
}

__device__ __forceinline__ f32x4 bf4(unsigned a, unsigned b) { return (f32x4){bf_lo(a), bf_hi(a), bf_lo(b), bf_hi(b)}; }
template <int MODE>
__device__ __forceinline__ void rowpass(const bf16_t* __restrict__ dbuf, const float* __restrict__ slab, int nsl, const float* __restrict__ pp, const float* resP, const float* resS, float* hout, bf16_t* __restrict__ xn,
                                        const float* __restrict__ gpost, float sc, const float* __restrict__ gnext, int gw, int NGW, int lane) {
    f32x4 gp[4], gn[4];
#pragma unroll
    for (int j = 0; j < 4; ++j) { gp[j] = (MODE & 1) ? ((const f32x4*)gpost)[lane + 64 * j] : (f32x4){0.f, 0.f, 0.f, 0.f}; gn[j] = (MODE & 4) ? ((const f32x4*)gnext)[lane + 64 * j] : (f32x4){0.f, 0.f, 0.f, 0.f}; }
    for (int m = gw; m < M_; m += NGW) {
        const float* rrow = (m < MP_) ? resP + (size_t)m * DM : resS + (size_t)(m - MP_) * DM;
        f32x4 h[4];
#pragma unroll
        for (int j = 0; j < 4; ++j) h[j] = ((const f32x4*)rrow)[lane + 64 * j];
        if (MODE & 1) {
            f32x4 d[4]; float ss = 0.f;
            if (m < MP_) { const u32x2* dr = (const u32x2*)(dbuf + (size_t)m * DM) + lane;
#pragma unroll
                for (int j = 0; j < 4; ++j) { const u32x2 w = dr[64 * j]; d[j] = bf4(w.x, w.y); } }
            else { const f32x4* sr = (const f32x4*)(slab + (size_t)(m - MP_) * DM) + lane;
#pragma unroll
                for (int j = 0; j < 4; ++j) d[j] = sr[64 * j];
                for (int s = 1; s < nsl; ++s) { sr += (1 << 18);
#pragma unroll
                    for (int j = 0; j < 4; ++j) d[j] += sr[64 * j]; }
                if (MODE & 16) { const f32x4* pr = (const f32x4*)(pp + (size_t)m * DM) + lane;
#pragma unroll
                    for (int j = 0; j < 4; ++j) { const f32x4 p = pr[64 * j]; d[j].x = pg8::sigmoid_f(d[j].x) * p.x; d[j].y = pg8::sigmoid_f(d[j].y) * p.y; d[j].z = pg8::sigmoid_f(d[j].z) * p.z; d[j].w = pg8::sigmoid_f(d[j].w) * p.w; } } }
#pragma unroll
            for (int j = 0; j < 4; ++j) ss += dot4(d[j]);
            const float rs = sc * rsqrtf(wave_sum(ss) * (1.0f / DM) + EPS_);
#pragma unroll
            for (int j = 0; j < 4; ++j) h[j] += d[j] * rs * gp[j];
        }
        if (MODE & 2) { f32x4* ho = (f32x4*)(hout + (size_t)m * DM) + lane;
#pragma unroll
            for (int j = 0; j < 4; ++j) ho[64 * j] = h[j]; }
        if (MODE & 4) {
            float s2 = 0.f;
#pragma unroll
            for (int j = 0; j < 4; ++j) s2 += dot4(h[j]);
            const float rs2 = rsqrtf(wave_sum(s2) * (1.0f / DM) + EPS_);
            u32x2* o = (u32x2*)(xn + (size_t)m * DM) + lane;
#pragma unroll
            for (int j = 0; j < 4; ++j) { const f32x4 v = h[j] * rs2 * gn[j]; u32x2 w; w.x = cvt_pk_bf16(v.x, v.y); w.y = cvt_pk_bf16(v.z, v.w); o[64 * j] = w; }
        } else if (MODE & 8) {
            u32x2* o = (u32x2*)(xn + (size_t)m * DM) + lane;
#pragma unroll
            for (int j = 0; j < 4; ++j) { const f32x4 v = h[j]; u32x2 w; w.x = cvt_pk_bf16(v.x, v.y); w.y = cvt_pk_bf16(v.z, v.w); o[64 * j] = w; }
        }
    }
}

__device__ __forceinline__ void mixer_phase(const Args& a, LAS unsigned char* lds, const bf16_t* __restrict__ PROJ, bf16_t* __restrict__ YC, int wave, int lane) {
    constexpr int VP = 272;
    LAS float* part = (LAS float*)(lds + 512 * VP);
    const int fr = lane & 15, fq = lane >> 4;
    const float* __restrict__ wsm = a.in[15]; const float* __restrict__ bsm = a.in[16];
    float* out = a.out;
    for (int u = blockIdx.x; u < 272; u += gridDim.x) {
        const bool samp = (u >= 256);
        const int R0 = u * 64;
        int s0 = 0, t0 = 0;
        if (!samp) { s0 = (u & 31) * 64; t0 = s0 & 127; }
        const int CB = R0 - t0, kext = t0 + 64;
        {
            const f32x4 vg0 = *(const f32x4*)(a.in[14] + lane * 8), vg1 = *(const f32x4*)(a.in[14] + lane * 8 + 4);
            for (int s = wave; s < kext; s += 8) {
                const int row = CB + s;
                const u32x4 raw = *(const u32x4*)(PROJ + (size_t)row * NIN + 2048 + lane * 8);
                f32x4 v0 = bf4(raw.x, raw.y), v1 = bf4(raw.z, raw.w);
                float ss = dot4(v0) + dot4(v1);
                ss += __shfl_xor(ss, 1); ss += __shfl_xor(ss, 2); ss += __shfl_xor(ss, 4);
                const float rs = rsqrtf(ss * (1.0f / 64.0f) + EPS_);
                v0 = v0 * rs * vg0; v1 = v1 * rs * vg1;
                LAS bf16_t* dst = (LAS bf16_t*)(lds + (lane * 8) * VP + s * 2);
                const unsigned p0 = cvt_pk_bf16(v0.x, v0.y), p1 = cvt_pk_bf16(v0.z, v0.w), p2 = cvt_pk_bf16(v1.x, v1.y), p3 = cvt_pk_bf16(v1.z, v1.w);
                dst[0 * (VP / 2)] = (bf16_t)(p0 & 0xffffu); dst[1 * (VP / 2)] = (bf16_t)(p0 >> 16);
                dst[2 * (VP / 2)] = (bf16_t)(p1 & 0xffffu); dst[3 * (VP / 2)] = (bf16_t)(p1 >> 16);
                dst[4 * (VP / 2)] = (bf16_t)(p2 & 0xffffu); dst[5 * (VP / 2)] = (bf16_t)(p2 >> 16);
                dst[6 * (VP / 2)] = (bf16_t)(p3 & 0xffffu); dst[7 * (VP / 2)] = (bf16_t)(p3 >> 16);
                if (s >= t0) {
                    if (samp) { float* o = out + OUT_CVS + (size_t)(row - MP_) * 512 + lane * 8; *(f32x4*)o = v0; *(f32x4*)(o + 4) = v1; }
                    else if (s0 - t0 == 1920) { float* o = out + OUT_CVP + (size_t)((u >> 5) * 128 + s) * 512 + lane * 8; *(f32x4*)o = v0; *(f32x4*)(o + 4) = v1; }
                }
            }
        }
        __syncthreads();
        const int h = wave;
        f32x4 acc[4][4];
#pragma unroll
        for (int i = 0; i < 4; ++i)
#pragma unroll
            for (int j = 0; j < 4; ++j) acc[i][j] = (f32x4){0.f, 0.f, 0.f, 0.f};
        const int nkb = kext >> 5;
        for (int kb = 0; kb < nkb; ++kb) {
            bf16x8 af[4];
#pragma unroll
            for (int tb = 0; tb < 4; ++tb) {
                f32x4 w0, w1; int lim;
                if (!samp) { const int tt = t0 + tb * 16 + fr, sb = kb * 32 + fq * 8; const float* wp = wsm + (size_t)(h * 128 + tt) * 128 + sb;
                    w0 = *(const f32x4*)wp; w1 = *(const f32x4*)(wp + 4); lim = tt - sb; }
                else { const int tt = fr & 7; const float* wp = wsm + (size_t)(h * 128 + tt) * 128;
                    w0 = *(const f32x4*)wp; w1 = *(const f32x4*)(wp + 4); lim = ((kb * 4 + fq) == (tb * 2 + (fr >> 3))) ? tt : -1; }
                w0.x = (0 <= lim) ? w0.x : 0.f; w0.y = (1 <= lim) ? w0.y : 0.f; w0.z = (2 <= lim) ? w0.z : 0.f; w0.w = (3 <= lim) ? w0.w : 0.f;
                w1.x = (4 <= lim) ? w1.x : 0.f; w1.y = (5 <= lim) ? w1.y : 0.f; w1.z = (6 <= lim) ? w1.z : 0.f; w1.w = (7 <= lim) ? w1.w : 0.f;
                u32x4 pk; pk.x = cvt_pk_bf16(w0.x, w0.y); pk.y = cvt_pk_bf16(w0.z, w0.w); pk.z = cvt_pk_bf16(w1.x, w1.y); pk.w = cvt_pk_bf16(w1.z, w1.w);
                af[tb] = __builtin_bit_cast(bf16x8, pk);
            }
#pragma unroll
            for (int db = 0; db < 4; ++db) {
                const bf16x8 bfv = *(const LAS bf16x8*)(lds + (h * 64 + db * 16 + fr) * VP + (kb * 32 + fq * 8) * 2);
#pragma unroll
                for (int tb = 0; tb < 4; ++tb) acc[tb][db] = __builtin_amdgcn_mfma_f32_16x16x32_bf16(bfv, af[tb], acc[tb][db], 0, 0, 0);
            }
        }
#pragma unroll
        for (int tb = 0; tb < 4; ++tb) {
            const int t = tb * 16 + fr; const int tt = samp ? (fr & 7) : (t0 + t); const float bias = bsm[h * 128 + tt];
            const bf16_t* up = PROJ + (size_t)(R0 + t) * NIN + 1536 + h * 64 + fq * 4;
            float s = 0.f;
#pragma unroll
            for (int db = 0; db < 4; ++db) { const u32x2 ur = *(const u32x2*)(up + db * 16); const f32x4 uu = bf4(ur.x, ur.y);
                const f32x4 y = uu * (acc[tb][db] + bias); acc[tb][db] = y; s += dot4(y); }
            s += __shfl_xor(s, 16); s += __shfl_xor(s, 32);
            if (fq == 0) part[h * 64 + t] = s;
        }
        __syncthreads();
#pragma unroll
        for (int tb = 0; tb < 4; ++tb) {
            const int t = tb * 16 + fr; float tot = 0.f;
#pragma unroll
            for (int hh = 0; hh < 8; ++hh) tot += part[hh * 64 + t];
            const float rs = rsqrtf(tot * (1.0f / 512.0f) + EPS_);
            bf16_t* yp = YC + (size_t)(R0 + t) * DM + 512 + h * 64 + fq * 4;
#pragma unroll
            for (int db = 0; db < 4; ++db) { const f32x4 gb = *(const f32x4*)(a.in[18] + h * 64 + db * 16 + fq * 4); const f32x4 y = acc[tb][db] * rs * gb;
                u32x2 w; w.x = cvt_pk_bf16(y.x, y.y); w.y = cvt_pk_bf16(y.z, y.w); *(u32x2*)(yp + db * 16) = w; }
        }
        {
            const int c0 = lane * 8; const float* cw = a.in[13];
            const f32x4 w0a = *(const f32x4*)(cw + c0), w0b = *(const f32x4*)(cw + c0 + 4), w1a = *(const f32x4*)(cw + 512 + c0), w1b = *(const f32x4*)(cw + 512 + c0 + 4),
                        w2a = *(const f32x4*)(cw + 1024 + c0), w2b = *(const f32x4*)(cw + 1024 + c0 + 4);
            const f32x4 gaa = *(const f32x4*)(a.in[17] + c0), gab = *(const f32x4*)(a.in[17] + c0 + 4);
            f32x4 zp2a = {0.f, 0.f, 0.f, 0.f}, zp2b = zp2a, zp1a = zp2a, zp1b = zp2a;
            const int rb = R0 + wave * 8; const int sb_ = (u - 256) * 8 + wave;
            if (samp) { const float* st = a.in[4] + (size_t)sb_ * 1024 + c0; zp2a = *(const f32x4*)st; zp2b = *(const f32x4*)(st + 4); zp1a = *(const f32x4*)(st + 512); zp1b = *(const f32x4*)(st + 516); }
            else if (s0 + wave * 8 > 0) {
                const bf16_t* p2 = PROJ + (size_t)(rb - 2) * NIN + c0; const bf16_t* p1 = p2 + NIN;
                const u32x4 c2 = *(const u32x4*)(p2 + 512), h2 = *(const u32x4*)(p2 + 1024), c1 = *(const u32x4*)(p1 + 512), h1 = *(const u32x4*)(p1 + 1024);
                zp2a = bf4(c2.x, c2.y) * bf4(h2.x, h2.y); zp2b = bf4(c2.z, c2.w) * bf4(h2.z, h2.w); zp1a = bf4(c1.x, c1.y) * bf4(h1.x, h1.y); zp1b = bf4(c1.z, c1.w) * bf4(h1.z, h1.w);
            }
            f32x4 ya[8], yb[8]; float ss[8];
#pragma unroll
            for (int i = 0; i < 8; ++i) {
                const bf16_t* pr = PROJ + (size_t)(rb + i) * NIN + c0;
                const u32x4 braw = *(const u32x4*)pr, craw = *(const u32x4*)(pr + 512), hraw = *(const u32x4*)(pr + 1024);
                const f32x4 za = bf4(craw.x, craw.y) * bf4(hraw.x, hraw.y), zb = bf4(craw.z, craw.w) * bf4(hraw.z, hraw.w);
                const f32x4 ca = w0a * zp2a + w1a * zp1a + w2a * za, cb = w0b * zp2b + w1b * zp1b + w2b * zb;
                ya[i] = bf4(braw.x, braw.y) * ca; yb[i] = bf4(braw.z, braw.w) * cb;
                ss[i] = wave_sum(dot4(ya[i]) + dot4(yb[i]));
                if (i >= 6) {
                    if (samp) { float* o = out + OUT_NCS + ((size_t)sb_ * 2 + (i - 6)) * 512 + c0; *(f32x4*)o = za; *(f32x4*)(o + 4) = zb; }
                    else if ((u & 31) == 31 && wave == 7) { float* o = out + OUT_NCP + ((size_t)(u >> 5) * 2 + (i - 6)) * 512 + c0; *(f32x4*)o = za; *(f32x4*)(o + 4) = zb; }
                }
                zp2a = zp1a; zp2b = zp1b; zp1a = za; zp1b = zb;
            }
#pragma unroll
            for (int i = 0; i < 8; ++i) {
                const float rs = rsqrtf(ss[i] * (1.0f / 512.0f) + EPS_);
                const f32x4 y0 = ya[i] * rs * gaa, y1 = yb[i] * rs * gab;
                u32x4 w; w.x = cvt_pk_bf16(y0.x, y0.y); w.y = cvt_pk_bf16(y0.z, y0.w); w.z = cvt_pk_bf16(y1.x, y1.y); w.w = cvt_pk_bf16(y1.z, y1.w);
                *(u32x4*)(YC + (size_t)(rb + i) * DM + c0) = w;
            }
        }
        __syncthreads();
    }
}

__device__ __forceinline__ int fresh_tid() { int t = threadIdx.x; asm volatile("" : "+v"(t)); return t; }
template <bool COOP>
__global__ void __launch_bounds__(512, 2) fwd_kernel(Args a) {
    extern __shared__ __attribute__((aligned(16))) unsigned char lds_raw[];
    LAS unsigned char* lds = (LAS unsigned char*)lds_raw;
    const int tid = threadIdx.x;
    const int G = gridDim.x, NGW = G * 8;
#define LANE_ (fresh_tid() & 63)
#define WAVE_ (__builtin_amdgcn_readfirstlane(fresh_tid() >> 6))
#define GW_ ((int)blockIdx.x * 8 + WAVE_)
    unsigned char* ws = a.ws;
    bf16_t* WGU1 = (bf16_t*)(ws + WS_WGU1); bf16_t* WD1 = (bf16_t*)(ws + WS_WD1); bf16_t* WIN = (bf16_t*)(ws + WS_WIN); bf16_t* WOUT = (bf16_t*)(ws + WS_WOUT);
    bf16_t* WGU2 = (bf16_t*)(ws + WS_WGU2); bf16_t* WD2 = (bf16_t*)(ws + WS_WD2); bf16_t* WPG = (bf16_t*)(ws + WS_WPG); bf16_t* WPP = (bf16_t*)(ws + WS_WPP);
    bf16_t* XN = (bf16_t*)(ws + WS_XN); bf16_t* ACT = (bf16_t*)(ws + WS_ACT); bf16_t* PROJ = (bf16_t*)(ws + WS_PROJ); bf16_t* PB = (bf16_t*)(ws + WS_PB);
    bf16_t* DB = (bf16_t*)(ws + WS_D); float* SLAB = (float*)(ws + WS_SLAB); float* PP = (float*)(ws + WS_PP);
    float* H = a.out;
#define IN(k) (a.ph_lo <= (k) && (k) < a.ph_hi)
#define REP(k) for (int rep_ = 0; rep_ < (((MK_DUP >> (k)) & 1u) ? 2 : 1); ++rep_)
    XcdBarrier bar; bar.bar = (unsigned*)(ws + WS_BAR); bar.x = 0; bar.st = nullptr;
    if (COOP) {
        volatile LAS unsigned* st = (volatile LAS unsigned*)(lds + LDS_BYTES - 16);
        if (tid < 4) st[tid] = 0u;
        __syncthreads();
        bar = xcd_barrier_post((unsigned*)(ws + WS_BAR), st);
        if (a.ph_lo < 0) cg::this_grid().sync();
    }
#define SEAM(k) do { if (COOP && IN(k) && IN((k) + 1)) xcd_barrier(bar); } while (0)

    if (IN(0)) REP(0) {
        const int lane = LANE_, wave = WAVE_, gw = GW_; LAS float* scr = (LAS float*)(lds + wave * 8448);
        constexpr int I_G = (DM / 64) * (FF / 32), I_D = (FF / 64) * (DM / 32), I_IN = (DM / 64) * (NIN / 32), I_O = (DM / 64) * (DM / 32), I_PP = (PLE / 64) * (DM / 32);
        constexpr int NITEMS = 4 * I_G + 2 * I_D + I_IN + 2 * I_O + I_PP;
        for (int it = gw; it < NITEMS; it += NGW) {
            int r = it; const float* W; int K, N; bf16_t* WT; int mode = 0;
            if (r < I_G) { W = a.in[7]; K = DM; N = FF; WT = WGU1; mode = 1; }
            else if ((r -= I_G) < I_G) { W = a.in[8]; K = DM; N = FF; WT = WGU1; mode = 2; }
            else if ((r -= I_G) < I_G) { W = a.in[22]; K = DM; N = FF; WT = WGU2; mode = 1; }
            else if ((r -= I_G) < I_G) { W = a.in[23]; K = DM; N = FF; WT = WGU2; mode = 2; }
            else if ((r -= I_G) < I_D) { W = a.in[9]; K = FF; N = DM; WT = WD1; }
            else if ((r -= I_D) < I_D) { W = a.in[24]; K = FF; N = DM; WT = WD2; }
            else if ((r -= I_D) < I_IN) { W = a.in[12]; K = DM; N = NIN; WT = WIN; }
            else if ((r -= I_IN) < I_O) { W = a.in[19]; K = DM; N = DM; WT = WOUT; }
            else if ((r -= I_O) < I_O) { W = a.in[25]; K = DM; N = DM; WT = WPG; }
            else { r -= I_O; W = a.in[26]; K = PLE; N = DM; WT = WPP; }
            const int nblk = N / 32, kb = r / nblk, nb = r % nblk, k0 = 64 * kb, n0 = 32 * nb;
            int drow0 = n0; if (mode) drow0 = (n0 >> 7) * 256 + (n0 & 127) + (mode == 2 ? 128 : 0);
            transpose_item(W, K, N, WT, k0, n0, drow0, scr, lane);
        }
        rowpass<4>(nullptr, nullptr, 0, nullptr, a.in[0], a.in[1], nullptr, XN, nullptr, 0.f, a.in[5], gw, NGW, lane);
    }
    SEAM(0);
    const int bid = (int)blockIdx.x;
#define GEMM_FULL(EPI, Aop, Bop, KK, MM, NN, ...) do { pg8::Gemm g_{Aop, Bop, KK, KK}; pg8::StaticOrder S_; S_.init(MM, NN, G, bid); pg8::EPI E_{__VA_ARGS__}; \
        pg8::gemm_phase<pg8::EPI, pg8::StaticOrder, true, true>(lds, g_, S_, E_); } while (0)
#define GEMM_SPLIT(Aop, Bop, KK, NSL, ROT) do { pg8::Gemm g_{Aop, Bop, KK, 256}; pg8::SubOrder S_{64, 4, 4, NSL, G, (bid + (ROT)) % G}; pg8::EpiF32Slab E_{SLAB, 64}; \
        pg8::gemm_phase<pg8::EpiF32Slab, pg8::SubOrder, true, true>(lds, g_, S_, E_); } while (0)
    if (IN(1)) REP(1) GEMM_FULL(EpiSwiglu, XN, WGU1, DM, M_, NGU, ACT, FF);
    SEAM(1);
    if (IN(2)) REP(2) { GEMM_FULL(EpiBf16, ACT, WD1, FF, MP_, DM, DB, DM); GEMM_SPLIT(ACT, WD1, FF, 11, 0); }
    SEAM(2);
    if (IN(3)) REP(3) rowpass<1 | 2 | 4>(DB, SLAB, 11, nullptr, a.in[0], a.in[1], H, XN, a.in[6], 0.5f, a.in[10], GW_, NGW, LANE_);
    SEAM(3);
    if (IN(4)) REP(4) GEMM_FULL(EpiBf16, XN, WIN, DM, M_, NIN, PROJ, NIN);
    SEAM(4);
    if (IN(5)) REP(5) mixer_phase(a, lds, PROJ, XN, WAVE_, LANE_);
    SEAM(5);
    if (IN(6)) REP(6) { GEMM_FULL(EpiBf16, XN, WOUT, DM, MP_, DM, DB, DM); GEMM_SPLIT(XN, WOUT, DM, 4, 0); }
    SEAM(6);
    if (IN(7)) rowpass<1 | 2 | 4>(DB, SLAB, 4, nullptr, H, H + (size_t)MP_ * DM, H, XN, a.in[11], 1.0f, a.in[20], GW_, NGW, LANE_);
    SEAM(7);
    if (IN(8)) REP(8) GEMM_FULL(EpiSwiglu, XN, WGU2, DM, M_, NGU, ACT, FF);
    SEAM(8);
    if (IN(9)) REP(9) { GEMM_FULL(EpiBf16, ACT, WD2, FF, MP_, DM, DB, DM); GEMM_SPLIT(ACT, WD2, FF, 11, 0); }
    SEAM(9);
    if (IN(10)) {
        rowpass<1 | 2 | 8>(DB, SLAB, 11, nullptr, H, H + (size_t)MP_ * DM, H, XN, a.in[21], 0.5f, nullptr, GW_, NGW, LANE_);
        const int lane = LANE_, gw = GW_;
        for (int m = gw; m < M_; m += NGW) { const float* pr = (m < MP_) ? a.in[2] + (size_t)m * PLE : a.in[3] + (size_t)(m - MP_) * PLE;
            const f32x4 v = ((const f32x4*)pr)[lane]; u32x2 w; w.x = cvt_pk_bf16(v.x, v.y); w.y = cvt_pk_bf16(v.z, v.w); ((u32x2*)(PB + (size_t)m * PLE))[lane] = w; }
    }
    SEAM(10);
    if (IN(11)) REP(11) { GEMM_FULL(EpiF32, PB, WPP, PLE, MP_, DM, PP, DM);
        { pg8::Gemm g_{PB, WPP, PLE, PLE}; pg8::SubOrder S_{64, 4, 4, 1, G, (bid >= 64 && bid < 80) ? bid - 64 : -1}; pg8::EpiF32 E_{PP, DM};
          pg8::gemm_phase<pg8::EpiF32, pg8::SubOrder, true, true>(lds, g_, S_, E_); } }
    if (IN(12)) REP(12) { GEMM_FULL(EpiPle, XN, WPG, DM, MP_, DM, DB, PP, DM); GEMM_SPLIT(XN, WPG, DM, 4, 0); }
    SEAM(12);
    if (IN(13)) rowpass<1 | 2 | 16>(DB, SLAB, 4, PP, H, H + (size_t)MP_ * DM, H, nullptr, a.in[27], 1.0f, nullptr, GW_, NGW, LANE_);
#undef IN
#undef SEAM
}

extern "C" void kernel_launch(void* const* d_in, const int* in_sizes, int n_in, void* d_out, int out_size, void* d_ws, size_t ws_size, hipStream_t stream) {
    static int grid = 0;
    if (grid == 0) {
        if (n_in != 28 || out_size != 19013632 || ws_size < WS_TOTAL) { fprintf(stderr, "kernel_launch: unexpected shapes: n_in %d out %d ws %zu (need %zu)\n", n_in, out_size, ws_size, (size_t)WS_TOTAL); grid = -1; return; }
        int dev = 0, cus = 0, per_cu = 0;
        if (hipGetDevice(&dev) != hipSuccess || hipDeviceGetAttribute(&cus, hipDeviceAttributeMultiprocessorCount, dev) != hipSuccess) { fprintf(stderr, "kernel_launch: device query failed\n"); grid = -1; return; }
        if (hipFuncSetAttribute((const void*)fwd_kernel<true>, hipFuncAttributeMaxDynamicSharedMemorySize, LDS_BYTES) != hipSuccess ||
            hipFuncSetAttribute((const void*)fwd_kernel<false>, hipFuncAttributeMaxDynamicSharedMemorySize, LDS_BYTES) != hipSuccess) { fprintf(stderr, "kernel_launch: hipFuncSetAttribute failed\n"); grid = -1; return; }
        if (hipOccupancyMaxActiveBlocksPerMultiprocessor(&per_cu, (const void*)fwd_kernel<true>, 512, LDS_BYTES) != hipSuccess || per_cu < 1) { fprintf(stderr, "kernel_launch: occupancy query says %d blocks per CU\n", per_cu); per_cu = 1; }
        (void)hipGetLastError();
        grid = cus * per_cu;
        fprintf(stderr, "kernel_launch: grid %d (cus %d x %d)\n", grid, cus, per_cu);
    }
    if (grid < 0) return;
    Args a{};
    for (int i = 0; i < 28; ++i) a.in[i] = (const float*)d_in[i];
    a.out = (float*)d_out; a.ws = (unsigned char*)d_ws;
#if MK_COOP
    if (hipMemsetAsync((char*)d_ws + WS_BAR, 0, (size_t)XCD_BAR_WORDS * 4, stream) != hipSuccess) { fprintf(stderr, "kernel_launch: memset of the barrier words failed\n"); return; }
    a.ph_lo = 0; a.ph_hi = NPHASE;
    void* args[] = {&a};
    const hipError_t e = hipLaunchCooperativeKernel((const void*)fwd_kernel<true>, dim3(grid), dim3(512), args, LDS_BYTES, stream);
    if (e != hipSuccess) fprintf(stderr, "kernel_launch: cooperative launch failed: %s (grid %d)\n", hipGetErrorString(e), grid);
#else
    for (int p = 0; p < NPHASE; ++p) { a.ph_lo = p; a.ph_hi = p + 1; hipLaunchKernelGGL(fwd_kernel<false>, dim3(grid), dim3(512), LDS_BYTES, stream, a); }
#endif
}
```

```cpp
#include <hip/hip_runtime.h>
#include <hip/hip_cooperative_groups.h>
#include <cstdio>
#include <cstdint>
namespace cg = cooperative_groups;
#define MK_DUP 0u
namespace pg8 {
#define PG8_LAS __attribute__((address_space(3)))
typedef unsigned short bf16_t;
typedef short bf16x8 __attribute__((ext_vector_type(8)));
typedef float f32x4 __attribute__((ext_vector_type(4)));
typedef unsigned u32x4 __attribute__((ext_vector_type(4)));
constexpr int BM = 256, BK = 64, HALF = 128, HTB = HALF * BK * 2  , STAGE_BYTES = 8 * HTB, NXCD = 8, WGM = 8;

__host__ __device__ __forceinline__ int lds_byte(int r, int c) { const int st = (r >> 4) * 2 + (c >> 5), rr = r & 15, cc = c & 31, ob = rr * 64 + cc * 2; return st * 1024 + (ob ^ (((ob >> 9) & 1) << 5)); }
__host__ __device__ __forceinline__ void stage_rc(int b, int& R, int& C) { const int st = b / 1024, sb = b % 1024, swz = sb ^ (((sb >> 9) & 1) << 5); R = (st >> 1) * 16 + swz / 64; C = (st & 1) * 32 + (swz % 64) / 2; }
__host__ __device__ __forceinline__ int perm32(int rho) { const int n = rho >> 4, i = rho & 15; return 8 * (i >> 2) + 4 * n + (i & 3); }

struct Unit { int pm, pn, ks; };
struct Gemm { const bf16_t* A; const bf16_t* Bt; int ld, K; };

struct StaticOrder {
    int nM, nN, nwg, G, c;
    __host__ __device__ void init(int M, int N, int G_, int c_) { nM = M / BM; nN = N / BM; nwg = nM * nN; G = G_; c = c_; }
    __host__ __device__ bool next(int i, Unit& u) const {
        const long L = (long)i * G + c; if (L >= nwg) return false;
        int wgid = (int)L; { const int q = nwg / NXCD, r = nwg % NXCD, xcd = wgid % NXCD, off = wgid / NXCD; wgid = (xcd < r ? xcd * (q + 1) : r * (q + 1) + (xcd - r) * q) + off; }
        const int nig = WGM * nN, gid = wgid / nig, fm = gid * WGM, gsz = (nM - fm) < WGM ? (nM - fm) : WGM;
        u.pm = fm + ((wgid % nig) % gsz); u.pn = (wgid % nig) / gsz; u.ks = 0; return true;
    }
    __device__ __forceinline__ void a_ready(const Unit&) const {}
    __device__ __forceinline__ void done(const Unit&) const {}
};
struct SubOrder {
    int pm0, npm, nN, nsl, G, c;
    __host__ __device__ bool next(int i, Unit& u) const {
        const int L = i * G + c; if (c < 0 || L >= npm * nN * nsl) return false;
        const int t = L / nsl; u.ks = L - t * nsl; u.pn = t % nN; u.pm = pm0 + t / nN; return true;
    }
    __device__ __forceinline__ void a_ready(const Unit&) const {}
    __device__ __forceinline__ void done(const Unit&) const {}
};
typedef unsigned u32x2 __attribute__((ext_vector_type(2)));

__device__ __forceinline__ unsigned cvt_pk_bf16(float lo, float hi) { unsigned r; asm("v_cvt_pk_bf16_f32 %0, %1, %2" : "=v"(r) : "v"(lo), "v"(hi)); return r; }
__device__ __forceinline__ float sigmoid_f(float x) { return __builtin_amdgcn_rcpf(1.0f + __builtin_amdgcn_exp2f(x * -1.44269504089f)); }

struct EpiF32 {
    static constexpr bool PERM = false, AFTER_DRAIN = false;
    float* C; int ldc;
    __device__ __forceinline__ void operator()(const f32x4 (&acc)[2][2][4][2], const Unit& u, int wr, int wc, int fr, int fq) const {
        const int row0 = u.pm * BM + wr * 64 + fr, col0 = u.pn * BM + wc * 32 + 4 * fq;
#pragma unroll
        for (int ai = 0; ai < 2; ++ai)
#pragma unroll
            for (int m = 0; m < 4; ++m) { float* rowp = C + (size_t)(row0 + ai * HALF + m * 16) * ldc + col0;
#pragma unroll
                for (int bj = 0; bj < 2; ++bj)
#pragma unroll
                    for (int n = 0; n < 2; ++n) *(f32x4*)(rowp + bj * HALF + n * 16) = acc[ai][bj][m][n]; }
    }
};
struct EpiPle {
    static constexpr bool PERM = false, AFTER_DRAIN = false;
    bf16_t* T; const float* P; int ldc;
    __device__ __forceinline__ void operator()(const f32x4 (&acc)[2][2][4][2], const Unit& u, int wr, int wc, int fr, int fq) const {
        const int row0 = u.pm * BM + wr * 64 + fr, col0 = u.pn * BM + wc * 32 + 4 * fq;
#pragma unroll
        for (int ai = 0; ai < 2; ++ai)
#pragma unroll
            for (int m = 0; m < 4; ++m) { const size_t off = (size_t)(row0 + ai * HALF + m * 16) * ldc + col0;
#pragma unroll
                for (int bj = 0; bj < 2; ++bj)
#pragma unroll
                    for (int n = 0; n < 2; ++n) { const f32x4 p = *(const f32x4*)(P + off + bj * HALF + n * 16); const f32x4 a = acc[ai][bj][m][n];
                        u32x2 w; w.x = cvt_pk_bf16(sigmoid_f(a.x) * p.x, sigmoid_f(a.y) * p.y); w.y = cvt_pk_bf16(sigmoid_f(a.z) * p.z, sigmoid_f(a.w) * p.w);
                        *(u32x2*)(T + off + bj * HALF + n * 16) = w; } }
    }
};
struct EpiF32Slab {
    static constexpr bool PERM = false, AFTER_DRAIN = false;
    float* base0; float* base1; int n0; int pm0;
    __device__ __forceinline__ void operator()(const f32x4 (&acc)[2][2][4][2], const Unit& u, int wr, int wc, int fr, int fq) const {
        const int row0 = (u.pm - pm0) * BM + wr * 64 + fr, col0 = u.pn * BM + wc * 32 + 4 * fq;
        float* C = (u.ks < n0) ? base0 + ((size_t)u.ks << 20) : base1 + ((size_t)(u.ks - n0) << 20);
#pragma unroll
        for (int ai = 0; ai < 2; ++ai)
#pragma unroll
            for (int m = 0; m < 4; ++m) { float* rowp = C + (size_t)(row0 + ai * HALF + m * 16) * 1024 + col0;
#pragma unroll
                for (int bj = 0; bj < 2; ++bj)
#pragma unroll
                    for (int n = 0; n < 2; ++n) *(f32x4*)(rowp + bj * HALF + n * 16) = acc[ai][bj][m][n]; }
    }
};
struct EpiBf16 {
    static constexpr bool PERM = true, AFTER_DRAIN = false;
    bf16_t* O; int ldc; const float* rs;
    __device__ __forceinline__ void operator()(const f32x4 (&acc)[2][2][4][2], const Unit& u, int wr, int wc, int fr, int fq) const {
        const int row0 = u.pm * BM + wr * 64 + fr, col0 = u.pn * BM + wc * 32 + 8 * fq;
#pragma unroll
        for (int ai = 0; ai < 2; ++ai)
#pragma unroll
            for (int m = 0; m < 4; ++m) { const int row = row0 + ai * HALF + m * 16; bf16_t* rowp = O + (size_t)row * ldc + col0; const float r = rs ? rs[row] : 1.0f;
#pragma unroll
                for (int bj = 0; bj < 2; ++bj) { const f32x4 v0 = acc[ai][bj][m][0] * r, v1 = acc[ai][bj][m][1] * r;
                    u32x4 w; w.x = cvt_pk_bf16(v0[0], v0[1]); w.y = cvt_pk_bf16(v0[2], v0[3]); w.z = cvt_pk_bf16(v1[0], v1[1]); w.w = cvt_pk_bf16(v1[2], v1[3]);
                    *(u32x4*)(rowp + bj * HALF) = w; } }
    }
};
struct EpiSwiglu {
    static constexpr bool PERM = true, AFTER_DRAIN = false;
    bf16_t* O; int ldc; const float* rs;
    __device__ __forceinline__ void operator()(const f32x4 (&acc)[2][2][4][2], const Unit& u, int wr, int wc, int fr, int fq) const {
        const int row0 = u.pm * BM + wr * 64 + fr, col0 = u.pn * HALF + wc * 32 + 8 * fq;
#pragma unroll
        for (int ai = 0; ai < 2; ++ai)
#pragma unroll
            for (int m = 0; m < 4; ++m) { const int row = row0 + ai * HALF + m * 16; bf16_t* rowp = O + (size_t)row * ldc + col0; const float r = rs[row];
                const f32x4 g0 = acc[ai][0][m][0] * r, g1 = acc[ai][0][m][1] * r, u0 = acc[ai][1][m][0] * r, u1 = acc[ai][1][m][1] * r;
                f32x4 v0, v1;
#pragma unroll
                for (int j = 0; j < 4; ++j) { v0[j] = g0[j] * sigmoid_f(g0[j]) * u0[j]; v1[j] = g1[j] * sigmoid_f(g1[j]) * u1[j]; }
                u32x4 w; w.x = cvt_pk_bf16(v0[0], v0[1]); w.y = cvt_pk_bf16(v0[2], v0[3]); w.z = cvt_pk_bf16(v1[0], v1[1]); w.w = cvt_pk_bf16(v1[2], v1[3]);
                *(u32x4*)rowp = w; }
    }
};

template <class Epi, class Sched, bool ALIGN_EPI = false, bool SP2 = false>
__device__ __forceinline__ void gemm_phase(PG8_LAS unsigned char* lds, const Gemm g, const Sched& S, const Epi& E) {
    const int tid = threadIdx.x, wid = __builtin_amdgcn_readfirstlane(tid >> 6), lane = tid & 63, wr = wid >> 2, wc = wid & 3, fr = lane & 15, fq = lane >> 4;
    const int K = g.K, nt = K / BK;
    unsigned voffA[2], voffB[2];
#pragma unroll
    for (int i = 0; i < 2; ++i) { int R, C; stage_rc(tid * 16 + i * 8192, R, C); const int Rb = Epi::PERM ? ((R & ~31) + perm32(R & 31)) : R;
        voffA[i] = (unsigned)(R * g.ld + C) * 2u; voffB[i] = (unsigned)(Rb * g.ld + C) * 2u; }
    const size_t kstep = (size_t)(BK * 2);
    const size_t hstepA = (size_t)HALF * g.ld * 2, hstepB = hstepA;
    const size_t kslice = (size_t)K * 2;
    const unsigned ldsw = (unsigned)wid * 1024u;
    const int aoff = lds_byte(wr * 64 + fr, fq * 8), boff = lds_byte(wc * 32 + fr, fq * 8);
#define PG8_SA(b, h) (((b) * 2 + (h)) * HTB)
#define PG8_SB(b, h) ((4 + (b) * 2 + (h)) * HTB)
#define PG8_STAGE(bufoff, gbase, voff) do { _Pragma("unroll") for (int _i = 0; _i < 2; ++_i) \
        __builtin_amdgcn_global_load_lds((const unsigned*)((const char*)(gbase) + (voff)[_i]), (PG8_LAS unsigned*)(lds + (bufoff) + ldsw + _i * 8192), 16, 0, 0); } while (0)
#define PG8_LDA(dst, b, h) do { _Pragma("unroll") for (int m = 0; m < 4; ++m) _Pragma("unroll") for (int k = 0; k < 2; ++k) dst[m][k] = *(const PG8_LAS bf16x8*)(lds + PG8_SA(b, h) + aoff + m * 2048 + k * 1024); } while (0)
#define PG8_LDB(dst, b, h) do { _Pragma("unroll") for (int n = 0; n < 2; ++n) _Pragma("unroll") for (int k = 0; k < 2; ++k) dst[n][k] = *(const PG8_LAS bf16x8*)(lds + PG8_SB(b, h) + boff + n * 2048 + k * 1024); } while (0)
#define PG8_MMA(ai, bj, At, Bt) do { __builtin_amdgcn_s_setprio(1); _Pragma("unroll") for (int m = 0; m < 4; ++m) _Pragma("unroll") for (int n = 0; n < 2; ++n) _Pragma("unroll") for (int k = 0; k < 2; ++k) \
        acc[ai][bj][m][n] = __builtin_amdgcn_mfma_f32_16x16x32_bf16(Bt[n][k], At[m][k], acc[ai][bj][m][n], 0, 0, 0); __builtin_amdgcn_s_setprio(0); } while (0)
#define PG8_WAIT_V(n) asm volatile("s_waitcnt vmcnt(" #n ")" ::: "memory")
#define PG8_WAIT_L(n) asm volatile("s_waitcnt lgkmcnt(" #n ")" ::: "memory")
#define PG8_BAR __builtin_amdgcn_s_barrier()
#define PG8_SCHED __builtin_amdgcn_sched_barrier(0)
    Unit cur, nxt; int ui = 0;
    if (!S.next(0, cur)) return;
    f32x4 acc[2][2][4][2];
#pragma unroll
    for (int a = 0; a < 2; ++a)
#pragma unroll
        for (int b = 0; b < 2; ++b)
#pragma unroll
            for (int m = 0; m < 4; ++m)
#pragma unroll
                for (int n = 0; n < 2; ++n) acc[a][b][m][n] = (f32x4){0.f, 0.f, 0.f, 0.f};
    bf16x8 At[4][2], B0[2][2], B1[2][2];
    const char* cA = (const char*)g.A + (size_t)cur.pm * 2 * hstepA + (size_t)cur.ks * kslice; const char* cB = (const char*)g.Bt + (size_t)cur.pn * 2 * hstepB + (size_t)cur.ks * kslice;
    S.a_ready(cur);
    if constexpr (SP2) {
        PG8_STAGE(PG8_SB(0, 0), cB, voffB); PG8_STAGE(PG8_SB(0, 1), cB + hstepB, voffB); PG8_STAGE(PG8_SA(0, 0), cA, voffA); PG8_STAGE(PG8_SA(0, 1), cA + hstepA, voffA);
        if (wr == 1) PG8_BAR;
        PG8_WAIT_V(2); PG8_BAR;
        PG8_STAGE(PG8_SB(1, 0), cB + kstep, voffB); PG8_STAGE(PG8_SA(1, 0), cA + kstep, voffA); PG8_STAGE(PG8_SB(1, 1), cB + hstepB + kstep, voffB);
        PG8_WAIT_V(6); PG8_BAR;
    } else {
        PG8_STAGE(PG8_SB(0, 0), cB, voffB); PG8_STAGE(PG8_SA(0, 0), cA, voffA); PG8_STAGE(PG8_SB(0, 1), cB + hstepB, voffB); PG8_STAGE(PG8_SA(0, 1), cA + hstepA, voffA);
        if (wr == 1) PG8_BAR;
        PG8_WAIT_V(4); PG8_BAR;
        PG8_STAGE(PG8_SB(1, 0), cB + kstep, voffB); PG8_STAGE(PG8_SA(1, 0), cA + kstep, voffA); PG8_STAGE(PG8_SB(1, 1), cB + hstepB + kstep, voffB);
        PG8_WAIT_V(6); PG8_BAR;
    }
    for (;;) {
        const bool has_next = S.next(ui + 1, nxt);
        const char* nA = has_next ? (const char*)g.A + (size_t)nxt.pm * 2 * hstepA + (size_t)nxt.ks * kslice : cA; const char* nB = has_next ? (const char*)g.Bt + (size_t)nxt.pn * 2 * hstepB + (size_t)nxt.ks * kslice : cB;
        for (int t = 0; t < nt; t += 2) {
            const bool last = (t == nt - 2);
            const char* a1 = cA + (size_t)(t + 1) * kstep;
            const char* a2 = last ? nA : cA + (size_t)(t + 2) * kstep; const char* b2 = last ? nB : cB + (size_t)(t + 2) * kstep;
            const char* a3 = a2 + kstep; const char* b3 = b2 + kstep;
            if (last && has_next) S.a_ready(nxt);
            if constexpr (SP2) {
            PG8_LDB(B0, 0, 0); PG8_LDB(B1, 0, 1); PG8_SCHED; PG8_LDA(At, 0, 0); PG8_STAGE(PG8_SA(1, 1), a1 + hstepA, voffA);
            PG8_WAIT_V(8); PG8_WAIT_L(0); PG8_BAR; PG8_MMA(0, 0, At, B0); PG8_MMA(0, 1, At, B1); PG8_BAR; PG8_SCHED;
            PG8_LDA(At, 0, 1); PG8_STAGE(PG8_SB(0, 0), b2, voffB); PG8_STAGE(PG8_SB(0, 1), b2 + hstepB, voffB); PG8_STAGE(PG8_SA(0, 0), a2, voffA);
            PG8_WAIT_V(8); PG8_WAIT_L(0); PG8_BAR; PG8_MMA(1, 0, At, B0); PG8_MMA(1, 1, At, B1); PG8_BAR; PG8_SCHED;
            PG8_LDB(B0, 1, 0); PG8_LDB(B1, 1, 1); PG8_SCHED; PG8_LDA(At, 1, 0); PG8_STAGE(PG8_SA(0, 1), a2 + hstepA, voffA);
            PG8_WAIT_V(8); PG8_WAIT_L(0); PG8_BAR; PG8_MMA(0, 0, At, B0); PG8_MMA(0, 1, At, B1); PG8_BAR; PG8_SCHED;
            PG8_LDA(At, 1, 1); PG8_STAGE(PG8_SB(1, 0), b3, voffB); PG8_STAGE(PG8_SB(1, 1), b3 + hstepB, voffB); PG8_STAGE(PG8_SA(1, 0), a3, voffA);
            PG8_WAIT_V(8); PG8_WAIT_L(0); PG8_BAR; PG8_MMA(1, 0, At, B0); PG8_MMA(1, 1, At, B1); PG8_BAR; PG8_SCHED;
            } else {
            PG8_LDB(B0, 0, 0); PG8_SCHED; PG8_LDA(At, 0, 0); PG8_STAGE(PG8_SA(1, 1), a1 + hstepA, voffA);
            PG8_WAIT_L(8); PG8_BAR; PG8_WAIT_L(0); PG8_MMA(0, 0, At, B0); PG8_BAR; PG8_SCHED;
            PG8_LDB(B1, 0, 1); PG8_STAGE(PG8_SB(0, 0), b2, voffB);
            PG8_BAR; PG8_WAIT_L(0); PG8_MMA(0, 1, At, B1); PG8_BAR;
            PG8_LDA(At, 0, 1); PG8_STAGE(PG8_SA(0, 0), a2, voffA);
            PG8_BAR; PG8_WAIT_L(0); PG8_MMA(1, 0, At, B0); PG8_BAR; PG8_SCHED;
            PG8_STAGE(PG8_SB(0, 1), b2 + hstepB, voffB);
            PG8_WAIT_V(6); PG8_BAR; PG8_MMA(1, 1, At, B1); PG8_BAR;
            PG8_LDB(B0, 1, 0); PG8_SCHED; PG8_LDA(At, 1, 0); PG8_STAGE(PG8_SA(0, 1), a2 + hstepA, voffA);
            PG8_WAIT_L(8); PG8_BAR; PG8_WAIT_L(0); PG8_MMA(0, 0, At, B0); PG8_BAR; PG8_SCHED;
            PG8_LDB(B1, 1, 1); PG8_STAGE(PG8_SB(1, 0), b3, voffB);
            PG8_BAR; PG8_WAIT_L(0); PG8_MMA(0, 1, At, B1); PG8_BAR;
            PG8_LDA(At, 1, 1); PG8_STAGE(PG8_SA(1, 0), a3, voffA);
            PG8_BAR; PG8_WAIT_L(0); PG8_MMA(1, 0, At, B0); PG8_BAR; PG8_SCHED;
            PG8_STAGE(PG8_SB(1, 1), b3 + hstepB, voffB);
            PG8_WAIT_V(6); PG8_BAR; PG8_MMA(1, 1, At, B1); PG8_BAR;
            }
        }
        if constexpr (ALIGN_EPI) { if (wr == 0) PG8_BAR; }
        if constexpr (!Epi::AFTER_DRAIN) { E(acc, cur, wr, wc, fr, fq); S.done(cur); }
        if (!has_next) break;
#pragma unroll
        for (int a = 0; a < 2; ++a)
#pragma unroll
            for (int b = 0; b < 2; ++b)
#pragma unroll
                for (int m = 0; m < 4; ++m)
#pragma unroll
                    for (int n = 0; n < 2; ++n) acc[a][b][m][n] = (f32x4){0.f, 0.f, 0.f, 0.f};
        cur = nxt; cA = nA; cB = nB; ++ui;
        if constexpr (ALIGN_EPI) { if (wr == 1) PG8_BAR; }
    }
    PG8_WAIT_V(0);
    if constexpr (!ALIGN_EPI) { if (wr == 0) PG8_BAR; }
    PG8_BAR;
    if constexpr (Epi::AFTER_DRAIN) { E.fused(acc, cur, wr, wc, fr, fq, lds, wid, lane); S.done(cur); }
#undef PG8_SA
#undef PG8_SB
#undef PG8_STAGE
#undef PG8_LDA
#undef PG8_LDB
#undef PG8_MMA
#undef PG8_WAIT_V
#undef PG8_WAIT_L
#undef PG8_BAR
#undef PG8_SCHED
}
}

using pg8::bf16_t; using pg8::bf16x8; using pg8::f32x4; using pg8::u32x4; using pg8::u32x2; using pg8::cvt_pk_bf16;
#define LAS __attribute__((address_space(3)))
#define XB_TMO      128
#define XB_XCNT(j)  (256  + 64 * (j))
#define XB_XSUB(j)  (1280 + 64 * (j))
#define XB_XGEN(j)  (2304 + 64 * (j))
#define XB_TOP      3328
#define XB_TOPGEN   3392
#define XCD_BAR_WORDS 3456
#define XB_SPIN_CAP (1u << 18)

__device__ __forceinline__ unsigned xb_ld(unsigned* p)              { return __hip_atomic_load(p, __ATOMIC_RELAXED, __HIP_MEMORY_SCOPE_AGENT); }
__device__ __forceinline__ unsigned xb_add(unsigned* p, unsigned v) { return __hip_atomic_fetch_add(p, v, __ATOMIC_RELAXED, __HIP_MEMORY_SCOPE_AGENT); }
__device__ __forceinline__ unsigned xb_xcc_id() { return (unsigned)__builtin_amdgcn_s_getreg((3 << 11) | 20) & 0xFu; }
#define XB_SPIN(cond, bar) do { unsigned _sp = 0; while (cond) { __builtin_amdgcn_s_sleep(1); \
    if ((++_sp & 255u) == 0u) { if (xb_ld(&(bar)[XB_TMO])) break; if (_sp > XB_SPIN_CAP) { atomicAdd(&(bar)[XB_TMO], 1u); break; } } } } while (0)

struct XcdBarrier {
    unsigned* bar; unsigned x;
    volatile LAS unsigned* st;
};

__device__ __forceinline__ XcdBarrier xcd_barrier_post(unsigned* bar, volatile LAS unsigned* st) {
    XcdBarrier b; b.bar = bar; b.x = xb_xcc_id(); b.st = st;
    if (threadIdx.x == 0) (void)xb_add(&bar[XB_XCNT(b.x)], 1u);
    return b;
}
__device__ __forceinline__ void xcd_barrier_complete(unsigned* bar, unsigned x, unsigned& nloc, unsigned& nx) {
    const unsigned G = gridDim.x * gridDim.y * gridDim.z;
    unsigned sum, cnt, mine, sp = 0u;
    for (;;) {
        sum = 0u; cnt = 0u; mine = 0u;
#pragma unroll
        for (unsigned j = 0; j < 16; ++j) { const unsigned c = xb_ld(&bar[XB_XCNT(j)]); sum += c; cnt += (c > 0u) ? 1u : 0u; mine = (j == x) ? c : mine; }
        if (sum == G) break;
        __builtin_amdgcn_s_sleep(1);
        if ((++sp & 255u) == 0u) { if (xb_ld(&bar[XB_TMO])) break; if (sp > XB_SPIN_CAP) { atomicAdd(&bar[XB_TMO], 1u); break; } }
    }
    nloc = mine > 0u ? mine : 1u; nx = cnt > 0u ? cnt : 1u;
}

__device__ __forceinline__ void xcd_barrier(const XcdBarrier& b) {
    asm volatile("s_waitcnt vmcnt(0)" ::: "memory");
    __syncthreads();
    if (threadIdx.x == 0) {
        unsigned* bar = b.bar;
        __builtin_amdgcn_s_waitcnt(0);
        unsigned nloc = b.st[0], nx = b.st[1];
        if (nloc == 0u) { xcd_barrier_complete(bar, b.x, nloc, nx); b.st[0] = nloc; b.st[1] = nx; }
        const unsigned old = xb_add(&bar[XB_XSUB(b.x)], 1u);
        const unsigned gen = old / nloc;
        if (old + 1u == (gen + 1u) * nloc) {
            __builtin_amdgcn_fence(__ATOMIC_RELEASE, "agent");
            asm volatile("s_waitcnt vmcnt(0)" ::: "memory");
            const unsigned og = xb_add(&bar[XB_TOP], 1u);
            const unsigned tg = og / nx;
            if (og + 1u == (tg + 1u) * nx) xb_add(&bar[XB_TOPGEN], 1u);
            else XB_SPIN(xb_ld(&bar[XB_TOPGEN]) == tg, bar);
            __builtin_amdgcn_fence(__ATOMIC_ACQUIRE, "agent");
            xb_add(&bar[XB_XGEN(b.x)], 1u);
            asm volatile("s_waitcnt vmcnt(0)" ::: "memory");
        } else {
            XB_SPIN(xb_ld(&bar[XB_XGEN(b.x)]) == gen, bar);
            __builtin_amdgcn_fence(__ATOMIC_ACQUIRE, "agent");
            asm volatile("s_waitcnt vmcnt(0)" ::: "memory");
        }
    }
    __syncthreads();
}


#ifndef MK_DUP
#define MK_DUP 0u
#endif
#ifndef MK_COOP
#define MK_COOP 1
#endif
constexpr int M_ = 17408, MP_ = 16384, DM = 1024, FF = 2816, NGU = 5632, NIN = 2560, PLE = 256;
constexpr float EPS_ = 1e-6f;
constexpr int LDS_BYTES = 147456;
constexpr int NPHASE = 14;
constexpr size_t WS_WGU1 = 0;
constexpr size_t WS_WD1 = WS_WGU1 + (size_t)NGU * DM * 2;
constexpr size_t WS_WIN = WS_WD1 + (size_t)DM * FF * 2;
constexpr size_t WS_WOUT = WS_WIN + (size_t)NIN * DM * 2;
constexpr size_t WS_WGU2 = WS_WOUT + (size_t)DM * DM * 2;
constexpr size_t WS_WD2 = WS_WGU2 + (size_t)NGU * DM * 2;
constexpr size_t WS_WPG = WS_WD2 + (size_t)DM * FF * 2;
constexpr size_t WS_WPP = WS_WPG + (size_t)DM * DM * 2;
constexpr size_t WS_YC = WS_WPP + (size_t)DM * PLE * 2;
constexpr size_t WS_ACT = WS_YC + (size_t)M_ * DM * 2;
constexpr size_t WS_D = WS_ACT + (size_t)M_ * FF * 2;
constexpr size_t WS_HB = WS_D + (size_t)M_ * DM * 2;
constexpr size_t WS_SLAB2 = WS_HB + (size_t)M_ * DM * 2;
constexpr size_t WS_RS = WS_SLAB2 + (size_t)3 * 1024 * 1024 * 4;
constexpr size_t WS_END = WS_RS + (size_t)M_ * 4;
constexpr size_t WS_BAR = WS_END;
constexpr size_t WS_TOTAL = WS_BAR + (size_t)XCD_BAR_WORDS * 4;
constexpr size_t WS_PROJ = WS_ACT;
constexpr size_t WS_PP = WS_ACT;
constexpr size_t WS_PB = WS_ACT + (size_t)M_ * DM * 4;
constexpr size_t WS_SLAB4 = WS_PB + (size_t)M_ * PLE * 2;
static_assert(WS_SLAB4 + (size_t)4 * 1024 * 1024 * 4 <= WS_D, "aliases fit");
constexpr size_t OUT_NCP = 17825792, OUT_NCS = 17833984, OUT_CVP = 17965056, OUT_CVS = 18489344;

struct Args { const float* in[28]; float* out; unsigned char* ws; int ph_lo, ph_hi; };

__device__ __forceinline__ float wave_sum(float v) {
#pragma unroll
    for (int o = 1; o < 64; o <<= 1) v += __shfl_xor(v, o);
    return v;
}
__device__ __forceinline__ float bf_lo(unsigned w) { return __uint_as_float(w << 16); }
__device__ __forceinline__ float bf_hi(unsigned w) { return __uint_as_float(w & 0xffff0000u); }
__device__ __forceinline__ float dot4(f32x4 a) { return (a.x * a.x + a.y * a.y) + (a.z * a.z + a.w * a.w); }
#define LDS_WAIT() asm volatile("s_waitcnt lgkmcnt(0)" ::: "memory")

__device__ __forceinline__ void transpose_item(const float* __restrict__ W, int K, int N, bf16_t* __restrict__ WT, int k0, int n0, int drow0, LAS float* scr, int lane, const float* __restrict__ gk) {
    float g8[8]; f32x4 v8[8];
#pragma unroll
    for (int i = 0; i < 8; ++i) { const int kk = 8 * i + (lane >> 3); v8[i] = *(const f32x4*)(W + (size_t)(k0 + kk) * N + n0 + (lane & 7) * 4); g8[i] = gk ? gk[k0 + kk] : 1.0f; }
#pragma unroll
    for (int i = 0; i < 8; ++i) { const int kk = 8 * i + (lane >> 3); LAS float* d = scr + kk * 33 + (lane & 7) * 4; const f32x4 v = v8[i] * g8[i]; d[0] = v.x; d[1] = v.y; d[2] = v.z; d[3] = v.w; }
    LDS_WAIT();
    const int c = lane & 7;
#pragma unroll
    for (int j = 0; j < 4; ++j) { const int n = (lane >> 3) + 8 * j; const LAS float* s = scr + (8 * c) * 33 + n;
        u32x4 o; o.x = cvt_pk_bf16(s[0 * 33], s[1 * 33]); o.y = cvt_pk_bf16(s[2 * 33], s[3 * 33]); o.z = cvt_pk_bf16(s[4 * 33], s[5 * 33]); o.w = cvt_pk_bf16(s[6 * 33], s[7 * 33]);
        *(u32x4*)(WT + (size_t)(drow0 + n) * K + k0 + 8 * c) = o; }
    LDS_WAIT();
}

__device__ __forceinline__ f32x4 bf4(unsigned a, unsigned b) { return (f32x4){bf_lo(a), bf_hi(a), bf_lo(b), bf_hi(b)}; }
template <int MODE>
__device__ __forceinline__ void rp_load_res(int m, const float* __restrict__ resP, const float* __restrict__ resS, const bf16_t* hb, int lane, f32x4 (&h)[4]) {
    if (MODE & 2) { const float* rrow = (m < MP_) ? resP + (size_t)m * DM : resS + (size_t)(m - MP_) * DM;
#pragma unroll
        for (int j = 0; j < 4; ++j) h[j] = ((const f32x4*)rrow)[lane + 64 * j]; }
    else { const u32x2* hr = (const u32x2*)(hb + (size_t)m * DM) + lane;
#pragma unroll
        for (int j = 0; j < 4; ++j) { const u32x2 w = hr[64 * j]; h[j] = bf4(w.x, w.y); } }
}
template <int MODE>
__device__ __forceinline__ void rp_finish(int m, f32x4 (&h)[4], f32x4 (&d)[4], const f32x4 (&gp)[4], float sc, bf16_t* hb, float* __restrict__ rsv, float* __restrict__ outf, int lane) {
    if (MODE & 1) {
        float ss = 0.f;
#pragma unroll
        for (int j = 0; j < 4; ++j) ss += dot4(d[j]);
        const float rs = sc * rsqrtf(wave_sum(ss) * (1.0f / DM) + EPS_);
#pragma unroll
        for (int j = 0; j < 4; ++j) h[j] += d[j] * rs * gp[j];
    }
    if (MODE & 4) {
        float s2 = 0.f;
#pragma unroll
        for (int j = 0; j < 4; ++j) s2 += dot4(h[j]);
        const float rs2 = rsqrtf(wave_sum(s2) * (1.0f / DM) + EPS_);
        if (lane == 0) rsv[m] = rs2;
        u32x2* o = (u32x2*)(hb + (size_t)m * DM) + lane;
#pragma unroll
        for (int j = 0; j < 4; ++j) { const f32x4 v = h[j]; u32x2 w; w.x = cvt_pk_bf16(v.x, v.y); w.y = cvt_pk_bf16(v.z, v.w); o[64 * j] = w; }
    }
    if (MODE & 8) { f32x4* ho = (f32x4*)(outf + (size_t)m * DM) + lane;
#pragma unroll
        for (int j = 0; j < 4; ++j) ho[64 * j] = h[j]; }
}
template <int MODE, int NSL, int N0>
__device__ __forceinline__ void rowpass(const bf16_t* __restrict__ dbuf, const float* slab0, const float* slab1, const float* __restrict__ pp, const float* __restrict__ resP, const float* __restrict__ resS,
                                        bf16_t* hb, float* __restrict__ rsv, float* __restrict__ outf, const float* __restrict__ gpost, float sc, int gw, int NGW, int lane) {
    f32x4 gp[4];
#pragma unroll
    for (int j = 0; j < 4; ++j) gp[j] = (MODE & 1) ? ((const f32x4*)gpost)[lane + 64 * j] : (f32x4){0.f, 0.f, 0.f, 0.f};
    constexpr int NR = 4;
    for (int m0 = gw; m0 < MP_; m0 += NR * NGW) {
        f32x4 hh[NR][4], dd[NR][4]; u32x2 ww[NR][4];
#pragma unroll
        for (int q = 0; q < NR; ++q) { const int m = m0 + q * NGW; if (m < MP_) rp_load_res<MODE>(m, resP, resS, hb, lane, hh[q]); }
        if (MODE & 1) {
#pragma unroll
            for (int q = 0; q < NR; ++q) { const int m = m0 + q * NGW; if (m < MP_) { const u32x2* dr = (const u32x2*)(dbuf + (size_t)m * DM) + lane;
#pragma unroll
                for (int j = 0; j < 4; ++j) ww[q][j] = dr[64 * j]; } }
#pragma unroll
            for (int q = 0; q < NR; ++q)
#pragma unroll
                for (int j = 0; j < 4; ++j) dd[q][j] = bf4(ww[q][j].x, ww[q][j].y);
        }
#pragma unroll
        for (int q = 0; q < NR; ++q) { const int m = m0 + q * NGW; if (m < MP_) rp_finish<MODE>(m, hh[q], dd[q], gp, sc, hb, rsv, outf, lane); }
    }
    if (((gw & 1) == 0)) for (int r = (gw >> 3) * 4 + ((gw & 7) >> 1); r < M_ - MP_; r += (NGW >> 3) * 4) {
        const int m = MP_ + r;
        f32x4 h[4], d[4];
        rp_load_res<MODE>(m, resP, resS, hb, lane, h);
        if (MODE & 1) {
#pragma unroll
            for (int j = 0; j < 4; ++j) { f32x4 t[NSL > 0 ? NSL : 1];
#pragma unroll
                for (int s = 0; s < NSL; ++s) t[s] = ((const f32x4*)(((s < N0) ? slab0 + ((size_t)s << 20) : slab1 + ((size_t)(s - N0) << 20)) + (size_t)r * DM))[lane + 64 * j];
                f32x4 acc = {0.f, 0.f, 0.f, 0.f};
#pragma unroll
                for (int s = 0; s < NSL; ++s) acc += t[s];
                d[j] = acc; }
            if (MODE & 16) { const f32x4* pr = (const f32x4*)(pp + (size_t)m * DM) + lane;
#pragma unroll
                for (int j = 0; j < 4; ++j) { const f32x4 p = pr[64 * j]; d[j].x = pg8::sigmoid_f(d[j].x) * p.x; d[j].y = pg8::sigmoid_f(d[j].y) * p.y; d[j].z = pg8::sigmoid_f(d[j].z) * p.z; d[j].w = pg8::sigmoid_f(d[j].w) * p.w; } }
        }
        rp_finish<MODE>(m, h, d, gp, sc, hb, rsv, outf, lane);
    }
}

__device__ __forceinline__ void mixer_phase(const Args& a, LAS unsigned char* lds, const bf16_t* __restrict__ PROJ, bf16_t* __restrict__ YC, int wave, int lane) {
    constexpr int VP = 1056;
    LAS float* part = (LAS float*)(lds + 128 * VP);
    const int fr = lane & 15, fq = lane >> 4;
    const float* __restrict__ wsm = a.in[15]; const float* __restrict__ bsm = a.in[16];
    float* out = a.out;
    for (int u = blockIdx.x; u < 272; u += gridDim.x) {
        const bool samp = (u >= 256);
        const int R0 = u * 64;
        int s0 = 0, t0 = 0;
        if (!samp) { s0 = (u & 31) * 64; t0 = s0 & 127; }
        const int CB = R0 - t0, kext = t0 + 64;
        const int h = wave; const int nkb = kext >> 5;
        bf16x8 afr[4][4];
#pragma unroll
        for (int kb = 0; kb < 4; ++kb) {
#pragma unroll
            for (int tb = 0; tb < 4; ++tb) {
                f32x4 w0 = {0.f, 0.f, 0.f, 0.f}, w1 = w0; int lim = -1;
                if (kb < nkb) {
                    if (!samp) { const int tt = t0 + tb * 16 + fr, sb = kb * 32 + fq * 8; const float* wp = wsm + (size_t)(h * 128 + tt) * 128 + sb;
                        w0 = *(const f32x4*)wp; w1 = *(const f32x4*)(wp + 4); lim = tt - sb; }
                    else { const int tt = fr & 7; const float* wp = wsm + (size_t)(h * 128 + tt) * 128;
                        w0 = *(const f32x4*)wp; w1 = *(const f32x4*)(wp + 4); lim = ((kb * 4 + fq) == (tb * 2 + (fr >> 3))) ? tt : -1; }
                }
                w0.x = (0 <= lim) ? w0.x : 0.f; w0.y = (1 <= lim) ? w0.y : 0.f; w0.z = (2 <= lim) ? w0.z : 0.f; w0.w = (3 <= lim) ? w0.w : 0.f;
                w1.x = (4 <= lim) ? w1.x : 0.f; w1.y = (5 <= lim) ? w1.y : 0.f; w1.z = (6 <= lim) ? w1.z : 0.f; w1.w = (7 <= lim) ? w1.w : 0.f;
                u32x4 pk; pk.x = cvt_pk_bf16(w0.x, w0.y); pk.y = cvt_pk_bf16(w0.z, w0.w); pk.z = cvt_pk_bf16(w1.x, w1.y); pk.w = cvt_pk_bf16(w1.z, w1.w);
                afr[kb][tb] = __builtin_bit_cast(bf16x8, pk);
            }
        }
        {
            const f32x4 vg0 = *(const f32x4*)(a.in[14] + lane * 8), vg1 = *(const f32x4*)(a.in[14] + lane * 8 + 4);
            for (int sb8 = 0; sb8 < kext; sb8 += 64) {
                u32x4 raw8[8];
#pragma unroll
                for (int i = 0; i < 8; ++i) raw8[i] = *(const u32x4*)(PROJ + (size_t)(CB + sb8 + i * 8 + wave) * NIN + 2048 + lane * 8);
#pragma unroll
                for (int i = 0; i < 8; ++i) {
                    const int s = sb8 + i * 8 + wave, row = CB + s; const u32x4 raw = raw8[i];
                    f32x4 v0 = bf4(raw.x, raw.y), v1 = bf4(raw.z, raw.w);
                    float ss = dot4(v0) + dot4(v1);
                    ss += __shfl_xor(ss, 1); ss += __shfl_xor(ss, 2); ss += __shfl_xor(ss, 4);
                    const float rs = rsqrtf(ss * (1.0f / 64.0f) + EPS_);
                    v0 = v0 * rs * vg0; v1 = v1 * rs * vg1;
                    u32x4 pk; pk.x = cvt_pk_bf16(v0.x, v0.y); pk.y = cvt_pk_bf16(v0.z, v0.w); pk.z = cvt_pk_bf16(v1.x, v1.y); pk.w = cvt_pk_bf16(v1.z, v1.w);
                    *(LAS u32x4*)(lds + s * VP + lane * 16) = pk;
                    if (s >= t0) {
                        if (samp) { float* o = out + OUT_CVS + (size_t)(row - MP_) * 512 + lane * 8; *(f32x4*)o = v0; *(f32x4*)(o + 4) = v1; }
                        else if (s0 - t0 == 1920) { float* o = out + OUT_CVP + (size_t)((u >> 5) * 128 + s) * 512 + lane * 8; *(f32x4*)o = v0; *(f32x4*)(o + 4) = v1; }
                    }
                }
            }
        }
        __syncthreads();
        f32x4 acc[4][4];
#pragma unroll
        for (int i = 0; i < 4; ++i)
#pragma unroll
            for (int j = 0; j < 4; ++j) acc[i][j] = (f32x4){0.f, 0.f, 0.f, 0.f};
#pragma unroll
        for (int kb = 0; kb < 4; ++kb) if (kb < nkb) {
            u32x2 r0[4], r1[4];
            { const unsigned ta = (unsigned)(uintptr_t)(lds + (kb * 32 + fq * 8 + (fr >> 2)) * VP + (h * 64 + (fr & 3) * 4) * 2);
              asm volatile("ds_read_b64_tr_b16 %0, %8\n\tds_read_b64_tr_b16 %1, %8 offset:4224\n\t"
                           "ds_read_b64_tr_b16 %2, %8 offset:32\n\tds_read_b64_tr_b16 %3, %8 offset:4256\n\t"
                           "ds_read_b64_tr_b16 %4, %8 offset:64\n\tds_read_b64_tr_b16 %5, %8 offset:4288\n\t"
                           "ds_read_b64_tr_b16 %6, %8 offset:96\n\tds_read_b64_tr_b16 %7, %8 offset:4320\n\ts_waitcnt lgkmcnt(0)"
                           : "=&v"(r0[0]), "=&v"(r1[0]), "=&v"(r0[1]), "=&v"(r1[1]), "=&v"(r0[2]), "=&v"(r1[2]), "=&v"(r0[3]), "=&v"(r1[3]) : "v"(ta) : "memory"); }
#pragma unroll
            for (int db = 0; db < 4; ++db) {
                u32x4 bq; bq.x = r0[db].x; bq.y = r0[db].y; bq.z = r1[db].x; bq.w = r1[db].y;
                const bf16x8 bfv = __builtin_bit_cast(bf16x8, bq);
#pragma unroll
                for (int tb = 0; tb < 4; ++tb) acc[tb][db] = __builtin_amdgcn_mfma_f32_16x16x32_bf16(bfv, afr[kb][tb], acc[tb][db], 0, 0, 0);
            }
        }
#pragma unroll
        for (int tb = 0; tb < 4; ++tb) {
            const int t = tb * 16 + fr; const int tt = samp ? (fr & 7) : (t0 + t); const float bias = bsm[h * 128 + tt];
            const bf16_t* up = PROJ + (size_t)(R0 + t) * NIN + 1536 + h * 64 + fq * 4;
            float s = 0.f;
#pragma unroll
            for (int db = 0; db < 4; ++db) { const u32x2 ur = *(const u32x2*)(up + db * 16); const f32x4 uu = bf4(ur.x, ur.y);
                const f32x4 y = uu * (acc[tb][db] + bias); acc[tb][db] = y; s += dot4(y); }
            s += __shfl_xor(s, 16); s += __shfl_xor(s, 32);
            if (fq == 0) part[h * 64 + t] = s;
        }
        __syncthreads();
#pragma unroll
        for (int tb = 0; tb < 4; ++tb) {
            const int t = tb * 16 + fr; float tot = 0.f;
#pragma unroll
            for (int hh = 0; hh < 8; ++hh) tot += part[hh * 64 + t];
            const float rs = rsqrtf(tot * (1.0f / 512.0f) + EPS_);
            bf16_t* yp = YC + (size_t)(R0 + t) * DM + 512 + h * 64 + fq * 4;
#pragma unroll
            for (int db = 0; db < 4; ++db) { const f32x4 gb = *(const f32x4*)(a.in[18] + h * 64 + db * 16 + fq * 4); const f32x4 y = acc[tb][db] * rs * gb;
                u32x2 w; w.x = cvt_pk_bf16(y.x, y.y); w.y = cvt_pk_bf16(y.z, y.w); *(u32x2*)(yp + db * 16) = w; }
        }
        {
            const int c0 = lane * 8; const float* cw = a.in[13];
            const f32x4 w0a = *(const f32x4*)(cw + c0), w0b = *(const f32x4*)(cw + c0 + 4), w1a = *(const f32x4*)(cw + 512 + c0), w1b = *(const f32x4*)(cw + 512 + c0 + 4),
                        w2a = *(const f32x4*)(cw + 1024 + c0), w2b = *(const f32x4*)(cw + 1024 + c0 + 4);
            const f32x4 gaa = *(const f32x4*)(a.in[17] + c0), gab = *(const f32x4*)(a.in[17] + c0 + 4);
            f32x4 zp2a = {0.f, 0.f, 0.f, 0.f}, zp2b = zp2a, zp1a = zp2a, zp1b = zp2a;
            const int rb = R0 + wave * 8; const int sb_ = (u - 256) * 8 + wave;
            if (samp) { const float* st = a.in[4] + (size_t)sb_ * 1024 + c0; zp2a = *(const f32x4*)st; zp2b = *(const f32x4*)(st + 4); zp1a = *(const f32x4*)(st + 512); zp1b = *(const f32x4*)(st + 516); }
            else if (s0 + wave * 8 > 0) {
                const bf16_t* p2 = PROJ + (size_t)(rb - 2) * NIN + c0; const bf16_t* p1 = p2 + NIN;
                const u32x4 c2 = *(const u32x4*)(p2 + 512), h2 = *(const u32x4*)(p2 + 1024), c1 = *(const u32x4*)(p1 + 512), h1 = *(const u32x4*)(p1 + 1024);
                zp2a = bf4(c2.x, c2.y) * bf4(h2.x, h2.y); zp2b = bf4(c2.z, c2.w) * bf4(h2.z, h2.w); zp1a = bf4(c1.x, c1.y) * bf4(h1.x, h1.y); zp1b = bf4(c1.z, c1.w) * bf4(h1.z, h1.w);
            }
            f32x4 ya[8], yb[8]; float ss[8];
            u32x4 braw8[8], craw8[8], hraw8[8];
#pragma unroll
            for (int i = 0; i < 8; ++i) { const bf16_t* pr = PROJ + (size_t)(rb + i) * NIN + c0; braw8[i] = *(const u32x4*)pr; craw8[i] = *(const u32x4*)(pr + 512); hraw8[i] = *(const u32x4*)(pr + 1024); }
#pragma unroll
            for (int i = 0; i < 8; ++i) {
                const u32x4 braw = braw8[i], craw = craw8[i], hraw = hraw8[i];
                const f32x4 za = bf4(craw.x, craw.y) * bf4(hraw.x, hraw.y), zb = bf4(craw.z, craw.w) * bf4(hraw.z, hraw.w);
                const f32x4 ca = w0a * zp2a + w1a * zp1a + w2a * za, cb = w0b * zp2b + w1b * zp1b + w2b * zb;
                ya[i] = bf4(braw.x, braw.y) * ca; yb[i] = bf4(braw.z, braw.w) * cb;
                ss[i] = wave_sum(dot4(ya[i]) + dot4(yb[i]));
                if (i >= 6) {
                    if (samp) { float* o = out + OUT_NCS + ((size_t)sb_ * 2 + (i - 6)) * 512 + c0; *(f32x4*)o = za; *(f32x4*)(o + 4) = zb; }
                    else if ((u & 31) == 31 && wave == 7) { float* o = out + OUT_NCP + ((size_t)(u >> 5) * 2 + (i - 6)) * 512 + c0; *(f32x4*)o = za; *(f32x4*)(o + 4) = zb; }
                }
                zp2a = zp1a; zp2b = zp1b; zp1a = za; zp1b = zb;
            }
#pragma unroll
            for (int i = 0; i < 8; ++i) {
                const float rs = rsqrtf(ss[i] * (1.0f / 512.0f) + EPS_);
                const f32x4 y0 = ya[i] * rs * gaa, y1 = yb[i] * rs * gab;
                u32x4 w; w.x = cvt_pk_bf16(y0.x, y0.y); w.y = cvt_pk_bf16(y0.z, y0.w); w.z = cvt_pk_bf16(y1.x, y1.y); w.w = cvt_pk_bf16(y1.z, y1.w);
                *(u32x4*)(YC + (size_t)(rb + i) * DM + c0) = w;
            }
        }
        __syncthreads();
    }
}

__device__ __forceinline__ int fresh_tid() { int t = threadIdx.x; asm volatile("" : "+v"(t)); return t; }
template <bool COOP>
__global__ void __launch_bounds__(512, 2) fwd_kernel(Args a) {
    extern __shared__ __attribute__((aligned(16))) unsigned char lds_raw[];
    LAS unsigned char* lds = (LAS unsigned char*)lds_raw;
    const int tid = threadIdx.x;
    const int G = gridDim.x, NGW = G * 8;
#define LANE_ (fresh_tid() & 63)
#define WAVE_ (__builtin_amdgcn_readfirstlane(fresh_tid() >> 6))
#define GW_ ((int)blockIdx.x * 8 + WAVE_)
    unsigned char* ws = a.ws;
    bf16_t* WGU1 = (bf16_t*)(ws + WS_WGU1); bf16_t* WD1 = (bf16_t*)(ws + WS_WD1); bf16_t* WIN = (bf16_t*)(ws + WS_WIN); bf16_t* WOUT = (bf16_t*)(ws + WS_WOUT);
    bf16_t* WGU2 = (bf16_t*)(ws + WS_WGU2); bf16_t* WD2 = (bf16_t*)(ws + WS_WD2); bf16_t* WPG = (bf16_t*)(ws + WS_WPG); bf16_t* WPP = (bf16_t*)(ws + WS_WPP);
    bf16_t* YC = (bf16_t*)(ws + WS_YC); bf16_t* HB = (bf16_t*)(ws + WS_HB); float* RS = (float*)(ws + WS_RS); bf16_t* ACT = (bf16_t*)(ws + WS_ACT); bf16_t* PROJ = (bf16_t*)(ws + WS_PROJ); bf16_t* PB = (bf16_t*)(ws + WS_PB);
    bf16_t* DB = (bf16_t*)(ws + WS_D); float* SLAB2 = (float*)(ws + WS_SLAB2); float* SLAB4 = (float*)(ws + WS_SLAB4); float* PP = (float*)(ws + WS_PP);
#define IN(k) (a.ph_lo <= (k) && (k) < a.ph_hi)
#define REP(k) for (int rep_ = 0; rep_ < (((MK_DUP >> (k)) & 1u) ? 2 : 1); ++rep_)
    XcdBarrier bar; bar.bar = (unsigned*)(ws + WS_BAR); bar.x = 0; bar.st = nullptr;
    if (COOP) {
        volatile LAS unsigned* st = (volatile LAS unsigned*)(lds + LDS_BYTES - 16);
        if (tid < 4) st[tid] = 0u;
        __syncthreads();
        bar = xcd_barrier_post((unsigned*)(ws + WS_BAR), st);
        if (a.ph_lo < 0) cg::this_grid().sync();
    }
#define SEAM(k) do { if (COOP && IN(k) && IN((k) + 1)) xcd_barrier(bar); } while (0)

    if (IN(0)) REP(0) {
        const int lane = LANE_, wave = WAVE_, gw = GW_; LAS float* scr = (LAS float*)(lds + wave * 8448);
        constexpr int I_G = (DM / 64) * (FF / 32), I_D = (FF / 64) * (DM / 32), I_IN = (DM / 64) * (NIN / 32), I_O = (DM / 64) * (DM / 32), I_PP = (PLE / 64) * (DM / 32);
        constexpr int NITEMS = 4 * I_G + 2 * I_D + I_IN + 2 * I_O + I_PP;
        for (int it = gw; it < NITEMS; it += NGW) {
            int r = it; const float* W; int K, N; bf16_t* WT; int mode = 0; const float* gk = nullptr;
            if (r < I_G) { W = a.in[7]; K = DM; N = FF; WT = WGU1; mode = 1; gk = a.in[5]; }
            else if ((r -= I_G) < I_G) { W = a.in[8]; K = DM; N = FF; WT = WGU1; mode = 2; gk = a.in[5]; }
            else if ((r -= I_G) < I_G) { W = a.in[22]; K = DM; N = FF; WT = WGU2; mode = 1; gk = a.in[20]; }
            else if ((r -= I_G) < I_G) { W = a.in[23]; K = DM; N = FF; WT = WGU2; mode = 2; gk = a.in[20]; }
            else if ((r -= I_G) < I_D) { W = a.in[9]; K = FF; N = DM; WT = WD1; }
            else if ((r -= I_D) < I_D) { W = a.in[24]; K = FF; N = DM; WT = WD2; }
            else if ((r -= I_D) < I_IN) { W = a.in[12]; K = DM; N = NIN; WT = WIN; gk = a.in[10]; }
            else if ((r -= I_IN) < I_O) { W = a.in[19]; K = DM; N = DM; WT = WOUT; }
            else if ((r -= I_O) < I_O) { W = a.in[25]; K = DM; N = DM; WT = WPG; }
            else { r -= I_O; W = a.in[26]; K = PLE; N = DM; WT = WPP; }
            const int nblk = N / 32, kb = r / nblk, nb = r % nblk, k0 = 64 * kb, n0 = 32 * nb;
            int drow0 = n0; if (mode) drow0 = (n0 >> 7) * 256 + (n0 & 127) + (mode == 2 ? 128 : 0);
            transpose_item(W, K, N, WT, k0, n0, drow0, scr, lane, gk);
        }
        rowpass<2 | 4, 0, 0>(nullptr, nullptr, nullptr, nullptr, a.in[0], a.in[1], HB, RS, nullptr, nullptr, 0.f, gw, NGW, lane);
    }
    SEAM(0);
    const int bid = (int)blockIdx.x;
#define GEMM_FULL(EPI, Aop, Bop, KK, MM, NN, ...) do { pg8::Gemm g_{Aop, Bop, KK, KK}; pg8::StaticOrder S_; S_.init(MM, NN, G, bid); pg8::EPI E_{__VA_ARGS__}; \
        pg8::gemm_phase<pg8::EPI, pg8::StaticOrder, true, true>(lds, g_, S_, E_); } while (0)
#define GEMM_SPLIT(Aop, Bop, KK, NSL, S0, S1, N0) do { pg8::Gemm g_{Aop, Bop, KK, 256}; pg8::SubOrder S_{64, 4, 4, NSL, G, bid}; pg8::EpiF32Slab E_{S0, S1, N0, 64}; \
        pg8::gemm_phase<pg8::EpiF32Slab, pg8::SubOrder, true, true>(lds, g_, S_, E_); } while (0)
    float* const YCF = (float*)YC;
    if (IN(1)) REP(1) GEMM_FULL(EpiSwiglu, HB, WGU1, DM, M_, NGU, ACT, FF, RS);
    SEAM(1);
    if (IN(2)) REP(2) { GEMM_FULL(EpiBf16, ACT, WD1, FF, MP_, DM, DB, DM, nullptr); GEMM_SPLIT(ACT, WD1, FF, 11, YCF, SLAB2, 8); }
    SEAM(2);
    if (IN(3)) REP(3) rowpass<1 | 2 | 4, 11, 8>(DB, YCF, SLAB2, nullptr, a.in[0], a.in[1], HB, RS, nullptr, a.in[6], 0.5f, GW_, NGW, LANE_);
    SEAM(3);
    if (IN(4)) REP(4) GEMM_FULL(EpiBf16, HB, WIN, DM, M_, NIN, PROJ, NIN, RS);
    SEAM(4);
    if (IN(5)) REP(5) mixer_phase(a, lds, PROJ, YC, WAVE_, LANE_);
    SEAM(5);
#ifdef MK_XBAR
#pragma nounroll
    for (int xb_ = 0; xb_ < MK_XBAR; ++xb_) xcd_barrier(bar);
#endif
    if (IN(6)) REP(6) { GEMM_FULL(EpiBf16, YC, WOUT, DM, MP_, DM, DB, DM, nullptr); GEMM_SPLIT(YC, WOUT, DM, 4, SLAB4, SLAB4, 4); }
    SEAM(6);
    if (IN(7)) rowpass<1 | 4, 4, 4>(DB, SLAB4, SLAB4, nullptr, nullptr, nullptr, HB, RS, nullptr, a.in[11], 1.0f, GW_, NGW, LANE_);
    SEAM(7);
    if (IN(8)) REP(8) GEMM_FULL(EpiSwiglu, HB, WGU2, DM, M_, NGU, ACT, FF, RS);
    SEAM(8);
    if (IN(9)) REP(9) { GEMM_FULL(EpiBf16, ACT, WD2, FF, MP_, DM, DB, DM, nullptr); GEMM_SPLIT(ACT, WD2, FF, 11, YCF, SLAB2, 8); }
    SEAM(9);
    if (IN(10)) {
        rowpass<1 | 4, 11, 8>(DB, YCF, SLAB2, nullptr, nullptr, nullptr, HB, RS, nullptr, a.in[21], 0.5f, GW_, NGW, LANE_);
        const int lane = LANE_, gw = GW_;
        for (int m = gw; m < M_; m += NGW) { const float* pr = (m < MP_) ? a.in[2] + (size_t)m * PLE : a.in[3] + (size_t)(m - MP_) * PLE;
            const f32x4 v = ((const f32x4*)pr)[lane]; u32x2 w; w.x = cvt_pk_bf16(v.x, v.y); w.y = cvt_pk_bf16(v.z, v.w); ((u32x2*)(PB + (size_t)m * PLE))[lane] = w; }
    }
    SEAM(10);
    if (IN(11)) REP(11) { GEMM_FULL(EpiF32, PB, WPP, PLE, MP_, DM, PP, DM);
        { pg8::Gemm g_{PB, WPP, PLE, PLE}; pg8::SubOrder S_{64, 4, 4, 1, G, (bid >= 64 && bid < 80) ? bid - 64 : -1}; pg8::EpiF32 E_{PP, DM};
          pg8::gemm_phase<pg8::EpiF32, pg8::SubOrder, true, true>(lds, g_, S_, E_); } }
    if (IN(12)) REP(12) { GEMM_FULL(EpiPle, HB, WPG, DM, MP_, DM, DB, PP, DM); GEMM_SPLIT(HB, WPG, DM, 4, SLAB4, SLAB4, 4); }
    SEAM(12);
    if (IN(13)) rowpass<1 | 8 | 16, 4, 4>(DB, SLAB4, SLAB4, PP, nullptr, nullptr, HB, nullptr, a.out, a.in[27], 1.0f, GW_, NGW, LANE_);
#undef IN
#undef SEAM
}

extern "C" void kernel_launch(void* const* d_in, const int* in_sizes, int n_in, void* d_out, int out_size, void* d_ws, size_t ws_size, hipStream_t stream) {
    static int grid = 0;
    if (grid == 0) {
        if (n_in != 28 || out_size != 19013632 || ws_size < WS_TOTAL) { fprintf(stderr, "kernel_launch: unexpected shapes: n_in %d out %d ws %zu (need %zu)\n", n_in, out_size, ws_size, (size_t)WS_TOTAL); grid = -1; return; }
        int dev = 0, cus = 0, per_cu = 0;
        if (hipGetDevice(&dev) != hipSuccess || hipDeviceGetAttribute(&cus, hipDeviceAttributeMultiprocessorCount, dev) != hipSuccess) { fprintf(stderr, "kernel_launch: device query failed\n"); grid = -1; return; }
        if (hipFuncSetAttribute((const void*)fwd_kernel<true>, hipFuncAttributeMaxDynamicSharedMemorySize, LDS_BYTES) != hipSuccess) { fprintf(stderr, "kernel_launch: hipFuncSetAttribute failed\n"); grid = -1; return; }
        if (hipOccupancyMaxActiveBlocksPerMultiprocessor(&per_cu, (const void*)fwd_kernel<true>, 512, LDS_BYTES) != hipSuccess || per_cu < 1) { fprintf(stderr, "kernel_launch: occupancy query says %d blocks per CU\n", per_cu); per_cu = 1; }
        (void)hipGetLastError();
        grid = cus * per_cu;
        fprintf(stderr, "kernel_launch: grid %d (cus %d x %d)\n", grid, cus, per_cu);
    }
    if (grid < 0) return;
    Args a{};
    for (int i = 0; i < 28; ++i) a.in[i] = (const float*)d_in[i];
    a.out = (float*)d_out; a.ws = (unsigned char*)d_ws;
#if MK_COOP
    if (hipMemsetAsync((char*)d_ws + WS_BAR, 0, (size_t)XCD_BAR_WORDS * 4, stream) != hipSuccess) { fprintf(stderr, "kernel_launch: memset of the barrier words failed\n"); return; }
    a.ph_lo = 0; a.ph_hi = NPHASE;
    void* args[] = {&a};
    const hipError_t e = hipLaunchCooperativeKernel((const void*)fwd_kernel<true>, dim3(grid), dim3(512), args, LDS_BYTES, stream);
    if (e != hipSuccess) fprintf(stderr, "kernel_launch: cooperative launch failed: %s (grid %d)\n", hipGetErrorString(e), grid);
#endif
}
```

```cpp
#include <hip/hip_runtime.h>
#include <hip/hip_cooperative_groups.h>
#include <cstdio>
#include <cstdint>
namespace cg = cooperative_groups;
#define MK_DUP 0u
namespace pg8 {
#define PG8_LAS __attribute__((address_space(3)))
typedef unsigned short bf16_t;
typedef short bf16x8 __attribute__((ext_vector_type(8)));
typedef float f32x4 __attribute__((ext_vector_type(4)));
typedef unsigned u32x4 __attribute__((ext_vector_type(4)));
constexpr int BM = 256, BK = 64, HALF = 128, HTB = HALF * BK * 2  , STAGE_BYTES = 8 * HTB, NXCD = 8, WGM = 8;

__host__ __device__ __forceinline__ int lds_byte(int r, int c) { const int st = (r >> 4) * 2 + (c >> 5), rr = r & 15, cc = c & 31, ob = rr * 64 + cc * 2; return st * 1024 + (ob ^ (((ob >> 9) & 1) << 5)); }
__host__ __device__ __forceinline__ void stage_rc(int b, int& R, int& C) { const int st = b / 1024, sb = b % 1024, swz = sb ^ (((sb >> 9) & 1) << 5); R = (st >> 1) * 16 + swz / 64; C = (st & 1) * 32 + (swz % 64) / 2; }
__host__ __device__ __forceinline__ int perm32(int rho) { const int n = rho >> 4, i = rho & 15; return 8 * (i >> 2) + 4 * n + (i & 3); }

struct Unit { int pm, pn, ks; };
struct Gemm { const bf16_t* A; const bf16_t* Bt; int ld, K; };

struct StaticOrder {
    int nM, nN, nwg, G, c;
    __host__ __device__ void init(int M, int N, int G_, int c_) { nM = M / BM; nN = N / BM; nwg = nM * nN; G = G_; c = c_; }
    __host__ __device__ bool next(int i, Unit& u) const {
        const long L = (long)i * G + c; if (L >= nwg) return false;
        int wgid = (int)L; { const int q = nwg / NXCD, r = nwg % NXCD, xcd = wgid % NXCD, off = wgid / NXCD; wgid = (xcd < r ? xcd * (q + 1) : r * (q + 1) + (xcd - r) * q) + off; }
        const int nig = WGM * nN, gid = wgid / nig, fm = gid * WGM, gsz = (nM - fm) < WGM ? (nM - fm) : WGM;
        u.pm = fm + ((wgid % nig) % gsz); u.pn = (wgid % nig) / gsz; u.ks = 0; return true;
    }
    __device__ __forceinline__ void a_ready(const Unit&) const {}
    __device__ __forceinline__ void done(const Unit&) const {}
};
struct SubOrder {
    int pm0, npm, nN, nsl, G, c;
    __host__ __device__ bool next(int i, Unit& u) const {
        const int L = i * G + c; if (c < 0 || L >= npm * nN * nsl) return false;
        const int t = L / nsl; u.ks = L - t * nsl; u.pn = t % nN; u.pm = pm0 + t / nN; return true;
    }
    __device__ __forceinline__ void a_ready(const Unit&) const {}
    __device__ __forceinline__ void done(const Unit&) const {}
};
typedef unsigned u32x2 __attribute__((ext_vector_type(2)));

__device__ __forceinline__ unsigned cvt_pk_bf16(float lo, float hi) { unsigned r; asm("v_cvt_pk_bf16_f32 %0, %1, %2" : "=v"(r) : "v"(lo), "v"(hi)); return r; }
__device__ __forceinline__ float sigmoid_f(float x) { return __builtin_amdgcn_rcpf(1.0f + __builtin_amdgcn_exp2f(x * -1.44269504089f)); }

#ifndef MK_WT
#define MK_WT 0
#endif
typedef __attribute__((__vector_size__(4 * sizeof(int)))) int rsrc_t;
constexpr int WT_AUX = MK_WT ? 16 : 0;
__device__ __forceinline__ auto mk_rsrc(const void* base) { return __builtin_amdgcn_make_buffer_rsrc((void*)base, 0, 0x7fffffff, 0x00020000); }
#define ST16(rsrc, byteoff, v) __builtin_amdgcn_raw_buffer_store_b128(__builtin_bit_cast(u32x4, v), rsrc, (int)(byteoff), 0, pg8::WT_AUX)
#define ST8(rsrc, byteoff, v)  __builtin_amdgcn_raw_buffer_store_b64(__builtin_bit_cast(u32x2, v), rsrc, (int)(byteoff), 0, pg8::WT_AUX)

struct EpiF32 {
    static constexpr bool PERM = false, AFTER_DRAIN = false;
    float* C; int ldc;
    __device__ __forceinline__ void operator()(const f32x4 (&acc)[2][2][4][2], const Unit& u, int wr, int wc, int fr_, int fq_) const {
        int tl_ = threadIdx.x; asm volatile("" : "+v"(tl_)); const int fr = tl_ & 15, fq = (tl_ >> 4) & 3;
        const int row0 = u.pm * BM + wr * 64 + fr, col0 = u.pn * BM + wc * 32 + 4 * fq; float* const Cb_ = C;
#pragma unroll
        for (int ai = 0; ai < 2; ++ai)
#pragma unroll
            for (int m = 0; m < 4; ++m) { const unsigned ro = ((unsigned)(row0 + ai * HALF + m * 16) * (unsigned)ldc + (unsigned)col0) * 4u;
#pragma unroll
                for (int bj = 0; bj < 2; ++bj)
#pragma unroll
                    for (int n = 0; n < 2; ++n) *(f32x4*)((char*)Cb_ + ro + (bj * HALF + n * 16) * 4) = acc[ai][bj][m][n]; }
    }
};
struct EpiPle {
    static constexpr bool PERM = false, AFTER_DRAIN = false;
    bf16_t* T; const float* P; int ldc;
    __device__ __forceinline__ void operator()(const f32x4 (&acc)[2][2][4][2], const Unit& u, int wr, int wc, int fr_, int fq_) const {
        int tl_ = threadIdx.x; asm volatile("" : "+v"(tl_)); const int fr = tl_ & 15, fq = (tl_ >> 4) & 3;
        const int row0 = u.pm * BM + wr * 64 + fr, col0 = u.pn * BM + wc * 32 + 4 * fq;
#pragma unroll
        for (int ai = 0; ai < 2; ++ai)
#pragma unroll
            for (int m = 0; m < 4; ++m) { const size_t off = (size_t)(row0 + ai * HALF + m * 16) * ldc + col0;
#pragma unroll
                for (int bj = 0; bj < 2; ++bj)
#pragma unroll
                    for (int n = 0; n < 2; ++n) { const f32x4 p = *(const f32x4*)(P + off + bj * HALF + n * 16); const f32x4 a = acc[ai][bj][m][n];
                        u32x2 w; w.x = cvt_pk_bf16(sigmoid_f(a.x) * p.x, sigmoid_f(a.y) * p.y); w.y = cvt_pk_bf16(sigmoid_f(a.z) * p.z, sigmoid_f(a.w) * p.w);
                        *(u32x2*)(T + off + bj * HALF + n * 16) = w; } }
    }
};
struct EpiF32Slab {
    static constexpr bool PERM = false, AFTER_DRAIN = false;
    float* base0; float* base1; int n0; int pm0;
    __device__ __forceinline__ void operator()(const f32x4 (&acc)[2][2][4][2], const Unit& u, int wr, int wc, int fr_, int fq_) const {
        int tl_ = threadIdx.x; asm volatile("" : "+v"(tl_)); const int fr = tl_ & 15, fq = (tl_ >> 4) & 3;
        const int row0 = (u.pm - pm0) * BM + wr * 64 + fr, col0 = u.pn * BM + wc * 32 + 4 * fq;
        float* const Cb_ = (u.ks < n0) ? base0 + ((size_t)u.ks << 20) : base1 + ((size_t)(u.ks - n0) << 20);
#pragma unroll
        for (int ai = 0; ai < 2; ++ai)
#pragma unroll
            for (int m = 0; m < 4; ++m) { const unsigned ro = ((unsigned)(row0 + ai * HALF + m * 16) * 1024u + (unsigned)col0) * 4u;
#pragma unroll
                for (int bj = 0; bj < 2; ++bj)
#pragma unroll
                    for (int n = 0; n < 2; ++n) *(f32x4*)((char*)Cb_ + ro + (bj * HALF + n * 16) * 4) = acc[ai][bj][m][n]; }
    }
};
struct EpiBf16 {
    static constexpr bool PERM = true, AFTER_DRAIN = false;
    bf16_t* O; int ldc; const float* rs;
    __device__ __forceinline__ void operator()(const f32x4 (&acc)[2][2][4][2], const Unit& u, int wr, int wc, int fr_, int fq_) const {
        int tl_ = threadIdx.x; asm volatile("" : "+v"(tl_)); const int fr = tl_ & 15, fq = (tl_ >> 4) & 3;
        const int row0 = u.pm * BM + wr * 64 + fr, col0 = u.pn * BM + wc * 32 + 8 * fq; const auto rs_ = mk_rsrc(O);
#pragma unroll
        for (int ai = 0; ai < 2; ++ai)
#pragma unroll
            for (int m = 0; m < 4; ++m) { const int row = row0 + ai * HALF + m * 16; const unsigned ro = ((unsigned)row * (unsigned)ldc + (unsigned)col0) * 2u; const float r = rs ? rs[row] : 1.0f;
#pragma unroll
                for (int bj = 0; bj < 2; ++bj) { const f32x4 v0 = acc[ai][bj][m][0] * r, v1 = acc[ai][bj][m][1] * r;
                    u32x4 w; w.x = cvt_pk_bf16(v0[0], v0[1]); w.y = cvt_pk_bf16(v0[2], v0[3]); w.z = cvt_pk_bf16(v1[0], v1[1]); w.w = cvt_pk_bf16(v1[2], v1[3]);
                    ST16(rs_, ro + bj * HALF * 2, w); } }
    }
};
struct EpiSwiglu {
    static constexpr bool PERM = true, AFTER_DRAIN = false;
    bf16_t* O; int ldc;
    static __device__ __forceinline__ f32x4 silu_mul(f32x4 g, f32x4 u) {
        const f32x4 gc = __builtin_elementwise_max(g, (f32x4){-40.f, -40.f, -40.f, -40.f});
        const f32x4 t = gc * -1.44269504089f;
        f32x4 e; e.x = __builtin_amdgcn_exp2f(t.x); e.y = __builtin_amdgcn_exp2f(t.y); e.z = __builtin_amdgcn_exp2f(t.z); e.w = __builtin_amdgcn_exp2f(t.w);
        const f32x4 d = e + 1.0f;
        const float r01 = __builtin_amdgcn_rcpf(d.x * d.y), r23 = __builtin_amdgcn_rcpf(d.z * d.w);
        const f32x4 sg = {d.y * r01, d.x * r01, d.w * r23, d.z * r23};
        return (gc * sg) * u;
    }
    __device__ __forceinline__ void operator()(const f32x4 (&acc)[2][2][4][2], const Unit& u, int wr, int wc, int fr_, int fq_) const {
        int tl_ = threadIdx.x; asm volatile("" : "+v"(tl_)); const int fr = tl_ & 15, fq = (tl_ >> 4) & 3;
        const int row0 = u.pm * BM + wr * 64 + fr, col0 = u.pn * HALF + wc * 32 + 8 * fq; const auto rs_ = mk_rsrc(O);
#pragma unroll
        for (int ai = 0; ai < 2; ++ai)
#pragma unroll
            for (int m = 0; m < 4; ++m) { const unsigned ro = ((unsigned)(row0 + ai * HALF + m * 16) * (unsigned)ldc + (unsigned)col0) * 2u;
                const f32x4 v0 = silu_mul(acc[ai][0][m][0], acc[ai][1][m][0]), v1 = silu_mul(acc[ai][0][m][1], acc[ai][1][m][1]);
                u32x4 w; w.x = cvt_pk_bf16(v0[0], v0[1]); w.y = cvt_pk_bf16(v0[2], v0[3]); w.z = cvt_pk_bf16(v1[0], v1[1]); w.w = cvt_pk_bf16(v1[2], v1[3]);
                ST16(rs_, ro, w); }
    }
};

template <class Epi, class Sched, bool ALIGN_EPI = false, bool SP2 = false>
__device__ __forceinline__ void gemm_phase(PG8_LAS unsigned char* lds, const Gemm g, const Sched& S, const Epi& E) {
    int tid_ = threadIdx.x; asm volatile("" : "+v"(tid_));
    const int tid = tid_, wid = __builtin_amdgcn_readfirstlane(tid >> 6), lane = tid & 63, wr = wid >> 2, wc = wid & 3, fr = lane & 15, fq = lane >> 4;
    const int K = g.K, nt = K / BK;
    unsigned voffA[2], voffB[2];
#pragma unroll
    for (int i = 0; i < 2; ++i) { int R, C; stage_rc(tid * 16 + i * 8192, R, C); const int Rb = Epi::PERM ? ((R & ~31) + perm32(R & 31)) : R;
        voffA[i] = (unsigned)(R * g.ld + C) * 2u; voffB[i] = (unsigned)(Rb * g.ld + C) * 2u; }
    const size_t kstep = (size_t)(BK * 2);
    const size_t hstepA = (size_t)HALF * g.ld * 2, hstepB = hstepA;
    const size_t kslice = (size_t)K * 2;
    const unsigned ldsw = (unsigned)wid * 1024u;
    const int aoff = lds_byte(wr * 64 + fr, fq * 8), boff = lds_byte(wc * 32 + fr, fq * 8);
#define PG8_SA(b, h) (((b) * 2 + (h)) * HTB)
#define PG8_SB(b, h) ((4 + (b) * 2 + (h)) * HTB)
#define PG8_STAGE(bufoff, gbase, voff) do { _Pragma("unroll") for (int _i = 0; _i < 2; ++_i) \
        __builtin_amdgcn_global_load_lds((const unsigned*)((const char*)(gbase) + (voff)[_i]), (PG8_LAS unsigned*)(lds + (bufoff) + ldsw + _i * 8192), 16, 0, 0); } while (0)
#define PG8_LDA(dst, b, h) do { _Pragma("unroll") for (int m = 0; m < 4; ++m) _Pragma("unroll") for (int k = 0; k < 2; ++k) dst[m][k] = *(const PG8_LAS bf16x8*)(lds + PG8_SA(b, h) + aoff + m * 2048 + k * 1024); } while (0)
#define PG8_LDB(dst, b, h) do { _Pragma("unroll") for (int n = 0; n < 2; ++n) _Pragma("unroll") for (int k = 0; k < 2; ++k) dst[n][k] = *(const PG8_LAS bf16x8*)(lds + PG8_SB(b, h) + boff + n * 2048 + k * 1024); } while (0)
#define PG8_MMA(ai, bj, At, Bt) do { __builtin_amdgcn_s_setprio(1); _Pragma("unroll") for (int m = 0; m < 4; ++m) _Pragma("unroll") for (int n = 0; n < 2; ++n) _Pragma("unroll") for (int k = 0; k < 2; ++k) \
        acc[ai][bj][m][n] = __builtin_amdgcn_mfma_f32_16x16x32_bf16(Bt[n][k], At[m][k], acc[ai][bj][m][n], 0, 0, 0); __builtin_amdgcn_s_setprio(0); } while (0)
#define PG8_WAIT_V(n) asm volatile("s_waitcnt vmcnt(" #n ")" ::: "memory")
#define PG8_WAIT_L(n) asm volatile("s_waitcnt lgkmcnt(" #n ")" ::: "memory")
#define PG8_BAR __builtin_amdgcn_s_barrier()
#define PG8_SCHED __builtin_amdgcn_sched_barrier(0)
    Unit cur, nxt; int ui = 0;
    if (!S.next(0, cur)) return;
    f32x4 acc[2][2][4][2];
#pragma unroll
    for (int a = 0; a < 2; ++a)
#pragma unroll
        for (int b = 0; b < 2; ++b)
#pragma unroll
            for (int m = 0; m < 4; ++m)
#pragma unroll
                for (int n = 0; n < 2; ++n) acc[a][b][m][n] = (f32x4){0.f, 0.f, 0.f, 0.f};
    bf16x8 At[4][2], B0[2][2], B1[2][2];
    const char* cA = (const char*)g.A + (size_t)cur.pm * 2 * hstepA + (size_t)cur.ks * kslice; const char* cB = (const char*)g.Bt + (size_t)cur.pn * 2 * hstepB + (size_t)cur.ks * kslice;
    S.a_ready(cur);
    if constexpr (SP2) {
        PG8_STAGE(PG8_SB(0, 0), cB, voffB); PG8_STAGE(PG8_SB(0, 1), cB + hstepB, voffB); PG8_STAGE(PG8_SA(0, 0), cA, voffA); PG8_STAGE(PG8_SA(0, 1), cA + hstepA, voffA);
        if (wr == 1) PG8_BAR;
        PG8_WAIT_V(2); PG8_BAR;
        PG8_STAGE(PG8_SB(1, 0), cB + kstep, voffB); PG8_STAGE(PG8_SA(1, 0), cA + kstep, voffA); PG8_STAGE(PG8_SB(1, 1), cB + hstepB + kstep, voffB);
        PG8_WAIT_V(6); PG8_BAR;
    } else {
        PG8_STAGE(PG8_SB(0, 0), cB, voffB); PG8_STAGE(PG8_SA(0, 0), cA, voffA); PG8_STAGE(PG8_SB(0, 1), cB + hstepB, voffB); PG8_STAGE(PG8_SA(0, 1), cA + hstepA, voffA);
        if (wr == 1) PG8_BAR;
        PG8_WAIT_V(4); PG8_BAR;
        PG8_STAGE(PG8_SB(1, 0), cB + kstep, voffB); PG8_STAGE(PG8_SA(1, 0), cA + kstep, voffA); PG8_STAGE(PG8_SB(1, 1), cB + hstepB + kstep, voffB);
        PG8_WAIT_V(6); PG8_BAR;
    }
    for (;;) {
        const bool has_next = S.next(ui + 1, nxt);
        const char* nA = has_next ? (const char*)g.A + (size_t)nxt.pm * 2 * hstepA + (size_t)nxt.ks * kslice : cA; const char* nB = has_next ? (const char*)g.Bt + (size_t)nxt.pn * 2 * hstepB + (size_t)nxt.ks * kslice : cB;
        for (int t = 0; t < nt; t += 2) {
            const bool last = (t == nt - 2);
            const char* a1 = cA + (size_t)(t + 1) * kstep;
            const char* a2 = last ? nA : cA + (size_t)(t + 2) * kstep; const char* b2 = last ? nB : cB + (size_t)(t + 2) * kstep;
            const char* a3 = a2 + kstep; const char* b3 = b2 + kstep;
            if (last && has_next) S.a_ready(nxt);
            if constexpr (SP2) {
            PG8_LDB(B0, 0, 0); PG8_LDB(B1, 0, 1); PG8_SCHED; PG8_LDA(At, 0, 0); PG8_STAGE(PG8_SA(1, 1), a1 + hstepA, voffA);
            PG8_WAIT_V(8); PG8_WAIT_L(0); PG8_BAR; PG8_MMA(0, 0, At, B0); PG8_MMA(0, 1, At, B1); PG8_BAR; PG8_SCHED;
            PG8_LDA(At, 0, 1); PG8_STAGE(PG8_SB(0, 0), b2, voffB); PG8_STAGE(PG8_SB(0, 1), b2 + hstepB, voffB); PG8_STAGE(PG8_SA(0, 0), a2, voffA);
            PG8_WAIT_V(8); PG8_WAIT_L(0); PG8_BAR; PG8_MMA(1, 0, At, B0); PG8_MMA(1, 1, At, B1); PG8_BAR; PG8_SCHED;
            PG8_LDB(B0, 1, 0); PG8_LDB(B1, 1, 1); PG8_SCHED; PG8_LDA(At, 1, 0); PG8_STAGE(PG8_SA(0, 1), a2 + hstepA, voffA);
            PG8_WAIT_V(8); PG8_WAIT_L(0); PG8_BAR; PG8_MMA(0, 0, At, B0); PG8_MMA(0, 1, At, B1); PG8_BAR; PG8_SCHED;
            PG8_LDA(At, 1, 1); PG8_STAGE(PG8_SB(1, 0), b3, voffB); PG8_STAGE(PG8_SB(1, 1), b3 + hstepB, voffB); PG8_STAGE(PG8_SA(1, 0), a3, voffA);
            PG8_WAIT_V(8); PG8_WAIT_L(0); PG8_BAR; PG8_MMA(1, 0, At, B0); PG8_MMA(1, 1, At, B1); PG8_BAR; PG8_SCHED;
            } else {
            PG8_LDB(B0, 0, 0); PG8_SCHED; PG8_LDA(At, 0, 0); PG8_STAGE(PG8_SA(1, 1), a1 + hstepA, voffA);
            PG8_WAIT_L(8); PG8_BAR; PG8_WAIT_L(0); PG8_MMA(0, 0, At, B0); PG8_BAR; PG8_SCHED;
            PG8_LDB(B1, 0, 1); PG8_STAGE(PG8_SB(0, 0), b2, voffB);
            PG8_BAR; PG8_WAIT_L(0); PG8_MMA(0, 1, At, B1); PG8_BAR;
            PG8_LDA(At, 0, 1); PG8_STAGE(PG8_SA(0, 0), a2, voffA);
            PG8_BAR; PG8_WAIT_L(0); PG8_MMA(1, 0, At, B0); PG8_BAR; PG8_SCHED;
            PG8_STAGE(PG8_SB(0, 1), b2 + hstepB, voffB);
            PG8_WAIT_V(6); PG8_BAR; PG8_MMA(1, 1, At, B1); PG8_BAR;
            PG8_LDB(B0, 1, 0); PG8_SCHED; PG8_LDA(At, 1, 0); PG8_STAGE(PG8_SA(0, 1), a2 + hstepA, voffA);
            PG8_WAIT_L(8); PG8_BAR; PG8_WAIT_L(0); PG8_MMA(0, 0, At, B0); PG8_BAR; PG8_SCHED;
            PG8_LDB(B1, 1, 1); PG8_STAGE(PG8_SB(1, 0), b3, voffB);
            PG8_BAR; PG8_WAIT_L(0); PG8_MMA(0, 1, At, B1); PG8_BAR;
            PG8_LDA(At, 1, 1); PG8_STAGE(PG8_SA(1, 0), a3, voffA);
            PG8_BAR; PG8_WAIT_L(0); PG8_MMA(1, 0, At, B0); PG8_BAR; PG8_SCHED;
            PG8_STAGE(PG8_SB(1, 1), b3 + hstepB, voffB);
            PG8_WAIT_V(6); PG8_BAR; PG8_MMA(1, 1, At, B1); PG8_BAR;
            }
        }
        if constexpr (ALIGN_EPI) { if (wr == 0) PG8_BAR; }
        if constexpr (!Epi::AFTER_DRAIN) { E(acc, cur, wr, wc, fr, fq); S.done(cur); }
        if (!has_next) break;
#pragma unroll
        for (int a = 0; a < 2; ++a)
#pragma unroll
            for (int b = 0; b < 2; ++b)
#pragma unroll
                for (int m = 0; m < 4; ++m)
#pragma unroll
                    for (int n = 0; n < 2; ++n) acc[a][b][m][n] = (f32x4){0.f, 0.f, 0.f, 0.f};
        cur = nxt; cA = nA; cB = nB; ++ui;
        if constexpr (ALIGN_EPI) { if (wr == 1) PG8_BAR; }
    }
    PG8_WAIT_V(0);
    if constexpr (!ALIGN_EPI) { if (wr == 0) PG8_BAR; }
    PG8_BAR;
    if constexpr (Epi::AFTER_DRAIN) { E.fused(acc, cur, wr, wc, fr, fq, lds, wid, lane); S.done(cur); }
#undef PG8_SA
#undef PG8_SB
#undef PG8_STAGE
#undef PG8_LDA
#undef PG8_LDB
#undef PG8_MMA
#undef PG8_WAIT_V
#undef PG8_WAIT_L
#undef PG8_BAR
#undef PG8_SCHED
}
}

using pg8::bf16_t; using pg8::bf16x8; using pg8::f32x4; using pg8::u32x4; using pg8::u32x2; using pg8::cvt_pk_bf16;
#define LAS __attribute__((address_space(3)))
#define XB_TMO      128
#define XB_XCNT(j)  (256  + 64 * (j))
#define XB_XSUB(j)  (1280 + 64 * (j))
#define XB_XGEN(j)  (2304 + 64 * (j))
#define XB_TOP      3328
#define XB_TOPGEN   3392
#define XCD_BAR_WORDS 3456
#define XB_SPIN_CAP (1u << 18)

__device__ __forceinline__ unsigned xb_ld(unsigned* p)              { return __hip_atomic_load(p, __ATOMIC_RELAXED, __HIP_MEMORY_SCOPE_AGENT); }
__device__ __forceinline__ unsigned xb_add(unsigned* p, unsigned v) { return __hip_atomic_fetch_add(p, v, __ATOMIC_RELAXED, __HIP_MEMORY_SCOPE_AGENT); }
__device__ __forceinline__ unsigned xb_xcc_id() { return (unsigned)__builtin_amdgcn_s_getreg((3 << 11) | 20) & 0xFu; }
#define XB_SPIN(cond, bar) do { unsigned _sp = 0; while (cond) { __builtin_amdgcn_s_sleep(1); \
    if ((++_sp & 255u) == 0u) { if (xb_ld(&(bar)[XB_TMO])) break; if (_sp > XB_SPIN_CAP) { atomicAdd(&(bar)[XB_TMO], 1u); break; } } } } while (0)

struct XcdBarrier {
    unsigned* bar; unsigned x;
    volatile LAS unsigned* st;
};

__device__ __forceinline__ XcdBarrier xcd_barrier_post(unsigned* bar, volatile LAS unsigned* st) {
    XcdBarrier b; b.bar = bar; b.x = xb_xcc_id(); b.st = st;
    if (threadIdx.x == 0) (void)xb_add(&bar[XB_XCNT(b.x)], 1u);
    return b;
}
__device__ __forceinline__ void xcd_barrier_complete(unsigned* bar, unsigned x, unsigned& nloc, unsigned& nx) {
    const unsigned G = gridDim.x * gridDim.y * gridDim.z;
    unsigned sum, cnt, mine, sp = 0u;
    for (;;) {
        sum = 0u; cnt = 0u; mine = 0u;
#pragma unroll
        for (unsigned j = 0; j < 16; ++j) { const unsigned c = xb_ld(&bar[XB_XCNT(j)]); sum += c; cnt += (c > 0u) ? 1u : 0u; mine = (j == x) ? c : mine; }
        if (sum == G) break;
        __builtin_amdgcn_s_sleep(1);
        if ((++sp & 255u) == 0u) { if (xb_ld(&bar[XB_TMO])) break; if (sp > XB_SPIN_CAP) { atomicAdd(&bar[XB_TMO], 1u); break; } }
    }
    nloc = mine > 0u ? mine : 1u; nx = cnt > 0u ? cnt : 1u;
}

__device__ __forceinline__ void xcd_barrier(const XcdBarrier& b) {
    asm volatile("s_waitcnt vmcnt(0)" ::: "memory");
    __syncthreads();
    if (threadIdx.x == 0) {
        unsigned* bar = b.bar;
        __builtin_amdgcn_s_waitcnt(0);
        unsigned nloc = b.st[0], nx = b.st[1];
        if (nloc == 0u) { xcd_barrier_complete(bar, b.x, nloc, nx); b.st[0] = nloc; b.st[1] = nx; }
        const unsigned old = xb_add(&bar[XB_XSUB(b.x)], 1u);
        const unsigned gen = old / nloc;
        if (old + 1u == (gen + 1u) * nloc) {
            __builtin_amdgcn_fence(__ATOMIC_RELEASE, "agent");
            asm volatile("s_waitcnt vmcnt(0)" ::: "memory");
            const unsigned og = xb_add(&bar[XB_TOP], 1u);
            const unsigned tg = og / nx;
            if (og + 1u == (tg + 1u) * nx) xb_add(&bar[XB_TOPGEN], 1u);
            else XB_SPIN(xb_ld(&bar[XB_TOPGEN]) == tg, bar);
            __builtin_amdgcn_fence(__ATOMIC_ACQUIRE, "agent");
            xb_add(&bar[XB_XGEN(b.x)], 1u);
            asm volatile("s_waitcnt vmcnt(0)" ::: "memory");
        } else {
            XB_SPIN(xb_ld(&bar[XB_XGEN(b.x)]) == gen, bar);
            __builtin_amdgcn_fence(__ATOMIC_ACQUIRE, "agent");
            asm volatile("s_waitcnt vmcnt(0)" ::: "memory");
        }
    }
    __syncthreads();
}


#ifndef MK_DUP
#define MK_DUP 0u
#endif
#ifndef MK_COOP
#define MK_COOP 1
#endif
constexpr int M_ = 17408, MP_ = 16384, DM = 1024, FF = 2816, NGU = 5632, NIN = 2560, PLE = 256;
constexpr float EPS_ = 1e-6f;
constexpr int LDS_BYTES = 147456;
constexpr int NPHASE = 14;
constexpr size_t WS_WGU1 = 0;
constexpr size_t WS_WD1 = WS_WGU1 + (size_t)NGU * DM * 2;
constexpr size_t WS_WIN = WS_WD1 + (size_t)DM * FF * 2;
constexpr size_t WS_WOUT = WS_WIN + (size_t)NIN * DM * 2;
constexpr size_t WS_WGU2 = WS_WOUT + (size_t)DM * DM * 2;
constexpr size_t WS_WD2 = WS_WGU2 + (size_t)NGU * DM * 2;
constexpr size_t WS_WPG = WS_WD2 + (size_t)DM * FF * 2;
constexpr size_t WS_WPP = WS_WPG + (size_t)DM * DM * 2;
constexpr size_t WS_YC = WS_WPP + (size_t)DM * PLE * 2;
constexpr size_t WS_ACT = WS_YC + (size_t)M_ * DM * 2;
constexpr size_t WS_D = WS_ACT + (size_t)M_ * FF * 2;
constexpr size_t WS_HB = WS_D + (size_t)M_ * DM * 2;
constexpr size_t WS_SLAB2 = WS_HB + (size_t)M_ * DM * 2;
constexpr size_t WS_RS = WS_SLAB2 + (size_t)3 * 1024 * 1024 * 4;
constexpr size_t WS_END = WS_RS + (size_t)M_ * 4;
constexpr size_t WS_BAR = WS_END;
constexpr size_t WS_TOTAL = WS_BAR + (size_t)XCD_BAR_WORDS * 4;
constexpr size_t WS_PROJ = WS_ACT;
constexpr size_t WS_PP = WS_ACT;
constexpr size_t WS_PB = WS_ACT + (size_t)M_ * DM * 4;
constexpr size_t WS_SLAB4 = WS_PB + (size_t)M_ * PLE * 2;
static_assert(WS_SLAB4 + (size_t)4 * 1024 * 1024 * 4 <= WS_D, "aliases fit");
constexpr size_t OUT_NCP = 17825792, OUT_NCS = 17833984, OUT_CVP = 17965056, OUT_CVS = 18489344;

struct Args { const float* in[28]; float* out; unsigned char* ws; int ph_lo, ph_hi; };

__device__ __forceinline__ float wave_sum(float v) {
#pragma unroll
    for (int o = 1; o < 64; o <<= 1) v += __shfl_xor(v, o);
    return v;
}
__device__ __forceinline__ float bf_lo(unsigned w) { return __uint_as_float(w << 16); }
__device__ __forceinline__ float bf_hi(unsigned w) { return __uint_as_float(w & 0xffff0000u); }
__device__ __forceinline__ float dot4(f32x4 a) { return (a.x * a.x + a.y * a.y) + (a.z * a.z + a.w * a.w); }
#define LDS_WAIT() asm volatile("s_waitcnt lgkmcnt(0)" ::: "memory")

__device__ __forceinline__ void transpose_item(const float* __restrict__ W, int K, int N, bf16_t* __restrict__ WT, int k0, int n0, int drow0, LAS float* scr, int lane, const float* __restrict__ gk) {
    float g8[8]; f32x4 v8[8];
#pragma unroll
    for (int i = 0; i < 8; ++i) { const int kk = 8 * i + (lane >> 3); v8[i] = *(const f32x4*)(W + (size_t)(k0 + kk) * N + n0 + (lane & 7) * 4); g8[i] = gk ? gk[k0 + kk] : 1.0f; }
#pragma unroll
    for (int i = 0; i < 8; ++i) { const int kk = 8 * i + (lane >> 3); LAS float* d = scr + kk * 33 + (lane & 7) * 4; const f32x4 v = v8[i] * g8[i]; d[0] = v.x; d[1] = v.y; d[2] = v.z; d[3] = v.w; }
    LDS_WAIT();
    const int c = lane & 7;
#pragma unroll
    for (int j = 0; j < 4; ++j) { const int n = (lane >> 3) + 8 * j; const LAS float* s = scr + (8 * c) * 33 + n;
        u32x4 o; o.x = cvt_pk_bf16(s[0 * 33], s[1 * 33]); o.y = cvt_pk_bf16(s[2 * 33], s[3 * 33]); o.z = cvt_pk_bf16(s[4 * 33], s[5 * 33]); o.w = cvt_pk_bf16(s[6 * 33], s[7 * 33]);
        *(u32x4*)(WT + (size_t)(drow0 + n) * K + k0 + 8 * c) = o; }
    LDS_WAIT();
}

__device__ __forceinline__ f32x4 bf4(unsigned a, unsigned b) { return (f32x4){bf_lo(a), bf_hi(a), bf_lo(b), bf_hi(b)}; }
template <int MODE>
__device__ __forceinline__ void rp_load_res(int m, const float* __restrict__ resP, const float* __restrict__ resS, const bf16_t* hb, int lane, f32x4 (&h)[4]) {
    if (MODE & 2) { const float* rrow = (m < MP_) ? resP + (size_t)m * DM : resS + (size_t)(m - MP_) * DM;
#pragma unroll
        for (int j = 0; j < 4; ++j) h[j] = ((const f32x4*)rrow)[lane + 64 * j]; }
    else { const u32x2* hr = (const u32x2*)(hb + (size_t)m * DM) + lane;
#pragma unroll
        for (int j = 0; j < 4; ++j) { const u32x2 w = hr[64 * j]; h[j] = bf4(w.x, w.y); } }
}
__device__ __forceinline__ int vzero() { int z; asm volatile("v_mov_b32 %0, 0" : "=v"(z)); return z; }
template <int MODE>
__device__ __forceinline__ void rp_finish(int m, f32x4 (&h)[4], f32x4 (&d)[4], const f32x4 (&gp)[4], float sc, bf16_t* hb, float* rsv, float* __restrict__ outf, int lane, float hin_scale) {
    if (MODE & 32) {
#pragma unroll
        for (int j = 0; j < 4; ++j) h[j] *= hin_scale; }
    if (MODE & 1) {
        float ss = 0.f;
#pragma unroll
        for (int j = 0; j < 4; ++j) ss += dot4(d[j]);
        const float rs = sc * rsqrtf(wave_sum(ss) * (1.0f / DM) + EPS_);
#pragma unroll
        for (int j = 0; j < 4; ++j) h[j] += d[j] * rs * gp[j];
    }
    if (MODE & 4) {
        float s2 = 0.f;
#pragma unroll
        for (int j = 0; j < 4; ++j) s2 += dot4(h[j]);
        const float rs2 = rsqrtf(wave_sum(s2) * (1.0f / DM) + EPS_);
        if (lane == 0) rsv[m] = rs2;
        const float osc = (MODE & 64) ? rs2 : 1.0f;
        const auto hrs = pg8::mk_rsrc(hb); const unsigned ho = (unsigned)m * (DM * 2u) + (unsigned)lane * 8u;
#pragma unroll
        for (int j = 0; j < 4; ++j) { const f32x4 v = h[j] * osc; u32x2 w; w.x = cvt_pk_bf16(v.x, v.y); w.y = cvt_pk_bf16(v.z, v.w); ST8(hrs, ho + 512u * j, w); }
    }
    if (MODE & 8) { f32x4* ho = (f32x4*)(outf + (size_t)m * DM) + lane;
#pragma unroll
        for (int j = 0; j < 4; ++j) ho[64 * j] = h[j]; }
}
template <int MODE, int NSL, int N0>
__device__ __forceinline__ void rowpass(const bf16_t* __restrict__ dbuf, const float* slab0, const float* slab1, const float* __restrict__ pp, const float* __restrict__ resP, const float* __restrict__ resS,
                                        bf16_t* hb, float* rsv, float* __restrict__ outf, const float* __restrict__ gpost, float sc, int gw, int NGW, int lane) {
    f32x4 gp[4]; const int vz = vzero();
#pragma unroll
    for (int j = 0; j < 4; ++j) gp[j] = (MODE & 1) ? ((const f32x4*)gpost)[lane + 64 * j] : (f32x4){0.f, 0.f, 0.f, 0.f};
    constexpr int NR = 4;
    for (int m0 = gw; m0 < MP_; m0 += NR * NGW) {
        f32x4 hh[NR][4], dd[NR][4]; u32x2 ww[NR][4]; float isc[NR];
#pragma unroll
        for (int q = 0; q < NR; ++q) { const int m = m0 + q * NGW; isc[q] = 1.0f; if (m < MP_) { rp_load_res<MODE>(m, resP, resS, hb, lane, hh[q]); if (MODE & 32) isc[q] = rsv[m + vz]; } }
        if (MODE & 1) {
#pragma unroll
            for (int q = 0; q < NR; ++q) { const int m = m0 + q * NGW; if (m < MP_) { const u32x2* dr = (const u32x2*)(dbuf + (size_t)m * DM) + lane;
#pragma unroll
                for (int j = 0; j < 4; ++j) ww[q][j] = dr[64 * j]; } }
#pragma unroll
            for (int q = 0; q < NR; ++q)
#pragma unroll
                for (int j = 0; j < 4; ++j) dd[q][j] = bf4(ww[q][j].x, ww[q][j].y);
        }
#pragma unroll
        for (int q = 0; q < NR; ++q) { const int m = m0 + q * NGW; if (m < MP_) rp_finish<MODE>(m, hh[q], dd[q], gp, sc, hb, rsv, outf, lane, (MODE & 32) ? 1.0f / isc[q] : 1.0f); }
    }
    if (((gw & 1) == 0)) for (int r = (gw >> 3) * 4 + ((gw & 7) >> 1); r < M_ - MP_; r += (NGW >> 3) * 4) {
        const int m = MP_ + r;
        f32x4 h[4], d[4]; float isc1 = 1.0f;
        rp_load_res<MODE>(m, resP, resS, hb, lane, h);
        if (MODE & 32) isc1 = rsv[m + vz];
        if (MODE & 1) {
#pragma unroll
            for (int j = 0; j < 4; ++j) { f32x4 t[NSL > 0 ? NSL : 1];
#pragma unroll
                for (int s = 0; s < NSL; ++s) t[s] = ((const f32x4*)(((s < N0) ? slab0 + ((size_t)s << 20) : slab1 + ((size_t)(s - N0) << 20)) + (size_t)r * DM))[lane + 64 * j];
                f32x4 acc = {0.f, 0.f, 0.f, 0.f};
#pragma unroll
                for (int s = 0; s < NSL; ++s) acc += t[s];
                d[j] = acc; }
            if (MODE & 16) { const f32x4* pr = (const f32x4*)(pp + (size_t)m * DM) + lane;
#pragma unroll
                for (int j = 0; j < 4; ++j) { const f32x4 p = pr[64 * j]; d[j].x = pg8::sigmoid_f(d[j].x) * p.x; d[j].y = pg8::sigmoid_f(d[j].y) * p.y; d[j].z = pg8::sigmoid_f(d[j].z) * p.z; d[j].w = pg8::sigmoid_f(d[j].w) * p.w; } }
        }
        rp_finish<MODE>(m, h, d, gp, sc, hb, rsv, outf, lane, (MODE & 32) ? 1.0f / isc1 : 1.0f);
    }
}

__device__ __forceinline__ void mixer_phase(const Args& a, LAS unsigned char* lds, const bf16_t* __restrict__ PROJ, bf16_t* __restrict__ YC, int wave, int lane) {
    constexpr int VP = 1056;
    const auto ycrs = pg8::mk_rsrc(YC);
    LAS float* part = (LAS float*)(lds + 128 * VP);
    const int fr = lane & 15, fq = lane >> 4;
    const float* __restrict__ wsm = a.in[15]; const float* __restrict__ bsm = a.in[16];
    float* out = a.out;
    const int G_ = (int)gridDim.x, b_ = (int)blockIdx.x;
    for (int it = 0;; ++it) {
        int u;
        if (G_ == 256) { if (it == 0) u = b_; else if (it == 1 && (b_ & 1) == 0 && b_ < 32) u = 256 + (b_ >> 1); else break; }
        else { u = b_ + it * G_; if (u >= 272) break; }
        const bool samp = (u >= 256);
        const int R0 = u * 64;
        int s0 = 0, t0 = 0;
        if (!samp) { s0 = (u & 31) * 64; t0 = s0 & 127; }
        const int CB = R0 - t0, kext = t0 + 64;
        const int h = wave; const int nkb = kext >> 5;
        bf16x8 afr[4][4];
#pragma unroll
        for (int kb = 0; kb < 4; ++kb) {
#pragma unroll
            for (int tb = 0; tb < 4; ++tb) {
                f32x4 w0 = {0.f, 0.f, 0.f, 0.f}, w1 = w0; int lim = -1;
                if (kb < nkb) {
                    if (!samp) { const int tt = t0 + tb * 16 + fr, sb = kb * 32 + fq * 8; const float* wp = wsm + (size_t)(h * 128 + tt) * 128 + sb;
                        w0 = *(const f32x4*)wp; w1 = *(const f32x4*)(wp + 4); lim = tt - sb; }
                    else { const int tt = fr & 7; const float* wp = wsm + (size_t)(h * 128 + tt) * 128;
                        w0 = *(const f32x4*)wp; w1 = *(const f32x4*)(wp + 4); lim = ((kb * 4 + fq) == (tb * 2 + (fr >> 3))) ? tt : -1; }
                }
                w0.x = (0 <= lim) ? w0.x : 0.f; w0.y = (1 <= lim) ? w0.y : 0.f; w0.z = (2 <= lim) ? w0.z : 0.f; w0.w = (3 <= lim) ? w0.w : 0.f;
                w1.x = (4 <= lim) ? w1.x : 0.f; w1.y = (5 <= lim) ? w1.y : 0.f; w1.z = (6 <= lim) ? w1.z : 0.f; w1.w = (7 <= lim) ? w1.w : 0.f;
                u32x4 pk; pk.x = cvt_pk_bf16(w0.x, w0.y); pk.y = cvt_pk_bf16(w0.z, w0.w); pk.z = cvt_pk_bf16(w1.x, w1.y); pk.w = cvt_pk_bf16(w1.z, w1.w);
                afr[kb][tb] = __builtin_bit_cast(bf16x8, pk);
            }
        }
        {
            const f32x4 vg0 = *(const f32x4*)(a.in[14] + lane * 8), vg1 = *(const f32x4*)(a.in[14] + lane * 8 + 4);
            for (int sb8 = 0; sb8 < kext; sb8 += 64) {
                u32x4 raw8[8];
#pragma unroll
                for (int i = 0; i < 8; ++i) raw8[i] = *(const u32x4*)(PROJ + (size_t)(CB + sb8 + i * 8 + wave) * NIN + 2048 + lane * 8);
#pragma unroll
                for (int i = 0; i < 8; ++i) {
                    const int s = sb8 + i * 8 + wave, row = CB + s; const u32x4 raw = raw8[i];
                    f32x4 v0 = bf4(raw.x, raw.y), v1 = bf4(raw.z, raw.w);
                    float ss = dot4(v0) + dot4(v1);
                    ss += __shfl_xor(ss, 1); ss += __shfl_xor(ss, 2); ss += __shfl_xor(ss, 4);
                    const float rs = rsqrtf(ss * (1.0f / 64.0f) + EPS_);
                    v0 = v0 * rs * vg0; v1 = v1 * rs * vg1;
                    u32x4 pk; pk.x = cvt_pk_bf16(v0.x, v0.y); pk.y = cvt_pk_bf16(v0.z, v0.w); pk.z = cvt_pk_bf16(v1.x, v1.y); pk.w = cvt_pk_bf16(v1.z, v1.w);
                    *(LAS u32x4*)(lds + s * VP + lane * 16) = pk;
                    if (s >= t0) {
                        if (samp) { float* o = out + OUT_CVS + (size_t)(row - MP_) * 512 + lane * 8; *(f32x4*)o = v0; *(f32x4*)(o + 4) = v1; }
                        else if (s0 - t0 == 1920) { float* o = out + OUT_CVP + (size_t)((u >> 5) * 128 + s) * 512 + lane * 8; *(f32x4*)o = v0; *(f32x4*)(o + 4) = v1; }
                    }
                }
            }
        }
        __syncthreads();
        f32x4 acc[4][4];
#pragma unroll
        for (int i = 0; i < 4; ++i)
#pragma unroll
            for (int j = 0; j < 4; ++j) acc[i][j] = (f32x4){0.f, 0.f, 0.f, 0.f};
#pragma unroll
        for (int kb = 0; kb < 4; ++kb) if (kb < nkb) {
            u32x2 r0[4], r1[4];
            { const unsigned ta = (unsigned)(uintptr_t)(lds + (kb * 32 + fq * 8 + (fr >> 2)) * VP + (h * 64 + (fr & 3) * 4) * 2);
              asm volatile("ds_read_b64_tr_b16 %0, %8\n\tds_read_b64_tr_b16 %1, %8 offset:4224\n\t"
                           "ds_read_b64_tr_b16 %2, %8 offset:32\n\tds_read_b64_tr_b16 %3, %8 offset:4256\n\t"
                           "ds_read_b64_tr_b16 %4, %8 offset:64\n\tds_read_b64_tr_b16 %5, %8 offset:4288\n\t"
                           "ds_read_b64_tr_b16 %6, %8 offset:96\n\tds_read_b64_tr_b16 %7, %8 offset:4320\n\ts_waitcnt lgkmcnt(0)"
                           : "=&v"(r0[0]), "=&v"(r1[0]), "=&v"(r0[1]), "=&v"(r1[1]), "=&v"(r0[2]), "=&v"(r1[2]), "=&v"(r0[3]), "=&v"(r1[3]) : "v"(ta) : "memory"); }
#pragma unroll
            for (int db = 0; db < 4; ++db) {
                u32x4 bq; bq.x = r0[db].x; bq.y = r0[db].y; bq.z = r1[db].x; bq.w = r1[db].y;
                const bf16x8 bfv = __builtin_bit_cast(bf16x8, bq);
#pragma unroll
                for (int tb = 0; tb < 4; ++tb) acc[tb][db] = __builtin_amdgcn_mfma_f32_16x16x32_bf16(bfv, afr[kb][tb], acc[tb][db], 0, 0, 0);
            }
        }
#pragma unroll
        for (int tb = 0; tb < 4; ++tb) {
            const int t = tb * 16 + fr; const int tt = samp ? (fr & 7) : (t0 + t); const float bias = bsm[h * 128 + tt];
            const bf16_t* up = PROJ + (size_t)(R0 + t) * NIN + 1536 + h * 64 + fq * 4;
            float s = 0.f;
#pragma unroll
            for (int db = 0; db < 4; ++db) { const u32x2 ur = *(const u32x2*)(up + db * 16); const f32x4 uu = bf4(ur.x, ur.y);
                const f32x4 y = uu * (acc[tb][db] + bias); acc[tb][db] = y; s += dot4(y); }
            s += __shfl_xor(s, 16); s += __shfl_xor(s, 32);
            if (fq == 0) part[h * 64 + t] = s;
        }
        __syncthreads();
#pragma unroll
        for (int tb = 0; tb < 4; ++tb) {
            const int t = tb * 16 + fr; float tot = 0.f;
#pragma unroll
            for (int hh = 0; hh < 8; ++hh) tot += part[hh * 64 + t];
            const float rs = rsqrtf(tot * (1.0f / 512.0f) + EPS_);
            bf16_t* yp = YC + (size_t)(R0 + t) * DM + 512 + h * 64 + fq * 4;
#pragma unroll
            for (int db = 0; db < 4; ++db) { const f32x4 gb = *(const f32x4*)(a.in[18] + h * 64 + db * 16 + fq * 4); const f32x4 y = acc[tb][db] * rs * gb;
                u32x2 w; w.x = cvt_pk_bf16(y.x, y.y); w.y = cvt_pk_bf16(y.z, y.w); ST8(ycrs, (unsigned)((R0 + t) * DM + 512 + h * 64 + fq * 4 + db * 16) * 2u, w); }
        }
        {
            const int c0 = lane * 8; const float* cw = a.in[13];
            const f32x4 w0a = *(const f32x4*)(cw + c0), w0b = *(const f32x4*)(cw + c0 + 4), w1a = *(const f32x4*)(cw + 512 + c0), w1b = *(const f32x4*)(cw + 512 + c0 + 4),
                        w2a = *(const f32x4*)(cw + 1024 + c0), w2b = *(const f32x4*)(cw + 1024 + c0 + 4);
            const f32x4 gaa = *(const f32x4*)(a.in[17] + c0), gab = *(const f32x4*)(a.in[17] + c0 + 4);
            f32x4 zp2a = {0.f, 0.f, 0.f, 0.f}, zp2b = zp2a, zp1a = zp2a, zp1b = zp2a;
            const int rb = R0 + wave * 8; const int sb_ = (u - 256) * 8 + wave;
            if (samp) { const float* st = a.in[4] + (size_t)sb_ * 1024 + c0; zp2a = *(const f32x4*)st; zp2b = *(const f32x4*)(st + 4); zp1a = *(const f32x4*)(st + 512); zp1b = *(const f32x4*)(st + 516); }
            else if (s0 + wave * 8 > 0) {
                const bf16_t* p2 = PROJ + (size_t)(rb - 2) * NIN + c0; const bf16_t* p1 = p2 + NIN;
                const u32x4 c2 = *(const u32x4*)(p2 + 512), h2 = *(const u32x4*)(p2 + 1024), c1 = *(const u32x4*)(p1 + 512), h1 = *(const u32x4*)(p1 + 1024);
                zp2a = bf4(c2.x, c2.y) * bf4(h2.x, h2.y); zp2b = bf4(c2.z, c2.w) * bf4(h2.z, h2.w); zp1a = bf4(c1.x, c1.y) * bf4(h1.x, h1.y); zp1b = bf4(c1.z, c1.w) * bf4(h1.z, h1.w);
            }
            f32x4 ya[8], yb[8]; float ss[8];
            u32x4 braw8[8], craw8[8], hraw8[8];
#pragma unroll
            for (int i = 0; i < 8; ++i) { const bf16_t* pr = PROJ + (size_t)(rb + i) * NIN + c0; braw8[i] = *(const u32x4*)pr; craw8[i] = *(const u32x4*)(pr + 512); hraw8[i] = *(const u32x4*)(pr + 1024); }
#pragma unroll
            for (int i = 0; i < 8; ++i) {
                const u32x4 braw = braw8[i], craw = craw8[i], hraw = hraw8[i];
                const f32x4 za = bf4(craw.x, craw.y) * bf4(hraw.x, hraw.y), zb = bf4(craw.z, craw.w) * bf4(hraw.z, hraw.w);
                const f32x4 ca = w0a * zp2a + w1a * zp1a + w2a * za, cb = w0b * zp2b + w1b * zp1b + w2b * zb;
                ya[i] = bf4(braw.x, braw.y) * ca; yb[i] = bf4(braw.z, braw.w) * cb;
                ss[i] = wave_sum(dot4(ya[i]) + dot4(yb[i]));
                if (i >= 6) {
                    if (samp) { float* o = out + OUT_NCS + ((size_t)sb_ * 2 + (i - 6)) * 512 + c0; *(f32x4*)o = za; *(f32x4*)(o + 4) = zb; }
                    else if ((u & 31) == 31 && wave == 7) { float* o = out + OUT_NCP + ((size_t)(u >> 5) * 2 + (i - 6)) * 512 + c0; *(f32x4*)o = za; *(f32x4*)(o + 4) = zb; }
                }
                zp2a = zp1a; zp2b = zp1b; zp1a = za; zp1b = zb;
            }
#pragma unroll
            for (int i = 0; i < 8; ++i) {
                const float rs = rsqrtf(ss[i] * (1.0f / 512.0f) + EPS_);
                const f32x4 y0 = ya[i] * rs * gaa, y1 = yb[i] * rs * gab;
                u32x4 w; w.x = cvt_pk_bf16(y0.x, y0.y); w.y = cvt_pk_bf16(y0.z, y0.w); w.z = cvt_pk_bf16(y1.x, y1.y); w.w = cvt_pk_bf16(y1.z, y1.w);
                ST16(ycrs, (unsigned)((rb + i) * DM + c0) * 2u, w);
            }
        }
        __syncthreads();
    }
}

__device__ __forceinline__ int fresh_tid() { int t = threadIdx.x; asm volatile("" : "+v"(t)); return t; }
template <bool COOP>
__global__ void __launch_bounds__(512, 2) fwd_kernel(Args a) {
    extern __shared__ __attribute__((aligned(16))) unsigned char lds_raw[];
    LAS unsigned char* lds = (LAS unsigned char*)lds_raw;
    const int tid = threadIdx.x;
    const int G = gridDim.x, NGW = G * 8;
#define LANE_ (fresh_tid() & 63)
#define WAVE_ (__builtin_amdgcn_readfirstlane(fresh_tid() >> 6))
#define GW_ ((int)blockIdx.x * 8 + WAVE_)
    unsigned char* ws = a.ws;
    bf16_t* WGU1 = (bf16_t*)(ws + WS_WGU1); bf16_t* WD1 = (bf16_t*)(ws + WS_WD1); bf16_t* WIN = (bf16_t*)(ws + WS_WIN); bf16_t* WOUT = (bf16_t*)(ws + WS_WOUT);
    bf16_t* WGU2 = (bf16_t*)(ws + WS_WGU2); bf16_t* WD2 = (bf16_t*)(ws + WS_WD2); bf16_t* WPG = (bf16_t*)(ws + WS_WPG); bf16_t* WPP = (bf16_t*)(ws + WS_WPP);
    bf16_t* YC = (bf16_t*)(ws + WS_YC); bf16_t* HB = (bf16_t*)(ws + WS_HB); float* RS = (float*)(ws + WS_RS); bf16_t* ACT = (bf16_t*)(ws + WS_ACT); bf16_t* PROJ = (bf16_t*)(ws + WS_PROJ); bf16_t* PB = (bf16_t*)(ws + WS_PB);
    bf16_t* DB = (bf16_t*)(ws + WS_D); float* SLAB2 = (float*)(ws + WS_SLAB2); float* SLAB4 = (float*)(ws + WS_SLAB4); float* PP = (float*)(ws + WS_PP);
#define IN(k) (a.ph_lo <= (k) && (k) < a.ph_hi)
#define REP(k) for (int rep_ = 0; rep_ < (((MK_DUP >> (k)) & 1u) ? 2 : 1); ++rep_)
    XcdBarrier bar; bar.bar = (unsigned*)(ws + WS_BAR); bar.x = 0; bar.st = nullptr;
    if (COOP) {
        volatile LAS unsigned* st = (volatile LAS unsigned*)(lds + LDS_BYTES - 16);
        if (tid < 4) st[tid] = 0u;
        __syncthreads();
        bar = xcd_barrier_post((unsigned*)(ws + WS_BAR), st);
        if (a.ph_lo < 0) cg::this_grid().sync();
    }
#define SEAM(k) do { if (COOP && IN(k) && IN((k) + 1)) xcd_barrier(bar); } while (0)

    if (IN(0)) REP(0) {
        const int lane = LANE_, wave = WAVE_, gw = GW_; LAS float* scr = (LAS float*)(lds + wave * 8448);
        constexpr int I_G = (DM / 64) * (FF / 32), I_D = (FF / 64) * (DM / 32), I_IN = (DM / 64) * (NIN / 32), I_O = (DM / 64) * (DM / 32), I_PP = (PLE / 64) * (DM / 32);
        constexpr int NITEMS = 4 * I_G + 2 * I_D + I_IN + 2 * I_O + I_PP;
        for (int it = gw; it < NITEMS; it += NGW) {
            int r = it; const float* W; int K, N; bf16_t* WT; int mode = 0; const float* gk = nullptr;
            if (r < I_G) { W = a.in[7]; K = DM; N = FF; WT = WGU1; mode = 1; gk = a.in[5]; }
            else if ((r -= I_G) < I_G) { W = a.in[8]; K = DM; N = FF; WT = WGU1; mode = 2; gk = a.in[5]; }
            else if ((r -= I_G) < I_G) { W = a.in[22]; K = DM; N = FF; WT = WGU2; mode = 1; gk = a.in[20]; }
            else if ((r -= I_G) < I_G) { W = a.in[23]; K = DM; N = FF; WT = WGU2; mode = 2; gk = a.in[20]; }
            else if ((r -= I_G) < I_D) { W = a.in[9]; K = FF; N = DM; WT = WD1; }
            else if ((r -= I_D) < I_D) { W = a.in[24]; K = FF; N = DM; WT = WD2; }
            else if ((r -= I_D) < I_IN) { W = a.in[12]; K = DM; N = NIN; WT = WIN; gk = a.in[10]; }
            else if ((r -= I_IN) < I_O) { W = a.in[19]; K = DM; N = DM; WT = WOUT; }
            else if ((r -= I_O) < I_O) { W = a.in[25]; K = DM; N = DM; WT = WPG; }
            else { r -= I_O; W = a.in[26]; K = PLE; N = DM; WT = WPP; }
            const int nblk = N / 32, kb = r / nblk, nb = r % nblk, k0 = 64 * kb, n0 = 32 * nb;
            int drow0 = n0; if (mode) drow0 = (n0 >> 7) * 256 + (n0 & 127) + (mode == 2 ? 128 : 0);
            transpose_item(W, K, N, WT, k0, n0, drow0, scr, lane, gk);
        }
        rowpass<2 | 4 | 64, 0, 0>(nullptr, nullptr, nullptr, nullptr, a.in[0], a.in[1], HB, RS, nullptr, nullptr, 0.f, gw, NGW, lane);
    }
    SEAM(0);
    const int bid = (int)blockIdx.x;
#define GEMM_FULL(EPI, Aop, Bop, KK, MM, NN, ...) do { pg8::Gemm g_{Aop, Bop, KK, KK}; pg8::StaticOrder S_; S_.init(MM, NN, G, bid); pg8::EPI E_{__VA_ARGS__}; \
        pg8::gemm_phase<pg8::EPI, pg8::StaticOrder, true, true>(lds, g_, S_, E_); } while (0)
#define GEMM_SPLIT(Aop, Bop, KK, NSL, S0, S1, N0) do { pg8::Gemm g_{Aop, Bop, KK, 256}; pg8::SubOrder S_{64, 4, 4, NSL, G, bid}; pg8::EpiF32Slab E_{S0, S1, N0, 64}; \
        pg8::gemm_phase<pg8::EpiF32Slab, pg8::SubOrder, true, true>(lds, g_, S_, E_); } while (0)
    float* const YCF = (float*)YC;
    if (IN(1)) REP(1) GEMM_FULL(EpiSwiglu, HB, WGU1, DM, M_, NGU, ACT, FF);
    SEAM(1);
    if (IN(2)) REP(2) { GEMM_FULL(EpiBf16, ACT, WD1, FF, MP_, DM, DB, DM, nullptr); GEMM_SPLIT(ACT, WD1, FF, 11, YCF, SLAB2, 8); }
    SEAM(2);
    if (IN(3)) rowpass<1 | 4 | 32 | 64, 11, 8>(DB, YCF, SLAB2, nullptr, nullptr, nullptr, HB, RS, nullptr, a.in[6], 0.5f, GW_, NGW, LANE_);
    SEAM(3);
    if (IN(4)) REP(4) GEMM_FULL(EpiBf16, HB, WIN, DM, M_, NIN, PROJ, NIN, nullptr);
    SEAM(4);
    if (IN(5)) REP(5) mixer_phase(a, lds, PROJ, YC, WAVE_, LANE_);
    SEAM(5);
#ifdef MK_XBAR
#pragma nounroll
    for (int xb_ = 0; xb_ < MK_XBAR; ++xb_) xcd_barrier(bar);
#endif
    if (IN(6)) REP(6) { GEMM_FULL(EpiBf16, YC, WOUT, DM, MP_, DM, DB, DM, nullptr); GEMM_SPLIT(YC, WOUT, DM, 4, SLAB4, SLAB4, 4); }
    SEAM(6);
    if (IN(7)) rowpass<1 | 4 | 32 | 64, 4, 4>(DB, SLAB4, SLAB4, nullptr, nullptr, nullptr, HB, RS, nullptr, a.in[11], 1.0f, GW_, NGW, LANE_);
    SEAM(7);
    if (IN(8)) REP(8) GEMM_FULL(EpiSwiglu, HB, WGU2, DM, M_, NGU, ACT, FF);
    SEAM(8);
    if (IN(9)) REP(9) { GEMM_FULL(EpiBf16, ACT, WD2, FF, MP_, DM, DB, DM, nullptr); GEMM_SPLIT(ACT, WD2, FF, 11, YCF, SLAB2, 8); }
    SEAM(9);
    if (IN(10)) {
        rowpass<1 | 4 | 32, 11, 8>(DB, YCF, SLAB2, nullptr, nullptr, nullptr, HB, RS, nullptr, a.in[21], 0.5f, GW_, NGW, LANE_);
        const int lane = LANE_, gw = GW_;
        for (int m = gw; m < M_; m += NGW) { const float* pr = (m < MP_) ? a.in[2] + (size_t)m * PLE : a.in[3] + (size_t)(m - MP_) * PLE;
            const f32x4 v = ((const f32x4*)pr)[lane]; u32x2 w; w.x = cvt_pk_bf16(v.x, v.y); w.y = cvt_pk_bf16(v.z, v.w); ((u32x2*)(PB + (size_t)m * PLE))[lane] = w; }
    }
    SEAM(10);
    if (IN(11)) REP(11) { GEMM_FULL(EpiF32, PB, WPP, PLE, MP_, DM, PP, DM);
        { pg8::Gemm g_{PB, WPP, PLE, PLE}; pg8::SubOrder S_{64, 4, 4, 1, G, (bid >= 64 && bid < 80) ? bid - 64 : -1}; pg8::EpiF32 E_{PP, DM};
          pg8::gemm_phase<pg8::EpiF32, pg8::SubOrder, true, true>(lds, g_, S_, E_); } }
    if (IN(12)) REP(12) { GEMM_FULL(EpiPle, HB, WPG, DM, MP_, DM, DB, PP, DM); GEMM_SPLIT(HB, WPG, DM, 4, SLAB4, SLAB4, 4); }
    SEAM(12);
    if (IN(13)) rowpass<1 | 8 | 16, 4, 4>(DB, SLAB4, SLAB4, PP, nullptr, nullptr, HB, nullptr, a.out, a.in[27], 1.0f, GW_, NGW, LANE_);
#undef IN
#undef SEAM
}

extern "C" void kernel_launch(void* const* d_in, const int* in_sizes, int n_in, void* d_out, int out_size, void* d_ws, size_t ws_size, hipStream_t stream) {
    static int grid = 0;
    if (grid == 0) {
        if (n_in != 28 || out_size != 19013632 || ws_size < WS_TOTAL) { fprintf(stderr, "kernel_launch: unexpected shapes: n_in %d out %d ws %zu (need %zu)\n", n_in, out_size, ws_size, (size_t)WS_TOTAL); grid = -1; return; }
        int dev = 0, cus = 0, per_cu = 0;
        if (hipGetDevice(&dev) != hipSuccess || hipDeviceGetAttribute(&cus, hipDeviceAttributeMultiprocessorCount, dev) != hipSuccess) { fprintf(stderr, "kernel_launch: device query failed\n"); grid = -1; return; }
        if (hipFuncSetAttribute((const void*)fwd_kernel<true>, hipFuncAttributeMaxDynamicSharedMemorySize, LDS_BYTES) != hipSuccess) { fprintf(stderr, "kernel_launch: hipFuncSetAttribute failed\n"); grid = -1; return; }
        if (hipOccupancyMaxActiveBlocksPerMultiprocessor(&per_cu, (const void*)fwd_kernel<true>, 512, LDS_BYTES) != hipSuccess || per_cu < 1) { fprintf(stderr, "kernel_launch: occupancy query says %d blocks per CU\n", per_cu); per_cu = 1; }
        (void)hipGetLastError();
        grid = cus * per_cu;
        fprintf(stderr, "kernel_launch: grid %d (cus %d x %d)\n", grid, cus, per_cu);
    }
    if (grid < 0) return;
    Args a{};
    for (int i = 0; i < 28; ++i) a.in[i] = (const float*)d_in[i];
    a.out = (float*)d_out; a.ws = (unsigned char*)d_ws;
#if MK_COOP
    if (hipMemsetAsync((char*)d_ws + WS_BAR, 0, (size_t)XCD_BAR_WORDS * 4, stream) != hipSuccess) { fprintf(stderr, "kernel_launch: memset of the barrier words failed\n"); return; }
    a.ph_lo = 0; a.ph_hi = NPHASE;
    void* args[] = {&a};
    const hipError_t e = hipLaunchCooperativeKernel((const void*)fwd_kernel<true>, dim3(grid), dim3(512), args, LDS_BYTES, stream);
    if (e != hipSuccess) fprintf(stderr, "kernel_launch: cooperative launch failed: %s (grid %d)\n", hipGetErrorString(e), grid);
#endif
}
```

```cpp
#include <hip/hip_runtime.h>
#include <hip/hip_cooperative_groups.h>
#include <cstdio>
#include <cstdint>
namespace cg = cooperative_groups;
#define MK_DUP 0u
namespace pg8 {
#define PG8_LAS __attribute__((address_space(3)))
typedef unsigned short bf16_t;
typedef short bf16x8 __attribute__((ext_vector_type(8)));
typedef float f32x4 __attribute__((ext_vector_type(4)));
typedef unsigned u32x4 __attribute__((ext_vector_type(4)));
constexpr int BM = 256, BK = 64, HALF = 128, HTB = HALF * BK * 2  , STAGE_BYTES = 8 * HTB, NXCD = 8, WGM = 8;

__host__ __device__ __forceinline__ int lds_byte(int r, int c) { const int st = (r >> 4) * 2 + (c >> 5), rr = r & 15, cc = c & 31, ob = rr * 64 + cc * 2; return st * 1024 + (ob ^ (((ob >> 9) & 1) << 5)); }
__host__ __device__ __forceinline__ void stage_rc(int b, int& R, int& C) { const int st = b / 1024, sb = b % 1024, swz = sb ^ (((sb >> 9) & 1) << 5); R = (st >> 1) * 16 + swz / 64; C = (st & 1) * 32 + (swz % 64) / 2; }
__host__ __device__ __forceinline__ int perm32(int rho) { const int n = rho >> 4, i = rho & 15; return 8 * (i >> 2) + 4 * n + (i & 3); }

struct Unit { int pm, pn, ks; };
struct Gemm { const bf16_t* A; const bf16_t* Bt; int ld, K; };

struct StaticOrder {
    int nM, nN, nwg, G, c;
    __host__ __device__ void init(int M, int N, int G_, int c_) { nM = M / BM; nN = N / BM; nwg = nM * nN; G = G_; c = c_; }
    __host__ __device__ bool next(int i, Unit& u) const {
        const long L = (long)i * G + c; if (L >= nwg) return false;
        int wgid = (int)L; { const int q = nwg / NXCD, r = nwg % NXCD, xcd = wgid % NXCD, off = wgid / NXCD; wgid = (xcd < r ? xcd * (q + 1) : r * (q + 1) + (xcd - r) * q) + off; }
        const int nig = WGM * nN, gid = wgid / nig, fm = gid * WGM, gsz = (nM - fm) < WGM ? (nM - fm) : WGM;
        u.pm = fm + ((wgid % nig) % gsz); u.pn = (wgid % nig) / gsz; u.ks = 0; return true;
    }
    __device__ __forceinline__ void a_ready(const Unit&) const {}
    __device__ __forceinline__ void done(const Unit&) const {}
};
struct SubOrder {
    int pm0, npm, nN, nsl, G, c;
    __host__ __device__ bool next(int i, Unit& u) const {
        const int L = i * G + c; if (c < 0 || L >= npm * nN * nsl) return false;
        const int t = L / nsl; u.ks = L - t * nsl; u.pn = t % nN; u.pm = pm0 + t / nN; return true;
    }
    __device__ __forceinline__ void a_ready(const Unit&) const {}
    __device__ __forceinline__ void done(const Unit&) const {}
};
typedef unsigned u32x2 __attribute__((ext_vector_type(2)));

__device__ __forceinline__ unsigned cvt_pk_bf16(float lo, float hi) { unsigned r; asm("v_cvt_pk_bf16_f32 %0, %1, %2" : "=v"(r) : "v"(lo), "v"(hi)); return r; }
__device__ __forceinline__ float sigmoid_f(float x) { return __builtin_amdgcn_rcpf(1.0f + __builtin_amdgcn_exp2f(x * -1.44269504089f)); }

#ifndef MK_WT
#define MK_WT 0
#endif
typedef __attribute__((__vector_size__(4 * sizeof(int)))) int rsrc_t;
constexpr int WT_AUX = MK_WT ? 16 : 0;
__device__ __forceinline__ auto mk_rsrc(const void* base) { return __builtin_amdgcn_make_buffer_rsrc((void*)base, 0, 0x7fffffff, 0x00020000); }
#define ST16(rsrc, byteoff, v) __builtin_amdgcn_raw_buffer_store_b128(__builtin_bit_cast(u32x4, v), rsrc, (int)(byteoff), 0, pg8::WT_AUX)
#define ST8(rsrc, byteoff, v)  __builtin_amdgcn_raw_buffer_store_b64(__builtin_bit_cast(u32x2, v), rsrc, (int)(byteoff), 0, pg8::WT_AUX)

struct EpiF32 {
    static constexpr bool PERM = false, AFTER_DRAIN = false;
    float* C; int ldc;
    __device__ __forceinline__ void operator()(const f32x4 (&acc)[2][2][4][2], const Unit& u, int wr, int wc, int fr_, int fq_) const {
        int tl_ = threadIdx.x; asm volatile("" : "+v"(tl_)); const int fr = tl_ & 15, fq = (tl_ >> 4) & 3;
        const int row0 = u.pm * BM + wr * 64 + fr, col0 = u.pn * BM + wc * 32 + 4 * fq; float* const Cb_ = C;
#pragma unroll
        for (int ai = 0; ai < 2; ++ai)
#pragma unroll
            for (int m = 0; m < 4; ++m) { const unsigned ro = ((unsigned)(row0 + ai * HALF + m * 16) * (unsigned)ldc + (unsigned)col0) * 4u;
#pragma unroll
                for (int bj = 0; bj < 2; ++bj)
#pragma unroll
                    for (int n = 0; n < 2; ++n) *(f32x4*)((char*)Cb_ + ro + (bj * HALF + n * 16) * 4) = acc[ai][bj][m][n]; }
    }
};
struct EpiBf16N {
    static constexpr bool PERM = false, AFTER_DRAIN = false;
    bf16_t* O; int ldc;
    __device__ __forceinline__ void operator()(const f32x4 (&acc)[2][2][4][2], const Unit& u, int wr, int wc, int fr_, int fq_) const {
        int tl_ = threadIdx.x; asm volatile("" : "+v"(tl_)); const int fr = tl_ & 15, fq = (tl_ >> 4) & 3;
        const int row0 = u.pm * BM + wr * 64 + fr, col0 = u.pn * BM + wc * 32 + 4 * fq;
#pragma unroll
        for (int ai = 0; ai < 2; ++ai)
#pragma unroll
            for (int m = 0; m < 4; ++m) { const size_t off = (size_t)(row0 + ai * HALF + m * 16) * ldc + col0;
#pragma unroll
                for (int bj = 0; bj < 2; ++bj)
#pragma unroll
                    for (int n = 0; n < 2; ++n) { const f32x4 a = acc[ai][bj][m][n]; u32x2 w; w.x = cvt_pk_bf16(a.x, a.y); w.y = cvt_pk_bf16(a.z, a.w); *(u32x2*)(O + off + bj * HALF + n * 16) = w; } }
    }
};
struct EpiPle {
    static constexpr bool PERM = false, AFTER_DRAIN = false;
    bf16_t* T; const bf16_t* P; int ldc;
    __device__ __forceinline__ void operator()(const f32x4 (&acc)[2][2][4][2], const Unit& u, int wr, int wc, int fr_, int fq_) const {
        int tl_ = threadIdx.x; asm volatile("" : "+v"(tl_)); const int fr = tl_ & 15, fq = (tl_ >> 4) & 3;
        const int row0 = u.pm * BM + wr * 64 + fr, col0 = u.pn * BM + wc * 32 + 4 * fq;
#pragma unroll
        for (int ai = 0; ai < 2; ++ai)
#pragma unroll
            for (int m = 0; m < 4; ++m) { const size_t off = (size_t)(row0 + ai * HALF + m * 16) * ldc + col0;
#pragma unroll
                for (int bj = 0; bj < 2; ++bj)
#pragma unroll
                    for (int n = 0; n < 2; ++n) { const u32x2 pw = *(const u32x2*)(P + off + bj * HALF + n * 16); const f32x4 a = acc[ai][bj][m][n];
                        const f32x4 p = {__uint_as_float(pw.x << 16), __uint_as_float(pw.x & 0xffff0000u), __uint_as_float(pw.y << 16), __uint_as_float(pw.y & 0xffff0000u)};
                        u32x2 w; w.x = cvt_pk_bf16(sigmoid_f(a.x) * p.x, sigmoid_f(a.y) * p.y); w.y = cvt_pk_bf16(sigmoid_f(a.z) * p.z, sigmoid_f(a.w) * p.w);
                        *(u32x2*)(T + off + bj * HALF + n * 16) = w; } }
    }
};
struct EpiF32Slab {
    static constexpr bool PERM = false, AFTER_DRAIN = false;
    bf16_t* base0; bf16_t* base1; int n0; int pm0;
    __device__ __forceinline__ void operator()(const f32x4 (&acc)[2][2][4][2], const Unit& u, int wr, int wc, int fr_, int fq_) const {
        int tl_ = threadIdx.x; asm volatile("" : "+v"(tl_)); const int fr = tl_ & 15, fq = (tl_ >> 4) & 3;
        const int row0 = (u.pm - pm0) * BM + wr * 64 + fr, col0 = u.pn * BM + wc * 32 + 4 * fq;
        bf16_t* const Cb_ = (u.ks < n0) ? base0 + ((size_t)u.ks << 20) : base1 + ((size_t)(u.ks - n0) << 20);
#pragma unroll
        for (int ai = 0; ai < 2; ++ai)
#pragma unroll
            for (int m = 0; m < 4; ++m) { const unsigned ro = ((unsigned)(row0 + ai * HALF + m * 16) * 1024u + (unsigned)col0) * 2u;
#pragma unroll
                for (int bj = 0; bj < 2; ++bj)
#pragma unroll
                    for (int n = 0; n < 2; ++n) { const f32x4 a = acc[ai][bj][m][n]; u32x2 w; w.x = cvt_pk_bf16(a.x, a.y); w.y = cvt_pk_bf16(a.z, a.w);
                        *(u32x2*)((char*)Cb_ + ro + (bj * HALF + n * 16) * 2) = w; } }
    }
};
struct EpiBf16 {
    static constexpr bool PERM = true, AFTER_DRAIN = false;
    bf16_t* O; int ldc; const float* rs;
    __device__ __forceinline__ void operator()(const f32x4 (&acc)[2][2][4][2], const Unit& u, int wr, int wc, int fr_, int fq_) const {
        int tl_ = threadIdx.x; asm volatile("" : "+v"(tl_)); const int fr = tl_ & 15, fq = (tl_ >> 4) & 3;
        const int row0 = u.pm * BM + wr * 64 + fr, col0 = u.pn * BM + wc * 32 + 8 * fq; const auto rs_ = mk_rsrc(O);
#pragma unroll
        for (int ai = 0; ai < 2; ++ai)
#pragma unroll
            for (int m = 0; m < 4; ++m) { const int row = row0 + ai * HALF + m * 16; const unsigned ro = ((unsigned)row * (unsigned)ldc + (unsigned)col0) * 2u; const float r = rs ? rs[row] : 1.0f;
#pragma unroll
                for (int bj = 0; bj < 2; ++bj) { const f32x4 v0 = acc[ai][bj][m][0] * r, v1 = acc[ai][bj][m][1] * r;
                    u32x4 w; w.x = cvt_pk_bf16(v0[0], v0[1]); w.y = cvt_pk_bf16(v0[2], v0[3]); w.z = cvt_pk_bf16(v1[0], v1[1]); w.w = cvt_pk_bf16(v1[2], v1[3]);
                    ST16(rs_, ro + bj * HALF * 2, w); } }
    }
};
struct EpiSwiglu {
    static constexpr bool PERM = true, AFTER_DRAIN = false;
    bf16_t* O; int ldc;
    static __device__ __forceinline__ f32x4 silu_mul(f32x4 g, f32x4 u) {
        const f32x4 gc = __builtin_elementwise_max(g, (f32x4){-40.f, -40.f, -40.f, -40.f});
        const f32x4 t = gc * -1.44269504089f;
        f32x4 e; e.x = __builtin_amdgcn_exp2f(t.x); e.y = __builtin_amdgcn_exp2f(t.y); e.z = __builtin_amdgcn_exp2f(t.z); e.w = __builtin_amdgcn_exp2f(t.w);
        const f32x4 d = e + 1.0f;
        const float r01 = __builtin_amdgcn_rcpf(d.x * d.y), r23 = __builtin_amdgcn_rcpf(d.z * d.w);
        const f32x4 sg = {d.y * r01, d.x * r01, d.w * r23, d.z * r23};
        return (gc * sg) * u;
    }
    __device__ __forceinline__ void operator()(const f32x4 (&acc)[2][2][4][2], const Unit& u, int wr, int wc, int fr_, int fq_) const {
        int tl_ = threadIdx.x; asm volatile("" : "+v"(tl_)); const int fr = tl_ & 15, fq = (tl_ >> 4) & 3;
        const int row0 = u.pm * BM + wr * 64 + fr, col0 = u.pn * HALF + wc * 32 + 8 * fq; const auto rs_ = mk_rsrc(O);
#pragma unroll
        for (int ai = 0; ai < 2; ++ai)
#pragma unroll
            for (int m = 0; m < 4; ++m) { const unsigned ro = ((unsigned)(row0 + ai * HALF + m * 16) * (unsigned)ldc + (unsigned)col0) * 2u;
                const f32x4 v0 = silu_mul(acc[ai][0][m][0], acc[ai][1][m][0]), v1 = silu_mul(acc[ai][0][m][1], acc[ai][1][m][1]);
                u32x4 w; w.x = cvt_pk_bf16(v0[0], v0[1]); w.y = cvt_pk_bf16(v0[2], v0[3]); w.z = cvt_pk_bf16(v1[0], v1[1]); w.w = cvt_pk_bf16(v1[2], v1[3]);
                ST16(rs_, ro, w); }
    }
};

template <class Epi, class Sched, bool ALIGN_EPI = false, bool SP2 = false>
__device__ __forceinline__ void gemm_phase(PG8_LAS unsigned char* lds, const Gemm g, const Sched& S, const Epi& E) {
    int tid_ = threadIdx.x; asm volatile("" : "+v"(tid_));
    const int tid = tid_, wid = __builtin_amdgcn_readfirstlane(tid >> 6), lane = tid & 63, wr = wid >> 2, wc = wid & 3, fr = lane & 15, fq = lane >> 4;
    const int K = g.K, nt = K / BK;
    unsigned voffA[2], voffB[2];
#pragma unroll
    for (int i = 0; i < 2; ++i) { int R, C; stage_rc(tid * 16 + i * 8192, R, C); const int Rb = Epi::PERM ? ((R & ~31) + perm32(R & 31)) : R;
        voffA[i] = (unsigned)(R * g.ld + C) * 2u; voffB[i] = (unsigned)(Rb * g.ld + C) * 2u; }
    const size_t kstep = (size_t)(BK * 2);
    const size_t hstepA = (size_t)HALF * g.ld * 2, hstepB = hstepA;
    const size_t kslice = (size_t)K * 2;
    const unsigned ldsw = (unsigned)wid * 1024u;
    const int aoff = lds_byte(wr * 64 + fr, fq * 8), boff = lds_byte(wc * 32 + fr, fq * 8);
#define PG8_SA(b, h) (((b) * 2 + (h)) * HTB)
#define PG8_SB(b, h) ((4 + (b) * 2 + (h)) * HTB)
#define PG8_STAGE(bufoff, gbase, voff) do { _Pragma("unroll") for (int _i = 0; _i < 2; ++_i) \
        __builtin_amdgcn_global_load_lds((const unsigned*)((const char*)(gbase) + (voff)[_i]), (PG8_LAS unsigned*)(lds + (bufoff) + ldsw + _i * 8192), 16, 0, 0); } while (0)
#define PG8_LDA(dst, b, h) do { _Pragma("unroll") for (int m = 0; m < 4; ++m) _Pragma("unroll") for (int k = 0; k < 2; ++k) dst[m][k] = *(const PG8_LAS bf16x8*)(lds + PG8_SA(b, h) + aoff + m * 2048 + k * 1024); } while (0)
#define PG8_LDB(dst, b, h) do { _Pragma("unroll") for (int n = 0; n < 2; ++n) _Pragma("unroll") for (int k = 0; k < 2; ++k) dst[n][k] = *(const PG8_LAS bf16x8*)(lds + PG8_SB(b, h) + boff + n * 2048 + k * 1024); } while (0)
#define PG8_MMA(ai, bj, At, Bt) do { __builtin_amdgcn_s_setprio(1); _Pragma("unroll") for (int m = 0; m < 4; ++m) _Pragma("unroll") for (int n = 0; n < 2; ++n) _Pragma("unroll") for (int k = 0; k < 2; ++k) \
        acc[ai][bj][m][n] = __builtin_amdgcn_mfma_f32_16x16x32_bf16(Bt[n][k], At[m][k], acc[ai][bj][m][n], 0, 0, 0); __builtin_amdgcn_s_setprio(0); } while (0)
#define PG8_WAIT_V(n) asm volatile("s_waitcnt vmcnt(" #n ")" ::: "memory")
#define PG8_WAIT_L(n) asm volatile("s_waitcnt lgkmcnt(" #n ")" ::: "memory")
#define PG8_BAR __builtin_amdgcn_s_barrier()
#define PG8_SCHED __builtin_amdgcn_sched_barrier(0)
    Unit cur, nxt; int ui = 0;
    if (!S.next(0, cur)) return;
    f32x4 acc[2][2][4][2];
#pragma unroll
    for (int a = 0; a < 2; ++a)
#pragma unroll
        for (int b = 0; b < 2; ++b)
#pragma unroll
            for (int m = 0; m < 4; ++m)
#pragma unroll
                for (int n = 0; n < 2; ++n) acc[a][b][m][n] = (f32x4){0.f, 0.f, 0.f, 0.f};
    bf16x8 At[4][2], B0[2][2], B1[2][2];
    const char* cA = (const char*)g.A + (size_t)cur.pm * 2 * hstepA + (size_t)cur.ks * kslice; const char* cB = (const char*)g.Bt + (size_t)cur.pn * 2 * hstepB + (size_t)cur.ks * kslice;
    S.a_ready(cur);
    if constexpr (SP2) {
        PG8_STAGE(PG8_SB(0, 0), cB, voffB); PG8_STAGE(PG8_SB(0, 1), cB + hstepB, voffB); PG8_STAGE(PG8_SA(0, 0), cA, voffA); PG8_STAGE(PG8_SA(0, 1), cA + hstepA, voffA);
        if (wr == 1) PG8_BAR;
        PG8_WAIT_V(2); PG8_BAR;
        PG8_STAGE(PG8_SB(1, 0), cB + kstep, voffB); PG8_STAGE(PG8_SA(1, 0), cA + kstep, voffA); PG8_STAGE(PG8_SB(1, 1), cB + hstepB + kstep, voffB);
        PG8_WAIT_V(6); PG8_BAR;
    } else {
        PG8_STAGE(PG8_SB(0, 0), cB, voffB); PG8_STAGE(PG8_SA(0, 0), cA, voffA); PG8_STAGE(PG8_SB(0, 1), cB + hstepB, voffB); PG8_STAGE(PG8_SA(0, 1), cA + hstepA, voffA);
        if (wr == 1) PG8_BAR;
        PG8_WAIT_V(4); PG8_BAR;
        PG8_STAGE(PG8_SB(1, 0), cB + kstep, voffB); PG8_STAGE(PG8_SA(1, 0), cA + kstep, voffA); PG8_STAGE(PG8_SB(1, 1), cB + hstepB + kstep, voffB);
        PG8_WAIT_V(6); PG8_BAR;
    }
    for (;;) {
        const bool has_next = S.next(ui + 1, nxt);
        const char* nA = has_next ? (const char*)g.A + (size_t)nxt.pm * 2 * hstepA + (size_t)nxt.ks * kslice : cA; const char* nB = has_next ? (const char*)g.Bt + (size_t)nxt.pn * 2 * hstepB + (size_t)nxt.ks * kslice : cB;
        for (int t = 0; t < nt; t += 2) {
            const bool last = (t == nt - 2);
            const char* a1 = cA + (size_t)(t + 1) * kstep;
            const char* a2 = last ? nA : cA + (size_t)(t + 2) * kstep; const char* b2 = last ? nB : cB + (size_t)(t + 2) * kstep;
            const char* a3 = a2 + kstep; const char* b3 = b2 + kstep;
            if (last && has_next) S.a_ready(nxt);
            if constexpr (SP2) {
            PG8_LDB(B0, 0, 0); PG8_LDB(B1, 0, 1); PG8_SCHED; PG8_LDA(At, 0, 0); PG8_STAGE(PG8_SA(1, 1), a1 + hstepA, voffA);
            PG8_WAIT_V(8); PG8_WAIT_L(0); PG8_BAR; PG8_MMA(0, 0, At, B0); PG8_MMA(0, 1, At, B1); PG8_BAR; PG8_SCHED;
            PG8_LDA(At, 0, 1); PG8_STAGE(PG8_SB(0, 0), b2, voffB); PG8_STAGE(PG8_SB(0, 1), b2 + hstepB, voffB); PG8_STAGE(PG8_SA(0, 0), a2, voffA);
            PG8_WAIT_V(8); PG8_WAIT_L(0); PG8_BAR; PG8_MMA(1, 0, At, B0); PG8_MMA(1, 1, At, B1); PG8_BAR; PG8_SCHED;
            PG8_LDB(B0, 1, 0); PG8_LDB(B1, 1, 1); PG8_SCHED; PG8_LDA(At, 1, 0); PG8_STAGE(PG8_SA(0, 1), a2 + hstepA, voffA);
            PG8_WAIT_V(8); PG8_WAIT_L(0); PG8_BAR; PG8_MMA(0, 0, At, B0); PG8_MMA(0, 1, At, B1); PG8_BAR; PG8_SCHED;
            PG8_LDA(At, 1, 1); PG8_STAGE(PG8_SB(1, 0), b3, voffB); PG8_STAGE(PG8_SB(1, 1), b3 + hstepB, voffB); PG8_STAGE(PG8_SA(1, 0), a3, voffA);
            PG8_WAIT_V(8); PG8_WAIT_L(0); PG8_BAR; PG8_MMA(1, 0, At, B0); PG8_MMA(1, 1, At, B1); PG8_BAR; PG8_SCHED;
            } else {
            PG8_LDB(B0, 0, 0); PG8_SCHED; PG8_LDA(At, 0, 0); PG8_STAGE(PG8_SA(1, 1), a1 + hstepA, voffA);
            PG8_WAIT_L(8); PG8_BAR; PG8_WAIT_L(0); PG8_MMA(0, 0, At, B0); PG8_BAR; PG8_SCHED;
            PG8_LDB(B1, 0, 1); PG8_STAGE(PG8_SB(0, 0), b2, voffB);
            PG8_BAR; PG8_WAIT_L(0); PG8_MMA(0, 1, At, B1); PG8_BAR;
            PG8_LDA(At, 0, 1); PG8_STAGE(PG8_SA(0, 0), a2, voffA);
            PG8_BAR; PG8_WAIT_L(0); PG8_MMA(1, 0, At, B0); PG8_BAR; PG8_SCHED;
            PG8_STAGE(PG8_SB(0, 1), b2 + hstepB, voffB);
            PG8_WAIT_V(6); PG8_BAR; PG8_MMA(1, 1, At, B1); PG8_BAR;
            PG8_LDB(B0, 1, 0); PG8_SCHED; PG8_LDA(At, 1, 0); PG8_STAGE(PG8_SA(0, 1), a2 + hstepA, voffA);
            PG8_WAIT_L(8); PG8_BAR; PG8_WAIT_L(0); PG8_MMA(0, 0, At, B0); PG8_BAR; PG8_SCHED;
            PG8_LDB(B1, 1, 1); PG8_STAGE(PG8_SB(1, 0), b3, voffB);
            PG8_BAR; PG8_WAIT_L(0); PG8_MMA(0, 1, At, B1); PG8_BAR;
            PG8_LDA(At, 1, 1); PG8_STAGE(PG8_SA(1, 0), a3, voffA);
            PG8_BAR; PG8_WAIT_L(0); PG8_MMA(1, 0, At, B0); PG8_BAR; PG8_SCHED;
            PG8_STAGE(PG8_SB(1, 1), b3 + hstepB, voffB);
            PG8_WAIT_V(6); PG8_BAR; PG8_MMA(1, 1, At, B1); PG8_BAR;
            }
        }
        if constexpr (ALIGN_EPI) { if (wr == 0) PG8_BAR; }
        if constexpr (!Epi::AFTER_DRAIN) { E(acc, cur, wr, wc, fr, fq); S.done(cur); }
        if (!has_next) break;
#pragma unroll
        for (int a = 0; a < 2; ++a)
#pragma unroll
            for (int b = 0; b < 2; ++b)
#pragma unroll
                for (int m = 0; m < 4; ++m)
#pragma unroll
                    for (int n = 0; n < 2; ++n) acc[a][b][m][n] = (f32x4){0.f, 0.f, 0.f, 0.f};
        cur = nxt; cA = nA; cB = nB; ++ui;
        if constexpr (ALIGN_EPI) { if (wr == 1) PG8_BAR; }
    }
    PG8_WAIT_V(0);
    if constexpr (!ALIGN_EPI) { if (wr == 0) PG8_BAR; }
    PG8_BAR;
    if constexpr (Epi::AFTER_DRAIN) { E.fused(acc, cur, wr, wc, fr, fq, lds, wid, lane); S.done(cur); }
#undef PG8_SA
#undef PG8_SB
#undef PG8_STAGE
#undef PG8_LDA
#undef PG8_LDB
#undef PG8_MMA
#undef PG8_WAIT_V
#undef PG8_WAIT_L
#undef PG8_BAR
#undef PG8_SCHED
}
}

using pg8::bf16_t; using pg8::bf16x8; using pg8::f32x4; using pg8::u32x4; using pg8::u32x2; using pg8::cvt_pk_bf16;
#define LAS __attribute__((address_space(3)))
#define XB_TMO      128
#define XB_XCNT(j)  (256  + 64 * (j))
#define XB_XSUB(j)  (1280 + 64 * (j))
#define XB_XGEN(j)  (2304 + 64 * (j))
#define XB_TOP      3328
#define XB_TOPGEN   3392
#define XCD_BAR_WORDS 3456
#define XB_SPIN_CAP (1u << 18)

__device__ __forceinline__ unsigned xb_ld(unsigned* p)              { return __hip_atomic_load(p, __ATOMIC_RELAXED, __HIP_MEMORY_SCOPE_AGENT); }
__device__ __forceinline__ unsigned xb_add(unsigned* p, unsigned v) { return __hip_atomic_fetch_add(p, v, __ATOMIC_RELAXED, __HIP_MEMORY_SCOPE_AGENT); }
__device__ __forceinline__ unsigned xb_xcc_id() { return (unsigned)__builtin_amdgcn_s_getreg((3 << 11) | 20) & 0xFu; }
#define XB_SPIN(cond, bar) do { unsigned _sp = 0; while (cond) { __builtin_amdgcn_s_sleep(1); \
    if ((++_sp & 255u) == 0u) { if (xb_ld(&(bar)[XB_TMO])) break; if (_sp > XB_SPIN_CAP) { atomicAdd(&(bar)[XB_TMO], 1u); break; } } } } while (0)

struct XcdBarrier {
    unsigned* bar; unsigned x;
    volatile LAS unsigned* st;
};

__device__ __forceinline__ XcdBarrier xcd_barrier_post(unsigned* bar, volatile LAS unsigned* st) {
    XcdBarrier b; b.bar = bar; b.x = xb_xcc_id(); b.st = st;
    if (threadIdx.x == 0) (void)xb_add(&bar[XB_XCNT(b.x)], 1u);
    return b;
}
__device__ __forceinline__ void xcd_barrier_complete(unsigned* bar, unsigned x, unsigned& nloc, unsigned& nx) {
    const unsigned G = gridDim.x * gridDim.y * gridDim.z;
    unsigned sum, cnt, mine, sp = 0u;
    for (;;) {
        sum = 0u; cnt = 0u; mine = 0u;
#pragma unroll
        for (unsigned j = 0; j < 16; ++j) { const unsigned c = xb_ld(&bar[XB_XCNT(j)]); sum += c; cnt += (c > 0u) ? 1u : 0u; mine = (j == x) ? c : mine; }
        if (sum == G) break;
        __builtin_amdgcn_s_sleep(1);
        if ((++sp & 255u) == 0u) { if (xb_ld(&bar[XB_TMO])) break; if (sp > XB_SPIN_CAP) { atomicAdd(&bar[XB_TMO], 1u); break; } }
    }
    nloc = mine > 0u ? mine : 1u; nx = cnt > 0u ? cnt : 1u;
}

__device__ __forceinline__ void xcd_barrier(const XcdBarrier& b) {
    asm volatile("s_waitcnt vmcnt(0)" ::: "memory");
    __syncthreads();
    if (threadIdx.x == 0) {
        unsigned* bar = b.bar;
        __builtin_amdgcn_s_waitcnt(0);
        unsigned nloc = b.st[0], nx = b.st[1];
        if (nloc == 0u) { xcd_barrier_complete(bar, b.x, nloc, nx); b.st[0] = nloc; b.st[1] = nx; }
        const unsigned old = xb_add(&bar[XB_XSUB(b.x)], 1u);
        const unsigned gen = old / nloc;
        if (old + 1u == (gen + 1u) * nloc) {
            __builtin_amdgcn_fence(__ATOMIC_RELEASE, "agent");
            asm volatile("s_waitcnt vmcnt(0)" ::: "memory");
            const unsigned og = xb_add(&bar[XB_TOP], 1u);
            const unsigned tg = og / nx;
            if (og + 1u == (tg + 1u) * nx) xb_add(&bar[XB_TOPGEN], 1u);
            else XB_SPIN(xb_ld(&bar[XB_TOPGEN]) == tg, bar);
            __builtin_amdgcn_fence(__ATOMIC_ACQUIRE, "agent");
            xb_add(&bar[XB_XGEN(b.x)], 1u);
            asm volatile("s_waitcnt vmcnt(0)" ::: "memory");
        } else {
            XB_SPIN(xb_ld(&bar[XB_XGEN(b.x)]) == gen, bar);
            __builtin_amdgcn_fence(__ATOMIC_ACQUIRE, "agent");
            asm volatile("s_waitcnt vmcnt(0)" ::: "memory");
        }
    }
    __syncthreads();
}


#ifndef MK_DUP
#define MK_DUP 0u
#endif
#ifndef MK_COOP
#define MK_COOP 1
#endif
constexpr int M_ = 17408, MP_ = 16384, DM = 1024, FF = 2816, NGU = 5632, NIN = 2560, PLE = 256;
constexpr float EPS_ = 1e-6f;
constexpr int LDS_BYTES = 147456;
constexpr int NPHASE = 14;
constexpr size_t WS_WGU1 = 0;
constexpr size_t WS_WD1 = WS_WGU1 + (size_t)NGU * DM * 2;
constexpr size_t WS_WIN = WS_WD1 + (size_t)DM * FF * 2;
constexpr size_t WS_WOUT = WS_WIN + (size_t)NIN * DM * 2;
constexpr size_t WS_WGU2 = WS_WOUT + (size_t)DM * DM * 2;
constexpr size_t WS_WD2 = WS_WGU2 + (size_t)NGU * DM * 2;
constexpr size_t WS_WPG = WS_WD2 + (size_t)DM * FF * 2;
constexpr size_t WS_WPP = WS_WPG + (size_t)DM * DM * 2;
constexpr size_t WS_YC = WS_WPP + (size_t)DM * PLE * 2;
constexpr size_t WS_ACT = WS_YC + (size_t)M_ * DM * 2;
constexpr size_t WS_D = WS_ACT + (size_t)M_ * FF * 2;
constexpr size_t WS_HB = WS_D + (size_t)M_ * DM * 2;
constexpr size_t WS_SLAB2 = WS_HB + (size_t)M_ * DM * 2;
constexpr size_t WS_RS = WS_SLAB2 + (size_t)3 * 1024 * 1024 * 4;
constexpr size_t WS_END = WS_RS + (size_t)M_ * 4;
constexpr size_t WS_BAR = WS_END;
constexpr size_t WS_TOTAL = WS_BAR + (size_t)XCD_BAR_WORDS * 4;
constexpr size_t WS_PROJ = WS_ACT;
constexpr size_t WS_PP = WS_ACT;
constexpr size_t WS_PB = WS_YC + (size_t)16 * 1024 * 1024;
constexpr size_t WS_SLAB4 = WS_ACT + (size_t)M_ * DM * 4 + (size_t)M_ * PLE * 2;
static_assert(WS_SLAB4 + (size_t)4 * 1024 * 1024 * 4 <= WS_D && WS_PB + (size_t)M_ * PLE * 2 <= WS_ACT, "aliases fit");
constexpr size_t OUT_NCP = 17825792, OUT_NCS = 17833984, OUT_CVP = 17965056, OUT_CVS = 18489344;

struct Args { const float* in[28]; float* out; unsigned char* ws; int ph_lo, ph_hi; };

__device__ __forceinline__ float wave_sum(float v) {
#pragma unroll
    for (int o = 1; o < 64; o <<= 1) v += __shfl_xor(v, o);
    return v;
}
__device__ __forceinline__ float bf_lo(unsigned w) { return __uint_as_float(w << 16); }
__device__ __forceinline__ float bf_hi(unsigned w) { return __uint_as_float(w & 0xffff0000u); }
__device__ __forceinline__ float dot4(f32x4 a) { return (a.x * a.x + a.y * a.y) + (a.z * a.z + a.w * a.w); }
#define LDS_WAIT() asm volatile("s_waitcnt lgkmcnt(0)" ::: "memory")

struct TrItem { const float* W; bf16_t* WT; const float* gk; int K, N, k0, n0, drow0; };
__device__ __forceinline__ void tr_load(const TrItem& d, int lane, f32x4 (&v8)[8], float (&g8)[8]) {
#pragma unroll
    for (int i = 0; i < 8; ++i) { const int kk = 8 * i + (lane >> 3); v8[i] = *(const f32x4*)(d.W + (size_t)(d.k0 + kk) * d.N + d.n0 + (lane & 7) * 4); g8[i] = d.gk ? d.gk[d.k0 + kk] : 1.0f; }
}
__device__ __forceinline__ void tr_store(const TrItem& d, LAS float* scr, int lane, const f32x4 (&v8)[8], const float (&g8)[8]) {
#pragma unroll
    for (int i = 0; i < 8; ++i) { const int kk = 8 * i + (lane >> 3); LAS float* q = scr + kk * 33 + (lane & 7) * 4; const f32x4 v = v8[i] * g8[i]; q[0] = v.x; q[1] = v.y; q[2] = v.z; q[3] = v.w; }
    LDS_WAIT();
    const int c = lane & 7;
#pragma unroll
    for (int j = 0; j < 4; ++j) { const int n = (lane >> 3) + 8 * j; const LAS float* t = scr + (8 * c) * 33 + n;
        u32x4 o; o.x = cvt_pk_bf16(t[0 * 33], t[1 * 33]); o.y = cvt_pk_bf16(t[2 * 33], t[3 * 33]); o.z = cvt_pk_bf16(t[4 * 33], t[5 * 33]); o.w = cvt_pk_bf16(t[6 * 33], t[7 * 33]);
        *(u32x4*)(d.WT + (size_t)(d.drow0 + n) * d.K + d.k0 + 8 * c) = o; }
    LDS_WAIT();
}

__device__ __forceinline__ f32x4 bf4(unsigned a, unsigned b) { return (f32x4){bf_lo(a), bf_hi(a), bf_lo(b), bf_hi(b)}; }
template <int MODE>
__device__ __forceinline__ void rp_load_res(int m, const float* __restrict__ resP, const float* __restrict__ resS, const bf16_t* hb, int lane, f32x4 (&h)[4]) {
    if (MODE & 2) { const float* rrow = (m < MP_) ? resP + (size_t)m * DM : resS + (size_t)(m - MP_) * DM;
#pragma unroll
        for (int j = 0; j < 4; ++j) h[j] = ((const f32x4*)rrow)[lane + 64 * j]; }
    else { const u32x2* hr = (const u32x2*)(hb + (size_t)m * DM) + lane;
#pragma unroll
        for (int j = 0; j < 4; ++j) { const u32x2 w = hr[64 * j]; h[j] = bf4(w.x, w.y); } }
}
__device__ __forceinline__ int vzero() { int z; asm volatile("v_mov_b32 %0, 0" : "=v"(z)); return z; }
template <int MODE>
__device__ __forceinline__ void rp_finish(int m, f32x4 (&h)[4], f32x4 (&d)[4], const f32x4 (&gp)[4], float sc, bf16_t* hb, float* rsv, float* __restrict__ outf, int lane, float hin_scale) {
    if (MODE & 32) {
#pragma unroll
        for (int j = 0; j < 4; ++j) h[j] *= hin_scale; }
    if (MODE & 1) {
        float ss = 0.f;
#pragma unroll
        for (int j = 0; j < 4; ++j) ss += dot4(d[j]);
        const float rs = sc * rsqrtf(wave_sum(ss) * (1.0f / DM) + EPS_);
#pragma unroll
        for (int j = 0; j < 4; ++j) h[j] += d[j] * rs * gp[j];
    }
    if (MODE & 4) {
        float s2 = 0.f;
#pragma unroll
        for (int j = 0; j < 4; ++j) s2 += dot4(h[j]);
        const float rs2 = rsqrtf(wave_sum(s2) * (1.0f / DM) + EPS_);
        if (lane == 0) rsv[m] = rs2;
        const float osc = (MODE & 64) ? rs2 : 1.0f;
        const auto hrs = pg8::mk_rsrc(hb); const unsigned ho = (unsigned)m * (DM * 2u) + (unsigned)lane * 8u;
#pragma unroll
        for (int j = 0; j < 4; ++j) { const f32x4 v = h[j] * osc; u32x2 w; w.x = cvt_pk_bf16(v.x, v.y); w.y = cvt_pk_bf16(v.z, v.w); ST8(hrs, ho + 512u * j, w); }
    }
    if (MODE & 8) { f32x4* ho = (f32x4*)(outf + (size_t)m * DM) + lane;
#pragma unroll
        for (int j = 0; j < 4; ++j) ho[64 * j] = h[j]; }
}
template <int MODE, int NSL, int N0>
__device__ __forceinline__ void rowpass(const bf16_t* __restrict__ dbuf, const bf16_t* slab0, const bf16_t* slab1, const bf16_t* __restrict__ pp, const float* __restrict__ resP, const float* __restrict__ resS,
                                        bf16_t* hb, float* rsv, float* __restrict__ outf, const float* __restrict__ gpost, float sc, int gw, int NGW, int lane) {
    f32x4 gp[4]; const int vz = vzero();
#pragma unroll
    for (int j = 0; j < 4; ++j) gp[j] = (MODE & 1) ? ((const f32x4*)gpost)[lane + 64 * j] : (f32x4){0.f, 0.f, 0.f, 0.f};
    constexpr int NR = 4;
    for (int m0 = gw; m0 < MP_; m0 += NR * NGW) {
        f32x4 hh[NR][4], dd[NR][4]; u32x2 ww[NR][4]; float isc[NR];
#pragma unroll
        for (int q = 0; q < NR; ++q) { const int m = m0 + q * NGW; isc[q] = 1.0f; if (m < MP_) { rp_load_res<MODE>(m, resP, resS, hb, lane, hh[q]); if (MODE & 32) isc[q] = rsv[m + vz]; } }
        if (MODE & 1) {
#pragma unroll
            for (int q = 0; q < NR; ++q) { const int m = m0 + q * NGW; if (m < MP_) { const u32x2* dr = (const u32x2*)(dbuf + (size_t)m * DM) + lane;
#pragma unroll
                for (int j = 0; j < 4; ++j) ww[q][j] = dr[64 * j]; } }
#pragma unroll
            for (int q = 0; q < NR; ++q)
#pragma unroll
                for (int j = 0; j < 4; ++j) dd[q][j] = bf4(ww[q][j].x, ww[q][j].y);
        }
#pragma unroll
        for (int q = 0; q < NR; ++q) { const int m = m0 + q * NGW; if (m < MP_) rp_finish<MODE>(m, hh[q], dd[q], gp, sc, hb, rsv, outf, lane, (MODE & 32) ? 1.0f / isc[q] : 1.0f); }
    }
    if (((gw & 1) == 0)) for (int r = (gw >> 3) * 4 + ((gw & 7) >> 1); r < M_ - MP_; r += (NGW >> 3) * 4) {
        const int m = MP_ + r;
        f32x4 h[4], d[4]; float isc1 = 1.0f;
        rp_load_res<MODE>(m, resP, resS, hb, lane, h);
        if (MODE & 32) isc1 = rsv[m + vz];
        if (MODE & 1) {
            u32x2 tq[4][NSL > 0 ? NSL : 1];
#pragma unroll
            for (int j = 0; j < 4; ++j)
#pragma unroll
                for (int s = 0; s < NSL; ++s) tq[j][s] = ((const u32x2*)(((s < N0) ? slab0 + ((size_t)s << 20) : slab1 + ((size_t)(s - N0) << 20)) + (size_t)r * DM))[lane + 64 * j];
#pragma unroll
            for (int j = 0; j < 4; ++j) { f32x4 acc = {0.f, 0.f, 0.f, 0.f};
#pragma unroll
                for (int s = 0; s < NSL; ++s) acc += bf4(tq[j][s].x, tq[j][s].y);
                d[j] = acc; }
            if (MODE & 16) { const u32x2* pr = (const u32x2*)(pp + (size_t)m * DM) + lane;
#pragma unroll
                for (int j = 0; j < 4; ++j) { const u32x2 pw = pr[64 * j]; const f32x4 p = bf4(pw.x, pw.y); d[j].x = pg8::sigmoid_f(d[j].x) * p.x; d[j].y = pg8::sigmoid_f(d[j].y) * p.y; d[j].z = pg8::sigmoid_f(d[j].z) * p.z; d[j].w = pg8::sigmoid_f(d[j].w) * p.w; } }
        }
        rp_finish<MODE>(m, h, d, gp, sc, hb, rsv, outf, lane, (MODE & 32) ? 1.0f / isc1 : 1.0f);
    }
}

#ifdef MK_TM
#define MIX_T(seg) do { const unsigned long long tn_ = __builtin_amdgcn_s_memrealtime(); if ((MK_TM >> (seg)) & 1u) *tqm += tn_ - tpm; tpm = tn_; } while (0)
#else
#define MIX_T(seg) do { } while (0)
#endif
__device__ __forceinline__ void mixer_phase(const Args& a, LAS unsigned char* lds, const bf16_t* __restrict__ PROJ, bf16_t* __restrict__ YC, int wave, int lane, unsigned long long* tqm) {
    unsigned long long tpm = 0ull;
    constexpr int VP = 1056;
    const auto ycrs = pg8::mk_rsrc(YC);
    LAS float* part = (LAS float*)(lds + 128 * VP);
    const int fr = lane & 15, fq = lane >> 4;
    const float* __restrict__ wsm = a.in[15]; const float* __restrict__ bsm = a.in[16];
    float* out = a.out;
    const int G_ = (int)gridDim.x, b_ = (int)blockIdx.x;
    for (int it = 0;; ++it) {
        int u, R0, nrows = 64;
        if (G_ == 256) { if (it == 0) { u = b_; R0 = u * 64; } else if (it == 1 && (b_ & 1) == 0 && b_ < 128) { u = 256; R0 = MP_ + 16 * (b_ >> 1); nrows = 16; } else break; }
        else { u = b_ + it * G_; if (u >= 272) break; R0 = u * 64; }
        const int ntb = nrows >> 4;
        const bool samp = (u >= 256);
#ifdef MK_TM
        tpm = __builtin_amdgcn_s_memrealtime();
#endif
        int s0 = 0, t0 = 0;
        if (!samp) { s0 = (u & 31) * 64; t0 = s0 & 127; }
        const int CB = R0 - t0, kext = t0 + 64;
        const int h = wave; const int nkb = kext >> 5;
        bf16x8 afr[4][4];
#pragma unroll
        for (int kb = 0; kb < 4; ++kb) {
#pragma unroll
            for (int tb = 0; tb < 4; ++tb) {
                f32x4 w0 = {0.f, 0.f, 0.f, 0.f}, w1 = w0; int lim = -1;
                if (kb < nkb) {
                    if (!samp) { const int tt = t0 + tb * 16 + fr, sb = kb * 32 + fq * 8; const float* wp = wsm + (size_t)(h * 128 + tt) * 128 + sb;
                        w0 = *(const f32x4*)wp; w1 = *(const f32x4*)(wp + 4); lim = tt - sb; }
                    else { const int tt = fr & 7; const float* wp = wsm + (size_t)(h * 128 + tt) * 128;
                        w0 = *(const f32x4*)wp; w1 = *(const f32x4*)(wp + 4); lim = ((kb * 4 + fq) == (tb * 2 + (fr >> 3))) ? tt : -1; }
                }
                w0.x = (0 <= lim) ? w0.x : 0.f; w0.y = (1 <= lim) ? w0.y : 0.f; w0.z = (2 <= lim) ? w0.z : 0.f; w0.w = (3 <= lim) ? w0.w : 0.f;
                w1.x = (4 <= lim) ? w1.x : 0.f; w1.y = (5 <= lim) ? w1.y : 0.f; w1.z = (6 <= lim) ? w1.z : 0.f; w1.w = (7 <= lim) ? w1.w : 0.f;
                u32x4 pk; pk.x = cvt_pk_bf16(w0.x, w0.y); pk.y = cvt_pk_bf16(w0.z, w0.w); pk.z = cvt_pk_bf16(w1.x, w1.y); pk.w = cvt_pk_bf16(w1.z, w1.w);
                afr[kb][tb] = __builtin_bit_cast(bf16x8, pk);
            }
        }
        {
            const f32x4 vg0 = *(const f32x4*)(a.in[14] + lane * 8), vg1 = *(const f32x4*)(a.in[14] + lane * 8 + 4);
            for (int sb8 = 0; sb8 < kext; sb8 += 64) {
                u32x4 raw8[8];
#pragma unroll
                for (int i = 0; i < 8; ++i) { int rr = CB + sb8 + i * 8 + wave; rr = rr < M_ ? rr : M_ - 1; raw8[i] = *(const u32x4*)(PROJ + (size_t)rr * NIN + 2048 + lane * 8); }
#pragma unroll
                for (int i = 0; i < 8; ++i) {
                    const int s = sb8 + i * 8 + wave, row = CB + s; const u32x4 raw = raw8[i];
                    f32x4 v0 = bf4(raw.x, raw.y), v1 = bf4(raw.z, raw.w);
                    float ss = dot4(v0) + dot4(v1);
                    ss += __shfl_xor(ss, 1); ss += __shfl_xor(ss, 2); ss += __shfl_xor(ss, 4);
                    const float rs = rsqrtf(ss * (1.0f / 64.0f) + EPS_);
                    v0 = v0 * rs * vg0; v1 = v1 * rs * vg1;
                    u32x4 pk; pk.x = cvt_pk_bf16(v0.x, v0.y); pk.y = cvt_pk_bf16(v0.z, v0.w); pk.z = cvt_pk_bf16(v1.x, v1.y); pk.w = cvt_pk_bf16(v1.z, v1.w);
                    *(LAS u32x4*)(lds + s * VP + lane * 16) = pk;
                    if (s >= t0 && s < t0 + nrows) {
                        if (samp) { float* o = out + OUT_CVS + (size_t)(row - MP_) * 512 + lane * 8; *(f32x4*)o = v0; *(f32x4*)(o + 4) = v1; }
                        else if (s0 - t0 == 1920) { float* o = out + OUT_CVP + (size_t)((u >> 5) * 128 + s) * 512 + lane * 8; *(f32x4*)o = v0; *(f32x4*)(o + 4) = v1; }
                    }
                }
            }
        }
        __syncthreads();
        MIX_T(0);
        f32x4 acc[4][4];
#pragma unroll
        for (int i = 0; i < 4; ++i)
#pragma unroll
            for (int j = 0; j < 4; ++j) acc[i][j] = (f32x4){0.f, 0.f, 0.f, 0.f};
#pragma unroll
        for (int kb = 0; kb < 4; ++kb) if (kb < nkb) {
            u32x2 r0[4], r1[4];
            { const unsigned ta = (unsigned)(uintptr_t)(lds + (kb * 32 + fq * 8 + (fr >> 2)) * VP + (h * 64 + (fr & 3) * 4) * 2);
              asm volatile("ds_read_b64_tr_b16 %0, %8\n\tds_read_b64_tr_b16 %1, %8 offset:4224\n\t"
                           "ds_read_b64_tr_b16 %2, %8 offset:32\n\tds_read_b64_tr_b16 %3, %8 offset:4256\n\t"
                           "ds_read_b64_tr_b16 %4, %8 offset:64\n\tds_read_b64_tr_b16 %5, %8 offset:4288\n\t"
                           "ds_read_b64_tr_b16 %6, %8 offset:96\n\tds_read_b64_tr_b16 %7, %8 offset:4320\n\ts_waitcnt lgkmcnt(0)"
                           : "=&v"(r0[0]), "=&v"(r1[0]), "=&v"(r0[1]), "=&v"(r1[1]), "=&v"(r0[2]), "=&v"(r1[2]), "=&v"(r0[3]), "=&v"(r1[3]) : "v"(ta) : "memory"); }
#pragma unroll
            for (int db = 0; db < 4; ++db) {
                u32x4 bq; bq.x = r0[db].x; bq.y = r0[db].y; bq.z = r1[db].x; bq.w = r1[db].y;
                const bf16x8 bfv = __builtin_bit_cast(bf16x8, bq);
#pragma unroll
                for (int tb = 0; tb < 4; ++tb) if (tb < ntb) acc[tb][db] = __builtin_amdgcn_mfma_f32_16x16x32_bf16(bfv, afr[kb][tb], acc[tb][db], 0, 0, 0);
            }
        }
#pragma unroll
        for (int tb = 0; tb < 4; ++tb) if (tb < ntb) {
            const int t = tb * 16 + fr; const int tt = samp ? (fr & 7) : (t0 + t); const float bias = bsm[h * 128 + tt];
            const bf16_t* up = PROJ + (size_t)(R0 + t) * NIN + 1536 + h * 64 + fq * 4;
            float s = 0.f;
#pragma unroll
            for (int db = 0; db < 4; ++db) { const u32x2 ur = *(const u32x2*)(up + db * 16); const f32x4 uu = bf4(ur.x, ur.y);
                const f32x4 y = uu * (acc[tb][db] + bias); acc[tb][db] = y; s += dot4(y); }
            s += __shfl_xor(s, 16); s += __shfl_xor(s, 32);
            if (fq == 0) part[h * 64 + t] = s;
        }
        __syncthreads();
        MIX_T(1);
#pragma unroll
        for (int tb = 0; tb < 4; ++tb) if (tb < ntb) {
            const int t = tb * 16 + fr; float tot = 0.f;
#pragma unroll
            for (int hh = 0; hh < 8; ++hh) tot += part[hh * 64 + t];
            const float rs = rsqrtf(tot * (1.0f / 512.0f) + EPS_);
            bf16_t* yp = YC + (size_t)(R0 + t) * DM + 512 + h * 64 + fq * 4;
#pragma unroll
            for (int db = 0; db < 4; ++db) { const f32x4 gb = *(const f32x4*)(a.in[18] + h * 64 + db * 16 + fq * 4); const f32x4 y = acc[tb][db] * rs * gb;
                u32x2 w; w.x = cvt_pk_bf16(y.x, y.y); w.y = cvt_pk_bf16(y.z, y.w); ST8(ycrs, (unsigned)((R0 + t) * DM + 512 + h * 64 + fq * 4 + db * 16) * 2u, w); }
        }
        MIX_T(2);
        if (wave * 8 < nrows)
        {
            const int c0 = lane * 8; const float* cw = a.in[13];
            const f32x4 w0a = *(const f32x4*)(cw + c0), w0b = *(const f32x4*)(cw + c0 + 4), w1a = *(const f32x4*)(cw + 512 + c0), w1b = *(const f32x4*)(cw + 512 + c0 + 4),
                        w2a = *(const f32x4*)(cw + 1024 + c0), w2b = *(const f32x4*)(cw + 1024 + c0 + 4);
            const f32x4 gaa = *(const f32x4*)(a.in[17] + c0), gab = *(const f32x4*)(a.in[17] + c0 + 4);
            f32x4 zp2a = {0.f, 0.f, 0.f, 0.f}, zp2b = zp2a, zp1a = zp2a, zp1b = zp2a;
            const int rb = R0 + wave * 8; const int sb_ = ((R0 - MP_) >> 3) + wave;
            if (samp) { const float* st = a.in[4] + (size_t)sb_ * 1024 + c0; zp2a = *(const f32x4*)st; zp2b = *(const f32x4*)(st + 4); zp1a = *(const f32x4*)(st + 512); zp1b = *(const f32x4*)(st + 516); }
            else if (s0 + wave * 8 > 0) {
                const bf16_t* p2 = PROJ + (size_t)(rb - 2) * NIN + c0; const bf16_t* p1 = p2 + NIN;
                const u32x4 c2 = *(const u32x4*)(p2 + 512), h2 = *(const u32x4*)(p2 + 1024), c1 = *(const u32x4*)(p1 + 512), h1 = *(const u32x4*)(p1 + 1024);
                zp2a = bf4(c2.x, c2.y) * bf4(h2.x, h2.y); zp2b = bf4(c2.z, c2.w) * bf4(h2.z, h2.w); zp1a = bf4(c1.x, c1.y) * bf4(h1.x, h1.y); zp1b = bf4(c1.z, c1.w) * bf4(h1.z, h1.w);
            }
            f32x4 ya[8], yb[8]; float ss[8];
            u32x4 braw8[8], craw8[8], hraw8[8];
#pragma unroll
            for (int i = 0; i < 8; ++i) { const bf16_t* pr = PROJ + (size_t)(rb + i) * NIN + c0; braw8[i] = *(const u32x4*)pr; craw8[i] = *(const u32x4*)(pr + 512); hraw8[i] = *(const u32x4*)(pr + 1024); }
#pragma unroll
            for (int i = 0; i < 8; ++i) {
                const u32x4 braw = braw8[i], craw = craw8[i], hraw = hraw8[i];
                const f32x4 za = bf4(craw.x, craw.y) * bf4(hraw.x, hraw.y), zb = bf4(craw.z, craw.w) * bf4(hraw.z, hraw.w);
                const f32x4 ca = w0a * zp2a + w1a * zp1a + w2a * za, cb = w0b * zp2b + w1b * zp1b + w2b * zb;
                ya[i] = bf4(braw.x, braw.y) * ca; yb[i] = bf4(braw.z, braw.w) * cb;
                ss[i] = wave_sum(dot4(ya[i]) + dot4(yb[i]));
                if (i >= 6) {
                    if (samp) { float* o = out + OUT_NCS + ((size_t)sb_ * 2 + (i - 6)) * 512 + c0; *(f32x4*)o = za; *(f32x4*)(o + 4) = zb; }
                    else if ((u & 31) == 31 && wave == 7) { float* o = out + OUT_NCP + ((size_t)(u >> 5) * 2 + (i - 6)) * 512 + c0; *(f32x4*)o = za; *(f32x4*)(o + 4) = zb; }
                }
                zp2a = zp1a; zp2b = zp1b; zp1a = za; zp1b = zb;
            }
#pragma unroll
            for (int i = 0; i < 8; ++i) {
                const float rs = rsqrtf(ss[i] * (1.0f / 512.0f) + EPS_);
                const f32x4 y0 = ya[i] * rs * gaa, y1 = yb[i] * rs * gab;
                u32x4 w; w.x = cvt_pk_bf16(y0.x, y0.y); w.y = cvt_pk_bf16(y0.z, y0.w); w.z = cvt_pk_bf16(y1.x, y1.y); w.w = cvt_pk_bf16(y1.z, y1.w);
                ST16(ycrs, (unsigned)((rb + i) * DM + c0) * 2u, w);
            }
        }
        __syncthreads();
        MIX_T(3);
    }
}

constexpr int TR_I_G = (DM / 64) * (FF / 32), TR_I_D = (FF / 64) * (DM / 32), TR_I_IN = (DM / 64) * (NIN / 32), TR_I_O = (DM / 64) * (DM / 32), TR_I_PP = (PLE / 64) * (DM / 32);
constexpr int TR_A_END = 2 * TR_I_G + TR_I_IN + TR_I_O, TR_B_END = TR_A_END + TR_I_D, TR_C_END = TR_B_END + TR_I_G + TR_I_D + TR_I_O + TR_I_PP, TR_D_END = TR_C_END + TR_I_G;
__device__ __forceinline__ void tr_decode(const Args& a, unsigned char* ws, int it, TrItem& d) {
    int r = it; int mode = 0; d.gk = nullptr;
    if (r < TR_I_G) { d.W = a.in[7]; d.K = DM; d.N = FF; d.WT = (bf16_t*)(ws + WS_WGU1); mode = 1; d.gk = a.in[5]; }
    else if ((r -= TR_I_G) < TR_I_G) { d.W = a.in[8]; d.K = DM; d.N = FF; d.WT = (bf16_t*)(ws + WS_WGU1); mode = 2; d.gk = a.in[5]; }
    else if ((r -= TR_I_G) < TR_I_IN) { d.W = a.in[12]; d.K = DM; d.N = NIN; d.WT = (bf16_t*)(ws + WS_WIN); d.gk = a.in[10]; }
    else if ((r -= TR_I_IN) < TR_I_O) { d.W = a.in[19]; d.K = DM; d.N = DM; d.WT = (bf16_t*)(ws + WS_WOUT); }
    else if ((r -= TR_I_O) < TR_I_D) { d.W = a.in[9]; d.K = FF; d.N = DM; d.WT = (bf16_t*)(ws + WS_WD1); }
    else if ((r -= TR_I_D) < TR_I_G) { d.W = a.in[23]; d.K = DM; d.N = FF; d.WT = (bf16_t*)(ws + WS_WGU2); mode = 2; d.gk = a.in[20]; }
    else if ((r -= TR_I_G) < TR_I_D) { d.W = a.in[24]; d.K = FF; d.N = DM; d.WT = (bf16_t*)(ws + WS_WD2); }
    else if ((r -= TR_I_D) < TR_I_O) { d.W = a.in[25]; d.K = DM; d.N = DM; d.WT = (bf16_t*)(ws + WS_WPG); }
    else if ((r -= TR_I_O) < TR_I_PP) { d.W = a.in[26]; d.K = PLE; d.N = DM; d.WT = (bf16_t*)(ws + WS_WPP); }
    else { r -= TR_I_PP; d.W = a.in[22]; d.K = DM; d.N = FF; d.WT = (bf16_t*)(ws + WS_WGU2); mode = 1; d.gk = a.in[20]; }
    const int nblk = d.N / 32, kb = r / nblk, nb = r % nblk; d.k0 = 64 * kb; d.n0 = 32 * nb;
    d.drow0 = mode ? (d.n0 >> 7) * 256 + (d.n0 & 127) + (mode == 2 ? 128 : 0) : d.n0;
}
__device__ __forceinline__ void do_transposes(const Args& a, unsigned char* ws, LAS unsigned char* lds, int first, int last, int widx, int nwaves, int wave, int lane) {
    LAS float* scr = (LAS float*)(lds + wave * 8448);
    int it = first + widx;
    if (it < last) {
        TrItem d0, d1; f32x4 v0[8], v1[8]; float g0[8], g1[8];
        tr_decode(a, ws, it, d0); tr_load(d0, lane, v0, g0);
        for (;;) {
            const bool m1 = it + nwaves < last;
            if (m1) { tr_decode(a, ws, it + nwaves, d1); tr_load(d1, lane, v1, g1); }
            tr_store(d0, scr, lane, v0, g0);
            if (!m1) break;
            it += nwaves;
            const bool m0 = it + nwaves < last;
            if (m0) { tr_decode(a, ws, it + nwaves, d0); tr_load(d0, lane, v0, g0); }
            tr_store(d1, scr, lane, v1, g1);
            if (!m0) break;
            it += nwaves;
        }
    }
}
__device__ __forceinline__ int fresh_tid() { int t = threadIdx.x; asm volatile("" : "+v"(t)); return t; }
template <bool COOP>
__global__ void __launch_bounds__(512, 2) fwd_kernel(Args a) {
    extern __shared__ __attribute__((aligned(16))) unsigned char lds_raw[];
    LAS unsigned char* lds = (LAS unsigned char*)lds_raw;
    const int tid = threadIdx.x;
    const int G = gridDim.x, NGW = G * 8;
#define LANE_ (fresh_tid() & 63)
#define WAVE_ (__builtin_amdgcn_readfirstlane(fresh_tid() >> 6))
#define GW_ ((int)blockIdx.x * 8 + WAVE_)
    unsigned char* ws = a.ws;
    bf16_t* WGU1 = (bf16_t*)(ws + WS_WGU1); bf16_t* WD1 = (bf16_t*)(ws + WS_WD1); bf16_t* WIN = (bf16_t*)(ws + WS_WIN); bf16_t* WOUT = (bf16_t*)(ws + WS_WOUT);
    bf16_t* WGU2 = (bf16_t*)(ws + WS_WGU2); bf16_t* WD2 = (bf16_t*)(ws + WS_WD2); bf16_t* WPG = (bf16_t*)(ws + WS_WPG); bf16_t* WPP = (bf16_t*)(ws + WS_WPP);
    bf16_t* YC = (bf16_t*)(ws + WS_YC); bf16_t* HB = (bf16_t*)(ws + WS_HB); float* RS = (float*)(ws + WS_RS); bf16_t* ACT = (bf16_t*)(ws + WS_ACT); bf16_t* PROJ = (bf16_t*)(ws + WS_PROJ); bf16_t* PB = (bf16_t*)(ws + WS_PB);
    bf16_t* DB = (bf16_t*)(ws + WS_D); bf16_t* SLAB2 = (bf16_t*)(ws + WS_SLAB2); bf16_t* SLAB4 = (bf16_t*)(ws + WS_SLAB4); bf16_t* PP = (bf16_t*)(ws + WS_PP);
#define IN(k) (a.ph_lo <= (k) && (k) < a.ph_hi)
#define REP(k) for (int rep_ = 0; rep_ < (((MK_DUP >> (k)) & 1u) ? 2 : 1); ++rep_)
    XcdBarrier bar; bar.bar = (unsigned*)(ws + WS_BAR); bar.x = 0; bar.st = nullptr;
    if (COOP) {
        volatile LAS unsigned* st = (volatile LAS unsigned*)(lds + LDS_BYTES - 16);
        if (tid < 4) st[tid] = 0u;
        __syncthreads();
        bar = xcd_barrier_post((unsigned*)(ws + WS_BAR), st);
        if (a.ph_lo < 0) cg::this_grid().sync();
    }
#ifdef MK_TPROBE
#define MIXTQ_ (&tq_)
#else
#define MIXTQ_ nullptr
#endif
#ifdef MK_TPROBE
    unsigned long long tq_ = 0ull, tp_ = __builtin_amdgcn_s_memrealtime();
#define SEAM(k) do { if (COOP && IN(k) && IN((k) + 1)) { const unsigned long long t1_ = __builtin_amdgcn_s_memrealtime(); if ((MK_TW >> (k)) & 1u) tq_ += t1_ - tp_; xcd_barrier(bar); \
        const unsigned long long t2_ = __builtin_amdgcn_s_memrealtime(); if ((MK_TB >> (k)) & 1u) tq_ += t2_ - t1_; tp_ = t2_; } } while (0)
#else
#define SEAM(k) do { if (COOP && IN(k) && IN((k) + 1)) xcd_barrier(bar); } while (0)
#endif

    if (IN(0)) REP(0) {
        const int lane = LANE_, wave = WAVE_, gw = GW_;
        do_transposes(a, ws, lds, 0, TR_A_END, gw, NGW, wave, lane);
        rowpass<2 | 4 | 64, 0, 0>(nullptr, nullptr, nullptr, nullptr, a.in[0], a.in[1], HB, RS, nullptr, nullptr, 0.f, gw, NGW, lane);
    }
    SEAM(0);
    const int bid = (int)blockIdx.x;
#define GEMM_FULL(EPI, Aop, Bop, KK, MM, NN, ...) do { pg8::Gemm g_{Aop, Bop, KK, KK}; pg8::StaticOrder S_; S_.init(MM, NN, G, bid); pg8::EPI E_{__VA_ARGS__}; \
        pg8::gemm_phase<pg8::EPI, pg8::StaticOrder, true, true>(lds, g_, S_, E_); } while (0)
#define GEMM_SPLIT(Aop, Bop, KK, NSL, S0, S1, N0) do { pg8::Gemm g_{Aop, Bop, KK, 256}; pg8::SubOrder S_{64, 4, 4, NSL, G, bid}; pg8::EpiF32Slab E_{S0, S1, N0, 64}; \
        pg8::gemm_phase<pg8::EpiF32Slab, pg8::SubOrder, true, true>(lds, g_, S_, E_); } while (0)
    bf16_t* const YCF = YC;
    if (IN(1)) { REP(1) GEMM_FULL(EpiSwiglu, HB, WGU1, DM, M_, NGU, ACT, FF);
        { const int nwg = (M_ / 256) * (NGU / 256), rem = nwg % G, nidle = rem ? G - rem : G, idx = rem ? bid - rem : bid;
          if (idx >= 0) do_transposes(a, ws, lds, TR_A_END, TR_B_END, idx * 8 + WAVE_, nidle * 8, WAVE_, LANE_); } }
    SEAM(1);
    if (IN(2)) REP(2) { GEMM_FULL(EpiBf16, ACT, WD1, FF, MP_, DM, DB, DM, nullptr); GEMM_SPLIT(ACT, WD1, FF, 11, YCF, SLAB2, 8); }
    SEAM(2);
    if (IN(3)) rowpass<1 | 4 | 32 | 64, 11, 8>(DB, YCF, SLAB2, nullptr, nullptr, nullptr, HB, RS, nullptr, a.in[6], 0.5f, GW_, NGW, LANE_);
    SEAM(3);
    if (IN(4)) { REP(4) GEMM_FULL(EpiBf16, HB, WIN, DM, M_, NIN, PROJ, NIN, nullptr);
        { const int nwg = (M_ / 256) * (NIN / 256), rem = nwg % G, nidle = rem ? G - rem : G, idx = rem ? bid - rem : bid;
          if (idx >= 0) do_transposes(a, ws, lds, TR_B_END, TR_C_END, idx * 8 + WAVE_, nidle * 8, WAVE_, LANE_); } }
    SEAM(4);
    if (IN(5)) REP(5) mixer_phase(a, lds, PROJ, YC, WAVE_, LANE_, MIXTQ_);
    SEAM(5);
#ifdef MK_XBAR
#pragma nounroll
    for (int xb_ = 0; xb_ < MK_XBAR; ++xb_) xcd_barrier(bar);
#endif
    if (IN(6)) { REP(6) { GEMM_FULL(EpiBf16, YC, WOUT, DM, MP_, DM, DB, DM, nullptr); GEMM_SPLIT(YC, WOUT, DM, 4, SLAB4, SLAB4, 4); }
        if (G > 64 && bid >= 64) do_transposes(a, ws, lds, TR_C_END, TR_D_END, (bid - 64) * 8 + WAVE_, (G - 64) * 8, WAVE_, LANE_);
        else if (G <= 64) do_transposes(a, ws, lds, TR_C_END, TR_D_END, bid * 8 + WAVE_, G * 8, WAVE_, LANE_); }
    SEAM(6);
    if (IN(7)) rowpass<1 | 4 | 32 | 64, 4, 4>(DB, SLAB4, SLAB4, nullptr, nullptr, nullptr, HB, RS, nullptr, a.in[11], 1.0f, GW_, NGW, LANE_);
    SEAM(7);
    if (IN(8)) { REP(8) GEMM_FULL(EpiSwiglu, HB, WGU2, DM, M_, NGU, ACT, FF);
        { const int nwg = (M_ / 256) * (NGU / 256), rem = nwg % G, nidle = rem ? G - rem : G, idx = rem ? bid - rem : bid;
          if (idx >= 0) { const int lane = LANE_, w0 = idx * 8 + WAVE_, nw = nidle * 8;
            for (int m0 = w0; m0 < M_; m0 += 8 * nw) {
                f32x4 v[8];
#pragma unroll
                for (int q = 0; q < 8; ++q) { const int m = m0 + q * nw; if (m < M_) { const float* pr = (m < MP_) ? a.in[2] + (size_t)m * PLE : a.in[3] + (size_t)(m - MP_) * PLE; v[q] = ((const f32x4*)pr)[lane]; } }
#pragma unroll
                for (int q = 0; q < 8; ++q) { const int m = m0 + q * nw; if (m < M_) { u32x2 w; w.x = cvt_pk_bf16(v[q].x, v[q].y); w.y = cvt_pk_bf16(v[q].z, v[q].w); ((u32x2*)(PB + (size_t)m * PLE))[lane] = w; } } } } } }
    SEAM(8);
    if (IN(9)) REP(9) { GEMM_FULL(EpiBf16, ACT, WD2, FF, MP_, DM, DB, DM, nullptr); GEMM_SPLIT(ACT, WD2, FF, 11, YCF, SLAB2, 8); }
    SEAM(9);
    if (IN(10)) {
        rowpass<1 | 4 | 32, 11, 8>(DB, YCF, SLAB2, nullptr, nullptr, nullptr, HB, RS, nullptr, a.in[21], 0.5f, GW_, NGW, LANE_);
    }
    SEAM(10);
    if (IN(11)) REP(11) { GEMM_FULL(EpiBf16N, PB, WPP, PLE, MP_, DM, PP, DM);
        { pg8::Gemm g_{PB, WPP, PLE, PLE}; pg8::SubOrder S_{64, 4, 4, 1, G, (bid >= 64 && bid < 80) ? bid - 64 : -1}; pg8::EpiBf16N E_{PP, DM};
          pg8::gemm_phase<pg8::EpiBf16N, pg8::SubOrder, true, true>(lds, g_, S_, E_); } }
    if (IN(12)) REP(12) { GEMM_FULL(EpiPle, HB, WPG, DM, MP_, DM, DB, PP, DM); GEMM_SPLIT(HB, WPG, DM, 4, SLAB4, SLAB4, 4); }
    SEAM(12);
    if (IN(13)) rowpass<1 | 8 | 16, 4, 4>(DB, SLAB4, SLAB4, PP, nullptr, nullptr, HB, nullptr, a.out, a.in[27], 1.0f, GW_, NGW, LANE_);
#ifdef MK_TPROBE
    if (blockIdx.x == 0) { const unsigned long long t1_ = __builtin_amdgcn_s_memrealtime(); if ((MK_TW >> 13) & 1u) tq_ += t1_ - tp_;
        while (__builtin_amdgcn_s_memrealtime() - t1_ < 4ull * tq_) __builtin_amdgcn_s_sleep(8); }
#endif
#undef IN
#undef SEAM
}

extern "C" void kernel_launch(void* const* d_in, const int* in_sizes, int n_in, void* d_out, int out_size, void* d_ws, size_t ws_size, hipStream_t stream) {
    static int grid = 0;
    if (grid == 0) {
        if (n_in != 28 || out_size != 19013632 || ws_size < WS_TOTAL) { fprintf(stderr, "kernel_launch: unexpected shapes: n_in %d out %d ws %zu (need %zu)\n", n_in, out_size, ws_size, (size_t)WS_TOTAL); grid = -1; return; }
        int dev = 0, cus = 0, per_cu = 0;
        if (hipGetDevice(&dev) != hipSuccess || hipDeviceGetAttribute(&cus, hipDeviceAttributeMultiprocessorCount, dev) != hipSuccess) { fprintf(stderr, "kernel_launch: device query failed\n"); grid = -1; return; }
        if (hipFuncSetAttribute((const void*)fwd_kernel<true>, hipFuncAttributeMaxDynamicSharedMemorySize, LDS_BYTES) != hipSuccess) { fprintf(stderr, "kernel_launch: hipFuncSetAttribute failed\n"); grid = -1; return; }
        if (hipOccupancyMaxActiveBlocksPerMultiprocessor(&per_cu, (const void*)fwd_kernel<true>, 512, LDS_BYTES) != hipSuccess || per_cu < 1) { fprintf(stderr, "kernel_launch: occupancy query says %d blocks per CU\n", per_cu); per_cu = 1; }
        (void)hipGetLastError();
        grid = cus * per_cu;
        fprintf(stderr, "kernel_launch: grid %d (cus %d x %d)\n", grid, cus, per_cu);
    }
    if (grid < 0) return;
    Args a{};
    for (int i = 0; i < 28; ++i) a.in[i] = (const float*)d_in[i];
    a.out = (float*)d_out; a.ws = (unsigned char*)d_ws;
#if MK_COOP
    if (hipMemsetAsync((char*)d_ws + WS_BAR, 0, (size_t)XCD_BAR_WORDS * 4, stream) != hipSuccess) { fprintf(stderr, "kernel_launch: memset of the barrier words failed\n"); return; }
    a.ph_lo = 0; a.ph_hi = NPHASE;
    void* args[] = {&a};
    const hipError_t e = hipLaunchCooperativeKernel((const void*)fwd_kernel<true>, dim3(grid), dim3(512), args, LDS_BYTES, stream);
    if (e != hipSuccess) fprintf(stderr, "kernel_launch: cooperative launch failed: %s (grid %d)\n", hipGetErrorString(e), grid);
#endif
}
```

```cpp
#include <hip/hip_runtime.h>
#include <hip/hip_cooperative_groups.h>
#include <cstdio>
#include <cstdint>
namespace cg = cooperative_groups;
#define MK_DUP 0u
namespace pg8 {
#define PG8_LAS __attribute__((address_space(3)))
typedef unsigned short bf16_t;
typedef short bf16x8 __attribute__((ext_vector_type(8)));
typedef float f32x4 __attribute__((ext_vector_type(4)));
typedef unsigned u32x4 __attribute__((ext_vector_type(4)));
constexpr int BM = 256, BK = 64, HALF = 128, HTB = HALF * BK * 2  , STAGE_BYTES = 8 * HTB, NXCD = 8, WGM = 8;

__host__ __device__ __forceinline__ int lds_byte(int r, int c) { const int st = (r >> 4) * 2 + (c >> 5), rr = r & 15, cc = c & 31, ob = rr * 64 + cc * 2; return st * 1024 + (ob ^ (((ob >> 9) & 1) << 5)); }
__host__ __device__ __forceinline__ void stage_rc(int b, int& R, int& C) { const int st = b / 1024, sb = b % 1024, swz = sb ^ (((sb >> 9) & 1) << 5); R = (st >> 1) * 16 + swz / 64; C = (st & 1) * 32 + (swz % 64) / 2; }
__host__ __device__ __forceinline__ int perm32(int rho) { const int n = rho >> 4, i = rho & 15; return 8 * (i >> 2) + 4 * n + (i & 3); }

struct Unit { int pm, pn, ks; };
struct Gemm { const bf16_t* A; const bf16_t* Bt; int ld, K; };

struct StaticOrder {
    int nM, nN, nwg, G, c;
    __host__ __device__ void init(int M, int N, int G_, int c_) { nM = M / BM; nN = N / BM; nwg = nM * nN; G = G_; c = c_; }
    __host__ __device__ bool next(int i, Unit& u) const {
        const long L = (long)i * G + c; if (L >= nwg) return false;
        int wgid = (int)L; { const int q = nwg / NXCD, r = nwg % NXCD, xcd = wgid % NXCD, off = wgid / NXCD; wgid = (xcd < r ? xcd * (q + 1) : r * (q + 1) + (xcd - r) * q) + off; }
        const int nig = WGM * nN, gid = wgid / nig, fm = gid * WGM, gsz = (nM - fm) < WGM ? (nM - fm) : WGM;
        u.pm = fm + ((wgid % nig) % gsz); u.pn = (wgid % nig) / gsz; u.ks = 0; return true;
    }
    __device__ __forceinline__ void a_ready(const Unit&) const {}
    __device__ __forceinline__ void done(const Unit&) const {}
};
struct SubOrder {
    int pm0, npm, nN, nsl, G, c;
    __host__ __device__ bool next(int i, Unit& u) const {
        const int L = i * G + c; if (c < 0 || L >= npm * nN * nsl) return false;
        const int t = L / nsl; u.ks = L - t * nsl; u.pn = t % nN; u.pm = pm0 + t / nN; return true;
    }
    __device__ __forceinline__ void a_ready(const Unit&) const {}
    __device__ __forceinline__ void done(const Unit&) const {}
};
typedef unsigned u32x2 __attribute__((ext_vector_type(2)));

__device__ __forceinline__ unsigned cvt_pk_bf16(float lo, float hi) { unsigned r; asm("v_cvt_pk_bf16_f32 %0, %1, %2" : "=v"(r) : "v"(lo), "v"(hi)); return r; }
__device__ __forceinline__ float sigmoid_f(float x) { return __builtin_amdgcn_rcpf(1.0f + __builtin_amdgcn_exp2f(x * -1.44269504089f)); }

#ifndef MK_WT
#define MK_WT 0
#endif
typedef __attribute__((__vector_size__(4 * sizeof(int)))) int rsrc_t;
constexpr int WT_AUX = MK_WT ? 16 : 0;
__device__ __forceinline__ auto mk_rsrc(const void* base) { return __builtin_amdgcn_make_buffer_rsrc((void*)base, 0, 0x7fffffff, 0x00020000); }
#define ST16(rsrc, byteoff, v) __builtin_amdgcn_raw_buffer_store_b128(__builtin_bit_cast(u32x4, v), rsrc, (int)(byteoff), 0, pg8::WT_AUX)
#define ST8(rsrc, byteoff, v)  __builtin_amdgcn_raw_buffer_store_b64(__builtin_bit_cast(u32x2, v), rsrc, (int)(byteoff), 0, pg8::WT_AUX)

struct EpiF32 {
    static constexpr bool PERM = false, AFTER_DRAIN = false;
    float* C; int ldc;
    __device__ __forceinline__ void operator()(const f32x4 (&acc)[2][2][4][2], const Unit& u, int wr, int wc, int fr_, int fq_) const {
        int tl_ = threadIdx.x; asm volatile("" : "+v"(tl_)); const int fr = tl_ & 15, fq = (tl_ >> 4) & 3;
        const int row0 = u.pm * BM + wr * 64 + fr, col0 = u.pn * BM + wc * 32 + 4 * fq; float* const Cb_ = C;
#pragma unroll
        for (int ai = 0; ai < 2; ++ai)
#pragma unroll
            for (int m = 0; m < 4; ++m) { const unsigned ro = ((unsigned)(row0 + ai * HALF + m * 16) * (unsigned)ldc + (unsigned)col0) * 4u;
#pragma unroll
                for (int bj = 0; bj < 2; ++bj)
#pragma unroll
                    for (int n = 0; n < 2; ++n) *(f32x4*)((char*)Cb_ + ro + (bj * HALF + n * 16) * 4) = acc[ai][bj][m][n]; }
    }
};
struct EpiBf16N {
    static constexpr bool PERM = false, AFTER_DRAIN = false;
    bf16_t* O; int ldc;
    __device__ __forceinline__ void operator()(const f32x4 (&acc)[2][2][4][2], const Unit& u, int wr, int wc, int fr_, int fq_) const {
        int tl_ = threadIdx.x; asm volatile("" : "+v"(tl_)); const int fr = tl_ & 15, fq = (tl_ >> 4) & 3;
        const int row0 = u.pm * BM + wr * 64 + fr, col0 = u.pn * BM + wc * 32 + 4 * fq;
#pragma unroll
        for (int ai = 0; ai < 2; ++ai)
#pragma unroll
            for (int m = 0; m < 4; ++m) { const size_t off = (size_t)(row0 + ai * HALF + m * 16) * ldc + col0;
#pragma unroll
                for (int bj = 0; bj < 2; ++bj)
#pragma unroll
                    for (int n = 0; n < 2; ++n) { const f32x4 a = acc[ai][bj][m][n]; u32x2 w; w.x = cvt_pk_bf16(a.x, a.y); w.y = cvt_pk_bf16(a.z, a.w); *(u32x2*)(O + off + bj * HALF + n * 16) = w; } }
    }
};
struct EpiPle {
    static constexpr bool PERM = false, AFTER_DRAIN = false;
    bf16_t* T; const bf16_t* P; int ldc;
    __device__ __forceinline__ void operator()(const f32x4 (&acc)[2][2][4][2], const Unit& u, int wr, int wc, int fr_, int fq_) const {
        int tl_ = threadIdx.x; asm volatile("" : "+v"(tl_)); const int fr = tl_ & 15, fq = (tl_ >> 4) & 3;
        const int row0 = u.pm * BM + wr * 64 + fr, col0 = u.pn * BM + wc * 32 + 4 * fq;
#pragma unroll
        for (int ai = 0; ai < 2; ++ai)
#pragma unroll
            for (int m = 0; m < 4; ++m) { const size_t off = (size_t)(row0 + ai * HALF + m * 16) * ldc + col0;
#pragma unroll
                for (int bj = 0; bj < 2; ++bj)
#pragma unroll
                    for (int n = 0; n < 2; ++n) { const u32x2 pw = *(const u32x2*)(P + off + bj * HALF + n * 16); const f32x4 a = acc[ai][bj][m][n];
                        const f32x4 p = {__uint_as_float(pw.x << 16), __uint_as_float(pw.x & 0xffff0000u), __uint_as_float(pw.y << 16), __uint_as_float(pw.y & 0xffff0000u)};
                        u32x2 w; w.x = cvt_pk_bf16(sigmoid_f(a.x) * p.x, sigmoid_f(a.y) * p.y); w.y = cvt_pk_bf16(sigmoid_f(a.z) * p.z, sigmoid_f(a.w) * p.w);
                        *(u32x2*)(T + off + bj * HALF + n * 16) = w; } }
    }
};
struct EpiF32Slab {
    static constexpr bool PERM = false, AFTER_DRAIN = false;
    bf16_t* base0; bf16_t* base1; int n0; int pm0;
    __device__ __forceinline__ void operator()(const f32x4 (&acc)[2][2][4][2], const Unit& u, int wr, int wc, int fr_, int fq_) const {
        int tl_ = threadIdx.x; asm volatile("" : "+v"(tl_)); const int fr = tl_ & 15, fq = (tl_ >> 4) & 3;
        const int row0 = (u.pm - pm0) * BM + wr * 64 + fr, col0 = u.pn * BM + wc * 32 + 4 * fq;
        bf16_t* const Cb_ = (u.ks < n0) ? base0 + ((size_t)u.ks << 20) : base1 + ((size_t)(u.ks - n0) << 20);
#pragma unroll
        for (int ai = 0; ai < 2; ++ai)
#pragma unroll
            for (int m = 0; m < 4; ++m) { const unsigned ro = ((unsigned)(row0 + ai * HALF + m * 16) * 1024u + (unsigned)col0) * 2u;
#pragma unroll
                for (int bj = 0; bj < 2; ++bj)
#pragma unroll
                    for (int n = 0; n < 2; ++n) { const f32x4 a = acc[ai][bj][m][n]; u32x2 w; w.x = cvt_pk_bf16(a.x, a.y); w.y = cvt_pk_bf16(a.z, a.w);
                        *(u32x2*)((char*)Cb_ + ro + (bj * HALF + n * 16) * 2) = w; } }
    }
};
struct EpiBf16 {
    static constexpr bool PERM = true, AFTER_DRAIN = false;
    bf16_t* O; int ldc; const float* rs;
    __device__ __forceinline__ void operator()(const f32x4 (&acc)[2][2][4][2], const Unit& u, int wr, int wc, int fr_, int fq_) const {
        int tl_ = threadIdx.x; asm volatile("" : "+v"(tl_)); const int fr = tl_ & 15, fq = (tl_ >> 4) & 3;
        const int row0 = u.pm * BM + wr * 64 + fr, col0 = u.pn * BM + wc * 32 + 8 * fq; const auto rs_ = mk_rsrc(O);
#pragma unroll
        for (int ai = 0; ai < 2; ++ai)
#pragma unroll
            for (int m = 0; m < 4; ++m) { const int row = row0 + ai * HALF + m * 16; const unsigned ro = ((unsigned)row * (unsigned)ldc + (unsigned)col0) * 2u; const float r = rs ? rs[row] : 1.0f;
#pragma unroll
                for (int bj = 0; bj < 2; ++bj) { const f32x4 v0 = acc[ai][bj][m][0] * r, v1 = acc[ai][bj][m][1] * r;
                    u32x4 w; w.x = cvt_pk_bf16(v0[0], v0[1]); w.y = cvt_pk_bf16(v0[2], v0[3]); w.z = cvt_pk_bf16(v1[0], v1[1]); w.w = cvt_pk_bf16(v1[2], v1[3]);
                    ST16(rs_, ro + bj * HALF * 2, w); } }
    }
};
struct EpiSwiglu {
    static constexpr bool PERM = true, AFTER_DRAIN = false;
    bf16_t* O; int ldc;
    static __device__ __forceinline__ f32x4 silu_mul(f32x4 g, f32x4 u) {
        const f32x4 gc = __builtin_elementwise_max(g, (f32x4){-40.f, -40.f, -40.f, -40.f});
        const f32x4 t = gc * -1.44269504089f;
        f32x4 e; e.x = __builtin_amdgcn_exp2f(t.x); e.y = __builtin_amdgcn_exp2f(t.y); e.z = __builtin_amdgcn_exp2f(t.z); e.w = __builtin_amdgcn_exp2f(t.w);
        const f32x4 d = e + 1.0f;
        const float r01 = __builtin_amdgcn_rcpf(d.x * d.y), r23 = __builtin_amdgcn_rcpf(d.z * d.w);
        const f32x4 sg = {d.y * r01, d.x * r01, d.w * r23, d.z * r23};
        return (gc * sg) * u;
    }
    __device__ __forceinline__ void operator()(const f32x4 (&acc)[2][2][4][2], const Unit& u, int wr, int wc, int fr_, int fq_) const {
        int tl_ = threadIdx.x; asm volatile("" : "+v"(tl_)); const int fr = tl_ & 15, fq = (tl_ >> 4) & 3;
        const int row0 = u.pm * BM + wr * 64 + fr, col0 = u.pn * HALF + wc * 32 + 8 * fq; const auto rs_ = mk_rsrc(O);
#pragma unroll
        for (int ai = 0; ai < 2; ++ai)
#pragma unroll
            for (int m = 0; m < 4; ++m) { const unsigned ro = ((unsigned)(row0 + ai * HALF + m * 16) * (unsigned)ldc + (unsigned)col0) * 2u;
                const f32x4 v0 = silu_mul(acc[ai][0][m][0], acc[ai][1][m][0]), v1 = silu_mul(acc[ai][0][m][1], acc[ai][1][m][1]);
                u32x4 w; w.x = cvt_pk_bf16(v0[0], v0[1]); w.y = cvt_pk_bf16(v0[2], v0[3]); w.z = cvt_pk_bf16(v1[0], v1[1]); w.w = cvt_pk_bf16(v1[2], v1[3]);
                ST16(rs_, ro, w); }
    }
};

template <class Epi, class Sched, bool ALIGN_EPI = false, bool SP2 = false>
__device__ __forceinline__ void gemm_phase(PG8_LAS unsigned char* lds, const Gemm g, const Sched& S, const Epi& E) {
    int tid_ = threadIdx.x; asm volatile("" : "+v"(tid_));
    const int tid = tid_, wid = __builtin_amdgcn_readfirstlane(tid >> 6), lane = tid & 63, wr = wid >> 2, wc = wid & 3, fr = lane & 15, fq = lane >> 4;
    const int K = g.K, nt = K / BK;
    unsigned voffA[2], voffB[2];
#pragma unroll
    for (int i = 0; i < 2; ++i) { int R, C; stage_rc(tid * 16 + i * 8192, R, C); const int Rb = Epi::PERM ? ((R & ~31) + perm32(R & 31)) : R;
        voffA[i] = (unsigned)(R * g.ld + C) * 2u; voffB[i] = (unsigned)(Rb * g.ld + C) * 2u; }
    const size_t kstep = (size_t)(BK * 2);
    const size_t hstepA = (size_t)HALF * g.ld * 2, hstepB = hstepA;
    const size_t kslice = (size_t)K * 2;
    const unsigned ldsw = (unsigned)wid * 1024u;
    const int aoff = lds_byte(wr * 64 + fr, fq * 8), boff = lds_byte(wc * 32 + fr, fq * 8);
#define PG8_SA(b, h) (((b) * 2 + (h)) * HTB)
#define PG8_SB(b, h) ((4 + (b) * 2 + (h)) * HTB)
#define PG8_STAGE(bufoff, gbase, voff) do { _Pragma("unroll") for (int _i = 0; _i < 2; ++_i) \
        __builtin_amdgcn_global_load_lds((const unsigned*)((const char*)(gbase) + (voff)[_i]), (PG8_LAS unsigned*)(lds + (bufoff) + ldsw + _i * 8192), 16, 0, 0); } while (0)
#define PG8_LDA(dst, b, h) do { _Pragma("unroll") for (int m = 0; m < 4; ++m) _Pragma("unroll") for (int k = 0; k < 2; ++k) dst[m][k] = *(const PG8_LAS bf16x8*)(lds + PG8_SA(b, h) + aoff + m * 2048 + k * 1024); } while (0)
#define PG8_LDB(dst, b, h) do { _Pragma("unroll") for (int n = 0; n < 2; ++n) _Pragma("unroll") for (int k = 0; k < 2; ++k) dst[n][k] = *(const PG8_LAS bf16x8*)(lds + PG8_SB(b, h) + boff + n * 2048 + k * 1024); } while (0)
#define PG8_MMA(ai, bj, At, Bt) do { __builtin_amdgcn_s_setprio(1); _Pragma("unroll") for (int m = 0; m < 4; ++m) _Pragma("unroll") for (int n = 0; n < 2; ++n) _Pragma("unroll") for (int k = 0; k < 2; ++k) \
        acc[ai][bj][m][n] = __builtin_amdgcn_mfma_f32_16x16x32_bf16(Bt[n][k], At[m][k], acc[ai][bj][m][n], 0, 0, 0); __builtin_amdgcn_s_setprio(0); } while (0)
#define PG8_WAIT_V(n) asm volatile("s_waitcnt vmcnt(" #n ")" ::: "memory")
#define PG8_WAIT_L(n) asm volatile("s_waitcnt lgkmcnt(" #n ")" ::: "memory")
#define PG8_BAR __builtin_amdgcn_s_barrier()
#define PG8_SCHED __builtin_amdgcn_sched_barrier(0)
    Unit cur, nxt; int ui = 0;
    if (!S.next(0, cur)) return;
    f32x4 acc[2][2][4][2];
#pragma unroll
    for (int a = 0; a < 2; ++a)
#pragma unroll
        for (int b = 0; b < 2; ++b)
#pragma unroll
            for (int m = 0; m < 4; ++m)
#pragma unroll
                for (int n = 0; n < 2; ++n) acc[a][b][m][n] = (f32x4){0.f, 0.f, 0.f, 0.f};
    bf16x8 At[4][2], B0[2][2], B1[2][2];
    const char* cA = (const char*)g.A + (size_t)cur.pm * 2 * hstepA + (size_t)cur.ks * kslice; const char* cB = (const char*)g.Bt + (size_t)cur.pn * 2 * hstepB + (size_t)cur.ks * kslice;
    S.a_ready(cur);
    if constexpr (SP2) {
        PG8_STAGE(PG8_SB(0, 0), cB, voffB); PG8_STAGE(PG8_SB(0, 1), cB + hstepB, voffB); PG8_STAGE(PG8_SA(0, 0), cA, voffA); PG8_STAGE(PG8_SA(0, 1), cA + hstepA, voffA);
        if (wr == 1) PG8_BAR;
        PG8_WAIT_V(2); PG8_BAR;
        PG8_STAGE(PG8_SB(1, 0), cB + kstep, voffB); PG8_STAGE(PG8_SA(1, 0), cA + kstep, voffA); PG8_STAGE(PG8_SB(1, 1), cB + hstepB + kstep, voffB);
        PG8_WAIT_V(6); PG8_BAR;
    } else {
        PG8_STAGE(PG8_SB(0, 0), cB, voffB); PG8_STAGE(PG8_SA(0, 0), cA, voffA); PG8_STAGE(PG8_SB(0, 1), cB + hstepB, voffB); PG8_STAGE(PG8_SA(0, 1), cA + hstepA, voffA);
        if (wr == 1) PG8_BAR;
        PG8_WAIT_V(4); PG8_BAR;
        PG8_STAGE(PG8_SB(1, 0), cB + kstep, voffB); PG8_STAGE(PG8_SA(1, 0), cA + kstep, voffA); PG8_STAGE(PG8_SB(1, 1), cB + hstepB + kstep, voffB);
        PG8_WAIT_V(6); PG8_BAR;
    }
    for (;;) {
        const bool has_next = S.next(ui + 1, nxt);
        const char* nA = has_next ? (const char*)g.A + (size_t)nxt.pm * 2 * hstepA + (size_t)nxt.ks * kslice : cA; const char* nB = has_next ? (const char*)g.Bt + (size_t)nxt.pn * 2 * hstepB + (size_t)nxt.ks * kslice : cB;
        for (int t = 0; t < nt; t += 2) {
            const bool last = (t == nt - 2);
            const char* a1 = cA + (size_t)(t + 1) * kstep;
            const char* a2 = last ? nA : cA + (size_t)(t + 2) * kstep; const char* b2 = last ? nB : cB + (size_t)(t + 2) * kstep;
            const char* a3 = a2 + kstep; const char* b3 = b2 + kstep;
            if (last && has_next) S.a_ready(nxt);
            if constexpr (SP2) {
            PG8_LDB(B0, 0, 0); PG8_LDB(B1, 0, 1); PG8_SCHED; PG8_LDA(At, 0, 0); PG8_STAGE(PG8_SA(1, 1), a1 + hstepA, voffA);
            PG8_WAIT_V(8); PG8_WAIT_L(0); PG8_BAR; PG8_MMA(0, 0, At, B0); PG8_MMA(0, 1, At, B1); PG8_BAR; PG8_SCHED;
            PG8_LDA(At, 0, 1); PG8_STAGE(PG8_SB(0, 0), b2, voffB); PG8_STAGE(PG8_SB(0, 1), b2 + hstepB, voffB); PG8_STAGE(PG8_SA(0, 0), a2, voffA);
            PG8_WAIT_V(8); PG8_WAIT_L(0); PG8_BAR; PG8_MMA(1, 0, At, B0); PG8_MMA(1, 1, At, B1); PG8_BAR; PG8_SCHED;
            PG8_LDB(B0, 1, 0); PG8_LDB(B1, 1, 1); PG8_SCHED; PG8_LDA(At, 1, 0); PG8_STAGE(PG8_SA(0, 1), a2 + hstepA, voffA);
            PG8_WAIT_V(8); PG8_WAIT_L(0); PG8_BAR; PG8_MMA(0, 0, At, B0); PG8_MMA(0, 1, At, B1); PG8_BAR; PG8_SCHED;
            PG8_LDA(At, 1, 1); PG8_STAGE(PG8_SB(1, 0), b3, voffB); PG8_STAGE(PG8_SB(1, 1), b3 + hstepB, voffB); PG8_STAGE(PG8_SA(1, 0), a3, voffA);
            PG8_WAIT_V(8); PG8_WAIT_L(0); PG8_BAR; PG8_MMA(1, 0, At, B0); PG8_MMA(1, 1, At, B1); PG8_BAR; PG8_SCHED;
            } else {
            PG8_LDB(B0, 0, 0); PG8_SCHED; PG8_LDA(At, 0, 0); PG8_STAGE(PG8_SA(1, 1), a1 + hstepA, voffA);
            PG8_WAIT_L(8); PG8_BAR; PG8_WAIT_L(0); PG8_MMA(0, 0, At, B0); PG8_BAR; PG8_SCHED;
            PG8_LDB(B1, 0, 1); PG8_STAGE(PG8_SB(0, 0), b2, voffB);
            PG8_BAR; PG8_WAIT_L(0); PG8_MMA(0, 1, At, B1); PG8_BAR;
            PG8_LDA(At, 0, 1); PG8_STAGE(PG8_SA(0, 0), a2, voffA);
            PG8_BAR; PG8_WAIT_L(0); PG8_MMA(1, 0, At, B0); PG8_BAR; PG8_SCHED;
            PG8_STAGE(PG8_SB(0, 1), b2 + hstepB, voffB);
            PG8_WAIT_V(6); PG8_BAR; PG8_MMA(1, 1, At, B1); PG8_BAR;
            PG8_LDB(B0, 1, 0); PG8_SCHED; PG8_LDA(At, 1, 0); PG8_STAGE(PG8_SA(0, 1), a2 + hstepA, voffA);
            PG8_WAIT_L(8); PG8_BAR; PG8_WAIT_L(0); PG8_MMA(0, 0, At, B0); PG8_BAR; PG8_SCHED;
            PG8_LDB(B1, 1, 1); PG8_STAGE(PG8_SB(1, 0), b3, voffB);
            PG8_BAR; PG8_WAIT_L(0); PG8_MMA(0, 1, At, B1); PG8_BAR;
            PG8_LDA(At, 1, 1); PG8_STAGE(PG8_SA(1, 0), a3, voffA);
            PG8_BAR; PG8_WAIT_L(0); PG8_MMA(1, 0, At, B0); PG8_BAR; PG8_SCHED;
            PG8_STAGE(PG8_SB(1, 1), b3 + hstepB, voffB);
            PG8_WAIT_V(6); PG8_BAR; PG8_MMA(1, 1, At, B1); PG8_BAR;
            }
        }
        if constexpr (ALIGN_EPI) { if (wr == 0) PG8_BAR; }
        if constexpr (!Epi::AFTER_DRAIN) { E(acc, cur, wr, wc, fr, fq); S.done(cur); }
        if (!has_next) break;
#pragma unroll
        for (int a = 0; a < 2; ++a)
#pragma unroll
            for (int b = 0; b < 2; ++b)
#pragma unroll
                for (int m = 0; m < 4; ++m)
#pragma unroll
                    for (int n = 0; n < 2; ++n) acc[a][b][m][n] = (f32x4){0.f, 0.f, 0.f, 0.f};
        cur = nxt; cA = nA; cB = nB; ++ui;
        if constexpr (ALIGN_EPI) { if (wr == 1) PG8_BAR; }
    }
    PG8_WAIT_V(0);
    if constexpr (!ALIGN_EPI) { if (wr == 0) PG8_BAR; }
    PG8_BAR;
    if constexpr (Epi::AFTER_DRAIN) { E.fused(acc, cur, wr, wc, fr, fq, lds, wid, lane); S.done(cur); }
#undef PG8_SA
#undef PG8_SB
#undef PG8_STAGE
#undef PG8_LDA
#undef PG8_LDB
#undef PG8_MMA
#undef PG8_WAIT_V
#undef PG8_WAIT_L
#undef PG8_BAR
#undef PG8_SCHED
}
}

using pg8::bf16_t; using pg8::bf16x8; using pg8::f32x4; using pg8::u32x4; using pg8::u32x2; using pg8::cvt_pk_bf16;
#define LAS __attribute__((address_space(3)))
#define XB_TMO      128
#define XB_XCNT(j)  (256  + 64 * (j))
#define XB_XSUB(j)  (1280 + 64 * (j))
#define XB_XGEN(j)  (2304 + 64 * (j))
#define XB_TOP      3328
#define XB_TOPGEN   3392
#define XCD_BAR_WORDS 3456
#define XB_SPIN_CAP (1u << 18)

__device__ __forceinline__ unsigned xb_ld(unsigned* p)              { return __hip_atomic_load(p, __ATOMIC_RELAXED, __HIP_MEMORY_SCOPE_AGENT); }
__device__ __forceinline__ unsigned xb_add(unsigned* p, unsigned v) { return __hip_atomic_fetch_add(p, v, __ATOMIC_RELAXED, __HIP_MEMORY_SCOPE_AGENT); }
__device__ __forceinline__ unsigned xb_xcc_id() { return (unsigned)__builtin_amdgcn_s_getreg((3 << 11) | 20) & 0xFu; }
#define XB_SPIN(cond, bar) do { unsigned _sp = 0; while (cond) { __builtin_amdgcn_s_sleep(1); \
    if ((++_sp & 255u) == 0u) { if (xb_ld(&(bar)[XB_TMO])) break; if (_sp > XB_SPIN_CAP) { atomicAdd(&(bar)[XB_TMO], 1u); break; } } } } while (0)

struct XcdBarrier {
    unsigned* bar; unsigned x;
    volatile LAS unsigned* st;
};

__device__ __forceinline__ XcdBarrier xcd_barrier_post(unsigned* bar, volatile LAS unsigned* st) {
    XcdBarrier b; b.bar = bar; b.x = xb_xcc_id(); b.st = st;
    if (threadIdx.x == 0) (void)xb_add(&bar[XB_XCNT(b.x)], 1u);
    return b;
}
__device__ __forceinline__ void xcd_barrier_complete(unsigned* bar, unsigned x, unsigned& nloc, unsigned& nx) {
    const unsigned G = gridDim.x * gridDim.y * gridDim.z;
    unsigned sum, cnt, mine, sp = 0u;
    for (;;) {
        sum = 0u; cnt = 0u; mine = 0u;
#pragma unroll
        for (unsigned j = 0; j < 16; ++j) { const unsigned c = xb_ld(&bar[XB_XCNT(j)]); sum += c; cnt += (c > 0u) ? 1u : 0u; mine = (j == x) ? c : mine; }
        if (sum == G) break;
        __builtin_amdgcn_s_sleep(1);
        if ((++sp & 255u) == 0u) { if (xb_ld(&bar[XB_TMO])) break; if (sp > XB_SPIN_CAP) { atomicAdd(&bar[XB_TMO], 1u); break; } }
    }
    nloc = mine > 0u ? mine : 1u; nx = cnt > 0u ? cnt : 1u;
}

__device__ __forceinline__ void xcd_barrier(const XcdBarrier& b) {
    asm volatile("s_waitcnt vmcnt(0)" ::: "memory");
    __syncthreads();
    if (threadIdx.x == 0) {
        unsigned* bar = b.bar;
        __builtin_amdgcn_s_waitcnt(0);
        unsigned nloc = b.st[0], nx = b.st[1];
        if (nloc == 0u) { xcd_barrier_complete(bar, b.x, nloc, nx); b.st[0] = nloc; b.st[1] = nx; }
        const unsigned old = xb_add(&bar[XB_XSUB(b.x)], 1u);
        const unsigned gen = old / nloc;
        if (old + 1u == (gen + 1u) * nloc) {
            __builtin_amdgcn_fence(__ATOMIC_RELEASE, "agent");
            asm volatile("s_waitcnt vmcnt(0)" ::: "memory");
            const unsigned og = xb_add(&bar[XB_TOP], 1u);
            const unsigned tg = og / nx;
            if (og + 1u == (tg + 1u) * nx) xb_add(&bar[XB_TOPGEN], 1u);
            else XB_SPIN(xb_ld(&bar[XB_TOPGEN]) == tg, bar);
            __builtin_amdgcn_fence(__ATOMIC_ACQUIRE, "agent");
            xb_add(&bar[XB_XGEN(b.x)], 1u);
            asm volatile("s_waitcnt vmcnt(0)" ::: "memory");
        } else {
            XB_SPIN(xb_ld(&bar[XB_XGEN(b.x)]) == gen, bar);
            __builtin_amdgcn_fence(__ATOMIC_ACQUIRE, "agent");
            asm volatile("s_waitcnt vmcnt(0)" ::: "memory");
        }
    }
    __syncthreads();
}


#ifndef MK_DUP
#define MK_DUP 0u
#endif
#ifndef MK_COOP
#define MK_COOP 1
#endif
constexpr int M_ = 17408, MP_ = 16384, DM = 1024, FF = 2816, NGU = 5632, NIN = 2560, PLE = 256;
constexpr float EPS_ = 1e-6f;
constexpr int LDS_BYTES = 147456;
constexpr int NPHASE = 14;
constexpr size_t WS_WGU1 = 0;
constexpr size_t WS_WD1 = WS_WGU1 + (size_t)NGU * DM * 2;
constexpr size_t WS_WIN = WS_WD1 + (size_t)DM * FF * 2;
constexpr size_t WS_WOUT = WS_WIN + (size_t)NIN * DM * 2;
constexpr size_t WS_WGU2 = WS_WOUT + (size_t)DM * DM * 2;
constexpr size_t WS_WD2 = WS_WGU2 + (size_t)NGU * DM * 2;
constexpr size_t WS_WPG = WS_WD2 + (size_t)DM * FF * 2;
constexpr size_t WS_WPP = WS_WPG + (size_t)DM * DM * 2;
constexpr size_t WS_YC = WS_WPP + (size_t)DM * PLE * 2;
constexpr size_t WS_ACT = WS_YC + (size_t)M_ * DM * 2;
constexpr size_t WS_D = WS_ACT + (size_t)M_ * FF * 2;
constexpr size_t WS_HB = WS_D + (size_t)M_ * DM * 2;
constexpr size_t WS_SLAB2 = WS_HB + (size_t)M_ * DM * 2;
constexpr size_t WS_RS = WS_SLAB2 + (size_t)3 * 1024 * 1024 * 4;
constexpr size_t WS_END = WS_RS + (size_t)M_ * 4;
constexpr size_t WS_BAR = WS_END;
constexpr size_t WS_TOTAL = WS_BAR + (size_t)XCD_BAR_WORDS * 4;
constexpr size_t WS_PROJ = WS_ACT;
constexpr size_t WS_PP = WS_ACT;
constexpr size_t WS_PB = WS_YC + (size_t)16 * 1024 * 1024;
constexpr size_t WS_SLAB4 = WS_ACT + (size_t)M_ * DM * 4 + (size_t)M_ * PLE * 2;
static_assert(WS_SLAB4 + (size_t)4 * 1024 * 1024 * 4 <= WS_D && WS_PB + (size_t)M_ * PLE * 2 <= WS_ACT, "aliases fit");
constexpr size_t OUT_NCP = 17825792, OUT_NCS = 17833984, OUT_CVP = 17965056, OUT_CVS = 18489344;

struct Args { const float* in[28]; float* out; unsigned char* ws; int ph_lo, ph_hi; };

__device__ __forceinline__ float wave_sum(float v) {
#pragma unroll
    for (int o = 1; o < 64; o <<= 1) v += __shfl_xor(v, o);
    return v;
}
__device__ __forceinline__ float bf_lo(unsigned w) { return __uint_as_float(w << 16); }
__device__ __forceinline__ float bf_hi(unsigned w) { return __uint_as_float(w & 0xffff0000u); }
__device__ __forceinline__ float dot4(f32x4 a) { return (a.x * a.x + a.y * a.y) + (a.z * a.z + a.w * a.w); }
#define LDS_WAIT() asm volatile("s_waitcnt lgkmcnt(0)" ::: "memory")

struct TrItem { const float* W; bf16_t* WT; const float* gk; int K, N, k0, n0, drow0; };
__device__ __forceinline__ void tr_load(const TrItem& d, int lane, f32x4 (&v8)[8], float (&g8)[8]) {
#pragma unroll
    for (int i = 0; i < 8; ++i) { const int kk = 8 * i + (lane >> 3); v8[i] = __builtin_nontemporal_load((const f32x4*)(d.W + (size_t)(d.k0 + kk) * d.N + d.n0 + (lane & 7) * 4)); g8[i] = d.gk ? d.gk[d.k0 + kk] : 1.0f; }
}
__device__ __forceinline__ void tr_store(const TrItem& d, LAS float* scr, int lane, const f32x4 (&v8)[8], const float (&g8)[8]) {
#pragma unroll
    for (int i = 0; i < 8; ++i) { const int kk = 8 * i + (lane >> 3); LAS float* q = scr + kk * 33 + (lane & 7) * 4; const f32x4 v = v8[i] * g8[i]; q[0] = v.x; q[1] = v.y; q[2] = v.z; q[3] = v.w; }
    LDS_WAIT();
    const int c = lane & 7;
#pragma unroll
    for (int j = 0; j < 4; ++j) { const int n = (lane >> 3) + 8 * j; const LAS float* t = scr + (8 * c) * 33 + n;
        u32x4 o; o.x = cvt_pk_bf16(t[0 * 33], t[1 * 33]); o.y = cvt_pk_bf16(t[2 * 33], t[3 * 33]); o.z = cvt_pk_bf16(t[4 * 33], t[5 * 33]); o.w = cvt_pk_bf16(t[6 * 33], t[7 * 33]);
        *(u32x4*)(d.WT + (size_t)(d.drow0 + n) * d.K + d.k0 + 8 * c) = o; }
    LDS_WAIT();
}

__device__ __forceinline__ f32x4 bf4(unsigned a, unsigned b) { return (f32x4){bf_lo(a), bf_hi(a), bf_lo(b), bf_hi(b)}; }
template <int MODE>
__device__ __forceinline__ void rp_load_res(int m, const float* __restrict__ resP, const float* __restrict__ resS, const bf16_t* hb, int lane, f32x4 (&h)[4]) {
    if (MODE & 2) { const float* rrow = (m < MP_) ? resP + (size_t)m * DM : resS + (size_t)(m - MP_) * DM;
#pragma unroll
        for (int j = 0; j < 4; ++j) h[j] = __builtin_nontemporal_load((const f32x4*)rrow + lane + 64 * j); }
    else { const u32x2* hr = (const u32x2*)(hb + (size_t)m * DM) + lane;
#pragma unroll
        for (int j = 0; j < 4; ++j) { const u32x2 w = hr[64 * j]; h[j] = bf4(w.x, w.y); } }
}
__device__ __forceinline__ int vzero() { int z; asm volatile("v_mov_b32 %0, 0" : "=v"(z)); return z; }
template <int MODE>
__device__ __forceinline__ void rp_finish(int m, f32x4 (&h)[4], f32x4 (&d)[4], const f32x4 (&gp)[4], float sc, bf16_t* hb, float* rsv, float* __restrict__ outf, int lane, float hin_scale) {
    if (MODE & 32) {
#pragma unroll
        for (int j = 0; j < 4; ++j) h[j] *= hin_scale; }
    if (MODE & 1) {
        float ss = 0.f;
#pragma unroll
        for (int j = 0; j < 4; ++j) ss += dot4(d[j]);
        const float rs = sc * rsqrtf(wave_sum(ss) * (1.0f / DM) + EPS_);
#pragma unroll
        for (int j = 0; j < 4; ++j) h[j] += d[j] * rs * gp[j];
    }
    if (MODE & 4) {
        float s2 = 0.f;
#pragma unroll
        for (int j = 0; j < 4; ++j) s2 += dot4(h[j]);
        const float rs2 = rsqrtf(wave_sum(s2) * (1.0f / DM) + EPS_);
        if (lane == 0) rsv[m] = rs2;
        const float osc = (MODE & 64) ? rs2 : 1.0f;
        const auto hrs = pg8::mk_rsrc(hb); const unsigned ho = (unsigned)m * (DM * 2u) + (unsigned)lane * 8u;
#pragma unroll
        for (int j = 0; j < 4; ++j) { const f32x4 v = h[j] * osc; u32x2 w; w.x = cvt_pk_bf16(v.x, v.y); w.y = cvt_pk_bf16(v.z, v.w); ST8(hrs, ho + 512u * j, w); }
    }
    if (MODE & 8) { f32x4* ho = (f32x4*)(outf + (size_t)m * DM) + lane;
#pragma unroll
        for (int j = 0; j < 4; ++j) __builtin_nontemporal_store(h[j], ho + 64 * j); }
}
template <int MODE, int NSL, int N0>
__device__ __forceinline__ void rowpass(const bf16_t* __restrict__ dbuf, const bf16_t* slab0, const bf16_t* slab1, const bf16_t* __restrict__ pp, const float* __restrict__ resP, const float* __restrict__ resS,
                                        bf16_t* hb, float* rsv, float* __restrict__ outf, const float* __restrict__ gpost, float sc, int gw, int NGW, int lane) {
    f32x4 gp[4]; const int vz = vzero();
#pragma unroll
    for (int j = 0; j < 4; ++j) gp[j] = (MODE & 1) ? ((const f32x4*)gpost)[lane + 64 * j] : (f32x4){0.f, 0.f, 0.f, 0.f};
    constexpr int NR = 4;
    for (int m0 = gw; m0 < MP_; m0 += NR * NGW) {
        f32x4 hh[NR][4], dd[NR][4]; u32x2 ww[NR][4]; float isc[NR];
#pragma unroll
        for (int q = 0; q < NR; ++q) { const int m = m0 + q * NGW; isc[q] = 1.0f; if (m < MP_) { rp_load_res<MODE>(m, resP, resS, hb, lane, hh[q]); if (MODE & 32) isc[q] = rsv[m + vz]; } }
        if (MODE & 1) {
#pragma unroll
            for (int q = 0; q < NR; ++q) { const int m = m0 + q * NGW; if (m < MP_) { const u32x2* dr = (const u32x2*)(dbuf + (size_t)m * DM) + lane;
#pragma unroll
                for (int j = 0; j < 4; ++j) ww[q][j] = dr[64 * j]; } }
#pragma unroll
            for (int q = 0; q < NR; ++q)
#pragma unroll
                for (int j = 0; j < 4; ++j) dd[q][j] = bf4(ww[q][j].x, ww[q][j].y);
        }
#pragma unroll
        for (int q = 0; q < NR; ++q) { const int m = m0 + q * NGW; if (m < MP_) rp_finish<MODE>(m, hh[q], dd[q], gp, sc, hb, rsv, outf, lane, (MODE & 32) ? 1.0f / isc[q] : 1.0f); }
    }
    if (((gw & 1) == 0)) for (int r = (gw >> 3) * 4 + ((gw & 7) >> 1); r < M_ - MP_; r += (NGW >> 3) * 4) {
        const int m = MP_ + r;
        f32x4 h[4], d[4]; float isc1 = 1.0f;
        rp_load_res<MODE>(m, resP, resS, hb, lane, h);
        if (MODE & 32) isc1 = rsv[m + vz];
        if (MODE & 1) {
            u32x2 tq[4][NSL > 0 ? NSL : 1];
#pragma unroll
            for (int j = 0; j < 4; ++j)
#pragma unroll
                for (int s = 0; s < NSL; ++s) tq[j][s] = ((const u32x2*)(((s < N0) ? slab0 + ((size_t)s << 20) : slab1 + ((size_t)(s - N0) << 20)) + (size_t)r * DM))[lane + 64 * j];
#pragma unroll
            for (int j = 0; j < 4; ++j) { f32x4 acc = {0.f, 0.f, 0.f, 0.f};
#pragma unroll
                for (int s = 0; s < NSL; ++s) acc += bf4(tq[j][s].x, tq[j][s].y);
                d[j] = acc; }
            if (MODE & 16) { const u32x2* pr = (const u32x2*)(pp + (size_t)m * DM) + lane;
#pragma unroll
                for (int j = 0; j < 4; ++j) { const u32x2 pw = pr[64 * j]; const f32x4 p = bf4(pw.x, pw.y); d[j].x = pg8::sigmoid_f(d[j].x) * p.x; d[j].y = pg8::sigmoid_f(d[j].y) * p.y; d[j].z = pg8::sigmoid_f(d[j].z) * p.z; d[j].w = pg8::sigmoid_f(d[j].w) * p.w; } }
        }
        rp_finish<MODE>(m, h, d, gp, sc, hb, rsv, outf, lane, (MODE & 32) ? 1.0f / isc1 : 1.0f);
    }
}

#ifdef MK_TM
#define MIX_T(seg) do { const unsigned long long tn_ = __builtin_amdgcn_s_memrealtime(); if ((MK_TM >> (seg)) & 1u) *tqm += tn_ - tpm; tpm = tn_; } while (0)
#else
#define MIX_T(seg) do { } while (0)
#endif
__device__ __forceinline__ void mixer_phase(const Args& a, LAS unsigned char* lds, const bf16_t* __restrict__ PROJ, bf16_t* __restrict__ YC, int wave, int lane, unsigned long long* tqm) {
    unsigned long long tpm = 0ull;
    constexpr int VP = 1056;
    const auto ycrs = pg8::mk_rsrc(YC);
    LAS float* part = (LAS float*)(lds + 128 * VP);
    const int fr = lane & 15, fq = lane >> 4;
    const float* __restrict__ wsm = a.in[15]; const float* __restrict__ bsm = a.in[16];
    float* out = a.out;
    const int G_ = (int)gridDim.x, b_ = (int)blockIdx.x;
    for (int it = 0;; ++it) {
        int u;
        if (G_ == 256) { if (it == 0) u = b_; else if (it == 1 && (b_ & 1) == 0 && b_ < 32) u = 256 + (b_ >> 1); else break; }
        else { u = b_ + it * G_; if (u >= 272) break; }
        const bool samp = (u >= 256);
#ifdef MK_TM
        tpm = __builtin_amdgcn_s_memrealtime();
#endif
        const int R0 = u * 64;
        int s0 = 0, t0 = 0;
        if (!samp) { s0 = (u & 31) * 64; t0 = s0 & 127; }
        const int CB = R0 - t0, kext = t0 + 64;
        const int h = wave; const int nkb = kext >> 5;
        bf16x8 afr[4][4];
#pragma unroll
        for (int kb = 0; kb < 4; ++kb) {
#pragma unroll
            for (int tb = 0; tb < 4; ++tb) {
                f32x4 w0 = {0.f, 0.f, 0.f, 0.f}, w1 = w0; int lim = -1;
                if (kb < nkb) {
                    if (!samp) { const int tt = t0 + tb * 16 + fr, sb = kb * 32 + fq * 8; const float* wp = wsm + (size_t)(h * 128 + tt) * 128 + sb;
                        w0 = *(const f32x4*)wp; w1 = *(const f32x4*)(wp + 4); lim = tt - sb; }
                    else { const int tt = fr & 7; const float* wp = wsm + (size_t)(h * 128 + tt) * 128;
                        w0 = *(const f32x4*)wp; w1 = *(const f32x4*)(wp + 4); lim = ((kb * 4 + fq) == (tb * 2 + (fr >> 3))) ? tt : -1; }
                }
                w0.x = (0 <= lim) ? w0.x : 0.f; w0.y = (1 <= lim) ? w0.y : 0.f; w0.z = (2 <= lim) ? w0.z : 0.f; w0.w = (3 <= lim) ? w0.w : 0.f;
                w1.x = (4 <= lim) ? w1.x : 0.f; w1.y = (5 <= lim) ? w1.y : 0.f; w1.z = (6 <= lim) ? w1.z : 0.f; w1.w = (7 <= lim) ? w1.w : 0.f;
                u32x4 pk; pk.x = cvt_pk_bf16(w0.x, w0.y); pk.y = cvt_pk_bf16(w0.z, w0.w); pk.z = cvt_pk_bf16(w1.x, w1.y); pk.w = cvt_pk_bf16(w1.z, w1.w);
                afr[kb][tb] = __builtin_bit_cast(bf16x8, pk);
            }
        }
        {
            const f32x4 vg0 = *(const f32x4*)(a.in[14] + lane * 8), vg1 = *(const f32x4*)(a.in[14] + lane * 8 + 4);
            for (int sb8 = 0; sb8 < kext; sb8 += 64) {
                u32x4 raw8[8];
#pragma unroll
                for (int i = 0; i < 8; ++i) raw8[i] = *(const u32x4*)(PROJ + (size_t)(CB + sb8 + i * 8 + wave) * NIN + 2048 + lane * 8);
#pragma unroll
                for (int i = 0; i < 8; ++i) {
                    const int s = sb8 + i * 8 + wave, row = CB + s; const u32x4 raw = raw8[i];
                    f32x4 v0 = bf4(raw.x, raw.y), v1 = bf4(raw.z, raw.w);
                    float ss = dot4(v0) + dot4(v1);
                    ss += __shfl_xor(ss, 1); ss += __shfl_xor(ss, 2); ss += __shfl_xor(ss, 4);
                    const float rs = rsqrtf(ss * (1.0f / 64.0f) + EPS_);
                    v0 = v0 * rs * vg0; v1 = v1 * rs * vg1;
                    u32x4 pk; pk.x = cvt_pk_bf16(v0.x, v0.y); pk.y = cvt_pk_bf16(v0.z, v0.w); pk.z = cvt_pk_bf16(v1.x, v1.y); pk.w = cvt_pk_bf16(v1.z, v1.w);
                    *(LAS u32x4*)(lds + s * VP + lane * 16) = pk;
                    if (s >= t0) {
                        if (samp) { float* o = out + OUT_CVS + (size_t)(row - MP_) * 512 + lane * 8; *(f32x4*)o = v0; *(f32x4*)(o + 4) = v1; }
                        else if (s0 - t0 == 1920) { float* o = out + OUT_CVP + (size_t)((u >> 5) * 128 + s) * 512 + lane * 8; *(f32x4*)o = v0; *(f32x4*)(o + 4) = v1; }
                    }
                }
            }
        }
        __syncthreads();
        MIX_T(0);
        f32x4 acc[4][4];
#pragma unroll
        for (int i = 0; i < 4; ++i)
#pragma unroll
            for (int j = 0; j < 4; ++j) acc[i][j] = (f32x4){0.f, 0.f, 0.f, 0.f};
#pragma unroll
        for (int kb = 0; kb < 4; ++kb) if (kb < nkb) {
            u32x2 r0[4], r1[4];
            { const unsigned ta = (unsigned)(uintptr_t)(lds + (kb * 32 + fq * 8 + (fr >> 2)) * VP + (h * 64 + (fr & 3) * 4) * 2);
              asm volatile("ds_read_b64_tr_b16 %0, %8\n\tds_read_b64_tr_b16 %1, %8 offset:4224\n\t"
                           "ds_read_b64_tr_b16 %2, %8 offset:32\n\tds_read_b64_tr_b16 %3, %8 offset:4256\n\t"
                           "ds_read_b64_tr_b16 %4, %8 offset:64\n\tds_read_b64_tr_b16 %5, %8 offset:4288\n\t"
                           "ds_read_b64_tr_b16 %6, %8 offset:96\n\tds_read_b64_tr_b16 %7, %8 offset:4320\n\ts_waitcnt lgkmcnt(0)"
                           : "=&v"(r0[0]), "=&v"(r1[0]), "=&v"(r0[1]), "=&v"(r1[1]), "=&v"(r0[2]), "=&v"(r1[2]), "=&v"(r0[3]), "=&v"(r1[3]) : "v"(ta) : "memory"); }
#pragma unroll
            for (int db = 0; db < 4; ++db) {
                u32x4 bq; bq.x = r0[db].x; bq.y = r0[db].y; bq.z = r1[db].x; bq.w = r1[db].y;
                const bf16x8 bfv = __builtin_bit_cast(bf16x8, bq);
#pragma unroll
                for (int tb = 0; tb < 4; ++tb) acc[tb][db] = __builtin_amdgcn_mfma_f32_16x16x32_bf16(bfv, afr[kb][tb], acc[tb][db], 0, 0, 0);
            }
        }
#pragma unroll
        for (int tb = 0; tb < 4; ++tb) {
            const int t = tb * 16 + fr; const int tt = samp ? (fr & 7) : (t0 + t); const float bias = bsm[h * 128 + tt];
            const bf16_t* up = PROJ + (size_t)(R0 + t) * NIN + 1536 + h * 64 + fq * 4;
            float s = 0.f;
#pragma unroll
            for (int db = 0; db < 4; ++db) { const u32x2 ur = *(const u32x2*)(up + db * 16); const f32x4 uu = bf4(ur.x, ur.y);
                const f32x4 y = uu * (acc[tb][db] + bias); acc[tb][db] = y; s += dot4(y); }
            s += __shfl_xor(s, 16); s += __shfl_xor(s, 32);
            if (fq == 0) part[h * 64 + t] = s;
        }
        __syncthreads();
        MIX_T(1);
#pragma unroll
        for (int tb = 0; tb < 4; ++tb) {
            const int t = tb * 16 + fr; float tot = 0.f;
#pragma unroll
            for (int hh = 0; hh < 8; ++hh) tot += part[hh * 64 + t];
            const float rs = rsqrtf(tot * (1.0f / 512.0f) + EPS_);
            bf16_t* yp = YC + (size_t)(R0 + t) * DM + 512 + h * 64 + fq * 4;
#pragma unroll
            for (int db = 0; db < 4; ++db) { const f32x4 gb = *(const f32x4*)(a.in[18] + h * 64 + db * 16 + fq * 4); const f32x4 y = acc[tb][db] * rs * gb;
                u32x2 w; w.x = cvt_pk_bf16(y.x, y.y); w.y = cvt_pk_bf16(y.z, y.w); ST8(ycrs, (unsigned)((R0 + t) * DM + 512 + h * 64 + fq * 4 + db * 16) * 2u, w); }
        }
        MIX_T(2);
        {
            const int c0 = lane * 8; const float* cw = a.in[13];
            const f32x4 w0a = *(const f32x4*)(cw + c0), w0b = *(const f32x4*)(cw + c0 + 4), w1a = *(const f32x4*)(cw + 512 + c0), w1b = *(const f32x4*)(cw + 512 + c0 + 4),
                        w2a = *(const f32x4*)(cw + 1024 + c0), w2b = *(const f32x4*)(cw + 1024 + c0 + 4);
            const f32x4 gaa = *(const f32x4*)(a.in[17] + c0), gab = *(const f32x4*)(a.in[17] + c0 + 4);
            f32x4 zp2a = {0.f, 0.f, 0.f, 0.f}, zp2b = zp2a, zp1a = zp2a, zp1b = zp2a;
            const int rb = R0 + wave * 8; const int sb_ = (u - 256) * 8 + wave;
            if (samp) { const float* st = a.in[4] + (size_t)sb_ * 1024 + c0; zp2a = *(const f32x4*)st; zp2b = *(const f32x4*)(st + 4); zp1a = *(const f32x4*)(st + 512); zp1b = *(const f32x4*)(st + 516); }
            else if (s0 + wave * 8 > 0) {
                const bf16_t* p2 = PROJ + (size_t)(rb - 2) * NIN + c0; const bf16_t* p1 = p2 + NIN;
                const u32x4 c2 = *(const u32x4*)(p2 + 512), h2 = *(const u32x4*)(p2 + 1024), c1 = *(const u32x4*)(p1 + 512), h1 = *(const u32x4*)(p1 + 1024);
                zp2a = bf4(c2.x, c2.y) * bf4(h2.x, h2.y); zp2b = bf4(c2.z, c2.w) * bf4(h2.z, h2.w); zp1a = bf4(c1.x, c1.y) * bf4(h1.x, h1.y); zp1b = bf4(c1.z, c1.w) * bf4(h1.z, h1.w);
            }
            f32x4 ya[8], yb[8]; float ss[8];
            u32x4 braw8[8], craw8[8], hraw8[8];
#pragma unroll
            for (int i = 0; i < 8; ++i) { const bf16_t* pr = PROJ + (size_t)(rb + i) * NIN + c0; braw8[i] = *(const u32x4*)pr; craw8[i] = *(const u32x4*)(pr + 512); hraw8[i] = *(const u32x4*)(pr + 1024); }
#pragma unroll
            for (int i = 0; i < 8; ++i) {
                const u32x4 braw = braw8[i], craw = craw8[i], hraw = hraw8[i];
                const f32x4 za = bf4(craw.x, craw.y) * bf4(hraw.x, hraw.y), zb = bf4(craw.z, craw.w) * bf4(hraw.z, hraw.w);
                const f32x4 ca = w0a * zp2a + w1a * zp1a + w2a * za, cb = w0b * zp2b + w1b * zp1b + w2b * zb;
                ya[i] = bf4(braw.x, braw.y) * ca; yb[i] = bf4(braw.z, braw.w) * cb;
                ss[i] = wave_sum(dot4(ya[i]) + dot4(yb[i]));
                if (i >= 6) {
                    if (samp) { float* o = out + OUT_NCS + ((size_t)sb_ * 2 + (i - 6)) * 512 + c0; *(f32x4*)o = za; *(f32x4*)(o + 4) = zb; }
                    else if ((u & 31) == 31 && wave == 7) { float* o = out + OUT_NCP + ((size_t)(u >> 5) * 2 + (i - 6)) * 512 + c0; *(f32x4*)o = za; *(f32x4*)(o + 4) = zb; }
                }
                zp2a = zp1a; zp2b = zp1b; zp1a = za; zp1b = zb;
            }
#pragma unroll
            for (int i = 0; i < 8; ++i) {
                const float rs = rsqrtf(ss[i] * (1.0f / 512.0f) + EPS_);
                const f32x4 y0 = ya[i] * rs * gaa, y1 = yb[i] * rs * gab;
                u32x4 w; w.x = cvt_pk_bf16(y0.x, y0.y); w.y = cvt_pk_bf16(y0.z, y0.w); w.z = cvt_pk_bf16(y1.x, y1.y); w.w = cvt_pk_bf16(y1.z, y1.w);
                ST16(ycrs, (unsigned)((rb + i) * DM + c0) * 2u, w);
            }
        }
        __syncthreads();
        MIX_T(3);
    }
}

constexpr int TR_I_G = (DM / 64) * (FF / 32), TR_I_D = (FF / 64) * (DM / 32), TR_I_IN = (DM / 64) * (NIN / 32), TR_I_O = (DM / 64) * (DM / 32), TR_I_PP = (PLE / 64) * (DM / 32);
constexpr int TR_A_END = 2 * TR_I_G + TR_I_IN + TR_I_O, TR_B_END = TR_A_END + TR_I_D, TR_C_END = TR_B_END + TR_I_G + TR_I_D + TR_I_O + TR_I_PP, TR_D_END = TR_C_END + TR_I_G;
__device__ __forceinline__ void tr_decode(const Args& a, unsigned char* ws, int it, TrItem& d) {
    int r = it; int mode = 0; d.gk = nullptr;
    if (r < TR_I_G) { d.W = a.in[7]; d.K = DM; d.N = FF; d.WT = (bf16_t*)(ws + WS_WGU1); mode = 1; d.gk = a.in[5]; }
    else if ((r -= TR_I_G) < TR_I_G) { d.W = a.in[8]; d.K = DM; d.N = FF; d.WT = (bf16_t*)(ws + WS_WGU1); mode = 2; d.gk = a.in[5]; }
    else if ((r -= TR_I_G) < TR_I_IN) { d.W = a.in[12]; d.K = DM; d.N = NIN; d.WT = (bf16_t*)(ws + WS_WIN); d.gk = a.in[10]; }
    else if ((r -= TR_I_IN) < TR_I_O) { d.W = a.in[19]; d.K = DM; d.N = DM; d.WT = (bf16_t*)(ws + WS_WOUT); }
    else if ((r -= TR_I_O) < TR_I_D) { d.W = a.in[9]; d.K = FF; d.N = DM; d.WT = (bf16_t*)(ws + WS_WD1); }
    else if ((r -= TR_I_D) < TR_I_G) { d.W = a.in[23]; d.K = DM; d.N = FF; d.WT = (bf16_t*)(ws + WS_WGU2); mode = 2; d.gk = a.in[20]; }
    else if ((r -= TR_I_G) < TR_I_D) { d.W = a.in[24]; d.K = FF; d.N = DM; d.WT = (bf16_t*)(ws + WS_WD2); }
    else if ((r -= TR_I_D) < TR_I_O) { d.W = a.in[25]; d.K = DM; d.N = DM; d.WT = (bf16_t*)(ws + WS_WPG); }
    else if ((r -= TR_I_O) < TR_I_PP) { d.W = a.in[26]; d.K = PLE; d.N = DM; d.WT = (bf16_t*)(ws + WS_WPP); }
    else { r -= TR_I_PP; d.W = a.in[22]; d.K = DM; d.N = FF; d.WT = (bf16_t*)(ws + WS_WGU2); mode = 1; d.gk = a.in[20]; }
    const int nblk = d.N / 32, kb = r / nblk, nb = r % nblk; d.k0 = 64 * kb; d.n0 = 32 * nb;
    d.drow0 = mode ? (d.n0 >> 7) * 256 + (d.n0 & 127) + (mode == 2 ? 128 : 0) : d.n0;
}
__device__ __forceinline__ void do_transposes(const Args& a, unsigned char* ws, LAS unsigned char* lds, int first, int last, int widx, int nwaves, int wave, int lane) {
    LAS float* scr = (LAS float*)(lds + wave * 8448);
    int it = first + widx;
    if (it < last) {
        TrItem d0, d1; f32x4 v0[8], v1[8]; float g0[8], g1[8];
        tr_decode(a, ws, it, d0); tr_load(d0, lane, v0, g0);
        for (;;) {
            const bool m1 = it + nwaves < last;
            if (m1) { tr_decode(a, ws, it + nwaves, d1); tr_load(d1, lane, v1, g1); }
            tr_store(d0, scr, lane, v0, g0);
            if (!m1) break;
            it += nwaves;
            const bool m0 = it + nwaves < last;
            if (m0) { tr_decode(a, ws, it + nwaves, d0); tr_load(d0, lane, v0, g0); }
            tr_store(d1, scr, lane, v1, g1);
            if (!m0) break;
            it += nwaves;
        }
    }
}
__device__ __forceinline__ int fresh_tid() { int t = threadIdx.x; asm volatile("" : "+v"(t)); return t; }
template <bool COOP>
__global__ void __launch_bounds__(512, 2) fwd_kernel(Args a) {
    extern __shared__ __attribute__((aligned(16))) unsigned char lds_raw[];
    LAS unsigned char* lds = (LAS unsigned char*)lds_raw;
    const int tid = threadIdx.x;
    const int G = gridDim.x, NGW = G * 8;
#define LANE_ (fresh_tid() & 63)
#define WAVE_ (__builtin_amdgcn_readfirstlane(fresh_tid() >> 6))
#define GW_ ((int)blockIdx.x * 8 + WAVE_)
    unsigned char* ws = a.ws;
    bf16_t* WGU1 = (bf16_t*)(ws + WS_WGU1); bf16_t* WD1 = (bf16_t*)(ws + WS_WD1); bf16_t* WIN = (bf16_t*)(ws + WS_WIN); bf16_t* WOUT = (bf16_t*)(ws + WS_WOUT);
    bf16_t* WGU2 = (bf16_t*)(ws + WS_WGU2); bf16_t* WD2 = (bf16_t*)(ws + WS_WD2); bf16_t* WPG = (bf16_t*)(ws + WS_WPG); bf16_t* WPP = (bf16_t*)(ws + WS_WPP);
    bf16_t* YC = (bf16_t*)(ws + WS_YC); bf16_t* HB = (bf16_t*)(ws + WS_HB); float* RS = (float*)(ws + WS_RS); bf16_t* ACT = (bf16_t*)(ws + WS_ACT); bf16_t* PROJ = (bf16_t*)(ws + WS_PROJ); bf16_t* PB = (bf16_t*)(ws + WS_PB);
    bf16_t* DB = (bf16_t*)(ws + WS_D); bf16_t* SLAB2 = (bf16_t*)(ws + WS_SLAB2); bf16_t* SLAB4 = (bf16_t*)(ws + WS_SLAB4); bf16_t* PP = (bf16_t*)(ws + WS_PP);
#define IN(k) (a.ph_lo <= (k) && (k) < a.ph_hi)
#define REP(k) for (int rep_ = 0; rep_ < (((MK_DUP >> (k)) & 1u) ? 2 : 1); ++rep_)
    XcdBarrier bar; bar.bar = (unsigned*)(ws + WS_BAR); bar.x = 0; bar.st = nullptr;
    if (COOP) {
        volatile LAS unsigned* st = (volatile LAS unsigned*)(lds + LDS_BYTES - 16);
        if (tid < 4) st[tid] = 0u;
        __syncthreads();
        bar = xcd_barrier_post((unsigned*)(ws + WS_BAR), st);
        if (a.ph_lo < 0) cg::this_grid().sync();
    }
#ifdef MK_TPROBE
#define MIXTQ_ (&tq_)
#else
#define MIXTQ_ nullptr
#endif
#ifdef MK_TPROBE
    unsigned long long tq_ = 0ull, tp_ = __builtin_amdgcn_s_memrealtime();
#define SEAM(k) do { if (COOP && IN(k) && IN((k) + 1)) { const unsigned long long t1_ = __builtin_amdgcn_s_memrealtime(); if ((MK_TW >> (k)) & 1u) tq_ += t1_ - tp_; xcd_barrier(bar); \
        const unsigned long long t2_ = __builtin_amdgcn_s_memrealtime(); if ((MK_TB >> (k)) & 1u) tq_ += t2_ - t1_; tp_ = t2_; } } while (0)
#else
#define SEAM(k) do { if (COOP && IN(k) && IN((k) + 1)) xcd_barrier(bar); } while (0)
#endif

    if (IN(0)) REP(0) {
        const int lane = LANE_, wave = WAVE_, gw = GW_;
        do_transposes(a, ws, lds, 0, TR_A_END, gw, NGW, wave, lane);
        rowpass<2 | 4 | 64, 0, 0>(nullptr, nullptr, nullptr, nullptr, a.in[0], a.in[1], HB, RS, nullptr, nullptr, 0.f, gw, NGW, lane);
    }
    SEAM(0);
    const int bid = (int)blockIdx.x;
#define GEMM_FULL(EPI, Aop, Bop, KK, MM, NN, ...) do { pg8::Gemm g_{Aop, Bop, KK, KK}; pg8::StaticOrder S_; S_.init(MM, NN, G, bid); pg8::EPI E_{__VA_ARGS__}; \
        pg8::gemm_phase<pg8::EPI, pg8::StaticOrder, true, true>(lds, g_, S_, E_); } while (0)
#define GEMM_SPLIT(Aop, Bop, KK, NSL, S0, S1, N0) do { pg8::Gemm g_{Aop, Bop, KK, 256}; pg8::SubOrder S_{64, 4, 4, NSL, G, bid}; pg8::EpiF32Slab E_{S0, S1, N0, 64}; \
        pg8::gemm_phase<pg8::EpiF32Slab, pg8::SubOrder, true, true>(lds, g_, S_, E_); } while (0)
    bf16_t* const YCF = YC;
    if (IN(1)) { REP(1) GEMM_FULL(EpiSwiglu, HB, WGU1, DM, M_, NGU, ACT, FF);
        { const int nwg = (M_ / 256) * (NGU / 256), rem = nwg % G, nidle = rem ? G - rem : G, idx = rem ? bid - rem : bid;
          if (idx >= 0) do_transposes(a, ws, lds, TR_A_END, TR_B_END, idx * 8 + WAVE_, nidle * 8, WAVE_, LANE_); } }
    SEAM(1);
    if (IN(2)) REP(2) { GEMM_FULL(EpiBf16, ACT, WD1, FF, MP_, DM, DB, DM, nullptr); GEMM_SPLIT(ACT, WD1, FF, 11, YCF, SLAB2, 8); }
    SEAM(2);
    if (IN(3)) rowpass<1 | 4 | 32 | 64, 11, 8>(DB, YCF, SLAB2, nullptr, nullptr, nullptr, HB, RS, nullptr, a.in[6], 0.5f, GW_, NGW, LANE_);
    SEAM(3);
    if (IN(4)) { REP(4) GEMM_FULL(EpiBf16, HB, WIN, DM, M_, NIN, PROJ, NIN, nullptr);
        { const int nwg = (M_ / 256) * (NIN / 256), rem = nwg % G, nidle = rem ? G - rem : G, idx = rem ? bid - rem : bid;
          if (idx >= 0) do_transposes(a, ws, lds, TR_B_END, TR_C_END, idx * 8 + WAVE_, nidle * 8, WAVE_, LANE_); } }
    SEAM(4);
    if (IN(5)) REP(5) mixer_phase(a, lds, PROJ, YC, WAVE_, LANE_, MIXTQ_);
    SEAM(5);
#ifdef MK_XBAR
#pragma nounroll
    for (int xb_ = 0; xb_ < MK_XBAR; ++xb_) xcd_barrier(bar);
#endif
    if (IN(6)) { REP(6) { GEMM_FULL(EpiBf16, YC, WOUT, DM, MP_, DM, DB, DM, nullptr); GEMM_SPLIT(YC, WOUT, DM, 4, SLAB4, SLAB4, 4); }
        if (G > 64 && bid >= 64) do_transposes(a, ws, lds, TR_C_END, TR_D_END, (bid - 64) * 8 + WAVE_, (G - 64) * 8, WAVE_, LANE_);
        else if (G <= 64) do_transposes(a, ws, lds, TR_C_END, TR_D_END, bid * 8 + WAVE_, G * 8, WAVE_, LANE_); }
    SEAM(6);
    if (IN(7)) rowpass<1 | 4 | 32 | 64, 4, 4>(DB, SLAB4, SLAB4, nullptr, nullptr, nullptr, HB, RS, nullptr, a.in[11], 1.0f, GW_, NGW, LANE_);
    SEAM(7);
    if (IN(8)) { REP(8) GEMM_FULL(EpiSwiglu, HB, WGU2, DM, M_, NGU, ACT, FF);
        { const int nwg = (M_ / 256) * (NGU / 256), rem = nwg % G, nidle = rem ? G - rem : G, idx = rem ? bid - rem : bid;
          if (idx >= 0) { const int lane = LANE_, w0 = idx * 8 + WAVE_, nw = nidle * 8;
            for (int m0 = w0; m0 < M_; m0 += 8 * nw) {
                f32x4 v[8];
#pragma unroll
                for (int q = 0; q < 8; ++q) { const int m = m0 + q * nw; if (m < M_) { const float* pr = (m < MP_) ? a.in[2] + (size_t)m * PLE : a.in[3] + (size_t)(m - MP_) * PLE; v[q] = ((const f32x4*)pr)[lane]; } }
#pragma unroll
                for (int q = 0; q < 8; ++q) { const int m = m0 + q * nw; if (m < M_) { u32x2 w; w.x = cvt_pk_bf16(v[q].x, v[q].y); w.y = cvt_pk_bf16(v[q].z, v[q].w); ((u32x2*)(PB + (size_t)m * PLE))[lane] = w; } } } } } }
    SEAM(8);
    if (IN(9)) REP(9) { GEMM_FULL(EpiBf16, ACT, WD2, FF, MP_, DM, DB, DM, nullptr); GEMM_SPLIT(ACT, WD2, FF, 11, YCF, SLAB2, 8); }
    SEAM(9);
    if (IN(10)) {
        rowpass<1 | 4 | 32, 11, 8>(DB, YCF, SLAB2, nullptr, nullptr, nullptr, HB, RS, nullptr, a.in[21], 0.5f, GW_, NGW, LANE_);
    }
    SEAM(10);
    if (IN(11)) REP(11) { GEMM_FULL(EpiBf16N, PB, WPP, PLE, MP_, DM, PP, DM);
        { pg8::Gemm g_{PB, WPP, PLE, PLE}; pg8::SubOrder S_{64, 4, 4, 1, G, (bid >= 64 && bid < 80) ? bid - 64 : -1}; pg8::EpiBf16N E_{PP, DM};
          pg8::gemm_phase<pg8::EpiBf16N, pg8::SubOrder, true, true>(lds, g_, S_, E_); } }
    if (IN(12)) REP(12) { GEMM_FULL(EpiPle, HB, WPG, DM, MP_, DM, DB, PP, DM); GEMM_SPLIT(HB, WPG, DM, 4, SLAB4, SLAB4, 4); }
    SEAM(12);
    if (IN(13)) rowpass<1 | 8 | 16, 4, 4>(DB, SLAB4, SLAB4, PP, nullptr, nullptr, HB, nullptr, a.out, a.in[27], 1.0f, GW_, NGW, LANE_);
#ifdef MK_TPROBE
    if (blockIdx.x == 0) { const unsigned long long t1_ = __builtin_amdgcn_s_memrealtime(); if ((MK_TW >> 13) & 1u) tq_ += t1_ - tp_;
        while (__builtin_amdgcn_s_memrealtime() - t1_ < 4ull * tq_) __builtin_amdgcn_s_sleep(8); }
#endif
#undef IN
#undef SEAM
}

extern "C" void kernel_launch(void* const* d_in, const int* in_sizes, int n_in, void* d_out, int out_size, void* d_ws, size_t ws_size, hipStream_t stream) {
    static int grid = 0;
    if (grid == 0) {
        if (n_in != 28 || out_size != 19013632 || ws_size < WS_TOTAL) { fprintf(stderr, "kernel_launch: unexpected shapes: n_in %d out %d ws %zu (need %zu)\n", n_in, out_size, ws_size, (size_t)WS_TOTAL); grid = -1; return; }
        int dev = 0, cus = 0, per_cu = 0;
        if (hipGetDevice(&dev) != hipSuccess || hipDeviceGetAttribute(&cus, hipDeviceAttributeMultiprocessorCount, dev) != hipSuccess) { fprintf(stderr, "kernel_launch: device query failed\n"); grid = -1; return; }
        if (hipFuncSetAttribute((const void*)fwd_kernel<true>, hipFuncAttributeMaxDynamicSharedMemorySize, LDS_BYTES) != hipSuccess) { fprintf(stderr, "kernel_launch: hipFuncSetAttribute failed\n"); grid = -1; return; }
        if (hipOccupancyMaxActiveBlocksPerMultiprocessor(&per_cu, (const void*)fwd_kernel<true>, 512, LDS_BYTES) != hipSuccess || per_cu < 1) { fprintf(stderr, "kernel_launch: occupancy query says %d blocks per CU\n", per_cu); per_cu = 1; }
        (void)hipGetLastError();
        grid = cus * per_cu;
        fprintf(stderr, "kernel_launch: grid %d (cus %d x %d)\n", grid, cus, per_cu);
    }
    if (grid < 0) return;
    Args a{};
    for (int i = 0; i < 28; ++i) a.in[i] = (const float*)d_in[i];
    a.out = (float*)d_out; a.ws = (unsigned char*)d_ws;
#if MK_COOP
    if (hipMemsetAsync((char*)d_ws + WS_BAR, 0, (size_t)XCD_BAR_WORDS * 4, stream) != hipSuccess) { fprintf(stderr, "kernel_launch: memset of the barrier words failed\n"); return; }
    a.ph_lo = 0; a.ph_hi = NPHASE;
    void* args[] = {&a};
    const hipError_t e = hipLaunchCooperativeKernel((const void*)fwd_kernel<true>, dim3(grid), dim3(512), args, LDS_BYTES, stream);
    if (e != hipSuccess) fprintf(stderr, "kernel_launch: cooperative launch failed: %s (grid %d)\n", hipGetErrorString(e), grid);
#endif
}
```

```cpp
#include <hip/hip_runtime.h>
#include <hip/hip_cooperative_groups.h>
#include <cstdio>
#include <cstdint>
namespace cg = cooperative_groups;
#define MK_DUP 0u
namespace pg8 {
#define PG8_LAS __attribute__((address_space(3)))
typedef unsigned short bf16_t;
typedef short bf16x8 __attribute__((ext_vector_type(8)));
typedef float f32x4 __attribute__((ext_vector_type(4)));
typedef unsigned u32x4 __attribute__((ext_vector_type(4)));
constexpr int BM = 256, BK = 64, HALF = 128, HTB = HALF * BK * 2  , STAGE_BYTES = 8 * HTB, NXCD = 8, WGM = 8;

__host__ __device__ __forceinline__ int lds_byte(int r, int c) { const int st = (r >> 4) * 2 + (c >> 5), rr = r & 15, cc = c & 31, ob = rr * 64 + cc * 2; return st * 1024 + (ob ^ (((ob >> 9) & 1) << 5)); }
__host__ __device__ __forceinline__ void stage_rc(int b, int& R, int& C) { const int st = b / 1024, sb = b % 1024, swz = sb ^ (((sb >> 9) & 1) << 5); R = (st >> 1) * 16 + swz / 64; C = (st & 1) * 32 + (swz % 64) / 2; }
__host__ __device__ __forceinline__ int perm32(int rho) { const int n = rho >> 4, i = rho & 15; return 8 * (i >> 2) + 4 * n + (i & 3); }

struct Unit { int pm, pn, ks; };
struct Gemm { const bf16_t* A; const bf16_t* Bt; int ld, K; };

struct StaticOrder {
    int nM, nN, nwg, G, c;
    __host__ __device__ void init(int M, int N, int G_, int c_) { nM = M / BM; nN = N / BM; nwg = nM * nN; G = G_; c = c_; }
    __host__ __device__ bool next(int i, Unit& u) const {
        const long L = (long)i * G + c; if (L >= nwg) return false;
        int wgid = (int)L; { const int q = nwg / NXCD, r = nwg % NXCD, xcd = wgid % NXCD, off = wgid / NXCD; wgid = (xcd < r ? xcd * (q + 1) : r * (q + 1) + (xcd - r) * q) + off; }
        const int nig = WGM * nN, gid = wgid / nig, fm = gid * WGM, gsz = (nM - fm) < WGM ? (nM - fm) : WGM;
        u.pm = fm + ((wgid % nig) % gsz); u.pn = (wgid % nig) / gsz; u.ks = 0; return true;
    }
    __device__ __forceinline__ void a_ready(const Unit&) const {}
    __device__ __forceinline__ void done(const Unit&) const {}
};
struct SubOrder {
    int pm0, npm, nN, nsl, G, c;
    __host__ __device__ bool next(int i, Unit& u) const {
        const int L = i * G + c; if (c < 0 || L >= npm * nN * nsl) return false;
        const int t = L / nsl; u.ks = L - t * nsl; u.pn = t % nN; u.pm = pm0 + t / nN; return true;
    }
    __device__ __forceinline__ void a_ready(const Unit&) const {}
    __device__ __forceinline__ void done(const Unit&) const {}
};
typedef unsigned u32x2 __attribute__((ext_vector_type(2)));

__device__ __forceinline__ unsigned cvt_pk_bf16(float lo, float hi) { unsigned r; asm("v_cvt_pk_bf16_f32 %0, %1, %2" : "=v"(r) : "v"(lo), "v"(hi)); return r; }
__device__ __forceinline__ float sigmoid_f(float x) { return __builtin_amdgcn_rcpf(1.0f + __builtin_amdgcn_exp2f(x * -1.44269504089f)); }

#ifndef MK_WT
#define MK_WT 0
#endif
typedef __attribute__((__vector_size__(4 * sizeof(int)))) int rsrc_t;
constexpr int WT_AUX = MK_WT ? 16 : 0;
__device__ __forceinline__ auto mk_rsrc(const void* base) { return __builtin_amdgcn_make_buffer_rsrc((void*)base, 0, 0x7fffffff, 0x00020000); }
#define ST16(rsrc, byteoff, v) __builtin_amdgcn_raw_buffer_store_b128(__builtin_bit_cast(u32x4, v), rsrc, (int)(byteoff), 0, pg8::WT_AUX)
#define ST8(rsrc, byteoff, v)  __builtin_amdgcn_raw_buffer_store_b64(__builtin_bit_cast(u32x2, v), rsrc, (int)(byteoff), 0, pg8::WT_AUX)

struct EpiF32 {
    static constexpr bool PERM = false, AFTER_DRAIN = false;
    float* C; int ldc;
    __device__ __forceinline__ void operator()(const f32x4 (&acc)[2][2][4][2], const Unit& u, int wr, int wc, int fr_, int fq_) const {
        int tl_ = threadIdx.x; asm volatile("" : "+v"(tl_)); const int fr = tl_ & 15, fq = (tl_ >> 4) & 3;
        const int row0 = u.pm * BM + wr * 64 + fr, col0 = u.pn * BM + wc * 32 + 4 * fq; float* const Cb_ = C;
#pragma unroll
        for (int ai = 0; ai < 2; ++ai)
#pragma unroll
            for (int m = 0; m < 4; ++m) { const unsigned ro = ((unsigned)(row0 + ai * HALF + m * 16) * (unsigned)ldc + (unsigned)col0) * 4u;
#pragma unroll
                for (int bj = 0; bj < 2; ++bj)
#pragma unroll
                    for (int n = 0; n < 2; ++n) *(f32x4*)((char*)Cb_ + ro + (bj * HALF + n * 16) * 4) = acc[ai][bj][m][n]; }
    }
};
struct EpiBf16N {
    static constexpr bool PERM = false, AFTER_DRAIN = false;
    bf16_t* O; int ldc;
    __device__ __forceinline__ void operator()(const f32x4 (&acc)[2][2][4][2], const Unit& u, int wr, int wc, int fr_, int fq_) const {
        int tl_ = threadIdx.x; asm volatile("" : "+v"(tl_)); const int fr = tl_ & 15, fq = (tl_ >> 4) & 3;
        const int row0 = u.pm * BM + wr * 64 + fr, col0 = u.pn * BM + wc * 32 + 4 * fq;
#pragma unroll
        for (int ai = 0; ai < 2; ++ai)
#pragma unroll
            for (int m = 0; m < 4; ++m) { const size_t off = (size_t)(row0 + ai * HALF + m * 16) * ldc + col0;
#pragma unroll
                for (int bj = 0; bj < 2; ++bj)
#pragma unroll
                    for (int n = 0; n < 2; ++n) { const f32x4 a = acc[ai][bj][m][n]; u32x2 w; w.x = cvt_pk_bf16(a.x, a.y); w.y = cvt_pk_bf16(a.z, a.w); *(u32x2*)(O + off + bj * HALF + n * 16) = w; } }
    }
};
struct EpiPle {
    static constexpr bool PERM = false, AFTER_DRAIN = false;
    bf16_t* T; const bf16_t* P; int ldc;
    __device__ __forceinline__ void operator()(const f32x4 (&acc)[2][2][4][2], const Unit& u, int wr, int wc, int fr_, int fq_) const {
        int tl_ = threadIdx.x; asm volatile("" : "+v"(tl_)); const int fr = tl_ & 15, fq = (tl_ >> 4) & 3;
        const int row0 = u.pm * BM + wr * 64 + fr, col0 = u.pn * BM + wc * 32 + 4 * fq;
#pragma unroll
        for (int ai = 0; ai < 2; ++ai)
#pragma unroll
            for (int m = 0; m < 4; ++m) { const size_t off = (size_t)(row0 + ai * HALF + m * 16) * ldc + col0;
#pragma unroll
                for (int bj = 0; bj < 2; ++bj)
#pragma unroll
                    for (int n = 0; n < 2; ++n) { const u32x2 pw = *(const u32x2*)(P + off + bj * HALF + n * 16); const f32x4 a = acc[ai][bj][m][n];
                        const f32x4 p = {__uint_as_float(pw.x << 16), __uint_as_float(pw.x & 0xffff0000u), __uint_as_float(pw.y << 16), __uint_as_float(pw.y & 0xffff0000u)};
                        u32x2 w; w.x = cvt_pk_bf16(sigmoid_f(a.x) * p.x, sigmoid_f(a.y) * p.y); w.y = cvt_pk_bf16(sigmoid_f(a.z) * p.z, sigmoid_f(a.w) * p.w);
                        *(u32x2*)(T + off + bj * HALF + n * 16) = w; } }
    }
};
struct EpiF32Slab {
    static constexpr bool PERM = false, AFTER_DRAIN = false;
    bf16_t* base0; bf16_t* base1; int n0; int pm0;
    __device__ __forceinline__ void operator()(const f32x4 (&acc)[2][2][4][2], const Unit& u, int wr, int wc, int fr_, int fq_) const {
        int tl_ = threadIdx.x; asm volatile("" : "+v"(tl_)); const int fr = tl_ & 15, fq = (tl_ >> 4) & 3;
        const int row0 = (u.pm - pm0) * BM + wr * 64 + fr, col0 = u.pn * BM + wc * 32 + 4 * fq;
        bf16_t* const Cb_ = (u.ks < n0) ? base0 + ((size_t)u.ks << 20) : base1 + ((size_t)(u.ks - n0) << 20);
#pragma unroll
        for (int ai = 0; ai < 2; ++ai)
#pragma unroll
            for (int m = 0; m < 4; ++m) { const unsigned ro = ((unsigned)(row0 + ai * HALF + m * 16) * 1024u + (unsigned)col0) * 2u;
#pragma unroll
                for (int bj = 0; bj < 2; ++bj)
#pragma unroll
                    for (int n = 0; n < 2; ++n) { const f32x4 a = acc[ai][bj][m][n]; u32x2 w; w.x = cvt_pk_bf16(a.x, a.y); w.y = cvt_pk_bf16(a.z, a.w);
                        *(u32x2*)((char*)Cb_ + ro + (bj * HALF + n * 16) * 2) = w; } }
    }
};
struct EpiBf16 {
    static constexpr bool PERM = true, AFTER_DRAIN = false;
    bf16_t* O; int ldc; const float* rs;
    __device__ __forceinline__ void operator()(const f32x4 (&acc)[2][2][4][2], const Unit& u, int wr, int wc, int fr_, int fq_) const {
        int tl_ = threadIdx.x; asm volatile("" : "+v"(tl_)); const int fr = tl_ & 15, fq = (tl_ >> 4) & 3;
        const int row0 = u.pm * BM + wr * 64 + fr, col0 = u.pn * BM + wc * 32 + 8 * fq; const auto rs_ = mk_rsrc(O);
#pragma unroll
        for (int ai = 0; ai < 2; ++ai)
#pragma unroll
            for (int m = 0; m < 4; ++m) { const int row = row0 + ai * HALF + m * 16; const unsigned ro = ((unsigned)row * (unsigned)ldc + (unsigned)col0) * 2u; const float r = rs ? rs[row] : 1.0f;
#pragma unroll
                for (int bj = 0; bj < 2; ++bj) { const f32x4 v0 = acc[ai][bj][m][0] * r, v1 = acc[ai][bj][m][1] * r;
                    u32x4 w; w.x = cvt_pk_bf16(v0[0], v0[1]); w.y = cvt_pk_bf16(v0[2], v0[3]); w.z = cvt_pk_bf16(v1[0], v1[1]); w.w = cvt_pk_bf16(v1[2], v1[3]);
                    ST16(rs_, ro + bj * HALF * 2, w); } }
    }
};
struct EpiSwiglu {
    static constexpr bool PERM = true, AFTER_DRAIN = false;
    bf16_t* O; int ldc;
    static __device__ __forceinline__ f32x4 silu_mul(f32x4 g, f32x4 u) {
        const f32x4 gc = __builtin_elementwise_max(g, (f32x4){-40.f, -40.f, -40.f, -40.f});
        const f32x4 t = gc * -1.44269504089f;
        f32x4 e; e.x = __builtin_amdgcn_exp2f(t.x); e.y = __builtin_amdgcn_exp2f(t.y); e.z = __builtin_amdgcn_exp2f(t.z); e.w = __builtin_amdgcn_exp2f(t.w);
        const f32x4 d = e + 1.0f;
        const float r01 = __builtin_amdgcn_rcpf(d.x * d.y), r23 = __builtin_amdgcn_rcpf(d.z * d.w);
        const f32x4 sg = {d.y * r01, d.x * r01, d.w * r23, d.z * r23};
        return (gc * sg) * u;
    }
    __device__ __forceinline__ void operator()(const f32x4 (&acc)[2][2][4][2], const Unit& u, int wr, int wc, int fr_, int fq_) const {
        int tl_ = threadIdx.x; asm volatile("" : "+v"(tl_)); const int fr = tl_ & 15, fq = (tl_ >> 4) & 3;
        const int row0 = u.pm * BM + wr * 64 + fr, col0 = u.pn * HALF + wc * 32 + 8 * fq; const auto rs_ = mk_rsrc(O);
#pragma unroll
        for (int ai = 0; ai < 2; ++ai)
#pragma unroll
            for (int m = 0; m < 4; ++m) { const unsigned ro = ((unsigned)(row0 + ai * HALF + m * 16) * (unsigned)ldc + (unsigned)col0) * 2u;
                const f32x4 v0 = silu_mul(acc[ai][0][m][0], acc[ai][1][m][0]), v1 = silu_mul(acc[ai][0][m][1], acc[ai][1][m][1]);
                u32x4 w; w.x = cvt_pk_bf16(v0[0], v0[1]); w.y = cvt_pk_bf16(v0[2], v0[3]); w.z = cvt_pk_bf16(v1[0], v1[1]); w.w = cvt_pk_bf16(v1[2], v1[3]);
                ST16(rs_, ro, w); }
    }
};

template <class Epi, class Sched, bool ALIGN_EPI = false, bool SP2 = false>
__device__ __forceinline__ void gemm_phase(PG8_LAS unsigned char* lds, const Gemm g, const Sched& S, const Epi& E) {
    int tid_ = threadIdx.x; asm volatile("" : "+v"(tid_));
    const int tid = tid_, wid = __builtin_amdgcn_readfirstlane(tid >> 6), lane = tid & 63, wr = wid >> 2, wc = wid & 3, fr = lane & 15, fq = lane >> 4;
    const int K = g.K, nt = K / BK;
    unsigned voffA[2], voffB[2];
#pragma unroll
    for (int i = 0; i < 2; ++i) { int R, C; stage_rc(tid * 16 + i * 8192, R, C); const int Rb = Epi::PERM ? ((R & ~31) + perm32(R & 31)) : R;
        voffA[i] = (unsigned)(R * g.ld + C) * 2u; voffB[i] = (unsigned)(Rb * g.ld + C) * 2u; }
    const size_t kstep = (size_t)(BK * 2);
    const size_t hstepA = (size_t)HALF * g.ld * 2, hstepB = hstepA;
    const size_t kslice = (size_t)K * 2;
    const unsigned ldsw = (unsigned)wid * 1024u;
    const int aoff = lds_byte(wr * 64 + fr, fq * 8), boff = lds_byte(wc * 32 + fr, fq * 8);
#define PG8_SA(b, h) (((b) * 2 + (h)) * HTB)
#define PG8_SB(b, h) ((4 + (b) * 2 + (h)) * HTB)
#define PG8_STAGE(bufoff, gbase, voff) do { _Pragma("unroll") for (int _i = 0; _i < 2; ++_i) \
        __builtin_amdgcn_global_load_lds((const unsigned*)((const char*)(gbase) + (voff)[_i]), (PG8_LAS unsigned*)(lds + (bufoff) + ldsw + _i * 8192), 16, 0, 0); } while (0)
#define PG8_LDA(dst, b, h) do { _Pragma("unroll") for (int m = 0; m < 4; ++m) _Pragma("unroll") for (int k = 0; k < 2; ++k) dst[m][k] = *(const PG8_LAS bf16x8*)(lds + PG8_SA(b, h) + aoff + m * 2048 + k * 1024); } while (0)
#define PG8_LDB(dst, b, h) do { _Pragma("unroll") for (int n = 0; n < 2; ++n) _Pragma("unroll") for (int k = 0; k < 2; ++k) dst[n][k] = *(const PG8_LAS bf16x8*)(lds + PG8_SB(b, h) + boff + n * 2048 + k * 1024); } while (0)
#define PG8_MMA(ai, bj, At, Bt) do { __builtin_amdgcn_s_setprio(1); _Pragma("unroll") for (int m = 0; m < 4; ++m) _Pragma("unroll") for (int n = 0; n < 2; ++n) _Pragma("unroll") for (int k = 0; k < 2; ++k) \
        acc[ai][bj][m][n] = __builtin_amdgcn_mfma_f32_16x16x32_bf16(Bt[n][k], At[m][k], acc[ai][bj][m][n], 0, 0, 0); __builtin_amdgcn_s_setprio(0); } while (0)
#define PG8_WAIT_V(n) asm volatile("s_waitcnt vmcnt(" #n ")" ::: "memory")
#define PG8_WAIT_L(n) asm volatile("s_waitcnt lgkmcnt(" #n ")" ::: "memory")
#define PG8_BAR __builtin_amdgcn_s_barrier()
#define PG8_SCHED __builtin_amdgcn_sched_barrier(0)
    Unit cur, nxt; int ui = 0;
    if (!S.next(0, cur)) return;
    f32x4 acc[2][2][4][2];
#pragma unroll
    for (int a = 0; a < 2; ++a)
#pragma unroll
        for (int b = 0; b < 2; ++b)
#pragma unroll
            for (int m = 0; m < 4; ++m)
#pragma unroll
                for (int n = 0; n < 2; ++n) acc[a][b][m][n] = (f32x4){0.f, 0.f, 0.f, 0.f};
    bf16x8 At[4][2], B0[2][2], B1[2][2];
    const char* cA = (const char*)g.A + (size_t)cur.pm * 2 * hstepA + (size_t)cur.ks * kslice; const char* cB = (const char*)g.Bt + (size_t)cur.pn * 2 * hstepB + (size_t)cur.ks * kslice;
    S.a_ready(cur);
    if constexpr (SP2) {
        PG8_STAGE(PG8_SB(0, 0), cB, voffB); PG8_STAGE(PG8_SB(0, 1), cB + hstepB, voffB); PG8_STAGE(PG8_SA(0, 0), cA, voffA); PG8_STAGE(PG8_SA(0, 1), cA + hstepA, voffA);
        if (wr == 1) PG8_BAR;
        PG8_WAIT_V(2); PG8_BAR;
        PG8_STAGE(PG8_SB(1, 0), cB + kstep, voffB); PG8_STAGE(PG8_SA(1, 0), cA + kstep, voffA); PG8_STAGE(PG8_SB(1, 1), cB + hstepB + kstep, voffB);
        PG8_WAIT_V(6); PG8_BAR;
    } else {
        PG8_STAGE(PG8_SB(0, 0), cB, voffB); PG8_STAGE(PG8_SA(0, 0), cA, voffA); PG8_STAGE(PG8_SB(0, 1), cB + hstepB, voffB); PG8_STAGE(PG8_SA(0, 1), cA + hstepA, voffA);
        if (wr == 1) PG8_BAR;
        PG8_WAIT_V(4); PG8_BAR;
        PG8_STAGE(PG8_SB(1, 0), cB + kstep, voffB); PG8_STAGE(PG8_SA(1, 0), cA + kstep, voffA); PG8_STAGE(PG8_SB(1, 1), cB + hstepB + kstep, voffB);
        PG8_WAIT_V(6); PG8_BAR;
    }
    for (;;) {
        const bool has_next = S.next(ui + 1, nxt);
        const char* nA = has_next ? (const char*)g.A + (size_t)nxt.pm * 2 * hstepA + (size_t)nxt.ks * kslice : cA; const char* nB = has_next ? (const char*)g.Bt + (size_t)nxt.pn * 2 * hstepB + (size_t)nxt.ks * kslice : cB;
        for (int t = 0; t < nt; t += 2) {
            const bool last = (t == nt - 2);
            const char* a1 = cA + (size_t)(t + 1) * kstep;
            const char* a2 = last ? nA : cA + (size_t)(t + 2) * kstep; const char* b2 = last ? nB : cB + (size_t)(t + 2) * kstep;
            const char* a3 = a2 + kstep; const char* b3 = b2 + kstep;
            if (last && has_next) S.a_ready(nxt);
            if constexpr (SP2) {
            PG8_LDB(B0, 0, 0); PG8_LDB(B1, 0, 1); PG8_SCHED; PG8_LDA(At, 0, 0); PG8_STAGE(PG8_SA(1, 1), a1 + hstepA, voffA);
            PG8_WAIT_V(8); PG8_WAIT_L(0); PG8_BAR; PG8_MMA(0, 0, At, B0); PG8_MMA(0, 1, At, B1); PG8_BAR; PG8_SCHED;
            PG8_LDA(At, 0, 1); PG8_STAGE(PG8_SB(0, 0), b2, voffB); PG8_STAGE(PG8_SB(0, 1), b2 + hstepB, voffB); PG8_STAGE(PG8_SA(0, 0), a2, voffA);
            PG8_WAIT_V(8); PG8_WAIT_L(0); PG8_BAR; PG8_MMA(1, 0, At, B0); PG8_MMA(1, 1, At, B1); PG8_BAR; PG8_SCHED;
            PG8_LDB(B0, 1, 0); PG8_LDB(B1, 1, 1); PG8_SCHED; PG8_LDA(At, 1, 0); PG8_STAGE(PG8_SA(0, 1), a2 + hstepA, voffA);
            PG8_WAIT_V(8); PG8_WAIT_L(0); PG8_BAR; PG8_MMA(0, 0, At, B0); PG8_MMA(0, 1, At, B1); PG8_BAR; PG8_SCHED;
            PG8_LDA(At, 1, 1); PG8_STAGE(PG8_SB(1, 0), b3, voffB); PG8_STAGE(PG8_SB(1, 1), b3 + hstepB, voffB); PG8_STAGE(PG8_SA(1, 0), a3, voffA);
            PG8_WAIT_V(8); PG8_WAIT_L(0); PG8_BAR; PG8_MMA(1, 0, At, B0); PG8_MMA(1, 1, At, B1); PG8_BAR; PG8_SCHED;
            } else {
            PG8_LDB(B0, 0, 0); PG8_SCHED; PG8_LDA(At, 0, 0); PG8_STAGE(PG8_SA(1, 1), a1 + hstepA, voffA);
            PG8_WAIT_L(8); PG8_BAR; PG8_WAIT_L(0); PG8_MMA(0, 0, At, B0); PG8_BAR; PG8_SCHED;
            PG8_LDB(B1, 0, 1); PG8_STAGE(PG8_SB(0, 0), b2, voffB);
            PG8_BAR; PG8_WAIT_L(0); PG8_MMA(0, 1, At, B1); PG8_BAR;
            PG8_LDA(At, 0, 1); PG8_STAGE(PG8_SA(0, 0), a2, voffA);
            PG8_BAR; PG8_WAIT_L(0); PG8_MMA(1, 0, At, B0); PG8_BAR; PG8_SCHED;
            PG8_STAGE(PG8_SB(0, 1), b2 + hstepB, voffB);
            PG8_WAIT_V(6); PG8_BAR; PG8_MMA(1, 1, At, B1); PG8_BAR;
            PG8_LDB(B0, 1, 0); PG8_SCHED; PG8_LDA(At, 1, 0); PG8_STAGE(PG8_SA(0, 1), a2 + hstepA, voffA);
            PG8_WAIT_L(8); PG8_BAR; PG8_WAIT_L(0); PG8_MMA(0, 0, At, B0); PG8_BAR; PG8_SCHED;
            PG8_LDB(B1, 1, 1); PG8_STAGE(PG8_SB(1, 0), b3, voffB);
            PG8_BAR; PG8_WAIT_L(0); PG8_MMA(0, 1, At, B1); PG8_BAR;
            PG8_LDA(At, 1, 1); PG8_STAGE(PG8_SA(1, 0), a3, voffA);
            PG8_BAR; PG8_WAIT_L(0); PG8_MMA(1, 0, At, B0); PG8_BAR; PG8_SCHED;
            PG8_STAGE(PG8_SB(1, 1), b3 + hstepB, voffB);
            PG8_WAIT_V(6); PG8_BAR; PG8_MMA(1, 1, At, B1); PG8_BAR;
            }
        }
        if constexpr (ALIGN_EPI) { if (wr == 0) PG8_BAR; }
        if constexpr (!Epi::AFTER_DRAIN) { E(acc, cur, wr, wc, fr, fq); S.done(cur); }
        if (!has_next) break;
#pragma unroll
        for (int a = 0; a < 2; ++a)
#pragma unroll
            for (int b = 0; b < 2; ++b)
#pragma unroll
                for (int m = 0; m < 4; ++m)
#pragma unroll
                    for (int n = 0; n < 2; ++n) acc[a][b][m][n] = (f32x4){0.f, 0.f, 0.f, 0.f};
        cur = nxt; cA = nA; cB = nB; ++ui;
        if constexpr (ALIGN_EPI) { if (wr == 1) PG8_BAR; }
    }
    PG8_WAIT_V(0);
    if constexpr (!ALIGN_EPI) { if (wr == 0) PG8_BAR; }
    PG8_BAR;
    if constexpr (Epi::AFTER_DRAIN) { E.fused(acc, cur, wr, wc, fr, fq, lds, wid, lane); S.done(cur); }
#undef PG8_SA
#undef PG8_SB
#undef PG8_STAGE
#undef PG8_LDA
#undef PG8_LDB
#undef PG8_MMA
#undef PG8_WAIT_V
#undef PG8_WAIT_L
#undef PG8_BAR
#undef PG8_SCHED
}
}

using pg8::bf16_t; using pg8::bf16x8; using pg8::f32x4; using pg8::u32x4; using pg8::u32x2; using pg8::cvt_pk_bf16;
#define LAS __attribute__((address_space(3)))
#define XB_TMO      128
#define XB_XCNT(j)  (256  + 64 * (j))
#define XB_XSUB(j)  (1280 + 64 * (j))
#define XB_XGEN(j)  (2304 + 64 * (j))
#define XB_TOP      3328
#define XB_TOPGEN   3392
#define XCD_BAR_WORDS 3456
#define XB_SPIN_CAP (1u << 18)

__device__ __forceinline__ unsigned xb_ld(unsigned* p)              { return __hip_atomic_load(p, __ATOMIC_RELAXED, __HIP_MEMORY_SCOPE_AGENT); }
__device__ __forceinline__ unsigned xb_add(unsigned* p, unsigned v) { return __hip_atomic_fetch_add(p, v, __ATOMIC_RELAXED, __HIP_MEMORY_SCOPE_AGENT); }
__device__ __forceinline__ unsigned xb_xcc_id() { return (unsigned)__builtin_amdgcn_s_getreg((3 << 11) | 20) & 0xFu; }
#define XB_SPIN(cond, bar) do { unsigned _sp = 0; while (cond) { __builtin_amdgcn_s_sleep(1); \
    if ((++_sp & 255u) == 0u) { if (xb_ld(&(bar)[XB_TMO])) break; if (_sp > XB_SPIN_CAP) { atomicAdd(&(bar)[XB_TMO], 1u); break; } } } } while (0)

struct XcdBarrier {
    unsigned* bar; unsigned x;
    volatile LAS unsigned* st;
};

__device__ __forceinline__ XcdBarrier xcd_barrier_post(unsigned* bar, volatile LAS unsigned* st) {
    XcdBarrier b; b.bar = bar; b.x = xb_xcc_id(); b.st = st;
    if (threadIdx.x == 0) (void)xb_add(&bar[XB_XCNT(b.x)], 1u);
    return b;
}
__device__ __forceinline__ void xcd_barrier_complete(unsigned* bar, unsigned x, unsigned& nloc, unsigned& nx) {
    const unsigned G = gridDim.x * gridDim.y * gridDim.z;
    unsigned sum, cnt, mine, sp = 0u;
    for (;;) {
        sum = 0u; cnt = 0u; mine = 0u;
#pragma unroll
        for (unsigned j = 0; j < 16; ++j) { const unsigned c = xb_ld(&bar[XB_XCNT(j)]); sum += c; cnt += (c > 0u) ? 1u : 0u; mine = (j == x) ? c : mine; }
        if (sum == G) break;
        __builtin_amdgcn_s_sleep(1);
        if ((++sp & 255u) == 0u) { if (xb_ld(&bar[XB_TMO])) break; if (sp > XB_SPIN_CAP) { atomicAdd(&bar[XB_TMO], 1u); break; } }
    }
    nloc = mine > 0u ? mine : 1u; nx = cnt > 0u ? cnt : 1u;
}

__device__ __forceinline__ void xcd_barrier(const XcdBarrier& b) {
    asm volatile("s_waitcnt vmcnt(0)" ::: "memory");
    __syncthreads();
    if (threadIdx.x == 0) {
        unsigned* bar = b.bar;
        __builtin_amdgcn_s_waitcnt(0);
        unsigned nloc = b.st[0], nx = b.st[1];
        if (nloc == 0u) { xcd_barrier_complete(bar, b.x, nloc, nx); b.st[0] = nloc; b.st[1] = nx; }
        const unsigned old = xb_add(&bar[XB_XSUB(b.x)], 1u);
        const unsigned gen = old / nloc;
        if (old + 1u == (gen + 1u) * nloc) {
            __builtin_amdgcn_fence(__ATOMIC_RELEASE, "agent");
            asm volatile("s_waitcnt vmcnt(0)" ::: "memory");
            const unsigned og = xb_add(&bar[XB_TOP], 1u);
            const unsigned tg = og / nx;
            if (og + 1u == (tg + 1u) * nx) xb_add(&bar[XB_TOPGEN], 1u);
            else XB_SPIN(xb_ld(&bar[XB_TOPGEN]) == tg, bar);
            __builtin_amdgcn_fence(__ATOMIC_ACQUIRE, "agent");
            xb_add(&bar[XB_XGEN(b.x)], 1u);
            asm volatile("s_waitcnt vmcnt(0)" ::: "memory");
        } else {
            XB_SPIN(xb_ld(&bar[XB_XGEN(b.x)]) == gen, bar);
            __builtin_amdgcn_fence(__ATOMIC_ACQUIRE, "agent");
            asm volatile("s_waitcnt vmcnt(0)" ::: "memory");
        }
    }
    __syncthreads();
}


#ifndef MK_DUP
#define MK_DUP 0u
#endif
#ifndef MK_COOP
#define MK_COOP 1
#endif
constexpr int M_ = 17408, MP_ = 16384, DM = 1024, FF = 2816, NGU = 5632, NIN = 2560, PLE = 256;
constexpr float EPS_ = 1e-6f;
constexpr int LDS_BYTES = 147456;
constexpr int NPHASE = 14;
constexpr size_t WS_WGU1 = 0;
constexpr size_t WS_WD1 = WS_WGU1 + (size_t)NGU * DM * 2;
constexpr size_t WS_WIN = WS_WD1 + (size_t)DM * FF * 2;
constexpr size_t WS_WOUT = WS_WIN + (size_t)NIN * DM * 2;
constexpr size_t WS_WGU2 = WS_WOUT + (size_t)DM * DM * 2;
constexpr size_t WS_WD2 = WS_WGU2 + (size_t)NGU * DM * 2;
constexpr size_t WS_WPG = WS_WD2 + (size_t)DM * FF * 2;
constexpr size_t WS_WPP = WS_WPG + (size_t)DM * DM * 2;
constexpr size_t WS_YC = WS_WPP + (size_t)DM * PLE * 2;
constexpr size_t WS_ACT = WS_YC + (size_t)M_ * DM * 2;
constexpr size_t WS_D = WS_ACT + (size_t)M_ * FF * 2;
constexpr size_t WS_HB = WS_D + (size_t)M_ * DM * 2;
constexpr size_t WS_SLAB2 = WS_HB + (size_t)M_ * DM * 2;
constexpr size_t WS_RS = WS_SLAB2 + (size_t)3 * 1024 * 1024 * 4;
constexpr size_t WS_END = WS_RS + (size_t)M_ * 4;
constexpr size_t WS_BAR = WS_END;
constexpr size_t WS_TOTAL = WS_BAR + (size_t)XCD_BAR_WORDS * 4;
constexpr size_t WS_PROJ = WS_ACT;
constexpr size_t WS_PP = WS_ACT;
constexpr size_t WS_PB = WS_YC + (size_t)16 * 1024 * 1024;
constexpr size_t WS_SLAB4 = WS_ACT + (size_t)M_ * DM * 4 + (size_t)M_ * PLE * 2;
static_assert(WS_SLAB4 + (size_t)4 * 1024 * 1024 * 4 <= WS_D && WS_PB + (size_t)M_ * PLE * 2 <= WS_ACT, "aliases fit");
constexpr size_t OUT_NCP = 17825792, OUT_NCS = 17833984, OUT_CVP = 17965056, OUT_CVS = 18489344;

struct Args { const float* in[28]; float* out; unsigned char* ws; int ph_lo, ph_hi; };

__device__ __forceinline__ float wave_sum(float v) {
#pragma unroll
    for (int o = 1; o < 64; o <<= 1) v += __shfl_xor(v, o);
    return v;
}
__device__ __forceinline__ float bf_lo(unsigned w) { return __uint_as_float(w << 16); }
__device__ __forceinline__ float bf_hi(unsigned w) { return __uint_as_float(w & 0xffff0000u); }
__device__ __forceinline__ float dot4(f32x4 a) { return (a.x * a.x + a.y * a.y) + (a.z * a.z + a.w * a.w); }
#define LDS_WAIT() asm volatile("s_waitcnt lgkmcnt(0)" ::: "memory")

struct TrItem { const float* W; bf16_t* WT; const float* gk; int K, N, k0, n0, drow0; };
__device__ __forceinline__ void tr_load(const TrItem& d, int lane, f32x4 (&v8)[8], float (&g8)[8]) {
#pragma unroll
    for (int i = 0; i < 8; ++i) { const int kk = 8 * i + (lane >> 3); v8[i] = __builtin_nontemporal_load((const f32x4*)(d.W + (size_t)(d.k0 + kk) * d.N + d.n0 + (lane & 7) * 4)); g8[i] = d.gk ? d.gk[d.k0 + kk] : 1.0f; }
}
__device__ __forceinline__ void tr_store(const TrItem& d, LAS float* scr, int lane, const f32x4 (&v8)[8], const float (&g8)[8]) {
#pragma unroll
    for (int i = 0; i < 8; ++i) { const int kk = 8 * i + (lane >> 3); LAS float* q = scr + kk * 33 + (lane & 7) * 4; const f32x4 v = v8[i] * g8[i]; q[0] = v.x; q[1] = v.y; q[2] = v.z; q[3] = v.w; }
    LDS_WAIT();
    const int c = lane & 7;
#pragma unroll
    for (int j = 0; j < 4; ++j) { const int n = (lane >> 3) + 8 * j; const LAS float* t = scr + (8 * c) * 33 + n;
        u32x4 o; o.x = cvt_pk_bf16(t[0 * 33], t[1 * 33]); o.y = cvt_pk_bf16(t[2 * 33], t[3 * 33]); o.z = cvt_pk_bf16(t[4 * 33], t[5 * 33]); o.w = cvt_pk_bf16(t[6 * 33], t[7 * 33]);
        *(u32x4*)(d.WT + (size_t)(d.drow0 + n) * d.K + d.k0 + 8 * c) = o; }
    LDS_WAIT();
}

__device__ __forceinline__ f32x4 bf4(unsigned a, unsigned b) { return (f32x4){bf_lo(a), bf_hi(a), bf_lo(b), bf_hi(b)}; }
template <int MODE>
__device__ __forceinline__ void rp_load_res(int m, const float* __restrict__ resP, const float* __restrict__ resS, const bf16_t* hb, int lane, f32x4 (&h)[4]) {
    if (MODE & 2) { const float* rrow = (m < MP_) ? resP + (size_t)m * DM : resS + (size_t)(m - MP_) * DM;
#pragma unroll
        for (int j = 0; j < 4; ++j) h[j] = __builtin_nontemporal_load((const f32x4*)rrow + lane + 64 * j); }
    else { const u32x2* hr = (const u32x2*)(hb + (size_t)m * DM) + lane;
#pragma unroll
        for (int j = 0; j < 4; ++j) { const u32x2 w = hr[64 * j]; h[j] = bf4(w.x, w.y); } }
}
__device__ __forceinline__ int vzero() { int z; asm volatile("v_mov_b32 %0, 0" : "=v"(z)); return z; }
template <int MODE>
__device__ __forceinline__ void rp_finish(int m, f32x4 (&h)[4], f32x4 (&d)[4], const f32x4 (&gp)[4], float sc, bf16_t* hb, float* rsv, float* __restrict__ outf, int lane, float hin_scale) {
    if (MODE & 32) {
#pragma unroll
        for (int j = 0; j < 4; ++j) h[j] *= hin_scale; }
    if (MODE & 1) {
        float ss = 0.f;
#pragma unroll
        for (int j = 0; j < 4; ++j) ss += dot4(d[j]);
        const float rs = sc * rsqrtf(wave_sum(ss) * (1.0f / DM) + EPS_);
#pragma unroll
        for (int j = 0; j < 4; ++j) h[j] += d[j] * rs * gp[j];
    }
    if (MODE & 4) {
        float s2 = 0.f;
#pragma unroll
        for (int j = 0; j < 4; ++j) s2 += dot4(h[j]);
        const float rs2 = rsqrtf(wave_sum(s2) * (1.0f / DM) + EPS_);
        if (lane == 0) rsv[m] = rs2;
        const float osc = (MODE & 64) ? rs2 : 1.0f;
        const auto hrs = pg8::mk_rsrc(hb); const unsigned ho = (unsigned)m * (DM * 2u) + (unsigned)lane * 8u;
#pragma unroll
        for (int j = 0; j < 4; ++j) { const f32x4 v = h[j] * osc; u32x2 w; w.x = cvt_pk_bf16(v.x, v.y); w.y = cvt_pk_bf16(v.z, v.w); ST8(hrs, ho + 512u * j, w); }
    }
    if (MODE & 8) { f32x4* ho = (f32x4*)(outf + (size_t)m * DM) + lane;
#pragma unroll
        for (int j = 0; j < 4; ++j) __builtin_nontemporal_store(h[j], ho + 64 * j); }
}
template <int MODE, int NSL, int N0>
__device__ __forceinline__ void rowpass(const bf16_t* __restrict__ dbuf, const bf16_t* slab0, const bf16_t* slab1, const bf16_t* __restrict__ pp, const float* __restrict__ resP, const float* __restrict__ resS,
                                        bf16_t* hb, float* rsv, float* __restrict__ outf, const float* __restrict__ gpost, float sc, int gw, int NGW, int lane) {
    f32x4 gp[4]; const int vz = vzero();
#pragma unroll
    for (int j = 0; j < 4; ++j) gp[j] = (MODE & 1) ? ((const f32x4*)gpost)[lane + 64 * j] : (f32x4){0.f, 0.f, 0.f, 0.f};
    constexpr int NR = 4;
    for (int m0 = gw; m0 < MP_; m0 += NR * NGW) {
        f32x4 hh[NR][4], dd[NR][4]; u32x2 ww[NR][4]; float isc[NR];
#pragma unroll
        for (int q = 0; q < NR; ++q) { const int m = m0 + q * NGW; isc[q] = 1.0f; if (m < MP_) { rp_load_res<MODE>(m, resP, resS, hb, lane, hh[q]); if (MODE & 32) isc[q] = rsv[m + vz]; } }
        if (MODE & 1) {
#pragma unroll
            for (int q = 0; q < NR; ++q) { const int m = m0 + q * NGW; if (m < MP_) { const u32x2* dr = (const u32x2*)(dbuf + (size_t)m * DM) + lane;
#pragma unroll
                for (int j = 0; j < 4; ++j) ww[q][j] = dr[64 * j]; } }
#pragma unroll
            for (int q = 0; q < NR; ++q)
#pragma unroll
                for (int j = 0; j < 4; ++j) dd[q][j] = bf4(ww[q][j].x, ww[q][j].y);
        }
#pragma unroll
        for (int q = 0; q < NR; ++q) { const int m = m0 + q * NGW; if (m < MP_) rp_finish<MODE>(m, hh[q], dd[q], gp, sc, hb, rsv, outf, lane, (MODE & 32) ? 1.0f / isc[q] : 1.0f); }
    }
    if (((gw & 1) == 0)) for (int r = (gw >> 3) * 4 + ((gw & 7) >> 1); r < M_ - MP_; r += (NGW >> 3) * 4) {
        const int m = MP_ + r;
        f32x4 h[4], d[4]; float isc1 = 1.0f;
        rp_load_res<MODE>(m, resP, resS, hb, lane, h);
        if (MODE & 32) isc1 = rsv[m + vz];
        if (MODE & 1) {
            u32x2 tq[4][NSL > 0 ? NSL : 1];
#pragma unroll
            for (int j = 0; j < 4; ++j)
#pragma unroll
                for (int s = 0; s < NSL; ++s) tq[j][s] = ((const u32x2*)(((s < N0) ? slab0 + ((size_t)s << 20) : slab1 + ((size_t)(s - N0) << 20)) + (size_t)r * DM))[lane + 64 * j];
#pragma unroll
            for (int j = 0; j < 4; ++j) { f32x4 acc = {0.f, 0.f, 0.f, 0.f};
#pragma unroll
                for (int s = 0; s < NSL; ++s) acc += bf4(tq[j][s].x, tq[j][s].y);
                d[j] = acc; }
            if (MODE & 16) { const u32x2* pr = (const u32x2*)(pp + (size_t)m * DM) + lane;
#pragma unroll
                for (int j = 0; j < 4; ++j) { const u32x2 pw = pr[64 * j]; const f32x4 p = bf4(pw.x, pw.y); d[j].x = pg8::sigmoid_f(d[j].x) * p.x; d[j].y = pg8::sigmoid_f(d[j].y) * p.y; d[j].z = pg8::sigmoid_f(d[j].z) * p.z; d[j].w = pg8::sigmoid_f(d[j].w) * p.w; } }
        }
        rp_finish<MODE>(m, h, d, gp, sc, hb, rsv, outf, lane, (MODE & 32) ? 1.0f / isc1 : 1.0f);
    }
}

#ifdef MK_TM
#define MIX_T(seg) do { const unsigned long long tn_ = __builtin_amdgcn_s_memrealtime(); if ((MK_TM >> (seg)) & 1u) *tqm += tn_ - tpm; tpm = tn_; } while (0)
#else
#define MIX_T(seg) do { } while (0)
#endif
__device__ __forceinline__ void mixer_phase(const Args& a, LAS unsigned char* lds, const bf16_t* __restrict__ PROJ, bf16_t* __restrict__ YC, int wave, int lane, unsigned long long* tqm) {
    unsigned long long tpm = 0ull;
    constexpr int VP = 1056;
    const auto ycrs = pg8::mk_rsrc(YC);
    LAS float* part = (LAS float*)(lds + 128 * VP);
    const int fr = lane & 15, fq = lane >> 4;
    const float* __restrict__ wsm = a.in[15]; const float* __restrict__ bsm = a.in[16];
    float* out = a.out;
    const int G_ = (int)gridDim.x, b_ = (int)blockIdx.x;
    for (int it = 0;; ++it) {
        int u, R0, nrows = 64;
        if (G_ == 256) { if (it == 0) { u = b_; R0 = u * 64; } else if (it == 1 && (b_ & 1) == 0 && b_ < 128) { u = 256; R0 = MP_ + 16 * (b_ >> 1); nrows = 16; } else break; }
        else { u = b_ + it * G_; if (u >= 272) break; R0 = u * 64; }
        const int ntb = nrows >> 4;
        const bool samp = (u >= 256);
#ifdef MK_TM
        tpm = __builtin_amdgcn_s_memrealtime();
#endif
        int s0 = 0, t0 = 0;
        if (!samp) { s0 = (u & 31) * 64; t0 = s0 & 127; }
        const int CB = R0 - t0, kext = t0 + 64;
        const int h = wave; const int nkb = kext >> 5;
        bf16x8 afr[4][4];
#pragma unroll
        for (int kb = 0; kb < 4; ++kb) {
#pragma unroll
            for (int tb = 0; tb < 4; ++tb) {
                f32x4 w0 = {0.f, 0.f, 0.f, 0.f}, w1 = w0; int lim = -1;
                if (kb < nkb) {
                    if (!samp) { const int tt = t0 + tb * 16 + fr, sb = kb * 32 + fq * 8; const float* wp = wsm + (size_t)(h * 128 + tt) * 128 + sb;
                        w0 = *(const f32x4*)wp; w1 = *(const f32x4*)(wp + 4); lim = tt - sb; }
                    else { const int tt = fr & 7; const float* wp = wsm + (size_t)(h * 128 + tt) * 128;
                        w0 = *(const f32x4*)wp; w1 = *(const f32x4*)(wp + 4); lim = ((kb * 4 + fq) == (tb * 2 + (fr >> 3))) ? tt : -1; }
                }
                w0.x = (0 <= lim) ? w0.x : 0.f; w0.y = (1 <= lim) ? w0.y : 0.f; w0.z = (2 <= lim) ? w0.z : 0.f; w0.w = (3 <= lim) ? w0.w : 0.f;
                w1.x = (4 <= lim) ? w1.x : 0.f; w1.y = (5 <= lim) ? w1.y : 0.f; w1.z = (6 <= lim) ? w1.z : 0.f; w1.w = (7 <= lim) ? w1.w : 0.f;
                u32x4 pk; pk.x = cvt_pk_bf16(w0.x, w0.y); pk.y = cvt_pk_bf16(w0.z, w0.w); pk.z = cvt_pk_bf16(w1.x, w1.y); pk.w = cvt_pk_bf16(w1.z, w1.w);
                afr[kb][tb] = __builtin_bit_cast(bf16x8, pk);
            }
        }
        {
            const f32x4 vg0 = *(const f32x4*)(a.in[14] + lane * 8), vg1 = *(const f32x4*)(a.in[14] + lane * 8 + 4);
            for (int sb8 = 0; sb8 < kext; sb8 += 64) {
                u32x4 raw8[8];
#pragma unroll
                for (int i = 0; i < 8; ++i) { int rr = CB + sb8 + i * 8 + wave; rr = rr < M_ ? rr : M_ - 1; raw8[i] = *(const u32x4*)(PROJ + (size_t)rr * NIN + 2048 + lane * 8); }
#pragma unroll
                for (int i = 0; i < 8; ++i) {
                    const int s = sb8 + i * 8 + wave, row = CB + s; const u32x4 raw = raw8[i];
                    f32x4 v0 = bf4(raw.x, raw.y), v1 = bf4(raw.z, raw.w);
                    float ss = dot4(v0) + dot4(v1);
                    ss += __shfl_xor(ss, 1); ss += __shfl_xor(ss, 2); ss += __shfl_xor(ss, 4);
                    const float rs = rsqrtf(ss * (1.0f / 64.0f) + EPS_);
                    v0 = v0 * rs * vg0; v1 = v1 * rs * vg1;
                    u32x4 pk; pk.x = cvt_pk_bf16(v0.x, v0.y); pk.y = cvt_pk_bf16(v0.z, v0.w); pk.z = cvt_pk_bf16(v1.x, v1.y); pk.w = cvt_pk_bf16(v1.z, v1.w);
                    *(LAS u32x4*)(lds + s * VP + lane * 16) = pk;
                    if (s >= t0 && s < t0 + nrows) {
                        if (samp) { float* o = out + OUT_CVS + (size_t)(row - MP_) * 512 + lane * 8; *(f32x4*)o = v0; *(f32x4*)(o + 4) = v1; }
                        else if (s0 - t0 == 1920) { float* o = out + OUT_CVP + (size_t)((u >> 5) * 128 + s) * 512 + lane * 8; *(f32x4*)o = v0; *(f32x4*)(o + 4) = v1; }
                    }
                }
            }
        }
        __syncthreads();
        MIX_T(0);
        f32x4 acc[4][4];
#pragma unroll
        for (int i = 0; i < 4; ++i)
#pragma unroll
            for (int j = 0; j < 4; ++j) acc[i][j] = (f32x4){0.f, 0.f, 0.f, 0.f};
#pragma unroll
        for (int kb = 0; kb < 4; ++kb) if (kb < nkb) {
            u32x2 r0[4], r1[4];
            { const unsigned ta = (unsigned)(uintptr_t)(lds + (kb * 32 + fq * 8 + (fr >> 2)) * VP + (h * 64 + (fr & 3) * 4) * 2);
              asm volatile("ds_read_b64_tr_b16 %0, %8\n\tds_read_b64_tr_b16 %1, %8 offset:4224\n\t"
                           "ds_read_b64_tr_b16 %2, %8 offset:32\n\tds_read_b64_tr_b16 %3, %8 offset:4256\n\t"
                           "ds_read_b64_tr_b16 %4, %8 offset:64\n\tds_read_b64_tr_b16 %5, %8 offset:4288\n\t"
                           "ds_read_b64_tr_b16 %6, %8 offset:96\n\tds_read_b64_tr_b16 %7, %8 offset:4320\n\ts_waitcnt lgkmcnt(0)"
                           : "=&v"(r0[0]), "=&v"(r1[0]), "=&v"(r0[1]), "=&v"(r1[1]), "=&v"(r0[2]), "=&v"(r1[2]), "=&v"(r0[3]), "=&v"(r1[3]) : "v"(ta) : "memory"); }
#pragma unroll
            for (int db = 0; db < 4; ++db) {
                u32x4 bq; bq.x = r0[db].x; bq.y = r0[db].y; bq.z = r1[db].x; bq.w = r1[db].y;
                const bf16x8 bfv = __builtin_bit_cast(bf16x8, bq);
#pragma unroll
                for (int tb = 0; tb < 4; ++tb) if (tb < ntb) acc[tb][db] = __builtin_amdgcn_mfma_f32_16x16x32_bf16(bfv, afr[kb][tb], acc[tb][db], 0, 0, 0);
            }
        }
#pragma unroll
        for (int tb = 0; tb < 4; ++tb) if (tb < ntb) {
            const int t = tb * 16 + fr; const int tt = samp ? (fr & 7) : (t0 + t); const float bias = bsm[h * 128 + tt];
            const bf16_t* up = PROJ + (size_t)(R0 + t) * NIN + 1536 + h * 64 + fq * 4;
            float s = 0.f;
#pragma unroll
            for (int db = 0; db < 4; ++db) { const u32x2 ur = *(const u32x2*)(up + db * 16); const f32x4 uu = bf4(ur.x, ur.y);
                const f32x4 y = uu * (acc[tb][db] + bias); acc[tb][db] = y; s += dot4(y); }
            s += __shfl_xor(s, 16); s += __shfl_xor(s, 32);
            if (fq == 0) part[h * 64 + t] = s;
        }
        __syncthreads();
        MIX_T(1);
#pragma unroll
        for (int tb = 0; tb < 4; ++tb) if (tb < ntb) {
            const int t = tb * 16 + fr; float tot = 0.f;
#pragma unroll
            for (int hh = 0; hh < 8; ++hh) tot += part[hh * 64 + t];
            const float rs = rsqrtf(tot * (1.0f / 512.0f) + EPS_);
            bf16_t* yp = YC + (size_t)(R0 + t) * DM + 512 + h * 64 + fq * 4;
#pragma unroll
            for (int db = 0; db < 4; ++db) { const f32x4 gb = *(const f32x4*)(a.in[18] + h * 64 + db * 16 + fq * 4); const f32x4 y = acc[tb][db] * rs * gb;
                u32x2 w; w.x = cvt_pk_bf16(y.x, y.y); w.y = cvt_pk_bf16(y.z, y.w); ST8(ycrs, (unsigned)((R0 + t) * DM + 512 + h * 64 + fq * 4 + db * 16) * 2u, w); }
        }
        MIX_T(2);
        if (wave * 8 < nrows)
        {
            const int c0 = lane * 8; const float* cw = a.in[13];
            const f32x4 w0a = *(const f32x4*)(cw + c0), w0b = *(const f32x4*)(cw + c0 + 4), w1a = *(const f32x4*)(cw + 512 + c0), w1b = *(const f32x4*)(cw + 512 + c0 + 4),
                        w2a = *(const f32x4*)(cw + 1024 + c0), w2b = *(const f32x4*)(cw + 1024 + c0 + 4);
            const f32x4 gaa = *(const f32x4*)(a.in[17] + c0), gab = *(const f32x4*)(a.in[17] + c0 + 4);
            f32x4 zp2a = {0.f, 0.f, 0.f, 0.f}, zp2b = zp2a, zp1a = zp2a, zp1b = zp2a;
            const int rb = R0 + wave * 8; const int sb_ = ((R0 - MP_) >> 3) + wave;
            if (samp) { const float* st = a.in[4] + (size_t)sb_ * 1024 + c0; zp2a = *(const f32x4*)st; zp2b = *(const f32x4*)(st + 4); zp1a = *(const f32x4*)(st + 512); zp1b = *(const f32x4*)(st + 516); }
            else if (s0 + wave * 8 > 0) {
                const bf16_t* p2 = PROJ + (size_t)(rb - 2) * NIN + c0; const bf16_t* p1 = p2 + NIN;
                const u32x4 c2 = *(const u32x4*)(p2 + 512), h2 = *(const u32x4*)(p2 + 1024), c1 = *(const u32x4*)(p1 + 512), h1 = *(const u32x4*)(p1 + 1024);
                zp2a = bf4(c2.x, c2.y) * bf4(h2.x, h2.y); zp2b = bf4(c2.z, c2.w) * bf4(h2.z, h2.w); zp1a = bf4(c1.x, c1.y) * bf4(h1.x, h1.y); zp1b = bf4(c1.z, c1.w) * bf4(h1.z, h1.w);
            }
            f32x4 ya[8], yb[8]; float ss[8];
            u32x4 braw8[8], craw8[8], hraw8[8];
#pragma unroll
            for (int i = 0; i < 8; ++i) { const bf16_t* pr = PROJ + (size_t)(rb + i) * NIN + c0; braw8[i] = *(const u32x4*)pr; craw8[i] = *(const u32x4*)(pr + 512); hraw8[i] = *(const u32x4*)(pr + 1024); }
#pragma unroll
            for (int i = 0; i < 8; ++i) {
                const u32x4 braw = braw8[i], craw = craw8[i], hraw = hraw8[i];
                const f32x4 za = bf4(craw.x, craw.y) * bf4(hraw.x, hraw.y), zb = bf4(craw.z, craw.w) * bf4(hraw.z, hraw.w);
                const f32x4 ca = w0a * zp2a + w1a * zp1a + w2a * za, cb = w0b * zp2b + w1b * zp1b + w2b * zb;
                ya[i] = bf4(braw.x, braw.y) * ca; yb[i] = bf4(braw.z, braw.w) * cb;
                ss[i] = wave_sum(dot4(ya[i]) + dot4(yb[i]));
                if (i >= 6) {
                    if (samp) { float* o = out + OUT_NCS + ((size_t)sb_ * 2 + (i - 6)) * 512 + c0; *(f32x4*)o = za; *(f32x4*)(o + 4) = zb; }
                    else if ((u & 31) == 31 && wave == 7) { float* o = out + OUT_NCP + ((size_t)(u >> 5) * 2 + (i - 6)) * 512 + c0; *(f32x4*)o = za; *(f32x4*)(o + 4) = zb; }
                }
                zp2a = zp1a; zp2b = zp1b; zp1a = za; zp1b = zb;
            }
#pragma unroll
            for (int i = 0; i < 8; ++i) {
                const float rs = rsqrtf(ss[i] * (1.0f / 512.0f) + EPS_);
                const f32x4 y0 = ya[i] * rs * gaa, y1 = yb[i] * rs * gab;
                u32x4 w; w.x = cvt_pk_bf16(y0.x, y0.y); w.y = cvt_pk_bf16(y0.z, y0.w); w.z = cvt_pk_bf16(y1.x, y1.y); w.w = cvt_pk_bf16(y1.z, y1.w);
                ST16(ycrs, (unsigned)((rb + i) * DM + c0) * 2u, w);
            }
        }
        __syncthreads();
        MIX_T(3);
    }
}

constexpr int TR_I_G = (DM / 64) * (FF / 32), TR_I_D = (FF / 64) * (DM / 32), TR_I_IN = (DM / 64) * (NIN / 32), TR_I_O = (DM / 64) * (DM / 32), TR_I_PP = (PLE / 64) * (DM / 32);
constexpr int TR_A_END = 2 * TR_I_G + TR_I_IN + TR_I_O, TR_B_END = TR_A_END + TR_I_D, TR_C_END = TR_B_END + TR_I_G + TR_I_D + TR_I_O + TR_I_PP, TR_D_END = TR_C_END + TR_I_G;
__device__ __forceinline__ void tr_decode(const Args& a, unsigned char* ws, int it, TrItem& d) {
    int r = it; int mode = 0; d.gk = nullptr;
    if (r < TR_I_G) { d.W = a.in[7]; d.K = DM; d.N = FF; d.WT = (bf16_t*)(ws + WS_WGU1); mode = 1; d.gk = a.in[5]; }
    else if ((r -= TR_I_G) < TR_I_G) { d.W = a.in[8]; d.K = DM; d.N = FF; d.WT = (bf16_t*)(ws + WS_WGU1); mode = 2; d.gk = a.in[5]; }
    else if ((r -= TR_I_G) < TR_I_IN) { d.W = a.in[12]; d.K = DM; d.N = NIN; d.WT = (bf16_t*)(ws + WS_WIN); d.gk = a.in[10]; }
    else if ((r -= TR_I_IN) < TR_I_O) { d.W = a.in[19]; d.K = DM; d.N = DM; d.WT = (bf16_t*)(ws + WS_WOUT); }
    else if ((r -= TR_I_O) < TR_I_D) { d.W = a.in[9]; d.K = FF; d.N = DM; d.WT = (bf16_t*)(ws + WS_WD1); }
    else if ((r -= TR_I_D) < TR_I_G) { d.W = a.in[23]; d.K = DM; d.N = FF; d.WT = (bf16_t*)(ws + WS_WGU2); mode = 2; d.gk = a.in[20]; }
    else if ((r -= TR_I_G) < TR_I_D) { d.W = a.in[24]; d.K = FF; d.N = DM; d.WT = (bf16_t*)(ws + WS_WD2); }
    else if ((r -= TR_I_D) < TR_I_O) { d.W = a.in[25]; d.K = DM; d.N = DM; d.WT = (bf16_t*)(ws + WS_WPG); }
    else if ((r -= TR_I_O) < TR_I_PP) { d.W = a.in[26]; d.K = PLE; d.N = DM; d.WT = (bf16_t*)(ws + WS_WPP); }
    else { r -= TR_I_PP; d.W = a.in[22]; d.K = DM; d.N = FF; d.WT = (bf16_t*)(ws + WS_WGU2); mode = 1; d.gk = a.in[20]; }
    const int nblk = d.N / 32, kb = r / nblk, nb = r % nblk; d.k0 = 64 * kb; d.n0 = 32 * nb;
    d.drow0 = mode ? (d.n0 >> 7) * 256 + (d.n0 & 127) + (mode == 2 ? 128 : 0) : d.n0;
}
__device__ __forceinline__ void do_transposes(const Args& a, unsigned char* ws, LAS unsigned char* lds, int first, int last, int widx, int nwaves, int wave, int lane) {
    LAS float* scr = (LAS float*)(lds + wave * 8448);
    int it = first + widx;
    if (it < last) {
        TrItem d0, d1; f32x4 v0[8], v1[8]; float g0[8], g1[8];
        tr_decode(a, ws, it, d0); tr_load(d0, lane, v0, g0);
        for (;;) {
            const bool m1 = it + nwaves < last;
            if (m1) { tr_decode(a, ws, it + nwaves, d1); tr_load(d1, lane, v1, g1); }
            tr_store(d0, scr, lane, v0, g0);
            if (!m1) break;
            it += nwaves;
            const bool m0 = it + nwaves < last;
            if (m0) { tr_decode(a, ws, it + nwaves, d0); tr_load(d0, lane, v0, g0); }
            tr_store(d1, scr, lane, v1, g1);
            if (!m0) break;
            it += nwaves;
        }
    }
}
__device__ __forceinline__ int fresh_tid() { int t = threadIdx.x; asm volatile("" : "+v"(t)); return t; }
template <bool COOP>
__global__ void __launch_bounds__(512, 2) fwd_kernel(Args a) {
    extern __shared__ __attribute__((aligned(16))) unsigned char lds_raw[];
    LAS unsigned char* lds = (LAS unsigned char*)lds_raw;
    const int tid = threadIdx.x;
    const int G = gridDim.x, NGW = G * 8;
#define LANE_ (fresh_tid() & 63)
#define WAVE_ (__builtin_amdgcn_readfirstlane(fresh_tid() >> 6))
#define GW_ ((int)blockIdx.x * 8 + WAVE_)
    unsigned char* ws = a.ws;
    bf16_t* WGU1 = (bf16_t*)(ws + WS_WGU1); bf16_t* WD1 = (bf16_t*)(ws + WS_WD1); bf16_t* WIN = (bf16_t*)(ws + WS_WIN); bf16_t* WOUT = (bf16_t*)(ws + WS_WOUT);
    bf16_t* WGU2 = (bf16_t*)(ws + WS_WGU2); bf16_t* WD2 = (bf16_t*)(ws + WS_WD2); bf16_t* WPG = (bf16_t*)(ws + WS_WPG); bf16_t* WPP = (bf16_t*)(ws + WS_WPP);
    bf16_t* YC = (bf16_t*)(ws + WS_YC); bf16_t* HB = (bf16_t*)(ws + WS_HB); float* RS = (float*)(ws + WS_RS); bf16_t* ACT = (bf16_t*)(ws + WS_ACT); bf16_t* PROJ = (bf16_t*)(ws + WS_PROJ); bf16_t* PB = (bf16_t*)(ws + WS_PB);
    bf16_t* DB = (bf16_t*)(ws + WS_D); bf16_t* SLAB2 = (bf16_t*)(ws + WS_SLAB2); bf16_t* SLAB4 = (bf16_t*)(ws + WS_SLAB4); bf16_t* PP = (bf16_t*)(ws + WS_PP);
#define IN(k) (a.ph_lo <= (k) && (k) < a.ph_hi)
#define REP(k) for (int rep_ = 0; rep_ < (((MK_DUP >> (k)) & 1u) ? 2 : 1); ++rep_)
    XcdBarrier bar; bar.bar = (unsigned*)(ws + WS_BAR); bar.x = 0; bar.st = nullptr;
    if (COOP) {
        volatile LAS unsigned* st = (volatile LAS unsigned*)(lds + LDS_BYTES - 16);
        if (tid < 4) st[tid] = 0u;
        __syncthreads();
        bar = xcd_barrier_post((unsigned*)(ws + WS_BAR), st);
        if (a.ph_lo < 0) cg::this_grid().sync();
    }
#ifdef MK_TPROBE
#define MIXTQ_ (&tq_)
#else
#define MIXTQ_ nullptr
#endif
#ifdef MK_TPROBE
    unsigned long long tq_ = 0ull, tp_ = __builtin_amdgcn_s_memrealtime();
#define SEAM(k) do { if (COOP && IN(k) && IN((k) + 1)) { const unsigned long long t1_ = __builtin_amdgcn_s_memrealtime(); if ((MK_TW >> (k)) & 1u) tq_ += t1_ - tp_; xcd_barrier(bar); \
        const unsigned long long t2_ = __builtin_amdgcn_s_memrealtime(); if ((MK_TB >> (k)) & 1u) tq_ += t2_ - t1_; tp_ = t2_; } } while (0)
#else
#define SEAM(k) do { if (COOP && IN(k) && IN((k) + 1)) xcd_barrier(bar); } while (0)
#endif

    if (IN(0)) REP(0) {
        const int lane = LANE_, wave = WAVE_, gw = GW_;
        do_transposes(a, ws, lds, 0, TR_A_END, gw, NGW, wave, lane);
        rowpass<2 | 4 | 64, 0, 0>(nullptr, nullptr, nullptr, nullptr, a.in[0], a.in[1], HB, RS, nullptr, nullptr, 0.f, gw, NGW, lane);
    }
    SEAM(0);
    const int bid = (int)blockIdx.x;
#define GEMM_FULL(EPI, Aop, Bop, KK, MM, NN, ...) do { pg8::Gemm g_{Aop, Bop, KK, KK}; pg8::StaticOrder S_; S_.init(MM, NN, G, bid); pg8::EPI E_{__VA_ARGS__}; \
        pg8::gemm_phase<pg8::EPI, pg8::StaticOrder, true, true>(lds, g_, S_, E_); } while (0)
#define GEMM_SPLIT(Aop, Bop, KK, NSL, S0, S1, N0) do { pg8::Gemm g_{Aop, Bop, KK, 256}; pg8::SubOrder S_{64, 4, 4, NSL, G, bid}; pg8::EpiF32Slab E_{S0, S1, N0, 64}; \
        pg8::gemm_phase<pg8::EpiF32Slab, pg8::SubOrder, true, true>(lds, g_, S_, E_); } while (0)
    bf16_t* const YCF = YC;
    if (IN(1)) { REP(1) GEMM_FULL(EpiSwiglu, HB, WGU1, DM, M_, NGU, ACT, FF);
        { const int nwg = (M_ / 256) * (NGU / 256), rem = nwg % G, nidle = rem ? G - rem : G, idx = rem ? bid - rem : bid;
          if (idx >= 0) do_transposes(a, ws, lds, TR_A_END, TR_B_END, idx * 8 + WAVE_, nidle * 8, WAVE_, LANE_); } }
    SEAM(1);
    if (IN(2)) REP(2) { GEMM_FULL(EpiBf16, ACT, WD1, FF, MP_, DM, DB, DM, nullptr); GEMM_SPLIT(ACT, WD1, FF, 11, YCF, SLAB2, 8); }
    SEAM(2);
    if (IN(3)) rowpass<1 | 4 | 32 | 64, 11, 8>(DB, YCF, SLAB2, nullptr, nullptr, nullptr, HB, RS, nullptr, a.in[6], 0.5f, GW_, NGW, LANE_);
    SEAM(3);
    if (IN(4)) { REP(4) GEMM_FULL(EpiBf16, HB, WIN, DM, M_, NIN, PROJ, NIN, nullptr);
        { const int nwg = (M_ / 256) * (NIN / 256), rem = nwg % G, nidle = rem ? G - rem : G, idx = rem ? bid - rem : bid;
          if (idx >= 0) do_transposes(a, ws, lds, TR_B_END, TR_C_END, idx * 8 + WAVE_, nidle * 8, WAVE_, LANE_); } }
    SEAM(4);
    if (IN(5)) REP(5) mixer_phase(a, lds, PROJ, YC, WAVE_, LANE_, MIXTQ_);
    SEAM(5);
#ifdef MK_XBAR
#pragma nounroll
    for (int xb_ = 0; xb_ < MK_XBAR; ++xb_) xcd_barrier(bar);
#endif
    if (IN(6)) { REP(6) { GEMM_FULL(EpiBf16, YC, WOUT, DM, MP_, DM, DB, DM, nullptr); GEMM_SPLIT(YC, WOUT, DM, 4, SLAB4, SLAB4, 4); }
        if (G > 64 && bid >= 64) do_transposes(a, ws, lds, TR_C_END, TR_D_END, (bid - 64) * 8 + WAVE_, (G - 64) * 8, WAVE_, LANE_);
        else if (G <= 64) do_transposes(a, ws, lds, TR_C_END, TR_D_END, bid * 8 + WAVE_, G * 8, WAVE_, LANE_); }
    SEAM(6);
    if (IN(7)) rowpass<1 | 4 | 32 | 64, 4, 4>(DB, SLAB4, SLAB4, nullptr, nullptr, nullptr, HB, RS, nullptr, a.in[11], 1.0f, GW_, NGW, LANE_);
    SEAM(7);
    if (IN(8)) { REP(8) GEMM_FULL(EpiSwiglu, HB, WGU2, DM, M_, NGU, ACT, FF);
        { const int nwg = (M_ / 256) * (NGU / 256), rem = nwg % G, nidle = rem ? G - rem : G, idx = rem ? bid - rem : bid;
          if (idx >= 0) { const int lane = LANE_, w0 = idx * 8 + WAVE_, nw = nidle * 8;
            for (int m0 = w0; m0 < M_; m0 += 8 * nw) {
                f32x4 v[8];
#pragma unroll
                for (int q = 0; q < 8; ++q) { const int m = m0 + q * nw; if (m < M_) { const float* pr = (m < MP_) ? a.in[2] + (size_t)m * PLE : a.in[3] + (size_t)(m - MP_) * PLE; v[q] = ((const f32x4*)pr)[lane]; } }
#pragma unroll
                for (int q = 0; q < 8; ++q) { const int m = m0 + q * nw; if (m < M_) { u32x2 w; w.x = cvt_pk_bf16(v[q].x, v[q].y); w.y = cvt_pk_bf16(v[q].z, v[q].w); ((u32x2*)(PB + (size_t)m * PLE))[lane] = w; } } } } } }
    SEAM(8);
    if (IN(9)) REP(9) { GEMM_FULL(EpiBf16, ACT, WD2, FF, MP_, DM, DB, DM, nullptr); GEMM_SPLIT(ACT, WD2, FF, 11, YCF, SLAB2, 8); }
    SEAM(9);
    if (IN(10)) {
        rowpass<1 | 4 | 32, 11, 8>(DB, YCF, SLAB2, nullptr, nullptr, nullptr, HB, RS, nullptr, a.in[21], 0.5f, GW_, NGW, LANE_);
    }
    SEAM(10);
    if (IN(11)) REP(11) { GEMM_FULL(EpiBf16N, PB, WPP, PLE, MP_, DM, PP, DM);
        { pg8::Gemm g_{PB, WPP, PLE, PLE}; pg8::SubOrder S_{64, 4, 4, 1, G, (bid >= 64 && bid < 80) ? bid - 64 : -1}; pg8::EpiBf16N E_{PP, DM};
          pg8::gemm_phase<pg8::EpiBf16N, pg8::SubOrder, true, true>(lds, g_, S_, E_); } }
    if (IN(12)) REP(12) { GEMM_FULL(EpiPle, HB, WPG, DM, MP_, DM, DB, PP, DM); GEMM_SPLIT(HB, WPG, DM, 4, SLAB4, SLAB4, 4); }
    SEAM(12);
    if (IN(13)) rowpass<1 | 8 | 16, 4, 4>(DB, SLAB4, SLAB4, PP, nullptr, nullptr, HB, nullptr, a.out, a.in[27], 1.0f, GW_, NGW, LANE_);
#ifdef MK_TPROBE
    if (blockIdx.x == 0) { const unsigned long long t1_ = __builtin_amdgcn_s_memrealtime(); if ((MK_TW >> 13) & 1u) tq_ += t1_ - tp_;
        while (__builtin_amdgcn_s_memrealtime() - t1_ < 4ull * tq_) __builtin_amdgcn_s_sleep(8); }
#endif
#undef IN
#undef SEAM
}

extern "C" void kernel_launch(void* const* d_in, const int* in_sizes, int n_in, void* d_out, int out_size, void* d_ws, size_t ws_size, hipStream_t stream) {
    static int grid = 0;
    if (grid == 0) {
        if (n_in != 28 || out_size != 19013632 || ws_size < WS_TOTAL) { fprintf(stderr, "kernel_launch: unexpected shapes: n_in %d out %d ws %zu (need %zu)\n", n_in, out_size, ws_size, (size_t)WS_TOTAL); grid = -1; return; }
        int dev = 0, cus = 0, per_cu = 0;
        if (hipGetDevice(&dev) != hipSuccess || hipDeviceGetAttribute(&cus, hipDeviceAttributeMultiprocessorCount, dev) != hipSuccess) { fprintf(stderr, "kernel_launch: device query failed\n"); grid = -1; return; }
        if (hipFuncSetAttribute((const void*)fwd_kernel<true>, hipFuncAttributeMaxDynamicSharedMemorySize, LDS_BYTES) != hipSuccess) { fprintf(stderr, "kernel_launch: hipFuncSetAttribute failed\n"); grid = -1; return; }
        if (hipOccupancyMaxActiveBlocksPerMultiprocessor(&per_cu, (const void*)fwd_kernel<true>, 512, LDS_BYTES) != hipSuccess || per_cu < 1) { fprintf(stderr, "kernel_launch: occupancy query says %d blocks per CU\n", per_cu); per_cu = 1; }
        (void)hipGetLastError();
        grid = cus * per_cu;
        fprintf(stderr, "kernel_launch: grid %d (cus %d x %d)\n", grid, cus, per_cu);
    }
    if (grid < 0) return;
    Args a{};
    for (int i = 0; i < 28; ++i) a.in[i] = (const float*)d_in[i];
    a.out = (float*)d_out; a.ws = (unsigned char*)d_ws;
#if MK_COOP
    if (hipMemsetAsync((char*)d_ws + WS_BAR, 0, (size_t)XCD_BAR_WORDS * 4, stream) != hipSuccess) { fprintf(stderr, "kernel_launch: memset of the barrier words failed\n"); return; }
    a.ph_lo = 0; a.ph_hi = NPHASE;
    void* args[] = {&a};
    const hipError_t e = hipLaunchCooperativeKernel((const void*)fwd_kernel<true>, dim3(grid), dim3(512), args, LDS_BYTES, stream);
    if (e != hipSuccess) fprintf(stderr, "kernel_launch: cooperative launch failed: %s (grid %d)\n", hipGetErrorString(e), grid);
#endif
}
```

```cpp
#include <hip/hip_runtime.h>
#include <hip/hip_cooperative_groups.h>
#include <cstdio>
#include <cstdint>
namespace cg = cooperative_groups;
#define MK_DUP 0u
namespace pg8 {
#define PG8_LAS __attribute__((address_space(3)))
typedef unsigned short bf16_t;
typedef short bf16x8 __attribute__((ext_vector_type(8)));
typedef float f32x4 __attribute__((ext_vector_type(4)));
typedef unsigned u32x4 __attribute__((ext_vector_type(4)));
constexpr int BM = 256, BK = 64, HALF = 128, HTB = HALF * BK * 2  , STAGE_BYTES = 8 * HTB, NXCD = 8, WGM = 8;

__host__ __device__ __forceinline__ int lds_byte(int r, int c) { const int st = (r >> 4) * 2 + (c >> 5), rr = r & 15, cc = c & 31, ob = rr * 64 + cc * 2; return st * 1024 + (ob ^ (((ob >> 9) & 1) << 5)); }
__host__ __device__ __forceinline__ void stage_rc(int b, int& R, int& C) { const int st = b / 1024, sb = b % 1024, swz = sb ^ (((sb >> 9) & 1) << 5); R = (st >> 1) * 16 + swz / 64; C = (st & 1) * 32 + (swz % 64) / 2; }
__host__ __device__ __forceinline__ int perm32(int rho) { const int n = rho >> 4, i = rho & 15; return 8 * (i >> 2) + 4 * n + (i & 3); }

struct Unit { int pm, pn, ks, kind; };
struct Gemm { const bf16_t* A; const bf16_t* Bt; int ld, K, kslice; };

struct StaticOrder {
    int nM, nN, nwg, G, c;
    __host__ __device__ void init(int M, int N, int G_, int c_) { nM = M / BM; nN = N / BM; nwg = nM * nN; G = G_; c = c_; }
    __host__ __device__ bool next(int i, Unit& u) const {
        const long L = (long)i * G + c; if (L >= nwg) return false;
        int wgid = (int)L; { const int q = nwg / NXCD, r = nwg % NXCD, xcd = wgid % NXCD, off = wgid / NXCD; wgid = (xcd < r ? xcd * (q + 1) : r * (q + 1) + (xcd - r) * q) + off; }
        const int nig = WGM * nN, gid = wgid / nig, fm = gid * WGM, gsz = (nM - fm) < WGM ? (nM - fm) : WGM;
        u.pm = fm + ((wgid % nig) % gsz); u.pn = (wgid % nig) / gsz; u.ks = 0; u.kind = 0; return true;
    }
    __device__ __forceinline__ void a_ready(const Unit&) const {}
    __device__ __forceinline__ void done(const Unit&) const {}
};
struct SubOrder {
    int pm0, npm, nN, nsl, G, c;
    __host__ __device__ bool next(int i, Unit& u) const {
        const int L = i * G + c; if (c < 0 || L >= npm * nN * nsl) return false;
        const int t = L / nsl; u.ks = L - t * nsl; u.pn = t % nN; u.pm = pm0 + t / nN; u.kind = (nsl > 1) ? 1 : 0; return true;
    }
    __device__ __forceinline__ void a_ready(const Unit&) const {}
    __device__ __forceinline__ void done(const Unit&) const {}
};
struct ComboOrder {
    StaticOrder full; SubOrder sub;
    __host__ __device__ bool next(int i, Unit& u) const {
        if (full.next(i, u)) return true;
        const int nf = (full.c < full.nwg) ? (full.nwg - full.c + full.G - 1) / full.G : 0;
        return sub.next(i - nf, u);
    }
    __device__ __forceinline__ void a_ready(const Unit&) const {}
    __device__ __forceinline__ void done(const Unit&) const {}
};
typedef unsigned u32x2 __attribute__((ext_vector_type(2)));

__device__ __forceinline__ unsigned cvt_pk_bf16(float lo, float hi) { unsigned r; asm("v_cvt_pk_bf16_f32 %0, %1, %2" : "=v"(r) : "v"(lo), "v"(hi)); return r; }
__device__ __forceinline__ float sigmoid_f(float x) { return __builtin_amdgcn_rcpf(1.0f + __builtin_amdgcn_exp2f(x * -1.44269504089f)); }

#ifndef MK_WT
#define MK_WT 0
#endif
typedef __attribute__((__vector_size__(4 * sizeof(int)))) int rsrc_t;
constexpr int WT_AUX = MK_WT ? 16 : 0;
__device__ __forceinline__ auto mk_rsrc(const void* base) { return __builtin_amdgcn_make_buffer_rsrc((void*)base, 0, 0x7fffffff, 0x00020000); }
#define ST16(rsrc, byteoff, v) __builtin_amdgcn_raw_buffer_store_b128(__builtin_bit_cast(u32x4, v), rsrc, (int)(byteoff), 0, pg8::WT_AUX)
#define ST8(rsrc, byteoff, v)  __builtin_amdgcn_raw_buffer_store_b64(__builtin_bit_cast(u32x2, v), rsrc, (int)(byteoff), 0, pg8::WT_AUX)

struct EpiF32 {
    static constexpr bool PERM = false, AFTER_DRAIN = false;
    float* C; int ldc;
    __device__ __forceinline__ void operator()(const f32x4 (&acc)[2][2][4][2], const Unit& u, int wr, int wc, int fr_, int fq_) const {
        int tl_ = threadIdx.x; asm volatile("" : "+v"(tl_)); const int fr = tl_ & 15, fq = (tl_ >> 4) & 3;
        const int row0 = u.pm * BM + wr * 64 + fr, col0 = u.pn * BM + wc * 32 + 4 * fq; float* const Cb_ = C;
#pragma unroll
        for (int ai = 0; ai < 2; ++ai)
#pragma unroll
            for (int m = 0; m < 4; ++m) { const unsigned ro = ((unsigned)(row0 + ai * HALF + m * 16) * (unsigned)ldc + (unsigned)col0) * 4u;
#pragma unroll
                for (int bj = 0; bj < 2; ++bj)
#pragma unroll
                    for (int n = 0; n < 2; ++n) *(f32x4*)((char*)Cb_ + ro + (bj * HALF + n * 16) * 4) = acc[ai][bj][m][n]; }
    }
};
struct EpiBf16N {
    static constexpr bool PERM = false, AFTER_DRAIN = false;
    bf16_t* O; int ldc;
    __device__ __forceinline__ void operator()(const f32x4 (&acc)[2][2][4][2], const Unit& u, int wr, int wc, int fr_, int fq_) const {
        int tl_ = threadIdx.x; asm volatile("" : "+v"(tl_)); const int fr = tl_ & 15, fq = (tl_ >> 4) & 3;
        const int row0 = u.pm * BM + wr * 64 + fr, col0 = u.pn * BM + wc * 32 + 4 * fq;
#pragma unroll
        for (int ai = 0; ai < 2; ++ai)
#pragma unroll
            for (int m = 0; m < 4; ++m) { const size_t off = (size_t)(row0 + ai * HALF + m * 16) * ldc + col0;
#pragma unroll
                for (int bj = 0; bj < 2; ++bj)
#pragma unroll
                    for (int n = 0; n < 2; ++n) { const f32x4 a = acc[ai][bj][m][n]; u32x2 w; w.x = cvt_pk_bf16(a.x, a.y); w.y = cvt_pk_bf16(a.z, a.w); *(u32x2*)(O + off + bj * HALF + n * 16) = w; } }
    }
};
struct EpiPle {
    static constexpr bool PERM = false, AFTER_DRAIN = false;
    bf16_t* T; const bf16_t* P; int ldc;
    __device__ __forceinline__ void operator()(const f32x4 (&acc)[2][2][4][2], const Unit& u, int wr, int wc, int fr_, int fq_) const {
        int tl_ = threadIdx.x; asm volatile("" : "+v"(tl_)); const int fr = tl_ & 15, fq = (tl_ >> 4) & 3;
        const int row0 = u.pm * BM + wr * 64 + fr, col0 = u.pn * BM + wc * 32 + 4 * fq;
#pragma unroll
        for (int ai = 0; ai < 2; ++ai)
#pragma unroll
            for (int m = 0; m < 4; ++m) { const size_t off = (size_t)(row0 + ai * HALF + m * 16) * ldc + col0;
#pragma unroll
                for (int bj = 0; bj < 2; ++bj)
#pragma unroll
                    for (int n = 0; n < 2; ++n) { const u32x2 pw = *(const u32x2*)(P + off + bj * HALF + n * 16); const f32x4 a = acc[ai][bj][m][n];
                        const f32x4 p = {__uint_as_float(pw.x << 16), __uint_as_float(pw.x & 0xffff0000u), __uint_as_float(pw.y << 16), __uint_as_float(pw.y & 0xffff0000u)};
                        u32x2 w; w.x = cvt_pk_bf16(sigmoid_f(a.x) * p.x, sigmoid_f(a.y) * p.y); w.y = cvt_pk_bf16(sigmoid_f(a.z) * p.z, sigmoid_f(a.w) * p.w);
                        *(u32x2*)(T + off + bj * HALF + n * 16) = w; } }
    }
};
template <bool PERM_> struct EpiSlabT {
    static constexpr bool PERM = PERM_, AFTER_DRAIN = false;
    bf16_t* base0; bf16_t* base1; int n0; int pm0;
    __device__ __forceinline__ void operator()(const f32x4 (&acc)[2][2][4][2], const Unit& u, int wr, int wc, int fr_, int fq_) const {
        int tl_ = threadIdx.x; asm volatile("" : "+v"(tl_)); const int fr = tl_ & 15, fq = (tl_ >> 4) & 3;
        const int row0 = (u.pm - pm0) * BM + wr * 64 + fr, col0 = u.pn * BM + wc * 32 + (PERM_ ? 8 : 4) * fq;
        bf16_t* const Cb_ = (u.ks < n0) ? base0 + ((size_t)u.ks << 20) : base1 + ((size_t)(u.ks - n0) << 20);
#pragma unroll
        for (int ai = 0; ai < 2; ++ai)
#pragma unroll
            for (int m = 0; m < 4; ++m) { const unsigned ro = ((unsigned)(row0 + ai * HALF + m * 16) * 1024u + (unsigned)col0) * 2u;
#pragma unroll
                for (int bj = 0; bj < 2; ++bj)
#pragma unroll
                    for (int n = 0; n < 2; ++n) { const f32x4 a = acc[ai][bj][m][n]; u32x2 w; w.x = cvt_pk_bf16(a.x, a.y); w.y = cvt_pk_bf16(a.z, a.w);
                        *(u32x2*)((char*)Cb_ + ro + (bj * HALF + n * (PERM_ ? 4 : 16)) * 2) = w; } }
    }
};
struct EpiBf16 {
    static constexpr bool PERM = true, AFTER_DRAIN = false;
    bf16_t* O; int ldc; const float* rs;
    __device__ __forceinline__ void operator()(const f32x4 (&acc)[2][2][4][2], const Unit& u, int wr, int wc, int fr_, int fq_) const {
        int tl_ = threadIdx.x; asm volatile("" : "+v"(tl_)); const int fr = tl_ & 15, fq = (tl_ >> 4) & 3;
        const int row0 = u.pm * BM + wr * 64 + fr, col0 = u.pn * BM + wc * 32 + 8 * fq; const auto rs_ = mk_rsrc(O);
#pragma unroll
        for (int ai = 0; ai < 2; ++ai)
#pragma unroll
            for (int m = 0; m < 4; ++m) { const int row = row0 + ai * HALF + m * 16; const unsigned ro = ((unsigned)row * (unsigned)ldc + (unsigned)col0) * 2u; const float r = rs ? rs[row] : 1.0f;
#pragma unroll
                for (int bj = 0; bj < 2; ++bj) { const f32x4 v0 = acc[ai][bj][m][0] * r, v1 = acc[ai][bj][m][1] * r;
                    u32x4 w; w.x = cvt_pk_bf16(v0[0], v0[1]); w.y = cvt_pk_bf16(v0[2], v0[3]); w.z = cvt_pk_bf16(v1[0], v1[1]); w.w = cvt_pk_bf16(v1[2], v1[3]);
                    ST16(rs_, ro + bj * HALF * 2, w); } }
    }
};
struct EpiSwiglu {
    static constexpr bool PERM = true, AFTER_DRAIN = false;
    bf16_t* O; int ldc;
    static __device__ __forceinline__ f32x4 silu_mul(f32x4 g, f32x4 u) {
        const f32x4 gc = __builtin_elementwise_max(g, (f32x4){-40.f, -40.f, -40.f, -40.f});
        const f32x4 t = gc * -1.44269504089f;
        f32x4 e; e.x = __builtin_amdgcn_exp2f(t.x); e.y = __builtin_amdgcn_exp2f(t.y); e.z = __builtin_amdgcn_exp2f(t.z); e.w = __builtin_amdgcn_exp2f(t.w);
        const f32x4 d = e + 1.0f;
        const float r01 = __builtin_amdgcn_rcpf(d.x * d.y), r23 = __builtin_amdgcn_rcpf(d.z * d.w);
        const f32x4 sg = {d.y * r01, d.x * r01, d.w * r23, d.z * r23};
        return (gc * sg) * u;
    }
    __device__ __forceinline__ void operator()(const f32x4 (&acc)[2][2][4][2], const Unit& u, int wr, int wc, int fr_, int fq_) const {
        int tl_ = threadIdx.x; asm volatile("" : "+v"(tl_)); const int fr = tl_ & 15, fq = (tl_ >> 4) & 3;
        const int row0 = u.pm * BM + wr * 64 + fr, col0 = u.pn * HALF + wc * 32 + 8 * fq; const auto rs_ = mk_rsrc(O);
#pragma unroll
        for (int ai = 0; ai < 2; ++ai)
#pragma unroll
            for (int m = 0; m < 4; ++m) { const unsigned ro = ((unsigned)(row0 + ai * HALF + m * 16) * (unsigned)ldc + (unsigned)col0) * 2u;
                const f32x4 v0 = silu_mul(acc[ai][0][m][0], acc[ai][1][m][0]), v1 = silu_mul(acc[ai][0][m][1], acc[ai][1][m][1]);
                u32x4 w; w.x = cvt_pk_bf16(v0[0], v0[1]); w.y = cvt_pk_bf16(v0[2], v0[3]); w.z = cvt_pk_bf16(v1[0], v1[1]); w.w = cvt_pk_bf16(v1[2], v1[3]);
                ST16(rs_, ro, w); }
    }
};
template <class E0, class E1> struct EpiCombo {
    static_assert(E0::PERM == E1::PERM, "one staging order per phase");
    static constexpr bool PERM = E0::PERM, AFTER_DRAIN = false;
    E0 e0; E1 e1;
    __device__ __forceinline__ void operator()(const f32x4 (&acc)[2][2][4][2], const Unit& u, int wr, int wc, int fr, int fq) const {
        if (u.kind == 0) e0(acc, u, wr, wc, fr, fq); else e1(acc, u, wr, wc, fr, fq);
    }
};

template <class Epi, class Sched, bool ALIGN_EPI = false, bool SP2 = false>
__device__ __forceinline__ void gemm_phase(PG8_LAS unsigned char* lds, const Gemm g, const Sched& S, const Epi& E) {
    int tid_ = threadIdx.x; asm volatile("" : "+v"(tid_));
    const int tid = tid_, wid = __builtin_amdgcn_readfirstlane(tid >> 6), lane = tid & 63, wr = wid >> 2, wc = wid & 3, fr = lane & 15, fq = lane >> 4;
    const int K = g.K, nt = K / BK;
    unsigned voffA[2], voffB[2];
#pragma unroll
    for (int i = 0; i < 2; ++i) { int R, C; stage_rc(tid * 16 + i * 8192, R, C); const int Rb = Epi::PERM ? ((R & ~31) + perm32(R & 31)) : R;
        voffA[i] = (unsigned)(R * g.ld + C) * 2u; voffB[i] = (unsigned)(Rb * g.ld + C) * 2u; }
    const size_t kstep = (size_t)(BK * 2);
    const size_t hstepA = (size_t)HALF * g.ld * 2, hstepB = hstepA;
    const size_t kslice = (size_t)g.kslice * 2;
    const unsigned ldsw = (unsigned)wid * 1024u;
    const int aoff = lds_byte(wr * 64 + fr, fq * 8), boff = lds_byte(wc * 32 + fr, fq * 8);
#define PG8_SA(b, h) (((b) * 2 + (h)) * HTB)
#define PG8_SB(b, h) ((4 + (b) * 2 + (h)) * HTB)
#define PG8_STAGE(bufoff, gbase, voff) do { _Pragma("unroll") for (int _i = 0; _i < 2; ++_i) \
        __builtin_amdgcn_global_load_lds((const unsigned*)((const char*)(gbase) + (voff)[_i]), (PG8_LAS unsigned*)(lds + (bufoff) + ldsw + _i * 8192), 16, 0, 0); } while (0)
#define PG8_LDA(dst, b, h) do { _Pragma("unroll") for (int m = 0; m < 4; ++m) _Pragma("unroll") for (int k = 0; k < 2; ++k) dst[m][k] = *(const PG8_LAS bf16x8*)(lds + PG8_SA(b, h) + aoff + m * 2048 + k * 1024); } while (0)
#define PG8_LDB(dst, b, h) do { _Pragma("unroll") for (int n = 0; n < 2; ++n) _Pragma("unroll") for (int k = 0; k < 2; ++k) dst[n][k] = *(const PG8_LAS bf16x8*)(lds + PG8_SB(b, h) + boff + n * 2048 + k * 1024); } while (0)
#define PG8_MMA(ai, bj, At, Bt) do { __builtin_amdgcn_s_setprio(1); _Pragma("unroll") for (int m = 0; m < 4; ++m) _Pragma("unroll") for (int n = 0; n < 2; ++n) _Pragma("unroll") for (int k = 0; k < 2; ++k) \
        acc[ai][bj][m][n] = __builtin_amdgcn_mfma_f32_16x16x32_bf16(Bt[n][k], At[m][k], acc[ai][bj][m][n], 0, 0, 0); __builtin_amdgcn_s_setprio(0); } while (0)
#define PG8_WAIT_V(n) asm volatile("s_waitcnt vmcnt(" #n ")" ::: "memory")
#define PG8_WAIT_L(n) asm volatile("s_waitcnt lgkmcnt(" #n ")" ::: "memory")
#define PG8_BAR __builtin_amdgcn_s_barrier()
#define PG8_SCHED __builtin_amdgcn_sched_barrier(0)
    Unit cur, nxt; int ui = 0;
    if (!S.next(0, cur)) return;
    f32x4 acc[2][2][4][2];
#pragma unroll
    for (int a = 0; a < 2; ++a)
#pragma unroll
        for (int b = 0; b < 2; ++b)
#pragma unroll
            for (int m = 0; m < 4; ++m)
#pragma unroll
                for (int n = 0; n < 2; ++n) acc[a][b][m][n] = (f32x4){0.f, 0.f, 0.f, 0.f};
    bf16x8 At[4][2], B0[2][2], B1[2][2];
    const char* cA = (const char*)g.A + (size_t)cur.pm * 2 * hstepA + (size_t)cur.ks * kslice; const char* cB = (const char*)g.Bt + (size_t)cur.pn * 2 * hstepB + (size_t)cur.ks * kslice;
    S.a_ready(cur);
    if constexpr (SP2) {
        PG8_STAGE(PG8_SB(0, 0), cB, voffB); PG8_STAGE(PG8_SB(0, 1), cB + hstepB, voffB); PG8_STAGE(PG8_SA(0, 0), cA, voffA); PG8_STAGE(PG8_SA(0, 1), cA + hstepA, voffA);
        if (wr == 1) PG8_BAR;
        PG8_WAIT_V(2); PG8_BAR;
        PG8_STAGE(PG8_SB(1, 0), cB + kstep, voffB); PG8_STAGE(PG8_SA(1, 0), cA + kstep, voffA); PG8_STAGE(PG8_SB(1, 1), cB + hstepB + kstep, voffB);
        PG8_WAIT_V(6); PG8_BAR;
    } else {
        PG8_STAGE(PG8_SB(0, 0), cB, voffB); PG8_STAGE(PG8_SA(0, 0), cA, voffA); PG8_STAGE(PG8_SB(0, 1), cB + hstepB, voffB); PG8_STAGE(PG8_SA(0, 1), cA + hstepA, voffA);
        if (wr == 1) PG8_BAR;
        PG8_WAIT_V(4); PG8_BAR;
        PG8_STAGE(PG8_SB(1, 0), cB + kstep, voffB); PG8_STAGE(PG8_SA(1, 0), cA + kstep, voffA); PG8_STAGE(PG8_SB(1, 1), cB + hstepB + kstep, voffB);
        PG8_WAIT_V(6); PG8_BAR;
    }
    for (;;) {
        const bool has_next = S.next(ui + 1, nxt);
        const char* nA = has_next ? (const char*)g.A + (size_t)nxt.pm * 2 * hstepA + (size_t)nxt.ks * kslice : cA; const char* nB = has_next ? (const char*)g.Bt + (size_t)nxt.pn * 2 * hstepB + (size_t)nxt.ks * kslice : cB;
        const int ntu = (cur.kind != 0) ? g.kslice / BK : nt;
        for (int t = 0; t < ntu; t += 2) {
            const bool last = (t == ntu - 2);
            const char* a1 = cA + (size_t)(t + 1) * kstep;
            const char* a2 = last ? nA : cA + (size_t)(t + 2) * kstep; const char* b2 = last ? nB : cB + (size_t)(t + 2) * kstep;
            const char* a3 = a2 + kstep; const char* b3 = b2 + kstep;
            if (last && has_next) S.a_ready(nxt);
            if constexpr (SP2) {
            PG8_LDB(B0, 0, 0); PG8_LDB(B1, 0, 1); PG8_SCHED; PG8_LDA(At, 0, 0); PG8_STAGE(PG8_SA(1, 1), a1 + hstepA, voffA);
            PG8_WAIT_V(8); PG8_WAIT_L(0); PG8_BAR; PG8_MMA(0, 0, At, B0); PG8_MMA(0, 1, At, B1); PG8_BAR; PG8_SCHED;
            PG8_LDA(At, 0, 1); PG8_STAGE(PG8_SB(0, 0), b2, voffB); PG8_STAGE(PG8_SB(0, 1), b2 + hstepB, voffB); PG8_STAGE(PG8_SA(0, 0), a2, voffA);
            PG8_WAIT_V(8); PG8_WAIT_L(0); PG8_BAR; PG8_MMA(1, 0, At, B0); PG8_MMA(1, 1, At, B1); PG8_BAR; PG8_SCHED;
            PG8_LDB(B0, 1, 0); PG8_LDB(B1, 1, 1); PG8_SCHED; PG8_LDA(At, 1, 0); PG8_STAGE(PG8_SA(0, 1), a2 + hstepA, voffA);
            PG8_WAIT_V(8); PG8_WAIT_L(0); PG8_BAR; PG8_MMA(0, 0, At, B0); PG8_MMA(0, 1, At, B1); PG8_BAR; PG8_SCHED;
            PG8_LDA(At, 1, 1); PG8_STAGE(PG8_SB(1, 0), b3, voffB); PG8_STAGE(PG8_SB(1, 1), b3 + hstepB, voffB); PG8_STAGE(PG8_SA(1, 0), a3, voffA);
            PG8_WAIT_V(8); PG8_WAIT_L(0); PG8_BAR; PG8_MMA(1, 0, At, B0); PG8_MMA(1, 1, At, B1); PG8_BAR; PG8_SCHED;
            } else {
            PG8_LDB(B0, 0, 0); PG8_SCHED; PG8_LDA(At, 0, 0); PG8_STAGE(PG8_SA(1, 1), a1 + hstepA, voffA);
            PG8_WAIT_L(8); PG8_BAR; PG8_WAIT_L(0); PG8_MMA(0, 0, At, B0); PG8_BAR; PG8_SCHED;
            PG8_LDB(B1, 0, 1); PG8_STAGE(PG8_SB(0, 0), b2, voffB);
            PG8_BAR; PG8_WAIT_L(0); PG8_MMA(0, 1, At, B1); PG8_BAR;
            PG8_LDA(At, 0, 1); PG8_STAGE(PG8_SA(0, 0), a2, voffA);
            PG8_BAR; PG8_WAIT_L(0); PG8_MMA(1, 0, At, B0); PG8_BAR; PG8_SCHED;
            PG8_STAGE(PG8_SB(0, 1), b2 + hstepB, voffB);
            PG8_WAIT_V(6); PG8_BAR; PG8_MMA(1, 1, At, B1); PG8_BAR;
            PG8_LDB(B0, 1, 0); PG8_SCHED; PG8_LDA(At, 1, 0); PG8_STAGE(PG8_SA(0, 1), a2 + hstepA, voffA);
            PG8_WAIT_L(8); PG8_BAR; PG8_WAIT_L(0); PG8_MMA(0, 0, At, B0); PG8_BAR; PG8_SCHED;
            PG8_LDB(B1, 1, 1); PG8_STAGE(PG8_SB(1, 0), b3, voffB);
            PG8_BAR; PG8_WAIT_L(0); PG8_MMA(0, 1, At, B1); PG8_BAR;
            PG8_LDA(At, 1, 1); PG8_STAGE(PG8_SA(1, 0), a3, voffA);
            PG8_BAR; PG8_WAIT_L(0); PG8_MMA(1, 0, At, B0); PG8_BAR; PG8_SCHED;
            PG8_STAGE(PG8_SB(1, 1), b3 + hstepB, voffB);
            PG8_WAIT_V(6); PG8_BAR; PG8_MMA(1, 1, At, B1); PG8_BAR;
            }
        }
        if constexpr (ALIGN_EPI) { if (wr == 0) PG8_BAR; }
        if constexpr (!Epi::AFTER_DRAIN) { E(acc, cur, wr, wc, fr, fq); S.done(cur); }
        if (!has_next) break;
#pragma unroll
        for (int a = 0; a < 2; ++a)
#pragma unroll
            for (int b = 0; b < 2; ++b)
#pragma unroll
                for (int m = 0; m < 4; ++m)
#pragma unroll
                    for (int n = 0; n < 2; ++n) acc[a][b][m][n] = (f32x4){0.f, 0.f, 0.f, 0.f};
        cur = nxt; cA = nA; cB = nB; ++ui;
        if constexpr (ALIGN_EPI) { if (wr == 1) PG8_BAR; }
    }
    PG8_WAIT_V(0);
    if constexpr (!ALIGN_EPI) { if (wr == 0) PG8_BAR; }
    PG8_BAR;
    if constexpr (Epi::AFTER_DRAIN) { E.fused(acc, cur, wr, wc, fr, fq, lds, wid, lane); S.done(cur); }
#undef PG8_SA
#undef PG8_SB
#undef PG8_STAGE
#undef PG8_LDA
#undef PG8_LDB
#undef PG8_MMA
#undef PG8_WAIT_V
#undef PG8_WAIT_L
#undef PG8_BAR
#undef PG8_SCHED
}
}

using pg8::bf16_t; using pg8::bf16x8; using pg8::f32x4; using pg8::u32x4; using pg8::u32x2; using pg8::cvt_pk_bf16;
#define LAS __attribute__((address_space(3)))
#define XB_TMO      128
#define XB_XCNT(j)  (256  + 64 * (j))
#define XB_XSUB(j)  (1280 + 64 * (j))
#define XB_XGEN(j)  (2304 + 64 * (j))
#define XB_TOP      3328
#define XB_TOPGEN   3392
#define XCD_BAR_WORDS 3456
#define XB_SPIN_CAP (1u << 18)

__device__ __forceinline__ unsigned xb_ld(unsigned* p)              { return __hip_atomic_load(p, __ATOMIC_RELAXED, __HIP_MEMORY_SCOPE_AGENT); }
__device__ __forceinline__ unsigned xb_add(unsigned* p, unsigned v) { return __hip_atomic_fetch_add(p, v, __ATOMIC_RELAXED, __HIP_MEMORY_SCOPE_AGENT); }
__device__ __forceinline__ unsigned xb_xcc_id() { return (unsigned)__builtin_amdgcn_s_getreg((3 << 11) | 20) & 0xFu; }
#define XB_SPIN(cond, bar) do { unsigned _sp = 0; while (cond) { __builtin_amdgcn_s_sleep(1); \
    if ((++_sp & 255u) == 0u) { if (xb_ld(&(bar)[XB_TMO])) break; if (_sp > XB_SPIN_CAP) { atomicAdd(&(bar)[XB_TMO], 1u); break; } } } } while (0)

struct XcdBarrier {
    unsigned* bar; unsigned x;
    volatile LAS unsigned* st;
};

__device__ __forceinline__ XcdBarrier xcd_barrier_post(unsigned* bar, volatile LAS unsigned* st) {
    XcdBarrier b; b.bar = bar; b.x = xb_xcc_id(); b.st = st;
    if (threadIdx.x == 0) (void)xb_add(&bar[XB_XCNT(b.x)], 1u);
    return b;
}
__device__ __forceinline__ void xcd_barrier_complete(unsigned* bar, unsigned x, unsigned& nloc, unsigned& nx) {
    const unsigned G = gridDim.x * gridDim.y * gridDim.z;
    unsigned sum, cnt, mine, sp = 0u;
    for (;;) {
        sum = 0u; cnt = 0u; mine = 0u;
#pragma unroll
        for (unsigned j = 0; j < 16; ++j) { const unsigned c = xb_ld(&bar[XB_XCNT(j)]); sum += c; cnt += (c > 0u) ? 1u : 0u; mine = (j == x) ? c : mine; }
        if (sum == G) break;
        __builtin_amdgcn_s_sleep(1);
        if ((++sp & 255u) == 0u) { if (xb_ld(&bar[XB_TMO])) break; if (sp > XB_SPIN_CAP) { atomicAdd(&bar[XB_TMO], 1u); break; } }
    }
    nloc = mine > 0u ? mine : 1u; nx = cnt > 0u ? cnt : 1u;
}

__device__ __forceinline__ void xcd_barrier(const XcdBarrier& b) {
    asm volatile("s_waitcnt vmcnt(0)" ::: "memory");
    __syncthreads();
    if (threadIdx.x == 0) {
        unsigned* bar = b.bar;
        __builtin_amdgcn_s_waitcnt(0);
        unsigned nloc = b.st[0], nx = b.st[1];
        if (nloc == 0u) { xcd_barrier_complete(bar, b.x, nloc, nx); b.st[0] = nloc; b.st[1] = nx; }
        const unsigned old = xb_add(&bar[XB_XSUB(b.x)], 1u);
        const unsigned gen = old / nloc;
        if (old + 1u == (gen + 1u) * nloc) {
            __builtin_amdgcn_fence(__ATOMIC_RELEASE, "agent");
            asm volatile("s_waitcnt vmcnt(0)" ::: "memory");
            const unsigned og = xb_add(&bar[XB_TOP], 1u);
            const unsigned tg = og / nx;
            if (og + 1u == (tg + 1u) * nx) xb_add(&bar[XB_TOPGEN], 1u);
            else XB_SPIN(xb_ld(&bar[XB_TOPGEN]) == tg, bar);
            __builtin_amdgcn_fence(__ATOMIC_ACQUIRE, "agent");
            xb_add(&bar[XB_XGEN(b.x)], 1u);
            asm volatile("s_waitcnt vmcnt(0)" ::: "memory");
        } else {
            XB_SPIN(xb_ld(&bar[XB_XGEN(b.x)]) == gen, bar);
            __builtin_amdgcn_fence(__ATOMIC_ACQUIRE, "agent");
            asm volatile("s_waitcnt vmcnt(0)" ::: "memory");
        }
    }
    __syncthreads();
}


#ifndef MK_DUP
#define MK_DUP 0u
#endif
#ifndef MK_COOP
#define MK_COOP 1
#endif
constexpr int M_ = 17408, MP_ = 16384, DM = 1024, FF = 2816, NGU = 5632, NIN = 2560, PLE = 256;
constexpr float EPS_ = 1e-6f;
constexpr int LDS_BYTES = 147456;
constexpr int NPHASE = 14;
constexpr size_t WS_WGU1 = 0;
constexpr size_t WS_WD1 = WS_WGU1 + (size_t)NGU * DM * 2;
constexpr size_t WS_WIN = WS_WD1 + (size_t)DM * FF * 2;
constexpr size_t WS_WOUT = WS_WIN + (size_t)NIN * DM * 2;
constexpr size_t WS_WGU2 = WS_WOUT + (size_t)DM * DM * 2;
constexpr size_t WS_WD2 = WS_WGU2 + (size_t)NGU * DM * 2;
constexpr size_t WS_WPG = WS_WD2 + (size_t)DM * FF * 2;
constexpr size_t WS_WPP = WS_WPG + (size_t)DM * DM * 2;
constexpr size_t WS_YC = WS_WPP + (size_t)DM * PLE * 2;
constexpr size_t WS_ACT = WS_YC + (size_t)M_ * DM * 2;
constexpr size_t WS_D = WS_ACT + (size_t)M_ * FF * 2;
constexpr size_t WS_HB = WS_D + (size_t)M_ * DM * 2;
constexpr size_t WS_SLAB2 = WS_HB + (size_t)M_ * DM * 2;
constexpr size_t WS_RS = WS_SLAB2 + (size_t)3 * 1024 * 1024 * 4;
constexpr size_t WS_END = WS_RS + (size_t)M_ * 4;
constexpr size_t WS_BAR = WS_END;
constexpr size_t WS_TOTAL = WS_BAR + (size_t)XCD_BAR_WORDS * 4;
constexpr size_t WS_PROJ = WS_ACT;
constexpr size_t WS_PP = WS_ACT;
constexpr size_t WS_PB = WS_YC + (size_t)16 * 1024 * 1024;
constexpr size_t WS_SLAB4 = WS_ACT + (size_t)M_ * DM * 4 + (size_t)M_ * PLE * 2;
static_assert(WS_SLAB4 + (size_t)4 * 1024 * 1024 * 4 <= WS_D && WS_PB + (size_t)M_ * PLE * 2 <= WS_ACT, "aliases fit");
constexpr size_t OUT_NCP = 17825792, OUT_NCS = 17833984, OUT_CVP = 17965056, OUT_CVS = 18489344;

struct Args { const float* in[28]; float* out; unsigned char* ws; int ph_lo, ph_hi; };

__device__ __forceinline__ float wave_sum(float v) {
#pragma unroll
    for (int o = 1; o < 64; o <<= 1) v += __shfl_xor(v, o);
    return v;
}
__device__ __forceinline__ float bf_lo(unsigned w) { return __uint_as_float(w << 16); }
__device__ __forceinline__ float bf_hi(unsigned w) { return __uint_as_float(w & 0xffff0000u); }
__device__ __forceinline__ float dot4(f32x4 a) { return (a.x * a.x + a.y * a.y) + (a.z * a.z + a.w * a.w); }
#define LDS_WAIT() asm volatile("s_waitcnt lgkmcnt(0)" ::: "memory")

struct TrItem { const float* W; bf16_t* WT; const float* gk; int K, N, k0, n0, drow0; };
__device__ __forceinline__ void tr_load(const TrItem& d, int lane, f32x4 (&v8)[8], float (&g8)[8]) {
#pragma unroll
    for (int i = 0; i < 8; ++i) { const int kk = 8 * i + (lane >> 3); v8[i] = __builtin_nontemporal_load((const f32x4*)(d.W + (size_t)(d.k0 + kk) * d.N + d.n0 + (lane & 7) * 4)); g8[i] = d.gk ? d.gk[d.k0 + kk] : 1.0f; }
}
__device__ __forceinline__ void tr_store(const TrItem& d, LAS float* scr, int lane, const f32x4 (&v8)[8], const float (&g8)[8]) {
#pragma unroll
    for (int i = 0; i < 8; ++i) { const int kk = 8 * i + (lane >> 3); LAS float* q = scr + kk * 33 + (lane & 7) * 4; const f32x4 v = v8[i] * g8[i]; q[0] = v.x; q[1] = v.y; q[2] = v.z; q[3] = v.w; }
    LDS_WAIT();
    const int c = lane & 7;
#pragma unroll
    for (int j = 0; j < 4; ++j) { const int n = (lane >> 3) + 8 * j; const LAS float* t = scr + (8 * c) * 33 + n;
        u32x4 o; o.x = cvt_pk_bf16(t[0 * 33], t[1 * 33]); o.y = cvt_pk_bf16(t[2 * 33], t[3 * 33]); o.z = cvt_pk_bf16(t[4 * 33], t[5 * 33]); o.w = cvt_pk_bf16(t[6 * 33], t[7 * 33]);
        *(u32x4*)(d.WT + (size_t)(d.drow0 + n) * d.K + d.k0 + 8 * c) = o; }
    LDS_WAIT();
}

__device__ __forceinline__ f32x4 bf4(unsigned a, unsigned b) { return (f32x4){bf_lo(a), bf_hi(a), bf_lo(b), bf_hi(b)}; }
template <int MODE>
__device__ __forceinline__ void rp_load_res(int m, const float* __restrict__ resP, const float* __restrict__ resS, const bf16_t* hb, int lane, f32x4 (&h)[4]) {
    if (MODE & 2) { const float* rrow = (m < MP_) ? resP + (size_t)m * DM : resS + (size_t)(m - MP_) * DM;
#pragma unroll
        for (int j = 0; j < 4; ++j) h[j] = __builtin_nontemporal_load((const f32x4*)rrow + lane + 64 * j); }
    else { const u32x2* hr = (const u32x2*)(hb + (size_t)m * DM) + lane;
#pragma unroll
        for (int j = 0; j < 4; ++j) { const u32x2 w = hr[64 * j]; h[j] = bf4(w.x, w.y); } }
}
__device__ __forceinline__ int vzero() { int z; asm volatile("v_mov_b32 %0, 0" : "=v"(z)); return z; }
template <int MODE>
__device__ __forceinline__ void rp_finish(int m, f32x4 (&h)[4], f32x4 (&d)[4], const f32x4 (&gp)[4], float sc, bf16_t* hb, float* rsv, float* __restrict__ outf, int lane, float hin_scale) {
    if (MODE & 32) {
#pragma unroll
        for (int j = 0; j < 4; ++j) h[j] *= hin_scale; }
    if (MODE & 1) {
        float ss = 0.f;
#pragma unroll
        for (int j = 0; j < 4; ++j) ss += dot4(d[j]);
        const float rs = sc * rsqrtf(wave_sum(ss) * (1.0f / DM) + EPS_);
#pragma unroll
        for (int j = 0; j < 4; ++j) h[j] += d[j] * rs * gp[j];
    }
    if (MODE & 4) {
        float s2 = 0.f;
#pragma unroll
        for (int j = 0; j < 4; ++j) s2 += dot4(h[j]);
        const float rs2 = rsqrtf(wave_sum(s2) * (1.0f / DM) + EPS_);
        if (lane == 0) rsv[m] = rs2;
        const float osc = (MODE & 64) ? rs2 : 1.0f;
        const auto hrs = pg8::mk_rsrc(hb); const unsigned ho = (unsigned)m * (DM * 2u) + (unsigned)lane * 8u;
#pragma unroll
        for (int j = 0; j < 4; ++j) { const f32x4 v = h[j] * osc; u32x2 w; w.x = cvt_pk_bf16(v.x, v.y); w.y = cvt_pk_bf16(v.z, v.w); ST8(hrs, ho + 512u * j, w); }
    }
    if (MODE & 8) { f32x4* ho = (f32x4*)(outf + (size_t)m * DM) + lane;
#pragma unroll
        for (int j = 0; j < 4; ++j) __builtin_nontemporal_store(h[j], ho + 64 * j); }
}
template <int MODE, int NSL, int N0>
__device__ __forceinline__ void rowpass(const bf16_t* __restrict__ dbuf, const bf16_t* slab0, const bf16_t* slab1, const bf16_t* __restrict__ pp, const float* __restrict__ resP, const float* __restrict__ resS,
                                        bf16_t* hb, float* rsv, float* __restrict__ outf, const float* __restrict__ gpost, float sc, int gw, int NGW, int lane) {
    f32x4 gp[4]; const int vz = vzero();
#pragma unroll
    for (int j = 0; j < 4; ++j) gp[j] = (MODE & 1) ? ((const f32x4*)gpost)[lane + 64 * j] : (f32x4){0.f, 0.f, 0.f, 0.f};
    constexpr int NR = 4;
    for (int m0 = gw; m0 < MP_; m0 += NR * NGW) {
        f32x4 hh[NR][4], dd[NR][4]; u32x2 ww[NR][4]; float isc[NR];
#pragma unroll
        for (int q = 0; q < NR; ++q) { const int m = m0 + q * NGW; isc[q] = 1.0f; if (m < MP_) { rp_load_res<MODE>(m, resP, resS, hb, lane, hh[q]); if (MODE & 32) isc[q] = rsv[m + vz]; } }
        if (MODE & 1) {
#pragma unroll
            for (int q = 0; q < NR; ++q) { const int m = m0 + q * NGW; if (m < MP_) { const u32x2* dr = (const u32x2*)(dbuf + (size_t)m * DM) + lane;
#pragma unroll
                for (int j = 0; j < 4; ++j) ww[q][j] = dr[64 * j]; } }
#pragma unroll
            for (int q = 0; q < NR; ++q)
#pragma unroll
                for (int j = 0; j < 4; ++j) dd[q][j] = bf4(ww[q][j].x, ww[q][j].y);
        }
#pragma unroll
        for (int q = 0; q < NR; ++q) { const int m = m0 + q * NGW; if (m < MP_) rp_finish<MODE>(m, hh[q], dd[q], gp, sc, hb, rsv, outf, lane, (MODE & 32) ? 1.0f / isc[q] : 1.0f); }
    }
    if (((gw & 1) == 0)) for (int r = (gw >> 3) * 4 + ((gw & 7) >> 1); r < M_ - MP_; r += (NGW >> 3) * 4) {
        const int m = MP_ + r;
        f32x4 h[4], d[4]; float isc1 = 1.0f;
        rp_load_res<MODE>(m, resP, resS, hb, lane, h);
        if (MODE & 32) isc1 = rsv[m + vz];
        if (MODE & 1) {
            u32x2 tq[4][NSL > 0 ? NSL : 1];
#pragma unroll
            for (int j = 0; j < 4; ++j)
#pragma unroll
                for (int s = 0; s < NSL; ++s) tq[j][s] = ((const u32x2*)(((s < N0) ? slab0 + ((size_t)s << 20) : slab1 + ((size_t)(s - N0) << 20)) + (size_t)r * DM))[lane + 64 * j];
#pragma unroll
            for (int j = 0; j < 4; ++j) { f32x4 acc = {0.f, 0.f, 0.f, 0.f};
#pragma unroll
                for (int s = 0; s < NSL; ++s) acc += bf4(tq[j][s].x, tq[j][s].y);
                d[j] = acc; }
            if (MODE & 16) { const u32x2* pr = (const u32x2*)(pp + (size_t)m * DM) + lane;
#pragma unroll
                for (int j = 0; j < 4; ++j) { const u32x2 pw = pr[64 * j]; const f32x4 p = bf4(pw.x, pw.y); d[j].x = pg8::sigmoid_f(d[j].x) * p.x; d[j].y = pg8::sigmoid_f(d[j].y) * p.y; d[j].z = pg8::sigmoid_f(d[j].z) * p.z; d[j].w = pg8::sigmoid_f(d[j].w) * p.w; } }
        }
        rp_finish<MODE>(m, h, d, gp, sc, hb, rsv, outf, lane, (MODE & 32) ? 1.0f / isc1 : 1.0f);
    }
}

#ifdef MK_TM
#define MIX_T(seg) do { const unsigned long long tn_ = __builtin_amdgcn_s_memrealtime(); if ((MK_TM >> (seg)) & 1u) *tqm += tn_ - tpm; tpm = tn_; } while (0)
#else
#define MIX_T(seg) do { } while (0)
#endif
__device__ __forceinline__ void mixer_phase(const Args& a, LAS unsigned char* lds, const bf16_t* __restrict__ PROJ, bf16_t* __restrict__ YC, int wave, int lane, unsigned long long* tqm) {
    unsigned long long tpm = 0ull;
    constexpr int VP = 1056;
    const auto ycrs = pg8::mk_rsrc(YC);
    LAS float* part = (LAS float*)(lds + 128 * VP);
    const int fr = lane & 15, fq = lane >> 4;
    const float* __restrict__ wsm = a.in[15]; const float* __restrict__ bsm = a.in[16];
    float* out = a.out;
    const int G_ = (int)gridDim.x, b_ = (int)blockIdx.x;
    for (int it = 0;; ++it) {
        int u, R0, nrows = 64;
        if (G_ == 256) { if (it == 0) { u = b_; R0 = u * 64; } else if (it == 1 && (b_ & 1) == 0 && b_ < 128) { u = 256; R0 = MP_ + 16 * (b_ >> 1); nrows = 16; } else break; }
        else { u = b_ + it * G_; if (u >= 272) break; R0 = u * 64; }
        const int ntb = nrows >> 4;
        const bool samp = (u >= 256);
#ifdef MK_TM
        tpm = __builtin_amdgcn_s_memrealtime();
#endif
        int s0 = 0, t0 = 0;
        if (!samp) { s0 = (u & 31) * 64; t0 = s0 & 127; }
        const int CB = R0 - t0, kext = t0 + 64;
        const int h = wave; const int nkb = kext >> 5;
        bf16x8 afr[4][4];
#pragma unroll
        for (int kb = 0; kb < 4; ++kb) {
#pragma unroll
            for (int tb = 0; tb < 4; ++tb) {
                f32x4 w0 = {0.f, 0.f, 0.f, 0.f}, w1 = w0; int lim = -1;
                if (kb < nkb) {
                    if (!samp) { const int tt = t0 + tb * 16 + fr, sb = kb * 32 + fq * 8; const float* wp = wsm + (size_t)(h * 128 + tt) * 128 + sb;
                        w0 = *(const f32x4*)wp; w1 = *(const f32x4*)(wp + 4); lim = tt - sb; }
                    else { const int tt = fr & 7; const float* wp = wsm + (size_t)(h * 128 + tt) * 128;
                        w0 = *(const f32x4*)wp; w1 = *(const f32x4*)(wp + 4); lim = ((kb * 4 + fq) == (tb * 2 + (fr >> 3))) ? tt : -1; }
                }
                w0.x = (0 <= lim) ? w0.x : 0.f; w0.y = (1 <= lim) ? w0.y : 0.f; w0.z = (2 <= lim) ? w0.z : 0.f; w0.w = (3 <= lim) ? w0.w : 0.f;
                w1.x = (4 <= lim) ? w1.x : 0.f; w1.y = (5 <= lim) ? w1.y : 0.f; w1.z = (6 <= lim) ? w1.z : 0.f; w1.w = (7 <= lim) ? w1.w : 0.f;
                u32x4 pk; pk.x = cvt_pk_bf16(w0.x, w0.y); pk.y = cvt_pk_bf16(w0.z, w0.w); pk.z = cvt_pk_bf16(w1.x, w1.y); pk.w = cvt_pk_bf16(w1.z, w1.w);
                afr[kb][tb] = __builtin_bit_cast(bf16x8, pk);
            }
        }
        {
            const f32x4 vg0 = *(const f32x4*)(a.in[14] + lane * 8), vg1 = *(const f32x4*)(a.in[14] + lane * 8 + 4);
            for (int sb8 = 0; sb8 < kext; sb8 += 64) {
                u32x4 raw8[8];
#pragma unroll
                for (int i = 0; i < 8; ++i) { int rr = CB + sb8 + i * 8 + wave; rr = rr < M_ ? rr : M_ - 1; raw8[i] = *(const u32x4*)(PROJ + (size_t)rr * NIN + 2048 + lane * 8); }
#pragma unroll
                for (int i = 0; i < 8; ++i) {
                    const int s = sb8 + i * 8 + wave, row = CB + s; const u32x4 raw = raw8[i];
                    f32x4 v0 = bf4(raw.x, raw.y), v1 = bf4(raw.z, raw.w);
                    float ss = dot4(v0) + dot4(v1);
                    ss += __shfl_xor(ss, 1); ss += __shfl_xor(ss, 2); ss += __shfl_xor(ss, 4);
                    const float rs = rsqrtf(ss * (1.0f / 64.0f) + EPS_);
                    v0 = v0 * rs * vg0; v1 = v1 * rs * vg1;
                    u32x4 pk; pk.x = cvt_pk_bf16(v0.x, v0.y); pk.y = cvt_pk_bf16(v0.z, v0.w); pk.z = cvt_pk_bf16(v1.x, v1.y); pk.w = cvt_pk_bf16(v1.z, v1.w);
                    *(LAS u32x4*)(lds + s * VP + lane * 16) = pk;
                    if (s >= t0 && s < t0 + nrows) {
                        if (samp) { float* o = out + OUT_CVS + (size_t)(row - MP_) * 512 + lane * 8; *(f32x4*)o = v0; *(f32x4*)(o + 4) = v1; }
                        else if (s0 - t0 == 1920) { float* o = out + OUT_CVP + (size_t)((u >> 5) * 128 + s) * 512 + lane * 8; *(f32x4*)o = v0; *(f32x4*)(o + 4) = v1; }
                    }
                }
            }
        }
        __syncthreads();
        MIX_T(0);
        f32x4 acc[4][4];
#pragma unroll
        for (int i = 0; i < 4; ++i)
#pragma unroll
            for (int j = 0; j < 4; ++j) acc[i][j] = (f32x4){0.f, 0.f, 0.f, 0.f};
#pragma unroll
        for (int kb = 0; kb < 4; ++kb) if (kb < nkb) {
            u32x2 r0[4], r1[4];
            { const unsigned ta = (unsigned)(uintptr_t)(lds + (kb * 32 + fq * 8 + (fr >> 2)) * VP + (h * 64 + (fr & 3) * 4) * 2);
              asm volatile("ds_read_b64_tr_b16 %0, %8\n\tds_read_b64_tr_b16 %1, %8 offset:4224\n\t"
                           "ds_read_b64_tr_b16 %2, %8 offset:32\n\tds_read_b64_tr_b16 %3, %8 offset:4256\n\t"
                           "ds_read_b64_tr_b16 %4, %8 offset:64\n\tds_read_b64_tr_b16 %5, %8 offset:4288\n\t"
                           "ds_read_b64_tr_b16 %6, %8 offset:96\n\tds_read_b64_tr_b16 %7, %8 offset:4320\n\ts_waitcnt lgkmcnt(0)"
                           : "=&v"(r0[0]), "=&v"(r1[0]), "=&v"(r0[1]), "=&v"(r1[1]), "=&v"(r0[2]), "=&v"(r1[2]), "=&v"(r0[3]), "=&v"(r1[3]) : "v"(ta) : "memory"); }
#pragma unroll
            for (int db = 0; db < 4; ++db) {
                u32x4 bq; bq.x = r0[db].x; bq.y = r0[db].y; bq.z = r1[db].x; bq.w = r1[db].y;
                const bf16x8 bfv = __builtin_bit_cast(bf16x8, bq);
#pragma unroll
                for (int tb = 0; tb < 4; ++tb) if (tb < ntb) acc[tb][db] = __builtin_amdgcn_mfma_f32_16x16x32_bf16(bfv, afr[kb][tb], acc[tb][db], 0, 0, 0);
            }
        }
#pragma unroll
        for (int tb = 0; tb < 4; ++tb) if (tb < ntb) {
            const int t = tb * 16 + fr; const int tt = samp ? (fr & 7) : (t0 + t); const float bias = bsm[h * 128 + tt];
            const bf16_t* up = PROJ + (size_t)(R0 + t) * NIN + 1536 + h * 64 + fq * 4;
            float s = 0.f;
#pragma unroll
            for (int db = 0; db < 4; ++db) { const u32x2 ur = *(const u32x2*)(up + db * 16); const f32x4 uu = bf4(ur.x, ur.y);
                const f32x4 y = uu * (acc[tb][db] + bias); acc[tb][db] = y; s += dot4(y); }
            s += __shfl_xor(s, 16); s += __shfl_xor(s, 32);
            if (fq == 0) part[h * 64 + t] = s;
        }
        __syncthreads();
        MIX_T(1);
#pragma unroll
        for (int tb = 0; tb < 4; ++tb) if (tb < ntb) {
            const int t = tb * 16 + fr; float tot = 0.f;
#pragma unroll
            for (int hh = 0; hh < 8; ++hh) tot += part[hh * 64 + t];
            const float rs = rsqrtf(tot * (1.0f / 512.0f) + EPS_);
            bf16_t* yp = YC + (size_t)(R0 + t) * DM + 512 + h * 64 + fq * 4;
#pragma unroll
            for (int db = 0; db < 4; ++db) { const f32x4 gb = *(const f32x4*)(a.in[18] + h * 64 + db * 16 + fq * 4); const f32x4 y = acc[tb][db] * rs * gb;
                u32x2 w; w.x = cvt_pk_bf16(y.x, y.y); w.y = cvt_pk_bf16(y.z, y.w); ST8(ycrs, (unsigned)((R0 + t) * DM + 512 + h * 64 + fq * 4 + db * 16) * 2u, w); }
        }
        MIX_T(2);
        if (wave * 8 < nrows)
        {
            const int c0 = lane * 8; const float* cw = a.in[13];
            const f32x4 w0a = *(const f32x4*)(cw + c0), w0b = *(const f32x4*)(cw + c0 + 4), w1a = *(const f32x4*)(cw + 512 + c0), w1b = *(const f32x4*)(cw + 512 + c0 + 4),
                        w2a = *(const f32x4*)(cw + 1024 + c0), w2b = *(const f32x4*)(cw + 1024 + c0 + 4);
            const f32x4 gaa = *(const f32x4*)(a.in[17] + c0), gab = *(const f32x4*)(a.in[17] + c0 + 4);
            f32x4 zp2a = {0.f, 0.f, 0.f, 0.f}, zp2b = zp2a, zp1a = zp2a, zp1b = zp2a;
            const int rb = R0 + wave * 8; const int sb_ = ((R0 - MP_) >> 3) + wave;
            if (samp) { const float* st = a.in[4] + (size_t)sb_ * 1024 + c0; zp2a = *(const f32x4*)st; zp2b = *(const f32x4*)(st + 4); zp1a = *(const f32x4*)(st + 512); zp1b = *(const f32x4*)(st + 516); }
            else if (s0 + wave * 8 > 0) {
                const bf16_t* p2 = PROJ + (size_t)(rb - 2) * NIN + c0; const bf16_t* p1 = p2 + NIN;
                const u32x4 c2 = *(const u32x4*)(p2 + 512), h2 = *(const u32x4*)(p2 + 1024), c1 = *(const u32x4*)(p1 + 512), h1 = *(const u32x4*)(p1 + 1024);
                zp2a = bf4(c2.x, c2.y) * bf4(h2.x, h2.y); zp2b = bf4(c2.z, c2.w) * bf4(h2.z, h2.w); zp1a = bf4(c1.x, c1.y) * bf4(h1.x, h1.y); zp1b = bf4(c1.z, c1.w) * bf4(h1.z, h1.w);
            }
            f32x4 ya[8], yb[8]; float ss[8];
            u32x4 braw8[8], craw8[8], hraw8[8];
#pragma unroll
            for (int i = 0; i < 8; ++i) { const bf16_t* pr = PROJ + (size_t)(rb + i) * NIN + c0; braw8[i] = *(const u32x4*)pr; craw8[i] = *(const u32x4*)(pr + 512); hraw8[i] = *(const u32x4*)(pr + 1024); }
#pragma unroll
            for (int i = 0; i < 8; ++i) {
                const u32x4 braw = braw8[i], craw = craw8[i], hraw = hraw8[i];
                const f32x4 za = bf4(craw.x, craw.y) * bf4(hraw.x, hraw.y), zb = bf4(craw.z, craw.w) * bf4(hraw.z, hraw.w);
                const f32x4 ca = w0a * zp2a + w1a * zp1a + w2a * za, cb = w0b * zp2b + w1b * zp1b + w2b * zb;
                ya[i] = bf4(braw.x, braw.y) * ca; yb[i] = bf4(braw.z, braw.w) * cb;
                ss[i] = wave_sum(dot4(ya[i]) + dot4(yb[i]));
                if (i >= 6) {
                    if (samp) { float* o = out + OUT_NCS + ((size_t)sb_ * 2 + (i - 6)) * 512 + c0; *(f32x4*)o = za; *(f32x4*)(o + 4) = zb; }
                    else if ((u & 31) == 31 && wave == 7) { float* o = out + OUT_NCP + ((size_t)(u >> 5) * 2 + (i - 6)) * 512 + c0; *(f32x4*)o = za; *(f32x4*)(o + 4) = zb; }
                }
                zp2a = zp1a; zp2b = zp1b; zp1a = za; zp1b = zb;
            }
#pragma unroll
            for (int i = 0; i < 8; ++i) {
                const float rs = rsqrtf(ss[i] * (1.0f / 512.0f) + EPS_);
                const f32x4 y0 = ya[i] * rs * gaa, y1 = yb[i] * rs * gab;
                u32x4 w; w.x = cvt_pk_bf16(y0.x, y0.y); w.y = cvt_pk_bf16(y0.z, y0.w); w.z = cvt_pk_bf16(y1.x, y1.y); w.w = cvt_pk_bf16(y1.z, y1.w);
                ST16(ycrs, (unsigned)((rb + i) * DM + c0) * 2u, w);
            }
        }
        __syncthreads();
        MIX_T(3);
    }
}

constexpr int TR_I_G = (DM / 64) * (FF / 32), TR_I_D = (FF / 64) * (DM / 32), TR_I_IN = (DM / 64) * (NIN / 32), TR_I_O = (DM / 64) * (DM / 32), TR_I_PP = (PLE / 64) * (DM / 32);
constexpr int TR_A_END = 2 * TR_I_G + TR_I_IN + TR_I_O, TR_B_END = TR_A_END + TR_I_D, TR_C_END = TR_B_END + TR_I_G + TR_I_D + TR_I_O + TR_I_PP, TR_D_END = TR_C_END + TR_I_G;
__device__ __forceinline__ void tr_decode(const Args& a, unsigned char* ws, int it, TrItem& d) {
    int r = it; int mode = 0; d.gk = nullptr;
    if (r < TR_I_G) { d.W = a.in[7]; d.K = DM; d.N = FF; d.WT = (bf16_t*)(ws + WS_WGU1); mode = 1; d.gk = a.in[5]; }
    else if ((r -= TR_I_G) < TR_I_G) { d.W = a.in[8]; d.K = DM; d.N = FF; d.WT = (bf16_t*)(ws + WS_WGU1); mode = 2; d.gk = a.in[5]; }
    else if ((r -= TR_I_G) < TR_I_IN) { d.W = a.in[12]; d.K = DM; d.N = NIN; d.WT = (bf16_t*)(ws + WS_WIN); d.gk = a.in[10]; }
    else if ((r -= TR_I_IN) < TR_I_O) { d.W = a.in[19]; d.K = DM; d.N = DM; d.WT = (bf16_t*)(ws + WS_WOUT); }
    else if ((r -= TR_I_O) < TR_I_D) { d.W = a.in[9]; d.K = FF; d.N = DM; d.WT = (bf16_t*)(ws + WS_WD1); }
    else if ((r -= TR_I_D) < TR_I_G) { d.W = a.in[23]; d.K = DM; d.N = FF; d.WT = (bf16_t*)(ws + WS_WGU2); mode = 2; d.gk = a.in[20]; }
    else if ((r -= TR_I_G) < TR_I_D) { d.W = a.in[24]; d.K = FF; d.N = DM; d.WT = (bf16_t*)(ws + WS_WD2); }
    else if ((r -= TR_I_D) < TR_I_O) { d.W = a.in[25]; d.K = DM; d.N = DM; d.WT = (bf16_t*)(ws + WS_WPG); }
    else if ((r -= TR_I_O) < TR_I_PP) { d.W = a.in[26]; d.K = PLE; d.N = DM; d.WT = (bf16_t*)(ws + WS_WPP); }
    else { r -= TR_I_PP; d.W = a.in[22]; d.K = DM; d.N = FF; d.WT = (bf16_t*)(ws + WS_WGU2); mode = 1; d.gk = a.in[20]; }
    const int nblk = d.N / 32, kb = r / nblk, nb = r % nblk; d.k0 = 64 * kb; d.n0 = 32 * nb;
    d.drow0 = mode ? (d.n0 >> 7) * 256 + (d.n0 & 127) + (mode == 2 ? 128 : 0) : d.n0;
}
__device__ __forceinline__ void do_transposes(const Args& a, unsigned char* ws, LAS unsigned char* lds, int first, int last, int widx, int nwaves, int wave, int lane) {
    LAS float* scr = (LAS float*)(lds + wave * 8448);
    int it = first + widx;
    if (it < last) {
        TrItem d0, d1; f32x4 v0[8], v1[8]; float g0[8], g1[8];
        tr_decode(a, ws, it, d0); tr_load(d0, lane, v0, g0);
        for (;;) {
            const bool m1 = it + nwaves < last;
            if (m1) { tr_decode(a, ws, it + nwaves, d1); tr_load(d1, lane, v1, g1); }
            tr_store(d0, scr, lane, v0, g0);
            if (!m1) break;
            it += nwaves;
            const bool m0 = it + nwaves < last;
            if (m0) { tr_decode(a, ws, it + nwaves, d0); tr_load(d0, lane, v0, g0); }
            tr_store(d1, scr, lane, v1, g1);
            if (!m0) break;
            it += nwaves;
        }
    }
}
__device__ __forceinline__ int fresh_tid() { int t = threadIdx.x; asm volatile("" : "+v"(t)); return t; }
template <bool COOP>
__global__ void __launch_bounds__(512, 2) fwd_kernel(Args a) {
    extern __shared__ __attribute__((aligned(16))) unsigned char lds_raw[];
    LAS unsigned char* lds = (LAS unsigned char*)lds_raw;
    const int tid = threadIdx.x;
    const int G = gridDim.x, NGW = G * 8;
#define LANE_ (fresh_tid() & 63)
#define WAVE_ (__builtin_amdgcn_readfirstlane(fresh_tid() >> 6))
#define GW_ ((int)blockIdx.x * 8 + WAVE_)
    unsigned char* ws = a.ws;
    bf16_t* WGU1 = (bf16_t*)(ws + WS_WGU1); bf16_t* WD1 = (bf16_t*)(ws + WS_WD1); bf16_t* WIN = (bf16_t*)(ws + WS_WIN); bf16_t* WOUT = (bf16_t*)(ws + WS_WOUT);
    bf16_t* WGU2 = (bf16_t*)(ws + WS_WGU2); bf16_t* WD2 = (bf16_t*)(ws + WS_WD2); bf16_t* WPG = (bf16_t*)(ws + WS_WPG); bf16_t* WPP = (bf16_t*)(ws + WS_WPP);
    bf16_t* YC = (bf16_t*)(ws + WS_YC); bf16_t* HB = (bf16_t*)(ws + WS_HB); float* RS = (float*)(ws + WS_RS); bf16_t* ACT = (bf16_t*)(ws + WS_ACT); bf16_t* PROJ = (bf16_t*)(ws + WS_PROJ); bf16_t* PB = (bf16_t*)(ws + WS_PB);
    bf16_t* DB = (bf16_t*)(ws + WS_D); bf16_t* SLAB2 = (bf16_t*)(ws + WS_SLAB2); bf16_t* SLAB4 = (bf16_t*)(ws + WS_SLAB4); bf16_t* PP = (bf16_t*)(ws + WS_PP);
#define IN(k) (a.ph_lo <= (k) && (k) < a.ph_hi)
#define REP(k) for (int rep_ = 0; rep_ < (((MK_DUP >> (k)) & 1u) ? 2 : 1); ++rep_)
    XcdBarrier bar; bar.bar = (unsigned*)(ws + WS_BAR); bar.x = 0; bar.st = nullptr;
    if (COOP) {
        volatile LAS unsigned* st = (volatile LAS unsigned*)(lds + LDS_BYTES - 16);
        if (tid < 4) st[tid] = 0u;
        __syncthreads();
        bar = xcd_barrier_post((unsigned*)(ws + WS_BAR), st);
        if (a.ph_lo < 0) cg::this_grid().sync();
    }
#ifdef MK_TPROBE
#define MIXTQ_ (&tq_)
#else
#define MIXTQ_ nullptr
#endif
#ifdef MK_TPROBE
    unsigned long long tq_ = 0ull, tp_ = __builtin_amdgcn_s_memrealtime();
#define SEAM(k) do { if (COOP && IN(k) && IN((k) + 1)) { const unsigned long long t1_ = __builtin_amdgcn_s_memrealtime(); if ((MK_TW >> (k)) & 1u) tq_ += t1_ - tp_; xcd_barrier(bar); \
        const unsigned long long t2_ = __builtin_amdgcn_s_memrealtime(); if ((MK_TB >> (k)) & 1u) tq_ += t2_ - t1_; tp_ = t2_; } } while (0)
#else
#define SEAM(k) do { if (COOP && IN(k) && IN((k) + 1)) xcd_barrier(bar); } while (0)
#endif

    if (IN(0)) REP(0) {
        const int lane = LANE_, wave = WAVE_, gw = GW_;
        do_transposes(a, ws, lds, 0, TR_A_END, gw, NGW, wave, lane);
        rowpass<2 | 4 | 64, 0, 0>(nullptr, nullptr, nullptr, nullptr, a.in[0], a.in[1], HB, RS, nullptr, nullptr, 0.f, gw, NGW, lane);
    }
    SEAM(0);
    const int bid = (int)blockIdx.x;
#define GEMM_FULL(EPI, Aop, Bop, KK, MM, NN, ...) do { pg8::Gemm g_{Aop, Bop, KK, KK, KK}; pg8::StaticOrder S_; S_.init(MM, NN, G, bid); pg8::EPI E_{__VA_ARGS__}; \
        pg8::gemm_phase<pg8::EPI, pg8::StaticOrder, true, true>(lds, g_, S_, E_); } while (0)
#define GEMM_COMBO(E0T, PERMV, Aop, Bop, KK, NSL, S0, S1, N0, ...) do { typedef pg8::EpiCombo<pg8::E0T, pg8::EpiSlabT<PERMV>> EC_; pg8::Gemm g_{Aop, Bop, KK, KK, 256}; \
        pg8::ComboOrder S_; S_.full.init(MP_, DM, G, bid); S_.sub = pg8::SubOrder{64, 4, 4, NSL, G, bid}; EC_ E_{pg8::E0T{__VA_ARGS__}, pg8::EpiSlabT<PERMV>{S0, S1, N0, 64}}; \
        pg8::gemm_phase<EC_, pg8::ComboOrder, true, true>(lds, g_, S_, E_); } while (0)
    bf16_t* const YCF = YC;
    if (IN(1)) { REP(1) GEMM_FULL(EpiSwiglu, HB, WGU1, DM, M_, NGU, ACT, FF);
        { const int nwg = (M_ / 256) * (NGU / 256), rem = nwg % G, nidle = rem ? G - rem : G, idx = rem ? bid - rem : bid;
          if (idx >= 0) do_transposes(a, ws, lds, TR_A_END, TR_B_END, idx * 8 + WAVE_, nidle * 8, WAVE_, LANE_); } }
    SEAM(1);
    if (IN(2)) REP(2) GEMM_COMBO(EpiBf16, true, ACT, WD1, FF, 11, YCF, SLAB2, 8, DB, DM, nullptr);
    SEAM(2);
    if (IN(3)) rowpass<1 | 4 | 32 | 64, 11, 8>(DB, YCF, SLAB2, nullptr, nullptr, nullptr, HB, RS, nullptr, a.in[6], 0.5f, GW_, NGW, LANE_);
    SEAM(3);
    if (IN(4)) { REP(4) GEMM_FULL(EpiBf16, HB, WIN, DM, M_, NIN, PROJ, NIN, nullptr);
        { const int nwg = (M_ / 256) * (NIN / 256), rem = nwg % G, nidle = rem ? G - rem : G, idx = rem ? bid - rem : bid;
          if (idx >= 0) do_transposes(a, ws, lds, TR_B_END, TR_C_END, idx * 8 + WAVE_, nidle * 8, WAVE_, LANE_); } }
    SEAM(4);
    if (IN(5)) REP(5) mixer_phase(a, lds, PROJ, YC, WAVE_, LANE_, MIXTQ_);
    SEAM(5);
#ifdef MK_XBAR
#pragma nounroll
    for (int xb_ = 0; xb_ < MK_XBAR; ++xb_) xcd_barrier(bar);
#endif
    if (IN(6)) { REP(6) GEMM_COMBO(EpiBf16, true, YC, WOUT, DM, 4, SLAB4, SLAB4, 4, DB, DM, nullptr);
        if (G > 64 && bid >= 64) do_transposes(a, ws, lds, TR_C_END, TR_D_END, (bid - 64) * 8 + WAVE_, (G - 64) * 8, WAVE_, LANE_);
        else if (G <= 64) do_transposes(a, ws, lds, TR_C_END, TR_D_END, bid * 8 + WAVE_, G * 8, WAVE_, LANE_); }
    SEAM(6);
    if (IN(7)) rowpass<1 | 4 | 32 | 64, 4, 4>(DB, SLAB4, SLAB4, nullptr, nullptr, nullptr, HB, RS, nullptr, a.in[11], 1.0f, GW_, NGW, LANE_);
    SEAM(7);
    if (IN(8)) { REP(8) GEMM_FULL(EpiSwiglu, HB, WGU2, DM, M_, NGU, ACT, FF);
        { const int nwg = (M_ / 256) * (NGU / 256), rem = nwg % G, nidle = rem ? G - rem : G, idx = rem ? bid - rem : bid;
          if (idx >= 0) { const int lane = LANE_, w0 = idx * 8 + WAVE_, nw = nidle * 8;
            for (int m0 = w0; m0 < M_; m0 += 8 * nw) {
                f32x4 v[8];
#pragma unroll
                for (int q = 0; q < 8; ++q) { const int m = m0 + q * nw; if (m < M_) { const float* pr = (m < MP_) ? a.in[2] + (size_t)m * PLE : a.in[3] + (size_t)(m - MP_) * PLE; v[q] = ((const f32x4*)pr)[lane]; } }
#pragma unroll
                for (int q = 0; q < 8; ++q) { const int m = m0 + q * nw; if (m < M_) { u32x2 w; w.x = cvt_pk_bf16(v[q].x, v[q].y); w.y = cvt_pk_bf16(v[q].z, v[q].w); ((u32x2*)(PB + (size_t)m * PLE))[lane] = w; } } } } } }
    SEAM(8);
    if (IN(9)) REP(9) GEMM_COMBO(EpiBf16, true, ACT, WD2, FF, 11, YCF, SLAB2, 8, DB, DM, nullptr);
    SEAM(9);
    if (IN(10)) {
        rowpass<1 | 4 | 32, 11, 8>(DB, YCF, SLAB2, nullptr, nullptr, nullptr, HB, RS, nullptr, a.in[21], 0.5f, GW_, NGW, LANE_);
    }
    SEAM(10);
    if (IN(11)) REP(11) { GEMM_FULL(EpiBf16N, PB, WPP, PLE, MP_, DM, PP, DM);
        { pg8::Gemm g_{PB, WPP, PLE, PLE, PLE}; pg8::SubOrder S_{64, 4, 4, 1, G, (bid >= 64 && bid < 80) ? bid - 64 : -1}; pg8::EpiBf16N E_{PP, DM};
          pg8::gemm_phase<pg8::EpiBf16N, pg8::SubOrder, true, true>(lds, g_, S_, E_); } }
    if (IN(12)) REP(12) GEMM_COMBO(EpiPle, false, HB, WPG, DM, 4, SLAB4, SLAB4, 4, DB, PP, DM);
    SEAM(12);
    if (IN(13)) rowpass<1 | 8 | 16, 4, 4>(DB, SLAB4, SLAB4, PP, nullptr, nullptr, HB, nullptr, a.out, a.in[27], 1.0f, GW_, NGW, LANE_);
#ifdef MK_TPROBE
    if (blockIdx.x == 0) { const unsigned long long t1_ = __builtin_amdgcn_s_memrealtime(); if ((MK_TW >> 13) & 1u) tq_ += t1_ - tp_;
        while (__builtin_amdgcn_s_memrealtime() - t1_ < 4ull * tq_) __builtin_amdgcn_s_sleep(8); }
#endif
#undef IN
#undef SEAM
}

extern "C" void kernel_launch(void* const* d_in, const int* in_sizes, int n_in, void* d_out, int out_size, void* d_ws, size_t ws_size, hipStream_t stream) {
    static int grid = 0;
    if (grid == 0) {
        if (n_in != 28 || out_size != 19013632 || ws_size < WS_TOTAL) { fprintf(stderr, "kernel_launch: unexpected shapes: n_in %d out %d ws %zu (need %zu)\n", n_in, out_size, ws_size, (size_t)WS_TOTAL); grid = -1; return; }
        int dev = 0, cus = 0, per_cu = 0;
        if (hipGetDevice(&dev) != hipSuccess || hipDeviceGetAttribute(&cus, hipDeviceAttributeMultiprocessorCount, dev) != hipSuccess) { fprintf(stderr, "kernel_launch: device query failed\n"); grid = -1; return; }
        if (hipFuncSetAttribute((const void*)fwd_kernel<true>, hipFuncAttributeMaxDynamicSharedMemorySize, LDS_BYTES) != hipSuccess) { fprintf(stderr, "kernel_launch: hipFuncSetAttribute failed\n"); grid = -1; return; }
        if (hipOccupancyMaxActiveBlocksPerMultiprocessor(&per_cu, (const void*)fwd_kernel<true>, 512, LDS_BYTES) != hipSuccess || per_cu < 1) { fprintf(stderr, "kernel_launch: occupancy query says %d blocks per CU\n", per_cu); per_cu = 1; }
        (void)hipGetLastError();
        grid = cus * per_cu;
        fprintf(stderr, "kernel_launch: grid %d (cus %d x %d)\n", grid, cus, per_cu);
    }
    if (grid < 0) return;
    Args a{};
    for (int i = 0; i < 28; ++i) a.in[i] = (const float*)d_in[i];
    a.out = (float*)d_out; a.ws = (unsigned char*)d_ws;
#if MK_COOP
    if (hipMemsetAsync((char*)d_ws + WS_BAR, 0, (size_t)XCD_BAR_WORDS * 4, stream) != hipSuccess) { fprintf(stderr, "kernel_launch: memset of the barrier words failed\n"); return; }
    a.ph_lo = 0; a.ph_hi = NPHASE;
    void* args[] = {&a};
    const hipError_t e = hipLaunchCooperativeKernel((const void*)fwd_kernel<true>, dim3(grid), dim3(512), args, LDS_BYTES, stream);
    if (e != hipSuccess) fprintf(stderr, "kernel_launch: cooperative launch failed: %s (grid %d)\n", hipGetErrorString(e), grid);
#endif
}
```

```cpp
#include <hip/hip_runtime.h>
#include <hip/hip_cooperative_groups.h>
#include <cstdio>
#include <cstdint>
namespace cg = cooperative_groups;
#define MK_DUP 0u
namespace pg8 {
#define PG8_LAS __attribute__((address_space(3)))
typedef unsigned short bf16_t;
typedef short bf16x8 __attribute__((ext_vector_type(8)));
typedef float f32x4 __attribute__((ext_vector_type(4)));
typedef unsigned u32x4 __attribute__((ext_vector_type(4)));
constexpr int BM = 256, BK = 64, HALF = 128, HTB = HALF * BK * 2  , STAGE_BYTES = 8 * HTB, NXCD = 8, WGM = 8;

__host__ __device__ __forceinline__ int lds_byte(int r, int c) { const int st = (r >> 4) * 2 + (c >> 5), rr = r & 15, cc = c & 31, ob = rr * 64 + cc * 2; return st * 1024 + (ob ^ (((ob >> 9) & 1) << 5)); }
__host__ __device__ __forceinline__ void stage_rc(int b, int& R, int& C) { const int st = b / 1024, sb = b % 1024, swz = sb ^ (((sb >> 9) & 1) << 5); R = (st >> 1) * 16 + swz / 64; C = (st & 1) * 32 + (swz % 64) / 2; }
__host__ __device__ __forceinline__ int perm32(int rho) { const int n = rho >> 4, i = rho & 15; return 8 * (i >> 2) + 4 * n + (i & 3); }

struct Unit { int pm, pn, ks, kind; };
struct Gemm { const bf16_t* A; const bf16_t* Bt; int ld, K, kslice; };

struct StaticOrder {
    int nM, nN, nwg, G, c;
    __host__ __device__ void init(int M, int N, int G_, int c_) { nM = M / BM; nN = N / BM; nwg = nM * nN; G = G_; c = c_; }
    __host__ __device__ bool next(int i, Unit& u) const {
        const long L = (long)i * G + c; if (L >= nwg) return false;
        int wgid = (int)L; { const int q = nwg / NXCD, r = nwg % NXCD, xcd = wgid % NXCD, off = wgid / NXCD; wgid = (xcd < r ? xcd * (q + 1) : r * (q + 1) + (xcd - r) * q) + off; }
        const int nig = WGM * nN, gid = wgid / nig, fm = gid * WGM, gsz = (nM - fm) < WGM ? (nM - fm) : WGM;
        u.pm = fm + ((wgid % nig) % gsz); u.pn = (wgid % nig) / gsz; u.ks = 0; u.kind = 0; return true;
    }
    __device__ __forceinline__ void a_ready(const Unit&) const {}
    __device__ __forceinline__ void done(const Unit&) const {}
};
struct SubOrder {
    int pm0, npm, nN, nsl, G, c;
    __host__ __device__ bool next(int i, Unit& u) const {
        const int L = i * G + c; if (c < 0 || L >= npm * nN * nsl) return false;
        const int t = L / nsl; u.ks = L - t * nsl; u.pn = t % nN; u.pm = pm0 + t / nN; u.kind = (nsl > 1) ? 1 : 0; return true;
    }
    __device__ __forceinline__ void a_ready(const Unit&) const {}
    __device__ __forceinline__ void done(const Unit&) const {}
};
struct ComboOrder {
    StaticOrder full; SubOrder sub;
    __host__ __device__ bool next(int i, Unit& u) const {
        if (full.next(i, u)) return true;
        const int nf = (full.c < full.nwg) ? (full.nwg - full.c + full.G - 1) / full.G : 0;
        return sub.next(i - nf, u);
    }
    __device__ __forceinline__ void a_ready(const Unit&) const {}
    __device__ __forceinline__ void done(const Unit&) const {}
};
typedef unsigned u32x2 __attribute__((ext_vector_type(2)));

__device__ __forceinline__ unsigned cvt_pk_bf16(float lo, float hi) { unsigned r; asm("v_cvt_pk_bf16_f32 %0, %1, %2" : "=v"(r) : "v"(lo), "v"(hi)); return r; }
__device__ __forceinline__ float sigmoid_f(float x) { return __builtin_amdgcn_rcpf(1.0f + __builtin_amdgcn_exp2f(x * -1.44269504089f)); }

#ifndef MK_WT
#define MK_WT 0
#endif
typedef __attribute__((__vector_size__(4 * sizeof(int)))) int rsrc_t;
constexpr int WT_AUX = MK_WT ? 16 : 0;
__device__ __forceinline__ auto mk_rsrc(const void* base) { return __builtin_amdgcn_make_buffer_rsrc((void*)base, 0, 0x7fffffff, 0x00020000); }
#define ST16(rsrc, byteoff, v) __builtin_amdgcn_raw_buffer_store_b128(__builtin_bit_cast(u32x4, v), rsrc, (int)(byteoff), 0, pg8::WT_AUX)
#define ST8(rsrc, byteoff, v)  __builtin_amdgcn_raw_buffer_store_b64(__builtin_bit_cast(u32x2, v), rsrc, (int)(byteoff), 0, pg8::WT_AUX)

struct EpiF32 {
    static constexpr bool PERM = false, AFTER_DRAIN = false;
    float* C; int ldc;
    __device__ __forceinline__ void operator()(const f32x4 (&acc)[2][2][4][2], const Unit& u, int wr, int wc, int fr_, int fq_) const {
        int tl_ = threadIdx.x; asm volatile("" : "+v"(tl_)); const int fr = tl_ & 15, fq = (tl_ >> 4) & 3;
        const int row0 = u.pm * BM + wr * 64 + fr, col0 = u.pn * BM + wc * 32 + 4 * fq; float* const Cb_ = C;
#pragma unroll
        for (int ai = 0; ai < 2; ++ai)
#pragma unroll
            for (int m = 0; m < 4; ++m) { const unsigned ro = ((unsigned)(row0 + ai * HALF + m * 16) * (unsigned)ldc + (unsigned)col0) * 4u;
#pragma unroll
                for (int bj = 0; bj < 2; ++bj)
#pragma unroll
                    for (int n = 0; n < 2; ++n) *(f32x4*)((char*)Cb_ + ro + (bj * HALF + n * 16) * 4) = acc[ai][bj][m][n]; }
    }
};
struct EpiBf16N {
    static constexpr bool PERM = false, AFTER_DRAIN = false;
    bf16_t* O; int ldc;
    __device__ __forceinline__ void operator()(const f32x4 (&acc)[2][2][4][2], const Unit& u, int wr, int wc, int fr_, int fq_) const {
        int tl_ = threadIdx.x; asm volatile("" : "+v"(tl_)); const int fr = tl_ & 15, fq = (tl_ >> 4) & 3;
        const int row0 = u.pm * BM + wr * 64 + fr, col0 = u.pn * BM + wc * 32 + 4 * fq;
#pragma unroll
        for (int ai = 0; ai < 2; ++ai)
#pragma unroll
            for (int m = 0; m < 4; ++m) { const size_t off = (size_t)(row0 + ai * HALF + m * 16) * ldc + col0;
#pragma unroll
                for (int bj = 0; bj < 2; ++bj)
#pragma unroll
                    for (int n = 0; n < 2; ++n) { const f32x4 a = acc[ai][bj][m][n]; u32x2 w; w.x = cvt_pk_bf16(a.x, a.y); w.y = cvt_pk_bf16(a.z, a.w); *(u32x2*)(O + off + bj * HALF + n * 16) = w; } }
    }
};
struct EpiPle {
    static constexpr bool PERM = false, AFTER_DRAIN = false;
    bf16_t* T; const bf16_t* P; int ldc;
    __device__ __forceinline__ void operator()(const f32x4 (&acc)[2][2][4][2], const Unit& u, int wr, int wc, int fr_, int fq_) const {
        int tl_ = threadIdx.x; asm volatile("" : "+v"(tl_)); const int fr = tl_ & 15, fq = (tl_ >> 4) & 3;
        const int row0 = u.pm * BM + wr * 64 + fr, col0 = u.pn * BM + wc * 32 + 4 * fq;
#pragma unroll
        for (int ai = 0; ai < 2; ++ai)
#pragma unroll
            for (int m = 0; m < 4; ++m) { const size_t off = (size_t)(row0 + ai * HALF + m * 16) * ldc + col0;
#pragma unroll
                for (int bj = 0; bj < 2; ++bj)
#pragma unroll
                    for (int n = 0; n < 2; ++n) { const u32x2 pw = *(const u32x2*)(P + off + bj * HALF + n * 16); const f32x4 a = acc[ai][bj][m][n];
                        const f32x4 p = {__uint_as_float(pw.x << 16), __uint_as_float(pw.x & 0xffff0000u), __uint_as_float(pw.y << 16), __uint_as_float(pw.y & 0xffff0000u)};
                        u32x2 w; w.x = cvt_pk_bf16(sigmoid_f(a.x) * p.x, sigmoid_f(a.y) * p.y); w.y = cvt_pk_bf16(sigmoid_f(a.z) * p.z, sigmoid_f(a.w) * p.w);
                        *(u32x2*)(T + off + bj * HALF + n * 16) = w; } }
    }
};
template <bool PERM_> struct EpiSlabT {
    static constexpr bool PERM = PERM_, AFTER_DRAIN = false;
    bf16_t* base0; bf16_t* base1; int n0; int pm0;
    __device__ __forceinline__ void operator()(const f32x4 (&acc)[2][2][4][2], const Unit& u, int wr, int wc, int fr_, int fq_) const {
        int tl_ = threadIdx.x; asm volatile("" : "+v"(tl_)); const int fr = tl_ & 15, fq = (tl_ >> 4) & 3;
        const int row0 = (u.pm - pm0) * BM + wr * 64 + fr, col0 = u.pn * BM + wc * 32 + (PERM_ ? 8 : 4) * fq;
        bf16_t* const Cb_ = (u.ks < n0) ? base0 + ((size_t)u.ks << 20) : base1 + ((size_t)(u.ks - n0) << 20);
#pragma unroll
        for (int ai = 0; ai < 2; ++ai)
#pragma unroll
            for (int m = 0; m < 4; ++m) { const unsigned ro = ((unsigned)(row0 + ai * HALF + m * 16) * 1024u + (unsigned)col0) * 2u;
#pragma unroll
                for (int bj = 0; bj < 2; ++bj)
#pragma unroll
                    for (int n = 0; n < 2; ++n) { const f32x4 a = acc[ai][bj][m][n]; u32x2 w; w.x = cvt_pk_bf16(a.x, a.y); w.y = cvt_pk_bf16(a.z, a.w);
                        *(u32x2*)((char*)Cb_ + ro + (bj * HALF + n * (PERM_ ? 4 : 16)) * 2) = w; } }
    }
};
struct EpiBf16 {
    static constexpr bool PERM = true, AFTER_DRAIN = false;
    bf16_t* O; int ldc; const float* rs;
    __device__ __forceinline__ void operator()(const f32x4 (&acc)[2][2][4][2], const Unit& u, int wr, int wc, int fr_, int fq_) const {
        int tl_ = threadIdx.x; asm volatile("" : "+v"(tl_)); const int fr = tl_ & 15, fq = (tl_ >> 4) & 3;
        const int row0 = u.pm * BM + wr * 64 + fr, col0 = u.pn * BM + wc * 32 + 8 * fq; const auto rs_ = mk_rsrc(O);
#pragma unroll
        for (int ai = 0; ai < 2; ++ai)
#pragma unroll
            for (int m = 0; m < 4; ++m) { const int row = row0 + ai * HALF + m * 16; const unsigned ro = ((unsigned)row * (unsigned)ldc + (unsigned)col0) * 2u; const float r = rs ? rs[row] : 1.0f;
#pragma unroll
                for (int bj = 0; bj < 2; ++bj) { const f32x4 v0 = acc[ai][bj][m][0] * r, v1 = acc[ai][bj][m][1] * r;
                    u32x4 w; w.x = cvt_pk_bf16(v0[0], v0[1]); w.y = cvt_pk_bf16(v0[2], v0[3]); w.z = cvt_pk_bf16(v1[0], v1[1]); w.w = cvt_pk_bf16(v1[2], v1[3]);
                    ST16(rs_, ro + bj * HALF * 2, w); } }
    }
};
struct EpiSwiglu {
    static constexpr bool PERM = true, AFTER_DRAIN = false;
    bf16_t* O; int ldc;
    static __device__ __forceinline__ f32x4 silu_mul(f32x4 g, f32x4 u) {
        f32x4 t = g * -1.44269504089f;
        t.x = __builtin_fminf(t.x, 60.f); t.y = __builtin_fminf(t.y, 60.f); t.z = __builtin_fminf(t.z, 60.f); t.w = __builtin_fminf(t.w, 60.f);
        f32x4 e; e.x = __builtin_amdgcn_exp2f(t.x); e.y = __builtin_amdgcn_exp2f(t.y); e.z = __builtin_amdgcn_exp2f(t.z); e.w = __builtin_amdgcn_exp2f(t.w);
        const f32x4 d = e + 1.0f;
        const float r01 = __builtin_amdgcn_rcpf(d.x * d.y), r23 = __builtin_amdgcn_rcpf(d.z * d.w);
        const f32x4 sg = {d.y * r01, d.x * r01, d.w * r23, d.z * r23};
        return (g * sg) * u;
    }
    __device__ __forceinline__ void operator()(const f32x4 (&acc)[2][2][4][2], const Unit& u, int wr, int wc, int fr_, int fq_) const {
        int tl_ = threadIdx.x; asm volatile("" : "+v"(tl_)); const int fr = tl_ & 15, fq = (tl_ >> 4) & 3;
        const int row0 = u.pm * BM + wr * 64 + fr, col0 = u.pn * HALF + wc * 32 + 8 * fq; const auto rs_ = mk_rsrc(O);
#pragma unroll
        for (int ai = 0; ai < 2; ++ai)
#pragma unroll
            for (int m = 0; m < 4; ++m) { const unsigned ro = ((unsigned)(row0 + ai * HALF + m * 16) * (unsigned)ldc + (unsigned)col0) * 2u;
                const f32x4 v0 = silu_mul(acc[ai][0][m][0], acc[ai][1][m][0]), v1 = silu_mul(acc[ai][0][m][1], acc[ai][1][m][1]);
                u32x4 w; w.x = cvt_pk_bf16(v0[0], v0[1]); w.y = cvt_pk_bf16(v0[2], v0[3]); w.z = cvt_pk_bf16(v1[0], v1[1]); w.w = cvt_pk_bf16(v1[2], v1[3]);
                ST16(rs_, ro, w); }
    }
};
template <class E0, class E1> struct EpiCombo {
    static_assert(E0::PERM == E1::PERM, "one staging order per phase");
    static constexpr bool PERM = E0::PERM, AFTER_DRAIN = false;
    E0 e0; E1 e1;
    __device__ __forceinline__ void operator()(const f32x4 (&acc)[2][2][4][2], const Unit& u, int wr, int wc, int fr, int fq) const {
        if (u.kind == 0) e0(acc, u, wr, wc, fr, fq); else e1(acc, u, wr, wc, fr, fq);
    }
};

template <class Epi, class Sched, bool ALIGN_EPI = false, bool SP2 = false>
__device__ __forceinline__ void gemm_phase(PG8_LAS unsigned char* lds, const Gemm g, const Sched& S, const Epi& E) {
    int tid_ = threadIdx.x; asm volatile("" : "+v"(tid_));
    const int tid = tid_, wid = __builtin_amdgcn_readfirstlane(tid >> 6), lane = tid & 63, wr = wid >> 2, wc = wid & 3, fr = lane & 15, fq = lane >> 4;
    const int K = g.K, nt = K / BK;
    unsigned voffA[2], voffB[2];
#pragma unroll
    for (int i = 0; i < 2; ++i) { int R, C; stage_rc(tid * 16 + i * 8192, R, C); const int Rb = Epi::PERM ? ((R & ~31) + perm32(R & 31)) : R;
        voffA[i] = (unsigned)(R * g.ld + C) * 2u; voffB[i] = (unsigned)(Rb * g.ld + C) * 2u; }
    const size_t kstep = (size_t)(BK * 2);
    const size_t hstepA = (size_t)HALF * g.ld * 2, hstepB = hstepA;
    const size_t kslice = (size_t)g.kslice * 2;
    const unsigned ldsw = (unsigned)wid * 1024u;
    const int aoff = lds_byte(wr * 64 + fr, fq * 8), boff = lds_byte(wc * 32 + fr, fq * 8);
#define PG8_SA(b, h) (((b) * 2 + (h)) * HTB)
#define PG8_SB(b, h) ((4 + (b) * 2 + (h)) * HTB)
#define PG8_STAGE(bufoff, gbase, voff) do { _Pragma("unroll") for (int _i = 0; _i < 2; ++_i) \
        __builtin_amdgcn_global_load_lds((const unsigned*)((const char*)(gbase) + (voff)[_i]), (PG8_LAS unsigned*)(lds + (bufoff) + ldsw + _i * 8192), 16, 0, 0); } while (0)
#define PG8_LDA(dst, b, h) do { _Pragma("unroll") for (int m = 0; m < 4; ++m) _Pragma("unroll") for (int k = 0; k < 2; ++k) dst[m][k] = *(const PG8_LAS bf16x8*)(lds + PG8_SA(b, h) + aoff + m * 2048 + k * 1024); } while (0)
#define PG8_LDB(dst, b, h) do { _Pragma("unroll") for (int n = 0; n < 2; ++n) _Pragma("unroll") for (int k = 0; k < 2; ++k) dst[n][k] = *(const PG8_LAS bf16x8*)(lds + PG8_SB(b, h) + boff + n * 2048 + k * 1024); } while (0)
#define PG8_MMA(ai, bj, At, Bt) do { __builtin_amdgcn_s_setprio(1); _Pragma("unroll") for (int m = 0; m < 4; ++m) _Pragma("unroll") for (int n = 0; n < 2; ++n) _Pragma("unroll") for (int k = 0; k < 2; ++k) \
        acc[ai][bj][m][n] = __builtin_amdgcn_mfma_f32_16x16x32_bf16(Bt[n][k], At[m][k], acc[ai][bj][m][n], 0, 0, 0); __builtin_amdgcn_s_setprio(0); } while (0)
#define PG8_WAIT_V(n) asm volatile("s_waitcnt vmcnt(" #n ")" ::: "memory")
#define PG8_WAIT_L(n) asm volatile("s_waitcnt lgkmcnt(" #n ")" ::: "memory")
#define PG8_BAR __builtin_amdgcn_s_barrier()
#define PG8_SCHED __builtin_amdgcn_sched_barrier(0)
    Unit cur, nxt; int ui = 0;
    if (!S.next(0, cur)) return;
    f32x4 acc[2][2][4][2];
#pragma unroll
    for (int a = 0; a < 2; ++a)
#pragma unroll
        for (int b = 0; b < 2; ++b)
#pragma unroll
            for (int m = 0; m < 4; ++m)
#pragma unroll
                for (int n = 0; n < 2; ++n) acc[a][b][m][n] = (f32x4){0.f, 0.f, 0.f, 0.f};
    bf16x8 At[4][2], B0[2][2], B1[2][2];
    const char* cA = (const char*)g.A + (size_t)cur.pm * 2 * hstepA + (size_t)cur.ks * kslice; const char* cB = (const char*)g.Bt + (size_t)cur.pn * 2 * hstepB + (size_t)cur.ks * kslice;
    S.a_ready(cur);
    if constexpr (SP2) {
        PG8_STAGE(PG8_SB(0, 0), cB, voffB); PG8_STAGE(PG8_SB(0, 1), cB + hstepB, voffB); PG8_STAGE(PG8_SA(0, 0), cA, voffA); PG8_STAGE(PG8_SA(0, 1), cA + hstepA, voffA);
        if (wr == 1) PG8_BAR;
        PG8_WAIT_V(2); PG8_BAR;
        PG8_STAGE(PG8_SB(1, 0), cB + kstep, voffB); PG8_STAGE(PG8_SA(1, 0), cA + kstep, voffA); PG8_STAGE(PG8_SB(1, 1), cB + hstepB + kstep, voffB);
        PG8_WAIT_V(6); PG8_BAR;
    } else {
        PG8_STAGE(PG8_SB(0, 0), cB, voffB); PG8_STAGE(PG8_SA(0, 0), cA, voffA); PG8_STAGE(PG8_SB(0, 1), cB + hstepB, voffB); PG8_STAGE(PG8_SA(0, 1), cA + hstepA, voffA);
        if (wr == 1) PG8_BAR;
        PG8_WAIT_V(4); PG8_BAR;
        PG8_STAGE(PG8_SB(1, 0), cB + kstep, voffB); PG8_STAGE(PG8_SA(1, 0), cA + kstep, voffA); PG8_STAGE(PG8_SB(1, 1), cB + hstepB + kstep, voffB);
        PG8_WAIT_V(6); PG8_BAR;
    }
    for (;;) {
        const bool has_next = S.next(ui + 1, nxt);
        const char* nA = has_next ? (const char*)g.A + (size_t)nxt.pm * 2 * hstepA + (size_t)nxt.ks * kslice : cA; const char* nB = has_next ? (const char*)g.Bt + (size_t)nxt.pn * 2 * hstepB + (size_t)nxt.ks * kslice : cB;
        const int ntu = (cur.kind != 0) ? g.kslice / BK : nt;
        for (int t = 0; t < ntu; t += 2) {
            const bool last = (t == ntu - 2);
            const char* a1 = cA + (size_t)(t + 1) * kstep;
            const char* a2 = last ? nA : cA + (size_t)(t + 2) * kstep; const char* b2 = last ? nB : cB + (size_t)(t + 2) * kstep;
            const char* a3 = a2 + kstep; const char* b3 = b2 + kstep;
            if (last && has_next) S.a_ready(nxt);
            if constexpr (SP2) {
            PG8_LDB(B0, 0, 0); PG8_LDB(B1, 0, 1); PG8_SCHED; PG8_LDA(At, 0, 0); PG8_STAGE(PG8_SA(1, 1), a1 + hstepA, voffA);
            PG8_WAIT_V(8); PG8_WAIT_L(0); PG8_BAR; PG8_MMA(0, 0, At, B0); PG8_MMA(0, 1, At, B1); PG8_BAR; PG8_SCHED;
            PG8_LDA(At, 0, 1); PG8_STAGE(PG8_SB(0, 0), b2, voffB); PG8_STAGE(PG8_SB(0, 1), b2 + hstepB, voffB); PG8_STAGE(PG8_SA(0, 0), a2, voffA);
            PG8_WAIT_V(8); PG8_WAIT_L(0); PG8_BAR; PG8_MMA(1, 0, At, B0); PG8_MMA(1, 1, At, B1); PG8_BAR; PG8_SCHED;
            PG8_LDB(B0, 1, 0); PG8_LDB(B1, 1, 1); PG8_SCHED; PG8_LDA(At, 1, 0); PG8_STAGE(PG8_SA(0, 1), a2 + hstepA, voffA);
            PG8_WAIT_V(8); PG8_WAIT_L(0); PG8_BAR; PG8_MMA(0, 0, At, B0); PG8_MMA(0, 1, At, B1); PG8_BAR; PG8_SCHED;
            PG8_LDA(At, 1, 1); PG8_STAGE(PG8_SB(1, 0), b3, voffB); PG8_STAGE(PG8_SB(1, 1), b3 + hstepB, voffB); PG8_STAGE(PG8_SA(1, 0), a3, voffA);
            PG8_WAIT_V(8); PG8_WAIT_L(0); PG8_BAR; PG8_MMA(1, 0, At, B0); PG8_MMA(1, 1, At, B1); PG8_BAR; PG8_SCHED;
            } else {
            PG8_LDB(B0, 0, 0); PG8_SCHED; PG8_LDA(At, 0, 0); PG8_STAGE(PG8_SA(1, 1), a1 + hstepA, voffA);
            PG8_WAIT_L(8); PG8_BAR; PG8_WAIT_L(0); PG8_MMA(0, 0, At, B0); PG8_BAR; PG8_SCHED;
            PG8_LDB(B1, 0, 1); PG8_STAGE(PG8_SB(0, 0), b2, voffB);
            PG8_BAR; PG8_WAIT_L(0); PG8_MMA(0, 1, At, B1); PG8_BAR;
            PG8_LDA(At, 0, 1); PG8_STAGE(PG8_SA(0, 0), a2, voffA);
            PG8_BAR; PG8_WAIT_L(0); PG8_MMA(1, 0, At, B0); PG8_BAR; PG8_SCHED;
            PG8_STAGE(PG8_SB(0, 1), b2 + hstepB, voffB);
            PG8_WAIT_V(6); PG8_BAR; PG8_MMA(1, 1, At, B1); PG8_BAR;
            PG8_LDB(B0, 1, 0); PG8_SCHED; PG8_LDA(At, 1, 0); PG8_STAGE(PG8_SA(0, 1), a2 + hstepA, voffA);
            PG8_WAIT_L(8); PG8_BAR; PG8_WAIT_L(0); PG8_MMA(0, 0, At, B0); PG8_BAR; PG8_SCHED;
            PG8_LDB(B1, 1, 1); PG8_STAGE(PG8_SB(1, 0), b3, voffB);
            PG8_BAR; PG8_WAIT_L(0); PG8_MMA(0, 1, At, B1); PG8_BAR;
            PG8_LDA(At, 1, 1); PG8_STAGE(PG8_SA(1, 0), a3, voffA);
            PG8_BAR; PG8_WAIT_L(0); PG8_MMA(1, 0, At, B0); PG8_BAR; PG8_SCHED;
            PG8_STAGE(PG8_SB(1, 1), b3 + hstepB, voffB);
            PG8_WAIT_V(6); PG8_BAR; PG8_MMA(1, 1, At, B1); PG8_BAR;
            }
        }
        if constexpr (ALIGN_EPI) { if (wr == 0) PG8_BAR; }
        if constexpr (!Epi::AFTER_DRAIN) { E(acc, cur, wr, wc, fr, fq); S.done(cur); }
        if (!has_next) break;
#pragma unroll
        for (int a = 0; a < 2; ++a)
#pragma unroll
            for (int b = 0; b < 2; ++b)
#pragma unroll
                for (int m = 0; m < 4; ++m)
#pragma unroll
                    for (int n = 0; n < 2; ++n) acc[a][b][m][n] = (f32x4){0.f, 0.f, 0.f, 0.f};
        cur = nxt; cA = nA; cB = nB; ++ui;
        if constexpr (ALIGN_EPI) { if (wr == 1) PG8_BAR; }
    }
    PG8_WAIT_V(0);
    if constexpr (!ALIGN_EPI) { if (wr == 0) PG8_BAR; }
    PG8_BAR;
    if constexpr (Epi::AFTER_DRAIN) { E.fused(acc, cur, wr, wc, fr, fq, lds, wid, lane); S.done(cur); }
#undef PG8_SA
#undef PG8_SB
#undef PG8_STAGE
#undef PG8_LDA
#undef PG8_LDB
#undef PG8_MMA
#undef PG8_WAIT_V
#undef PG8_WAIT_L
#undef PG8_BAR
#undef PG8_SCHED
}
}

using pg8::bf16_t; using pg8::bf16x8; using pg8::f32x4; using pg8::u32x4; using pg8::u32x2; using pg8::cvt_pk_bf16;
#define LAS __attribute__((address_space(3)))
#define XB_TMO      128
#define XB_XCNT(j)  (256  + 64 * (j))
#define XB_XSUB(j)  (1280 + 64 * (j))
#define XB_XGEN(j)  (2304 + 64 * (j))
#define XB_TOP      3328
#define XB_TOPGEN   3392
#define XCD_BAR_WORDS 3456
#define XB_SPIN_CAP (1u << 18)

__device__ __forceinline__ unsigned xb_ld(unsigned* p)              { return __hip_atomic_load(p, __ATOMIC_RELAXED, __HIP_MEMORY_SCOPE_AGENT); }
__device__ __forceinline__ unsigned xb_add(unsigned* p, unsigned v) { return __hip_atomic_fetch_add(p, v, __ATOMIC_RELAXED, __HIP_MEMORY_SCOPE_AGENT); }
__device__ __forceinline__ unsigned xb_xcc_id() { return (unsigned)__builtin_amdgcn_s_getreg((3 << 11) | 20) & 0xFu; }
#define XB_SPIN(cond, bar) do { unsigned _sp = 0; while (cond) { __builtin_amdgcn_s_sleep(1); \
    if ((++_sp & 255u) == 0u) { if (xb_ld(&(bar)[XB_TMO])) break; if (_sp > XB_SPIN_CAP) { atomicAdd(&(bar)[XB_TMO], 1u); break; } } } } while (0)

struct XcdBarrier {
    unsigned* bar; unsigned x;
    volatile LAS unsigned* st;
};

__device__ __forceinline__ XcdBarrier xcd_barrier_post(unsigned* bar, volatile LAS unsigned* st) {
    XcdBarrier b; b.bar = bar; b.x = xb_xcc_id(); b.st = st;
    if (threadIdx.x == 0) (void)xb_add(&bar[XB_XCNT(b.x)], 1u);
    return b;
}
__device__ __forceinline__ void xcd_barrier_complete(unsigned* bar, unsigned x, unsigned& nloc, unsigned& nx) {
    const unsigned G = gridDim.x * gridDim.y * gridDim.z;
    unsigned sum, cnt, mine, sp = 0u;
    for (;;) {
        sum = 0u; cnt = 0u; mine = 0u;
#pragma unroll
        for (unsigned j = 0; j < 16; ++j) { const unsigned c = xb_ld(&bar[XB_XCNT(j)]); sum += c; cnt += (c > 0u) ? 1u : 0u; mine = (j == x) ? c : mine; }
        if (sum == G) break;
        __builtin_amdgcn_s_sleep(1);
        if ((++sp & 255u) == 0u) { if (xb_ld(&bar[XB_TMO])) break; if (sp > XB_SPIN_CAP) { atomicAdd(&bar[XB_TMO], 1u); break; } }
    }
    nloc = mine > 0u ? mine : 1u; nx = cnt > 0u ? cnt : 1u;
}

__device__ __forceinline__ void xcd_barrier(const XcdBarrier& b) {
    asm volatile("s_waitcnt vmcnt(0)" ::: "memory");
    __syncthreads();
    if (threadIdx.x == 0) {
        unsigned* bar = b.bar;
        __builtin_amdgcn_s_waitcnt(0);
        unsigned nloc = b.st[0], nx = b.st[1];
        if (nloc == 0u) { xcd_barrier_complete(bar, b.x, nloc, nx); b.st[0] = nloc; b.st[1] = nx; }
        const unsigned old = xb_add(&bar[XB_XSUB(b.x)], 1u);
        const unsigned gen = old / nloc;
        if (old + 1u == (gen + 1u) * nloc) {
            __builtin_amdgcn_fence(__ATOMIC_RELEASE, "agent");
            asm volatile("s_waitcnt vmcnt(0)" ::: "memory");
            const unsigned og = xb_add(&bar[XB_TOP], 1u);
            const unsigned tg = og / nx;
            if (og + 1u == (tg + 1u) * nx) xb_add(&bar[XB_TOPGEN], 1u);
            else XB_SPIN(xb_ld(&bar[XB_TOPGEN]) == tg, bar);
            __builtin_amdgcn_fence(__ATOMIC_ACQUIRE, "agent");
            xb_add(&bar[XB_XGEN(b.x)], 1u);
            asm volatile("s_waitcnt vmcnt(0)" ::: "memory");
        } else {
            XB_SPIN(xb_ld(&bar[XB_XGEN(b.x)]) == gen, bar);
            __builtin_amdgcn_fence(__ATOMIC_ACQUIRE, "agent");
            asm volatile("s_waitcnt vmcnt(0)" ::: "memory");
        }
    }
    __syncthreads();
}


#ifndef MK_DUP
#define MK_DUP 0u
#endif
#ifndef MK_COOP
#define MK_COOP 1
#endif
constexpr int M_ = 17408, MP_ = 16384, DM = 1024, FF = 2816, NGU = 5632, NIN = 2560, PLE = 256;
constexpr float EPS_ = 1e-6f;
constexpr int LDS_BYTES = 147456;
constexpr int NPHASE = 14;
constexpr size_t WS_WGU1 = 0;
constexpr size_t WS_WD1 = WS_WGU1 + (size_t)NGU * DM * 2;
constexpr size_t WS_WIN = WS_WD1 + (size_t)DM * FF * 2;
constexpr size_t WS_WOUT = WS_WIN + (size_t)NIN * DM * 2;
constexpr size_t WS_WGU2 = WS_WOUT + (size_t)DM * DM * 2;
constexpr size_t WS_WD2 = WS_WGU2 + (size_t)NGU * DM * 2;
constexpr size_t WS_WPG = WS_WD2 + (size_t)DM * FF * 2;
constexpr size_t WS_WPP = WS_WPG + (size_t)DM * DM * 2;
constexpr size_t WS_YC = WS_WPP + (size_t)DM * PLE * 2;
constexpr size_t WS_ACT = WS_YC + (size_t)M_ * DM * 2;
constexpr size_t WS_D = WS_ACT + (size_t)M_ * FF * 2;
constexpr size_t WS_HB = WS_D + (size_t)M_ * DM * 2;
constexpr size_t WS_SLAB2 = WS_HB + (size_t)M_ * DM * 2;
constexpr size_t WS_RS = WS_SLAB2 + (size_t)3 * 1024 * 1024 * 4;
constexpr size_t WS_END = WS_RS + (size_t)M_ * 4;
constexpr size_t WS_BAR = WS_END;
constexpr size_t WS_TOTAL = WS_BAR + (size_t)XCD_BAR_WORDS * 4;
constexpr size_t WS_PROJ = WS_ACT;
constexpr size_t WS_PP = WS_ACT;
constexpr size_t WS_PB = WS_YC + (size_t)16 * 1024 * 1024;
constexpr size_t WS_SLAB4 = WS_ACT + (size_t)M_ * DM * 4 + (size_t)M_ * PLE * 2;
static_assert(WS_SLAB4 + (size_t)4 * 1024 * 1024 * 4 <= WS_D && WS_PB + (size_t)M_ * PLE * 2 <= WS_ACT, "aliases fit");
constexpr size_t OUT_NCP = 17825792, OUT_NCS = 17833984, OUT_CVP = 17965056, OUT_CVS = 18489344;

struct Args { const float* in[28]; float* out; unsigned char* ws; int ph_lo, ph_hi; };

__device__ __forceinline__ float wave_sum(float v) {
#pragma unroll
    for (int o = 1; o < 64; o <<= 1) v += __shfl_xor(v, o);
    return v;
}
__device__ __forceinline__ float bf_lo(unsigned w) { return __uint_as_float(w << 16); }
__device__ __forceinline__ float bf_hi(unsigned w) { return __uint_as_float(w & 0xffff0000u); }
__device__ __forceinline__ float dot4(f32x4 a) { return (a.x * a.x + a.y * a.y) + (a.z * a.z + a.w * a.w); }
#define LDS_WAIT() asm volatile("s_waitcnt lgkmcnt(0)" ::: "memory")

struct TrItem { const float* W; bf16_t* WT; const float* gk; int K, N, k0, n0, drow0; };
__device__ __forceinline__ void tr_load(const TrItem& d, int lane, f32x4 (&v8)[8], float (&g8)[8]) {
#pragma unroll
    for (int i = 0; i < 8; ++i) { const int kk = 8 * i + (lane >> 3); v8[i] = __builtin_nontemporal_load((const f32x4*)(d.W + (size_t)(d.k0 + kk) * d.N + d.n0 + (lane & 7) * 4)); g8[i] = d.gk ? d.gk[d.k0 + kk] : 1.0f; }
}
__device__ __forceinline__ void tr_store(const TrItem& d, LAS float* scr, int lane, const f32x4 (&v8)[8], const float (&g8)[8]) {
#pragma unroll
    for (int i = 0; i < 8; ++i) { const int kk = 8 * i + (lane >> 3); LAS float* q = scr + kk * 33 + (lane & 7) * 4; const f32x4 v = v8[i] * g8[i]; q[0] = v.x; q[1] = v.y; q[2] = v.z; q[3] = v.w; }
    LDS_WAIT();
    const int c = lane & 7;
#pragma unroll
    for (int j = 0; j < 4; ++j) { const int n = (lane >> 3) + 8 * j; const LAS float* t = scr + (8 * c) * 33 + n;
        u32x4 o; o.x = cvt_pk_bf16(t[0 * 33], t[1 * 33]); o.y = cvt_pk_bf16(t[2 * 33], t[3 * 33]); o.z = cvt_pk_bf16(t[4 * 33], t[5 * 33]); o.w = cvt_pk_bf16(t[6 * 33], t[7 * 33]);
        *(u32x4*)(d.WT + (size_t)(d.drow0 + n) * d.K + d.k0 + 8 * c) = o; }
    LDS_WAIT();
}

__device__ __forceinline__ f32x4 bf4(unsigned a, unsigned b) { return (f32x4){bf_lo(a), bf_hi(a), bf_lo(b), bf_hi(b)}; }
template <int MODE>
__device__ __forceinline__ void rp_load_res(int m, const float* __restrict__ resP, const float* __restrict__ resS, const bf16_t* hb, int lane, f32x4 (&h)[4]) {
    if (MODE & 2) { const float* rrow = (m < MP_) ? resP + (size_t)m * DM : resS + (size_t)(m - MP_) * DM;
#pragma unroll
        for (int j = 0; j < 4; ++j) h[j] = __builtin_nontemporal_load((const f32x4*)rrow + lane + 64 * j); }
    else { const u32x2* hr = (const u32x2*)(hb + (size_t)m * DM) + lane;
#pragma unroll
        for (int j = 0; j < 4; ++j) { const u32x2 w = hr[64 * j]; h[j] = bf4(w.x, w.y); } }
}
__device__ __forceinline__ int vzero() { int z; asm volatile("v_mov_b32 %0, 0" : "=v"(z)); return z; }
template <int MODE>
__device__ __forceinline__ void rp_finish(int m, f32x4 (&h)[4], f32x4 (&d)[4], const f32x4 (&gp)[4], float sc, bf16_t* hb, float* rsv, float* __restrict__ outf, int lane, float hin_scale) {
    if (MODE & 32) {
#pragma unroll
        for (int j = 0; j < 4; ++j) h[j] *= hin_scale; }
    if (MODE & 1) {
        float ss = 0.f;
#pragma unroll
        for (int j = 0; j < 4; ++j) ss += dot4(d[j]);
        const float rs = sc * rsqrtf(wave_sum(ss) * (1.0f / DM) + EPS_);
#pragma unroll
        for (int j = 0; j < 4; ++j) h[j] += d[j] * rs * gp[j];
    }
    if (MODE & 4) {
        float s2 = 0.f;
#pragma unroll
        for (int j = 0; j < 4; ++j) s2 += dot4(h[j]);
        const float rs2 = rsqrtf(wave_sum(s2) * (1.0f / DM) + EPS_);
        if (lane == 0) rsv[m] = rs2;
        const float osc = (MODE & 64) ? rs2 : 1.0f;
        const auto hrs = pg8::mk_rsrc(hb); const unsigned ho = (unsigned)m * (DM * 2u) + (unsigned)lane * 8u;
#pragma unroll
        for (int j = 0; j < 4; ++j) { const f32x4 v = h[j] * osc; u32x2 w; w.x = cvt_pk_bf16(v.x, v.y); w.y = cvt_pk_bf16(v.z, v.w); ST8(hrs, ho + 512u * j, w); }
    }
    if (MODE & 8) { f32x4* ho = (f32x4*)(outf + (size_t)m * DM) + lane;
#pragma unroll
        for (int j = 0; j < 4; ++j) __builtin_nontemporal_store(h[j], ho + 64 * j); }
}
template <int MODE, int NSL, int N0>
__device__ __forceinline__ void rowpass(const bf16_t* __restrict__ dbuf, const bf16_t* slab0, const bf16_t* slab1, const bf16_t* __restrict__ pp, const float* __restrict__ resP, const float* __restrict__ resS,
                                        bf16_t* hb, float* rsv, float* __restrict__ outf, const float* __restrict__ gpost, float sc, int gw, int NGW, int lane) {
    f32x4 gp[4]; const int vz = vzero();
#pragma unroll
    for (int j = 0; j < 4; ++j) gp[j] = (MODE & 1) ? ((const f32x4*)gpost)[lane + 64 * j] : (f32x4){0.f, 0.f, 0.f, 0.f};
    constexpr int NR = 4;
    for (int m0 = gw; m0 < MP_; m0 += NR * NGW) {
        f32x4 hh[NR][4], dd[NR][4]; u32x2 ww[NR][4]; float isc[NR];
#pragma unroll
        for (int q = 0; q < NR; ++q) { const int m = m0 + q * NGW; isc[q] = 1.0f; if (m < MP_) { rp_load_res<MODE>(m, resP, resS, hb, lane, hh[q]); if (MODE & 32) isc[q] = rsv[m + vz]; } }
        if (MODE & 1) {
#pragma unroll
            for (int q = 0; q < NR; ++q) { const int m = m0 + q * NGW; if (m < MP_) { const u32x2* dr = (const u32x2*)(dbuf + (size_t)m * DM) + lane;
#pragma unroll
                for (int j = 0; j < 4; ++j) ww[q][j] = dr[64 * j]; } }
#pragma unroll
            for (int q = 0; q < NR; ++q)
#pragma unroll
                for (int j = 0; j < 4; ++j) dd[q][j] = bf4(ww[q][j].x, ww[q][j].y);
        }
#pragma unroll
        for (int q = 0; q < NR; ++q) { const int m = m0 + q * NGW; if (m < MP_) rp_finish<MODE>(m, hh[q], dd[q], gp, sc, hb, rsv, outf, lane, (MODE & 32) ? 1.0f / isc[q] : 1.0f); }
    }
    if (((gw & 1) == 0)) for (int r = (gw >> 3) * 4 + ((gw & 7) >> 1); r < M_ - MP_; r += (NGW >> 3) * 4) {
        const int m = MP_ + r;
        f32x4 h[4], d[4]; float isc1 = 1.0f;
        rp_load_res<MODE>(m, resP, resS, hb, lane, h);
        if (MODE & 32) isc1 = rsv[m + vz];
        if (MODE & 1) {
            u32x2 tq[4][NSL > 0 ? NSL : 1];
#pragma unroll
            for (int j = 0; j < 4; ++j)
#pragma unroll
                for (int s = 0; s < NSL; ++s) tq[j][s] = ((const u32x2*)(((s < N0) ? slab0 + ((size_t)s << 20) : slab1 + ((size_t)(s - N0) << 20)) + (size_t)r * DM))[lane + 64 * j];
#pragma unroll
            for (int j = 0; j < 4; ++j) { f32x4 acc = {0.f, 0.f, 0.f, 0.f};
#pragma unroll
                for (int s = 0; s < NSL; ++s) acc += bf4(tq[j][s].x, tq[j][s].y);
                d[j] = acc; }
            if (MODE & 16) { const u32x2* pr = (const u32x2*)(pp + (size_t)m * DM) + lane;
#pragma unroll
                for (int j = 0; j < 4; ++j) { const u32x2 pw = pr[64 * j]; const f32x4 p = bf4(pw.x, pw.y); d[j].x = pg8::sigmoid_f(d[j].x) * p.x; d[j].y = pg8::sigmoid_f(d[j].y) * p.y; d[j].z = pg8::sigmoid_f(d[j].z) * p.z; d[j].w = pg8::sigmoid_f(d[j].w) * p.w; } }
        }
        rp_finish<MODE>(m, h, d, gp, sc, hb, rsv, outf, lane, (MODE & 32) ? 1.0f / isc1 : 1.0f);
    }
}

#ifdef MK_TM
#define MIX_T(seg) do { const unsigned long long tn_ = __builtin_amdgcn_s_memrealtime(); if ((MK_TM >> (seg)) & 1u) *tqm += tn_ - tpm; tpm = tn_; } while (0)
#else
#define MIX_T(seg) do { } while (0)
#endif
__device__ __forceinline__ void mixer_phase(const Args& a, LAS unsigned char* lds, const bf16_t* __restrict__ PROJ, bf16_t* __restrict__ YC, int wave, int lane, unsigned long long* tqm) {
    unsigned long long tpm = 0ull;
    constexpr int VP = 1056;
    const auto ycrs = pg8::mk_rsrc(YC);
    LAS float* part = (LAS float*)(lds + 128 * VP);
    const int fr = lane & 15, fq = lane >> 4;
    const float* __restrict__ wsm = a.in[15]; const float* __restrict__ bsm = a.in[16];
    float* out = a.out;
    const int G_ = (int)gridDim.x, b_ = (int)blockIdx.x;
    for (int it = 0;; ++it) {
        int u, R0, nrows = 64;
        if (G_ == 256) { if (it == 0) { u = b_; R0 = u * 64; } else if (it == 1 && (b_ & 1) == 0 && b_ < 128) { u = 256; R0 = MP_ + 16 * (b_ >> 1); nrows = 16; } else break; }
        else { u = b_ + it * G_; if (u >= 272) break; R0 = u * 64; }
        const int ntb = nrows >> 4;
        const bool samp = (u >= 256);
#ifdef MK_TM
        tpm = __builtin_amdgcn_s_memrealtime();
#endif
        int s0 = 0, t0 = 0;
        if (!samp) { s0 = (u & 31) * 64; t0 = s0 & 127; }
        const int CB = R0 - t0, kext = t0 + 64;
        const int h = wave; const int nkb = kext >> 5;
        bf16x8 afr[4][4];
#pragma unroll
        for (int kb = 0; kb < 4; ++kb) {
#pragma unroll
            for (int tb = 0; tb < 4; ++tb) {
                f32x4 w0 = {0.f, 0.f, 0.f, 0.f}, w1 = w0; int lim = -1;
                if (kb < nkb) {
                    if (!samp) { const int tt = t0 + tb * 16 + fr, sb = kb * 32 + fq * 8; const float* wp = wsm + (size_t)(h * 128 + tt) * 128 + sb;
                        w0 = *(const f32x4*)wp; w1 = *(const f32x4*)(wp + 4); lim = tt - sb; }
                    else { const int tt = fr & 7; const float* wp = wsm + (size_t)(h * 128 + tt) * 128;
                        w0 = *(const f32x4*)wp; w1 = *(const f32x4*)(wp + 4); lim = ((kb * 4 + fq) == (tb * 2 + (fr >> 3))) ? tt : -1; }
                }
                w0.x = (0 <= lim) ? w0.x : 0.f; w0.y = (1 <= lim) ? w0.y : 0.f; w0.z = (2 <= lim) ? w0.z : 0.f; w0.w = (3 <= lim) ? w0.w : 0.f;
                w1.x = (4 <= lim) ? w1.x : 0.f; w1.y = (5 <= lim) ? w1.y : 0.f; w1.z = (6 <= lim) ? w1.z : 0.f; w1.w = (7 <= lim) ? w1.w : 0.f;
                u32x4 pk; pk.x = cvt_pk_bf16(w0.x, w0.y); pk.y = cvt_pk_bf16(w0.z, w0.w); pk.z = cvt_pk_bf16(w1.x, w1.y); pk.w = cvt_pk_bf16(w1.z, w1.w);
                afr[kb][tb] = __builtin_bit_cast(bf16x8, pk);
            }
        }
        {
            const f32x4 vg0 = *(const f32x4*)(a.in[14] + lane * 8), vg1 = *(const f32x4*)(a.in[14] + lane * 8 + 4);
            for (int sb8 = 0; sb8 < kext; sb8 += 64) {
                u32x4 raw8[8];
#pragma unroll
                for (int i = 0; i < 8; ++i) { int rr = CB + sb8 + i * 8 + wave; rr = rr < M_ ? rr : M_ - 1; raw8[i] = *(const u32x4*)(PROJ + (size_t)rr * NIN + 2048 + lane * 8); }
#pragma unroll
                for (int i = 0; i < 8; ++i) {
                    const int s = sb8 + i * 8 + wave, row = CB + s; const u32x4 raw = raw8[i];
                    f32x4 v0 = bf4(raw.x, raw.y), v1 = bf4(raw.z, raw.w);
                    float ss = dot4(v0) + dot4(v1);
                    ss += __shfl_xor(ss, 1); ss += __shfl_xor(ss, 2); ss += __shfl_xor(ss, 4);
                    const float rs = rsqrtf(ss * (1.0f / 64.0f) + EPS_);
                    v0 = v0 * rs * vg0; v1 = v1 * rs * vg1;
                    u32x4 pk; pk.x = cvt_pk_bf16(v0.x, v0.y); pk.y = cvt_pk_bf16(v0.z, v0.w); pk.z = cvt_pk_bf16(v1.x, v1.y); pk.w = cvt_pk_bf16(v1.z, v1.w);
                    *(LAS u32x4*)(lds + s * VP + lane * 16) = pk;
                    if (s >= t0 && s < t0 + nrows) {
                        if (samp) { float* o = out + OUT_CVS + (size_t)(row - MP_) * 512 + lane * 8; *(f32x4*)o = v0; *(f32x4*)(o + 4) = v1; }
                        else if (s0 - t0 == 1920) { float* o = out + OUT_CVP + (size_t)((u >> 5) * 128 + s) * 512 + lane * 8; *(f32x4*)o = v0; *(f32x4*)(o + 4) = v1; }
                    }
                }
            }
        }
        __syncthreads();
        MIX_T(0);
        f32x4 acc[4][4];
#pragma unroll
        for (int i = 0; i < 4; ++i)
#pragma unroll
            for (int j = 0; j < 4; ++j) acc[i][j] = (f32x4){0.f, 0.f, 0.f, 0.f};
#pragma unroll
        for (int kb = 0; kb < 4; ++kb) if (kb < nkb) {
            u32x2 r0[4], r1[4];
            { const unsigned ta = (unsigned)(uintptr_t)(lds + (kb * 32 + fq * 8 + (fr >> 2)) * VP + (h * 64 + (fr & 3) * 4) * 2);
              asm volatile("ds_read_b64_tr_b16 %0, %8\n\tds_read_b64_tr_b16 %1, %8 offset:4224\n\t"
                           "ds_read_b64_tr_b16 %2, %8 offset:32\n\tds_read_b64_tr_b16 %3, %8 offset:4256\n\t"
                           "ds_read_b64_tr_b16 %4, %8 offset:64\n\tds_read_b64_tr_b16 %5, %8 offset:4288\n\t"
                           "ds_read_b64_tr_b16 %6, %8 offset:96\n\tds_read_b64_tr_b16 %7, %8 offset:4320\n\ts_waitcnt lgkmcnt(0)"
                           : "=&v"(r0[0]), "=&v"(r1[0]), "=&v"(r0[1]), "=&v"(r1[1]), "=&v"(r0[2]), "=&v"(r1[2]), "=&v"(r0[3]), "=&v"(r1[3]) : "v"(ta) : "memory"); }
#pragma unroll
            for (int db = 0; db < 4; ++db) {
                u32x4 bq; bq.x = r0[db].x; bq.y = r0[db].y; bq.z = r1[db].x; bq.w = r1[db].y;
                const bf16x8 bfv = __builtin_bit_cast(bf16x8, bq);
#pragma unroll
                for (int tb = 0; tb < 4; ++tb) if (tb < ntb) acc[tb][db] = __builtin_amdgcn_mfma_f32_16x16x32_bf16(bfv, afr[kb][tb], acc[tb][db], 0, 0, 0);
            }
        }
#pragma unroll
        for (int tb = 0; tb < 4; ++tb) if (tb < ntb) {
            const int t = tb * 16 + fr; const int tt = samp ? (fr & 7) : (t0 + t); const float bias = bsm[h * 128 + tt];
            const bf16_t* up = PROJ + (size_t)(R0 + t) * NIN + 1536 + h * 64 + fq * 4;
            float s = 0.f;
#pragma unroll
            for (int db = 0; db < 4; ++db) { const u32x2 ur = *(const u32x2*)(up + db * 16); const f32x4 uu = bf4(ur.x, ur.y);
                const f32x4 y = uu * (acc[tb][db] + bias); acc[tb][db] = y; s += dot4(y); }
            s += __shfl_xor(s, 16); s += __shfl_xor(s, 32);
            if (fq == 0) part[h * 64 + t] = s;
        }
        __syncthreads();
        MIX_T(1);
#pragma unroll
        for (int tb = 0; tb < 4; ++tb) if (tb < ntb) {
            const int t = tb * 16 + fr; float tot = 0.f;
#pragma unroll
            for (int hh = 0; hh < 8; ++hh) tot += part[hh * 64 + t];
            const float rs = rsqrtf(tot * (1.0f / 512.0f) + EPS_);
            bf16_t* yp = YC + (size_t)(R0 + t) * DM + 512 + h * 64 + fq * 4;
#pragma unroll
            for (int db = 0; db < 4; ++db) { const f32x4 gb = *(const f32x4*)(a.in[18] + h * 64 + db * 16 + fq * 4); const f32x4 y = acc[tb][db] * rs * gb;
                u32x2 w; w.x = cvt_pk_bf16(y.x, y.y); w.y = cvt_pk_bf16(y.z, y.w); ST8(ycrs, (unsigned)((R0 + t) * DM + 512 + h * 64 + fq * 4 + db * 16) * 2u, w); }
        }
        MIX_T(2);
        if (wave * 8 < nrows)
        {
            const int c0 = lane * 8; const float* cw = a.in[13];
            const f32x4 w0a = *(const f32x4*)(cw + c0), w0b = *(const f32x4*)(cw + c0 + 4), w1a = *(const f32x4*)(cw + 512 + c0), w1b = *(const f32x4*)(cw + 512 + c0 + 4),
                        w2a = *(const f32x4*)(cw + 1024 + c0), w2b = *(const f32x4*)(cw + 1024 + c0 + 4);
            const f32x4 gaa = *(const f32x4*)(a.in[17] + c0), gab = *(const f32x4*)(a.in[17] + c0 + 4);
            f32x4 zp2a = {0.f, 0.f, 0.f, 0.f}, zp2b = zp2a, zp1a = zp2a, zp1b = zp2a;
            const int rb = R0 + wave * 8; const int sb_ = ((R0 - MP_) >> 3) + wave;
            if (samp) { const float* st = a.in[4] + (size_t)sb_ * 1024 + c0; zp2a = *(const f32x4*)st; zp2b = *(const f32x4*)(st + 4); zp1a = *(const f32x4*)(st + 512); zp1b = *(const f32x4*)(st + 516); }
            else if (s0 + wave * 8 > 0) {
                const bf16_t* p2 = PROJ + (size_t)(rb - 2) * NIN + c0; const bf16_t* p1 = p2 + NIN;
                const u32x4 c2 = *(const u32x4*)(p2 + 512), h2 = *(const u32x4*)(p2 + 1024), c1 = *(const u32x4*)(p1 + 512), h1 = *(const u32x4*)(p1 + 1024);
                zp2a = bf4(c2.x, c2.y) * bf4(h2.x, h2.y); zp2b = bf4(c2.z, c2.w) * bf4(h2.z, h2.w); zp1a = bf4(c1.x, c1.y) * bf4(h1.x, h1.y); zp1b = bf4(c1.z, c1.w) * bf4(h1.z, h1.w);
            }
            f32x4 ya[8], yb[8]; float ss[8];
            u32x4 braw8[8], craw8[8], hraw8[8];
#pragma unroll
            for (int i = 0; i < 8; ++i) { const bf16_t* pr = PROJ + (size_t)(rb + i) * NIN + c0; braw8[i] = *(const u32x4*)pr; craw8[i] = *(const u32x4*)(pr + 512); hraw8[i] = *(const u32x4*)(pr + 1024); }
#pragma unroll
            for (int i = 0; i < 8; ++i) {
                const u32x4 braw = braw8[i], craw = craw8[i], hraw = hraw8[i];
                const f32x4 za = bf4(craw.x, craw.y) * bf4(hraw.x, hraw.y), zb = bf4(craw.z, craw.w) * bf4(hraw.z, hraw.w);
                const f32x4 ca = w0a * zp2a + w1a * zp1a + w2a * za, cb = w0b * zp2b + w1b * zp1b + w2b * zb;
                ya[i] = bf4(braw.x, braw.y) * ca; yb[i] = bf4(braw.z, braw.w) * cb;
                ss[i] = wave_sum(dot4(ya[i]) + dot4(yb[i]));
                if (i >= 6) {
                    if (samp) { float* o = out + OUT_NCS + ((size_t)sb_ * 2 + (i - 6)) * 512 + c0; *(f32x4*)o = za; *(f32x4*)(o + 4) = zb; }
                    else if ((u & 31) == 31 && wave == 7) { float* o = out + OUT_NCP + ((size_t)(u >> 5) * 2 + (i - 6)) * 512 + c0; *(f32x4*)o = za; *(f32x4*)(o + 4) = zb; }
                }
                zp2a = zp1a; zp2b = zp1b; zp1a = za; zp1b = zb;
            }
#pragma unroll
            for (int i = 0; i < 8; ++i) {
                const float rs = rsqrtf(ss[i] * (1.0f / 512.0f) + EPS_);
                const f32x4 y0 = ya[i] * rs * gaa, y1 = yb[i] * rs * gab;
                u32x4 w; w.x = cvt_pk_bf16(y0.x, y0.y); w.y = cvt_pk_bf16(y0.z, y0.w); w.z = cvt_pk_bf16(y1.x, y1.y); w.w = cvt_pk_bf16(y1.z, y1.w);
                ST16(ycrs, (unsigned)((rb + i) * DM + c0) * 2u, w);
            }
        }
        __syncthreads();
        MIX_T(3);
    }
}

constexpr int TR_I_G = (DM / 64) * (FF / 32), TR_I_D = (FF / 64) * (DM / 32), TR_I_IN = (DM / 64) * (NIN / 32), TR_I_O = (DM / 64) * (DM / 32), TR_I_PP = (PLE / 64) * (DM / 32);
constexpr int TR_A_END = 2 * TR_I_G + TR_I_IN + TR_I_O, TR_B_END = TR_A_END + TR_I_D, TR_C_END = TR_B_END + TR_I_G + TR_I_D + TR_I_O + TR_I_PP, TR_D_END = TR_C_END + TR_I_G;
__device__ __forceinline__ void tr_decode(const Args& a, unsigned char* ws, int it, TrItem& d) {
    int r = it; int mode = 0; d.gk = nullptr;
    if (r < TR_I_G) { d.W = a.in[7]; d.K = DM; d.N = FF; d.WT = (bf16_t*)(ws + WS_WGU1); mode = 1; d.gk = a.in[5]; }
    else if ((r -= TR_I_G) < TR_I_G) { d.W = a.in[8]; d.K = DM; d.N = FF; d.WT = (bf16_t*)(ws + WS_WGU1); mode = 2; d.gk = a.in[5]; }
    else if ((r -= TR_I_G) < TR_I_IN) { d.W = a.in[12]; d.K = DM; d.N = NIN; d.WT = (bf16_t*)(ws + WS_WIN); d.gk = a.in[10]; }
    else if ((r -= TR_I_IN) < TR_I_O) { d.W = a.in[19]; d.K = DM; d.N = DM; d.WT = (bf16_t*)(ws + WS_WOUT); }
    else if ((r -= TR_I_O) < TR_I_D) { d.W = a.in[9]; d.K = FF; d.N = DM; d.WT = (bf16_t*)(ws + WS_WD1); }
    else if ((r -= TR_I_D) < TR_I_G) { d.W = a.in[23]; d.K = DM; d.N = FF; d.WT = (bf16_t*)(ws + WS_WGU2); mode = 2; d.gk = a.in[20]; }
    else if ((r -= TR_I_G) < TR_I_D) { d.W = a.in[24]; d.K = FF; d.N = DM; d.WT = (bf16_t*)(ws + WS_WD2); }
    else if ((r -= TR_I_D) < TR_I_O) { d.W = a.in[25]; d.K = DM; d.N = DM; d.WT = (bf16_t*)(ws + WS_WPG); }
    else if ((r -= TR_I_O) < TR_I_PP) { d.W = a.in[26]; d.K = PLE; d.N = DM; d.WT = (bf16_t*)(ws + WS_WPP); }
    else { r -= TR_I_PP; d.W = a.in[22]; d.K = DM; d.N = FF; d.WT = (bf16_t*)(ws + WS_WGU2); mode = 1; d.gk = a.in[20]; }
    const int nblk = d.N / 32, kb = r / nblk, nb = r % nblk; d.k0 = 64 * kb; d.n0 = 32 * nb;
    d.drow0 = mode ? (d.n0 >> 7) * 256 + (d.n0 & 127) + (mode == 2 ? 128 : 0) : d.n0;
}
__device__ __forceinline__ void do_transposes(const Args& a, unsigned char* ws, LAS unsigned char* lds, int first, int last, int widx, int nwaves, int wave, int lane) {
    LAS float* scr = (LAS float*)(lds + wave * 8448);
    int it = first + widx;
    if (it < last) {
        TrItem d0, d1; f32x4 v0[8], v1[8]; float g0[8], g1[8];
        tr_decode(a, ws, it, d0); tr_load(d0, lane, v0, g0);
        for (;;) {
            const bool m1 = it + nwaves < last;
            if (m1) { tr_decode(a, ws, it + nwaves, d1); tr_load(d1, lane, v1, g1); }
            tr_store(d0, scr, lane, v0, g0);
            if (!m1) break;
            it += nwaves;
            const bool m0 = it + nwaves < last;
            if (m0) { tr_decode(a, ws, it + nwaves, d0); tr_load(d0, lane, v0, g0); }
            tr_store(d1, scr, lane, v1, g1);
            if (!m0) break;
            it += nwaves;
        }
    }
}
__device__ __forceinline__ int fresh_tid() { int t = threadIdx.x; asm volatile("" : "+v"(t)); return t; }
template <bool COOP>
__global__ void __launch_bounds__(512, 2) fwd_kernel(Args a) {
    extern __shared__ __attribute__((aligned(16))) unsigned char lds_raw[];
    LAS unsigned char* lds = (LAS unsigned char*)lds_raw;
    const int tid = threadIdx.x;
    const int G = gridDim.x, NGW = G * 8;
#define LANE_ (fresh_tid() & 63)
#define WAVE_ (__builtin_amdgcn_readfirstlane(fresh_tid() >> 6))
#define GW_ ((int)blockIdx.x * 8 + WAVE_)
    unsigned char* ws = a.ws;
    bf16_t* WGU1 = (bf16_t*)(ws + WS_WGU1); bf16_t* WD1 = (bf16_t*)(ws + WS_WD1); bf16_t* WIN = (bf16_t*)(ws + WS_WIN); bf16_t* WOUT = (bf16_t*)(ws + WS_WOUT);
    bf16_t* WGU2 = (bf16_t*)(ws + WS_WGU2); bf16_t* WD2 = (bf16_t*)(ws + WS_WD2); bf16_t* WPG = (bf16_t*)(ws + WS_WPG); bf16_t* WPP = (bf16_t*)(ws + WS_WPP);
    bf16_t* YC = (bf16_t*)(ws + WS_YC); bf16_t* HB = (bf16_t*)(ws + WS_HB); float* RS = (float*)(ws + WS_RS); bf16_t* ACT = (bf16_t*)(ws + WS_ACT); bf16_t* PROJ = (bf16_t*)(ws + WS_PROJ); bf16_t* PB = (bf16_t*)(ws + WS_PB);
    bf16_t* DB = (bf16_t*)(ws + WS_D); bf16_t* SLAB2 = (bf16_t*)(ws + WS_SLAB2); bf16_t* SLAB4 = (bf16_t*)(ws + WS_SLAB4); bf16_t* PP = (bf16_t*)(ws + WS_PP);
#define IN(k) (a.ph_lo <= (k) && (k) < a.ph_hi)
#define REP(k) for (int rep_ = 0; rep_ < (((MK_DUP >> (k)) & 1u) ? 2 : 1); ++rep_)
    XcdBarrier bar; bar.bar = (unsigned*)(ws + WS_BAR); bar.x = 0; bar.st = nullptr;
    if (COOP) {
        volatile LAS unsigned* st = (volatile LAS unsigned*)(lds + LDS_BYTES - 16);
        if (tid < 4) st[tid] = 0u;
        __syncthreads();
        bar = xcd_barrier_post((unsigned*)(ws + WS_BAR), st);
        if (a.ph_lo < 0) cg::this_grid().sync();
    }
#ifdef MK_TPROBE
#define MIXTQ_ (&tq_)
#else
#define MIXTQ_ nullptr
#endif
#ifdef MK_TPROBE
    unsigned long long tq_ = 0ull, tp_ = __builtin_amdgcn_s_memrealtime();
#define SEAM(k) do { if (COOP && IN(k) && IN((k) + 1)) { const unsigned long long t1_ = __builtin_amdgcn_s_memrealtime(); if ((MK_TW >> (k)) & 1u) tq_ += t1_ - tp_; xcd_barrier(bar); \
        const unsigned long long t2_ = __builtin_amdgcn_s_memrealtime(); if ((MK_TB >> (k)) & 1u) tq_ += t2_ - t1_; tp_ = t2_; } } while (0)
#else
#define SEAM(k) do { if (COOP && IN(k) && IN((k) + 1)) xcd_barrier(bar); } while (0)
#endif

    if (IN(0)) REP(0) {
        const int lane = LANE_, wave = WAVE_, gw = GW_;
        do_transposes(a, ws, lds, 0, TR_A_END, gw, NGW, wave, lane);
        rowpass<2 | 4 | 64, 0, 0>(nullptr, nullptr, nullptr, nullptr, a.in[0], a.in[1], HB, RS, nullptr, nullptr, 0.f, gw, NGW, lane);
    }
    SEAM(0);
    const int bid = (int)blockIdx.x;
#define GEMM_FULL(EPI, Aop, Bop, KK, MM, NN, ...) do { pg8::Gemm g_{Aop, Bop, KK, KK, KK}; pg8::StaticOrder S_; S_.init(MM, NN, G, bid); pg8::EPI E_{__VA_ARGS__}; \
        pg8::gemm_phase<pg8::EPI, pg8::StaticOrder, true, true>(lds, g_, S_, E_); } while (0)
#define GEMM_COMBO(E0T, PERMV, Aop, Bop, KK, NSL, S0, S1, N0, ...) do { typedef pg8::EpiCombo<pg8::E0T, pg8::EpiSlabT<PERMV>> EC_; pg8::Gemm g_{Aop, Bop, KK, KK, 256}; \
        pg8::ComboOrder S_; S_.full.init(MP_, DM, G, bid); S_.sub = pg8::SubOrder{64, 4, 4, NSL, G, bid}; EC_ E_{pg8::E0T{__VA_ARGS__}, pg8::EpiSlabT<PERMV>{S0, S1, N0, 64}}; \
        pg8::gemm_phase<EC_, pg8::ComboOrder, true, true>(lds, g_, S_, E_); } while (0)
    bf16_t* const YCF = YC;
    if (IN(1)) { REP(1) GEMM_FULL(EpiSwiglu, HB, WGU1, DM, M_, NGU, ACT, FF);
        { const int nwg = (M_ / 256) * (NGU / 256), rem = nwg % G, nidle = rem ? G - rem : G, idx = rem ? bid - rem : bid;
          if (idx >= 0) do_transposes(a, ws, lds, TR_A_END, TR_B_END, idx * 8 + WAVE_, nidle * 8, WAVE_, LANE_); } }
    SEAM(1);
    if (IN(2)) REP(2) GEMM_COMBO(EpiBf16, true, ACT, WD1, FF, 11, YCF, SLAB2, 8, DB, DM, nullptr);
    SEAM(2);
    if (IN(3)) rowpass<1 | 4 | 32 | 64, 11, 8>(DB, YCF, SLAB2, nullptr, nullptr, nullptr, HB, RS, nullptr, a.in[6], 0.5f, GW_, NGW, LANE_);
    SEAM(3);
    if (IN(4)) { REP(4) GEMM_FULL(EpiBf16, HB, WIN, DM, M_, NIN, PROJ, NIN, nullptr);
        { const int nwg = (M_ / 256) * (NIN / 256), rem = nwg % G, nidle = rem ? G - rem : G, idx = rem ? bid - rem : bid;
          if (idx >= 0) do_transposes(a, ws, lds, TR_B_END, TR_C_END, idx * 8 + WAVE_, nidle * 8, WAVE_, LANE_); } }
    SEAM(4);
    if (IN(5)) REP(5) mixer_phase(a, lds, PROJ, YC, WAVE_, LANE_, MIXTQ_);
    SEAM(5);
#ifdef MK_XBAR
#pragma nounroll
    for (int xb_ = 0; xb_ < MK_XBAR; ++xb_) xcd_barrier(bar);
#endif
    if (IN(6)) { REP(6) GEMM_COMBO(EpiBf16, true, YC, WOUT, DM, 4, SLAB4, SLAB4, 4, DB, DM, nullptr);
        if (G > 64 && bid >= 64) do_transposes(a, ws, lds, TR_C_END, TR_D_END, (bid - 64) * 8 + WAVE_, (G - 64) * 8, WAVE_, LANE_);
        else if (G <= 64) do_transposes(a, ws, lds, TR_C_END, TR_D_END, bid * 8 + WAVE_, G * 8, WAVE_, LANE_); }
    SEAM(6);
    if (IN(7)) rowpass<1 | 4 | 32 | 64, 4, 4>(DB, SLAB4, SLAB4, nullptr, nullptr, nullptr, HB, RS, nullptr, a.in[11], 1.0f, GW_, NGW, LANE_);
    SEAM(7);
    if (IN(8)) { REP(8) GEMM_FULL(EpiSwiglu, HB, WGU2, DM, M_, NGU, ACT, FF);
        { const int nwg = (M_ / 256) * (NGU / 256), rem = nwg % G, nidle = rem ? G - rem : G, idx = rem ? bid - rem : bid;
          if (idx >= 0) { const int lane = LANE_, w0 = idx * 8 + WAVE_, nw = nidle * 8;
            for (int m0 = w0; m0 < M_; m0 += 8 * nw) {
                f32x4 v[8];
#pragma unroll
                for (int q = 0; q < 8; ++q) { const int m = m0 + q * nw; if (m < M_) { const float* pr = (m < MP_) ? a.in[2] + (size_t)m * PLE : a.in[3] + (size_t)(m - MP_) * PLE; v[q] = ((const f32x4*)pr)[lane]; } }
#pragma unroll
                for (int q = 0; q < 8; ++q) { const int m = m0 + q * nw; if (m < M_) { u32x2 w; w.x = cvt_pk_bf16(v[q].x, v[q].y); w.y = cvt_pk_bf16(v[q].z, v[q].w); ((u32x2*)(PB + (size_t)m * PLE))[lane] = w; } } } } } }
    SEAM(8);
    if (IN(9)) REP(9) GEMM_COMBO(EpiBf16, true, ACT, WD2, FF, 11, YCF, SLAB2, 8, DB, DM, nullptr);
    SEAM(9);
    if (IN(10)) {
        rowpass<1 | 4 | 32, 11, 8>(DB, YCF, SLAB2, nullptr, nullptr, nullptr, HB, RS, nullptr, a.in[21], 0.5f, GW_, NGW, LANE_);
    }
    SEAM(10);
    if (IN(11)) REP(11) { GEMM_FULL(EpiBf16N, PB, WPP, PLE, MP_, DM, PP, DM);
        { pg8::Gemm g_{PB, WPP, PLE, PLE, PLE}; pg8::SubOrder S_{64, 4, 4, 1, G, (bid >= 64 && bid < 80) ? bid - 64 : -1}; pg8::EpiBf16N E_{PP, DM};
          pg8::gemm_phase<pg8::EpiBf16N, pg8::SubOrder, true, true>(lds, g_, S_, E_); } }
    if (IN(12)) REP(12) GEMM_COMBO(EpiPle, false, HB, WPG, DM, 4, SLAB4, SLAB4, 4, DB, PP, DM);
    SEAM(12);
    if (IN(13)) rowpass<1 | 8 | 16, 4, 4>(DB, SLAB4, SLAB4, PP, nullptr, nullptr, HB, nullptr, a.out, a.in[27], 1.0f, GW_, NGW, LANE_);
#ifdef MK_TPROBE
    if (blockIdx.x == 0) { const unsigned long long t1_ = __builtin_amdgcn_s_memrealtime(); if ((MK_TW >> 13) & 1u) tq_ += t1_ - tp_;
        while (__builtin_amdgcn_s_memrealtime() - t1_ < 4ull * tq_) __builtin_amdgcn_s_sleep(8); }
#endif
#undef IN
#undef SEAM
}

extern "C" void kernel_launch(void* const* d_in, const int* in_sizes, int n_in, void* d_out, int out_size, void* d_ws, size_t ws_size, hipStream_t stream) {
    static int grid = 0;
    if (grid == 0) {
        if (n_in != 28 || out_size != 19013632 || ws_size < WS_TOTAL) { fprintf(stderr, "kernel_launch: unexpected shapes: n_in %d out %d ws %zu (need %zu)\n", n_in, out_size, ws_size, (size_t)WS_TOTAL); grid = -1; return; }
        int dev = 0, cus = 0, per_cu = 0;
        if (hipGetDevice(&dev) != hipSuccess || hipDeviceGetAttribute(&cus, hipDeviceAttributeMultiprocessorCount, dev) != hipSuccess) { fprintf(stderr, "kernel_launch: device query failed\n"); grid = -1; return; }
        if (hipFuncSetAttribute((const void*)fwd_kernel<true>, hipFuncAttributeMaxDynamicSharedMemorySize, LDS_BYTES) != hipSuccess) { fprintf(stderr, "kernel_launch: hipFuncSetAttribute failed\n"); grid = -1; return; }
        if (hipOccupancyMaxActiveBlocksPerMultiprocessor(&per_cu, (const void*)fwd_kernel<true>, 512, LDS_BYTES) != hipSuccess || per_cu < 1) { fprintf(stderr, "kernel_launch: occupancy query says %d blocks per CU\n", per_cu); per_cu = 1; }
        (void)hipGetLastError();
        grid = cus * per_cu;
        fprintf(stderr, "kernel_launch: grid %d (cus %d x %d)\n", grid, cus, per_cu);
    }
    if (grid < 0) return;
    Args a{};
    for (int i = 0; i < 28; ++i) a.in[i] = (const float*)d_in[i];
    a.out = (float*)d_out; a.ws = (unsigned char*)d_ws;
#if MK_COOP
    if (hipMemsetAsync((char*)d_ws + WS_BAR, 0, (size_t)XCD_BAR_WORDS * 4, stream) != hipSuccess) { fprintf(stderr, "kernel_launch: memset of the barrier words failed\n"); return; }
    a.ph_lo = 0; a.ph_hi = NPHASE;
    void* args[] = {&a};
    const hipError_t e = hipLaunchCooperativeKernel((const void*)fwd_kernel<true>, dim3(grid), dim3(512), args, LDS_BYTES, stream);
    if (e != hipSuccess) fprintf(stderr, "kernel_launch: cooperative launch failed: %s (grid %d)\n", hipGetErrorString(e), grid);
#endif
}
```

```cpp
#include <hip/hip_runtime.h>
#include <hip/hip_cooperative_groups.h>
#include <cstdio>
#include <cstdint>
namespace cg = cooperative_groups;
#define MK_DUP 0u
namespace pg8 {
#define PG8_LAS __attribute__((address_space(3)))
typedef unsigned short bf16_t;
typedef short bf16x8 __attribute__((ext_vector_type(8)));
typedef float f32x4 __attribute__((ext_vector_type(4)));
typedef unsigned u32x4 __attribute__((ext_vector_type(4)));
constexpr int BM = 256, BK = 64, HALF = 128, HTB = HALF * BK * 2  , STAGE_BYTES = 8 * HTB, NXCD = 8, WGM = 8;

__host__ __device__ __forceinline__ int lds_byte(int r, int c) { const int st = (r >> 4) * 2 + (c >> 5), rr = r & 15, cc = c & 31, ob = rr * 64 + cc * 2; return st * 1024 + (ob ^ (((ob >> 9) & 1) << 5)); }
__host__ __device__ __forceinline__ void stage_rc(int b, int& R, int& C) { const int st = b / 1024, sb = b % 1024, swz = sb ^ (((sb >> 9) & 1) << 5); R = (st >> 1) * 16 + swz / 64; C = (st & 1) * 32 + (swz % 64) / 2; }
__host__ __device__ __forceinline__ int perm32(int rho) { const int n = rho >> 4, i = rho & 15; return 8 * (i >> 2) + 4 * n + (i & 3); }

struct Unit { int pm, pn, ks, kind; };
struct Gemm { const bf16_t* A; const bf16_t* Bt; int ld, K, kslice; };

struct StaticOrder {
    int nM, nN, nwg, G, c;
    __host__ __device__ void init(int M, int N, int G_, int c_) { nM = M / BM; nN = N / BM; nwg = nM * nN; G = G_; c = c_; }
    __host__ __device__ bool next(int i, Unit& u) const {
        const long L = (long)i * G + c; if (L >= nwg) return false;
        int wgid = (int)L; { const int q = nwg / NXCD, r = nwg % NXCD, xcd = wgid % NXCD, off = wgid / NXCD; wgid = (xcd < r ? xcd * (q + 1) : r * (q + 1) + (xcd - r) * q) + off; }
        const int nig = WGM * nN, gid = wgid / nig, fm = gid * WGM, gsz = (nM - fm) < WGM ? (nM - fm) : WGM;
        u.pm = fm + ((wgid % nig) % gsz); u.pn = (wgid % nig) / gsz; u.ks = 0; u.kind = 0; return true;
    }
    __device__ __forceinline__ void a_ready(const Unit&) const {}
    __device__ __forceinline__ void done(const Unit&) const {}
};
struct SubOrder {
    int pm0, npm, nN, nsl, G, c;
    __host__ __device__ bool next(int i, Unit& u) const {
        const int L = i * G + c; if (c < 0 || L >= npm * nN * nsl) return false;
        const int t = L / nsl; u.ks = L - t * nsl; u.pn = t % nN; u.pm = pm0 + t / nN; u.kind = (nsl > 1) ? 1 : 0; return true;
    }
    __device__ __forceinline__ void a_ready(const Unit&) const {}
    __device__ __forceinline__ void done(const Unit&) const {}
};
struct ComboOrder {
    StaticOrder full; SubOrder sub;
    __host__ __device__ bool next(int i, Unit& u) const {
        if (full.next(i, u)) return true;
        const int nf = (full.c < full.nwg) ? (full.nwg - full.c + full.G - 1) / full.G : 0;
        return sub.next(i - nf, u);
    }
    __device__ __forceinline__ void a_ready(const Unit&) const {}
    __device__ __forceinline__ void done(const Unit&) const {}
};
typedef unsigned u32x2 __attribute__((ext_vector_type(2)));

__device__ __forceinline__ unsigned cvt_pk_bf16(float lo, float hi) { unsigned r; asm("v_cvt_pk_bf16_f32 %0, %1, %2" : "=v"(r) : "v"(lo), "v"(hi)); return r; }
__device__ __forceinline__ float sigmoid_f(float x) { return __builtin_amdgcn_rcpf(1.0f + __builtin_amdgcn_exp2f(x * -1.44269504089f)); }

#ifndef MK_WT
#define MK_WT 0
#endif
typedef __attribute__((__vector_size__(4 * sizeof(int)))) int rsrc_t;
constexpr int WT_AUX = MK_WT ? 16 : 0;
__device__ __forceinline__ auto mk_rsrc(const void* base) { return __builtin_amdgcn_make_buffer_rsrc((void*)base, 0, 0x7fffffff, 0x00020000); }
#define ST16(rsrc, byteoff, v) __builtin_amdgcn_raw_buffer_store_b128(__builtin_bit_cast(u32x4, v), rsrc, (int)(byteoff), 0, pg8::WT_AUX)
#define ST8(rsrc, byteoff, v)  __builtin_amdgcn_raw_buffer_store_b64(__builtin_bit_cast(u32x2, v), rsrc, (int)(byteoff), 0, pg8::WT_AUX)

struct EpiF32 {
    static constexpr bool PERM = false, AFTER_DRAIN = false;
    float* C; int ldc;
    __device__ __forceinline__ void operator()(const f32x4 (&acc)[2][2][4][2], const Unit& u, int wr, int wc, int fr_, int fq_) const {
        int tl_ = threadIdx.x; asm volatile("" : "+v"(tl_)); const int fr = tl_ & 15, fq = (tl_ >> 4) & 3;
        const int row0 = u.pm * BM + wr * 64 + fr, col0 = u.pn * BM + wc * 32 + 4 * fq; float* const Cb_ = C;
#pragma unroll
        for (int ai = 0; ai < 2; ++ai)
#pragma unroll
            for (int m = 0; m < 4; ++m) { const unsigned ro = ((unsigned)(row0 + ai * HALF + m * 16) * (unsigned)ldc + (unsigned)col0) * 4u;
#pragma unroll
                for (int bj = 0; bj < 2; ++bj)
#pragma unroll
                    for (int n = 0; n < 2; ++n) *(f32x4*)((char*)Cb_ + ro + (bj * HALF + n * 16) * 4) = acc[ai][bj][m][n]; }
    }
};
struct EpiBf16N {
    static constexpr bool PERM = false, AFTER_DRAIN = false;
    bf16_t* O; int ldc;
    __device__ __forceinline__ void operator()(const f32x4 (&acc)[2][2][4][2], const Unit& u, int wr, int wc, int fr_, int fq_) const {
        int tl_ = threadIdx.x; asm volatile("" : "+v"(tl_)); const int fr = tl_ & 15, fq = (tl_ >> 4) & 3;
        const int row0 = u.pm * BM + wr * 64 + fr, col0 = u.pn * BM + wc * 32 + 4 * fq;
#pragma unroll
        for (int ai = 0; ai < 2; ++ai)
#pragma unroll
            for (int m = 0; m < 4; ++m) { const size_t off = (size_t)(row0 + ai * HALF + m * 16) * ldc + col0;
#pragma unroll
                for (int bj = 0; bj < 2; ++bj)
#pragma unroll
                    for (int n = 0; n < 2; ++n) { const f32x4 a = acc[ai][bj][m][n]; u32x2 w; w.x = cvt_pk_bf16(a.x, a.y); w.y = cvt_pk_bf16(a.z, a.w); *(u32x2*)(O + off + bj * HALF + n * 16) = w; } }
    }
};
struct EpiPle {
    static constexpr bool PERM = false, AFTER_DRAIN = false;
    bf16_t* T; const bf16_t* P; int ldc;
    __device__ __forceinline__ void operator()(const f32x4 (&acc)[2][2][4][2], const Unit& u, int wr, int wc, int fr_, int fq_) const {
        int tl_ = threadIdx.x; asm volatile("" : "+v"(tl_)); const int fr = tl_ & 15, fq = (tl_ >> 4) & 3;
        const int row0 = u.pm * BM + wr * 64 + fr, col0 = u.pn * BM + wc * 32 + 4 * fq;
#pragma unroll
        for (int ai = 0; ai < 2; ++ai)
#pragma unroll
            for (int m = 0; m < 4; ++m) { const size_t off = (size_t)(row0 + ai * HALF + m * 16) * ldc + col0;
#pragma unroll
                for (int bj = 0; bj < 2; ++bj)
#pragma unroll
                    for (int n = 0; n < 2; ++n) { const u32x2 pw = *(const u32x2*)(P + off + bj * HALF + n * 16); const f32x4 a = acc[ai][bj][m][n];
                        const f32x4 p = {__uint_as_float(pw.x << 16), __uint_as_float(pw.x & 0xffff0000u), __uint_as_float(pw.y << 16), __uint_as_float(pw.y & 0xffff0000u)};
                        u32x2 w; w.x = cvt_pk_bf16(sigmoid_f(a.x) * p.x, sigmoid_f(a.y) * p.y); w.y = cvt_pk_bf16(sigmoid_f(a.z) * p.z, sigmoid_f(a.w) * p.w);
                        *(u32x2*)(T + off + bj * HALF + n * 16) = w; } }
    }
};
template <bool PERM_> struct EpiSlabT {
    static constexpr bool PERM = PERM_, AFTER_DRAIN = false;
    bf16_t* base0; bf16_t* base1; int n0; int pm0;
    __device__ __forceinline__ void operator()(const f32x4 (&acc)[2][2][4][2], const Unit& u, int wr, int wc, int fr_, int fq_) const {
        int tl_ = threadIdx.x; asm volatile("" : "+v"(tl_)); const int fr = tl_ & 15, fq = (tl_ >> 4) & 3;
        const int row0 = (u.pm - pm0) * BM + wr * 64 + fr, col0 = u.pn * BM + wc * 32 + (PERM_ ? 8 : 4) * fq;
        bf16_t* const Cb_ = (u.ks < n0) ? base0 + ((size_t)u.ks << 20) : base1 + ((size_t)(u.ks - n0) << 20);
#pragma unroll
        for (int ai = 0; ai < 2; ++ai)
#pragma unroll
            for (int m = 0; m < 4; ++m) { const unsigned ro = ((unsigned)(row0 + ai * HALF + m * 16) * 1024u + (unsigned)col0) * 2u;
#pragma unroll
                for (int bj = 0; bj < 2; ++bj)
#pragma unroll
                    for (int n = 0; n < 2; ++n) { const f32x4 a = acc[ai][bj][m][n]; u32x2 w; w.x = cvt_pk_bf16(a.x, a.y); w.y = cvt_pk_bf16(a.z, a.w);
                        *(u32x2*)((char*)Cb_ + ro + (bj * HALF + n * (PERM_ ? 4 : 16)) * 2) = w; } }
    }
};
struct EpiBf16 {
    static constexpr bool PERM = true, AFTER_DRAIN = false;
    bf16_t* O; int ldc; const float* rs;
    __device__ __forceinline__ void operator()(const f32x4 (&acc)[2][2][4][2], const Unit& u, int wr, int wc, int fr_, int fq_) const {
        int tl_ = threadIdx.x; asm volatile("" : "+v"(tl_)); const int fr = tl_ & 15, fq = (tl_ >> 4) & 3;
        const int row0 = u.pm * BM + wr * 64 + fr, col0 = u.pn * BM + wc * 32 + 8 * fq; const auto rs_ = mk_rsrc(O);
#pragma unroll
        for (int ai = 0; ai < 2; ++ai)
#pragma unroll
            for (int m = 0; m < 4; ++m) { const int row = row0 + ai * HALF + m * 16; const unsigned ro = ((unsigned)row * (unsigned)ldc + (unsigned)col0) * 2u; const float r = rs ? rs[row] : 1.0f;
#pragma unroll
                for (int bj = 0; bj < 2; ++bj) { const f32x4 v0 = acc[ai][bj][m][0] * r, v1 = acc[ai][bj][m][1] * r;
                    u32x4 w; w.x = cvt_pk_bf16(v0[0], v0[1]); w.y = cvt_pk_bf16(v0[2], v0[3]); w.z = cvt_pk_bf16(v1[0], v1[1]); w.w = cvt_pk_bf16(v1[2], v1[3]);
                    ST16(rs_, ro + bj * HALF * 2, w); } }
    }
};
struct EpiSwiglu {
    static constexpr bool PERM = true, AFTER_DRAIN = false;
    bf16_t* O; int ldc;
    static __device__ __forceinline__ f32x4 silu_mul(f32x4 g, f32x4 u) {
        f32x4 t = g * -1.44269504089f;
        t.x = __builtin_fminf(t.x, 60.f); t.y = __builtin_fminf(t.y, 60.f); t.z = __builtin_fminf(t.z, 60.f); t.w = __builtin_fminf(t.w, 60.f);
        f32x4 e; e.x = __builtin_amdgcn_exp2f(t.x); e.y = __builtin_amdgcn_exp2f(t.y); e.z = __builtin_amdgcn_exp2f(t.z); e.w = __builtin_amdgcn_exp2f(t.w);
        const f32x4 d = e + 1.0f;
        const float r01 = __builtin_amdgcn_rcpf(d.x * d.y), r23 = __builtin_amdgcn_rcpf(d.z * d.w);
        const f32x4 sg = {d.y * r01, d.x * r01, d.w * r23, d.z * r23};
        return (g * sg) * u;
    }
    __device__ __forceinline__ void operator()(const f32x4 (&acc)[2][2][4][2], const Unit& u, int wr, int wc, int fr_, int fq_) const {
        int tl_ = threadIdx.x; asm volatile("" : "+v"(tl_)); const int fr = tl_ & 15, fq = (tl_ >> 4) & 3;
        const int row0 = u.pm * BM + wr * 64 + fr, col0 = u.pn * HALF + wc * 32 + 8 * fq; const auto rs_ = mk_rsrc(O);
#pragma unroll
        for (int ai = 0; ai < 2; ++ai)
#pragma unroll
            for (int m = 0; m < 4; ++m) { const unsigned ro = ((unsigned)(row0 + ai * HALF + m * 16) * (unsigned)ldc + (unsigned)col0) * 2u;
                const f32x4 v0 = silu_mul(acc[ai][0][m][0], acc[ai][1][m][0]), v1 = silu_mul(acc[ai][0][m][1], acc[ai][1][m][1]);
                u32x4 w; w.x = cvt_pk_bf16(v0[0], v0[1]); w.y = cvt_pk_bf16(v0[2], v0[3]); w.z = cvt_pk_bf16(v1[0], v1[1]); w.w = cvt_pk_bf16(v1[2], v1[3]);
                ST16(rs_, ro, w); }
    }
};
template <class E0, class E1> struct EpiCombo {
    static_assert(E0::PERM == E1::PERM, "one staging order per phase");
    static constexpr bool PERM = E0::PERM, AFTER_DRAIN = false;
    E0 e0; E1 e1;
    __device__ __forceinline__ void operator()(const f32x4 (&acc)[2][2][4][2], const Unit& u, int wr, int wc, int fr, int fq) const {
        if (u.kind == 0) e0(acc, u, wr, wc, fr, fq); else e1(acc, u, wr, wc, fr, fq);
    }
};

template <class Epi, class Sched, bool ALIGN_EPI = false, bool SP2 = false>
__device__ __forceinline__ void gemm_phase(PG8_LAS unsigned char* lds, const Gemm g, const Sched& S, const Epi& E) {
    int tid_ = threadIdx.x; asm volatile("" : "+v"(tid_));
    const int tid = tid_, wid = __builtin_amdgcn_readfirstlane(tid >> 6), lane = tid & 63, wr = wid >> 2, wc = wid & 3, fr = lane & 15, fq = lane >> 4;
    const int K = g.K, nt = K / BK;
    unsigned voffA[2], voffB[2];
#pragma unroll
    for (int i = 0; i < 2; ++i) { int R, C; stage_rc(tid * 16 + i * 8192, R, C); const int Rb = Epi::PERM ? ((R & ~31) + perm32(R & 31)) : R;
        voffA[i] = (unsigned)(R * g.ld + C) * 2u; voffB[i] = (unsigned)(Rb * g.ld + C) * 2u; }
    const size_t kstep = (size_t)(BK * 2);
    const size_t hstepA = (size_t)HALF * g.ld * 2, hstepB = hstepA;
    const size_t kslice = (size_t)g.kslice * 2;
    const unsigned ldsw = (unsigned)wid * 1024u;
    const int aoff = lds_byte(wr * 64 + fr, fq * 8), boff = lds_byte(wc * 32 + fr, fq * 8);
#define PG8_SA(b, h) (((b) * 2 + (h)) * HTB)
#define PG8_SB(b, h) ((4 + (b) * 2 + (h)) * HTB)
#define PG8_STAGE(bufoff, gbase, voff) do { _Pragma("unroll") for (int _i = 0; _i < 2; ++_i) \
        __builtin_amdgcn_global_load_lds((const unsigned*)((const char*)(gbase) + (voff)[_i]), (PG8_LAS unsigned*)(lds + (bufoff) + ldsw + _i * 8192), 16, 0, 0); } while (0)
#define PG8_LDA(dst, b, h) do { _Pragma("unroll") for (int m = 0; m < 4; ++m) _Pragma("unroll") for (int k = 0; k < 2; ++k) dst[m][k] = *(const PG8_LAS bf16x8*)(lds + PG8_SA(b, h) + aoff + m * 2048 + k * 1024); } while (0)
#define PG8_LDB(dst, b, h) do { _Pragma("unroll") for (int n = 0; n < 2; ++n) _Pragma("unroll") for (int k = 0; k < 2; ++k) dst[n][k] = *(const PG8_LAS bf16x8*)(lds + PG8_SB(b, h) + boff + n * 2048 + k * 1024); } while (0)
#define PG8_MMA(ai, bj, At, Bt) do { __builtin_amdgcn_s_setprio(1); _Pragma("unroll") for (int m = 0; m < 4; ++m) _Pragma("unroll") for (int n = 0; n < 2; ++n) _Pragma("unroll") for (int k = 0; k < 2; ++k) \
        acc[ai][bj][m][n] = __builtin_amdgcn_mfma_f32_16x16x32_bf16(Bt[n][k], At[m][k], acc[ai][bj][m][n], 0, 0, 0); __builtin_amdgcn_s_setprio(0); } while (0)
#define PG8_WAIT_V(n) asm volatile("s_waitcnt vmcnt(" #n ")" ::: "memory")
#define PG8_WAIT_L(n) asm volatile("s_waitcnt lgkmcnt(" #n ")" ::: "memory")
#define PG8_BAR __builtin_amdgcn_s_barrier()
#define PG8_SCHED __builtin_amdgcn_sched_barrier(0)
    Unit cur, nxt; int ui = 0;
    if (!S.next(0, cur)) return;
    f32x4 acc[2][2][4][2];
#pragma unroll
    for (int a = 0; a < 2; ++a)
#pragma unroll
        for (int b = 0; b < 2; ++b)
#pragma unroll
            for (int m = 0; m < 4; ++m)
#pragma unroll
                for (int n = 0; n < 2; ++n) acc[a][b][m][n] = (f32x4){0.f, 0.f, 0.f, 0.f};
    bf16x8 At[4][2], B0[2][2], B1[2][2];
    const char* cA = (const char*)g.A + (size_t)cur.pm * 2 * hstepA + (size_t)cur.ks * kslice; const char* cB = (const char*)g.Bt + (size_t)cur.pn * 2 * hstepB + (size_t)cur.ks * kslice;
    S.a_ready(cur);
    if constexpr (SP2) {
        PG8_STAGE(PG8_SB(0, 0), cB, voffB); PG8_STAGE(PG8_SB(0, 1), cB + hstepB, voffB); PG8_STAGE(PG8_SA(0, 0), cA, voffA); PG8_STAGE(PG8_SA(0, 1), cA + hstepA, voffA);
        if (wr == 1) PG8_BAR;
        PG8_WAIT_V(2); PG8_BAR;
        PG8_STAGE(PG8_SB(1, 0), cB + kstep, voffB); PG8_STAGE(PG8_SA(1, 0), cA + kstep, voffA); PG8_STAGE(PG8_SB(1, 1), cB + hstepB + kstep, voffB);
        PG8_WAIT_V(6); PG8_BAR;
    } else {
        PG8_STAGE(PG8_SB(0, 0), cB, voffB); PG8_STAGE(PG8_SA(0, 0), cA, voffA); PG8_STAGE(PG8_SB(0, 1), cB + hstepB, voffB); PG8_STAGE(PG8_SA(0, 1), cA + hstepA, voffA);
        if (wr == 1) PG8_BAR;
        PG8_WAIT_V(4); PG8_BAR;
        PG8_STAGE(PG8_SB(1, 0), cB + kstep, voffB); PG8_STAGE(PG8_SA(1, 0), cA + kstep, voffA); PG8_STAGE(PG8_SB(1, 1), cB + hstepB + kstep, voffB);
        PG8_WAIT_V(6); PG8_BAR;
    }
    for (;;) {
        const bool has_next = S.next(ui + 1, nxt);
        const char* nA = has_next ? (const char*)g.A + (size_t)nxt.pm * 2 * hstepA + (size_t)nxt.ks * kslice : cA; const char* nB = has_next ? (const char*)g.Bt + (size_t)nxt.pn * 2 * hstepB + (size_t)nxt.ks * kslice : cB;
        const int ntu = (cur.kind != 0) ? g.kslice / BK : nt;
        for (int t = 0; t < ntu; t += 2) {
            const bool last = (t == ntu - 2);
            const char* a1 = cA + (size_t)(t + 1) * kstep;
            const char* a2 = last ? nA : cA + (size_t)(t + 2) * kstep; const char* b2 = last ? nB : cB + (size_t)(t + 2) * kstep;
            const char* a3 = a2 + kstep; const char* b3 = b2 + kstep;
            if (last && has_next) S.a_ready(nxt);
            if constexpr (SP2) {
            PG8_LDB(B0, 0, 0); PG8_LDB(B1, 0, 1); PG8_SCHED; PG8_LDA(At, 0, 0); PG8_STAGE(PG8_SA(1, 1), a1 + hstepA, voffA);
            PG8_WAIT_V(8); PG8_WAIT_L(0); PG8_BAR; PG8_MMA(0, 0, At, B0); PG8_MMA(0, 1, At, B1); PG8_BAR; PG8_SCHED;
            PG8_LDA(At, 0, 1); PG8_STAGE(PG8_SB(0, 0), b2, voffB); PG8_STAGE(PG8_SB(0, 1), b2 + hstepB, voffB); PG8_STAGE(PG8_SA(0, 0), a2, voffA);
            PG8_WAIT_V(8); PG8_WAIT_L(0); PG8_BAR; PG8_MMA(1, 0, At, B0); PG8_MMA(1, 1, At, B1); PG8_BAR; PG8_SCHED;
            PG8_LDB(B0, 1, 0); PG8_LDB(B1, 1, 1); PG8_SCHED; PG8_LDA(At, 1, 0); PG8_STAGE(PG8_SA(0, 1), a2 + hstepA, voffA);
            PG8_WAIT_V(8); PG8_WAIT_L(0); PG8_BAR; PG8_MMA(0, 0, At, B0); PG8_MMA(0, 1, At, B1); PG8_BAR; PG8_SCHED;
            PG8_LDA(At, 1, 1); PG8_STAGE(PG8_SB(1, 0), b3, voffB); PG8_STAGE(PG8_SB(1, 1), b3 + hstepB, voffB); PG8_STAGE(PG8_SA(1, 0), a3, voffA);
            PG8_WAIT_V(8); PG8_WAIT_L(0); PG8_BAR; PG8_MMA(1, 0, At, B0); PG8_MMA(1, 1, At, B1); PG8_BAR; PG8_SCHED;
            } else {
            PG8_LDB(B0, 0, 0); PG8_SCHED; PG8_LDA(At, 0, 0); PG8_STAGE(PG8_SA(1, 1), a1 + hstepA, voffA);
            PG8_WAIT_L(8); PG8_BAR; PG8_WAIT_L(0); PG8_MMA(0, 0, At, B0); PG8_BAR; PG8_SCHED;
            PG8_LDB(B1, 0, 1); PG8_STAGE(PG8_SB(0, 0), b2, voffB);
            PG8_BAR; PG8_WAIT_L(0); PG8_MMA(0, 1, At, B1); PG8_BAR;
            PG8_LDA(At, 0, 1); PG8_STAGE(PG8_SA(0, 0), a2, voffA);
            PG8_BAR; PG8_WAIT_L(0); PG8_MMA(1, 0, At, B0); PG8_BAR; PG8_SCHED;
            PG8_STAGE(PG8_SB(0, 1), b2 + hstepB, voffB);
            PG8_WAIT_V(6); PG8_BAR; PG8_MMA(1, 1, At, B1); PG8_BAR;
            PG8_LDB(B0, 1, 0); PG8_SCHED; PG8_LDA(At, 1, 0); PG8_STAGE(PG8_SA(0, 1), a2 + hstepA, voffA);
            PG8_WAIT_L(8); PG8_BAR; PG8_WAIT_L(0); PG8_MMA(0, 0, At, B0); PG8_BAR; PG8_SCHED;
            PG8_LDB(B1, 1, 1); PG8_STAGE(PG8_SB(1, 0), b3, voffB);
            PG8_BAR; PG8_WAIT_L(0); PG8_MMA(0, 1, At, B1); PG8_BAR;
            PG8_LDA(At, 1, 1); PG8_STAGE(PG8_SA(1, 0), a3, voffA);
            PG8_BAR; PG8_WAIT_L(0); PG8_MMA(1, 0, At, B0); PG8_BAR; PG8_SCHED;
            PG8_STAGE(PG8_SB(1, 1), b3 + hstepB, voffB);
            PG8_WAIT_V(6); PG8_BAR; PG8_MMA(1, 1, At, B1); PG8_BAR;
            }
        }
        if constexpr (ALIGN_EPI) { if (wr == 0) PG8_BAR; }
        if constexpr (!Epi::AFTER_DRAIN) { E(acc, cur, wr, wc, fr, fq); S.done(cur); }
        if (!has_next) break;
#pragma unroll
        for (int a = 0; a < 2; ++a)
#pragma unroll
            for (int b = 0; b < 2; ++b)
#pragma unroll
                for (int m = 0; m < 4; ++m)
#pragma unroll
                    for (int n = 0; n < 2; ++n) acc[a][b][m][n] = (f32x4){0.f, 0.f, 0.f, 0.f};
        cur = nxt; cA = nA; cB = nB; ++ui;
        if constexpr (ALIGN_EPI) { if (wr == 1) PG8_BAR; }
    }
    PG8_WAIT_V(0);
    if constexpr (!ALIGN_EPI) { if (wr == 0) PG8_BAR; }
    PG8_BAR;
    if constexpr (Epi::AFTER_DRAIN) { E.fused(acc, cur, wr, wc, fr, fq, lds, wid, lane); S.done(cur); }
#undef PG8_SA
#undef PG8_SB
#undef PG8_STAGE
#undef PG8_LDA
#undef PG8_LDB
#undef PG8_MMA
#undef PG8_WAIT_V
#undef PG8_WAIT_L
#undef PG8_BAR
#undef PG8_SCHED
}
}

using pg8::bf16_t; using pg8::bf16x8; using pg8::f32x4; using pg8::u32x4; using pg8::u32x2; using pg8::cvt_pk_bf16;
#define LAS __attribute__((address_space(3)))
#define XB_TMO      128
#define XB_XCNT(j)  (256  + 64 * (j))
#define XB_XSUB(j)  (1280 + 64 * (j))
#define XB_XGEN(j)  (2304 + 64 * (j))
#define XB_TOP      3328
#define XB_TOPGEN   3392
#define XCD_BAR_WORDS 3456
#define XB_SPIN_CAP (1u << 18)

__device__ __forceinline__ unsigned xb_ld(unsigned* p)              { return __hip_atomic_load(p, __ATOMIC_RELAXED, __HIP_MEMORY_SCOPE_AGENT); }
__device__ __forceinline__ unsigned xb_add(unsigned* p, unsigned v) { return __hip_atomic_fetch_add(p, v, __ATOMIC_RELAXED, __HIP_MEMORY_SCOPE_AGENT); }
__device__ __forceinline__ unsigned xb_xcc_id() { return (unsigned)__builtin_amdgcn_s_getreg((3 << 11) | 20) & 0xFu; }
#define XB_SPIN(cond, bar) do { unsigned _sp = 0; while (cond) { __builtin_amdgcn_s_sleep(1); \
    if ((++_sp & 255u) == 0u) { if (xb_ld(&(bar)[XB_TMO])) break; if (_sp > XB_SPIN_CAP) { atomicAdd(&(bar)[XB_TMO], 1u); break; } } } } while (0)

struct XcdBarrier {
    unsigned* bar; unsigned x;
    volatile LAS unsigned* st;
};

__device__ __forceinline__ XcdBarrier xcd_barrier_post(unsigned* bar, volatile LAS unsigned* st) {
    XcdBarrier b; b.bar = bar; b.x = xb_xcc_id(); b.st = st;
    if (threadIdx.x == 0) (void)xb_add(&bar[XB_XCNT(b.x)], 1u);
    return b;
}
__device__ __forceinline__ void xcd_barrier_complete(unsigned* bar, unsigned x, unsigned& nloc, unsigned& nx) {
    const unsigned G = gridDim.x * gridDim.y * gridDim.z;
    unsigned sum, cnt, mine, sp = 0u;
    for (;;) {
        sum = 0u; cnt = 0u; mine = 0u;
#pragma unroll
        for (unsigned j = 0; j < 16; ++j) { const unsigned c = xb_ld(&bar[XB_XCNT(j)]); sum += c; cnt += (c > 0u) ? 1u : 0u; mine = (j == x) ? c : mine; }
        if (sum == G) break;
        __builtin_amdgcn_s_sleep(1);
        if ((++sp & 255u) == 0u) { if (xb_ld(&bar[XB_TMO])) break; if (sp > XB_SPIN_CAP) { atomicAdd(&bar[XB_TMO], 1u); break; } }
    }
    nloc = mine > 0u ? mine : 1u; nx = cnt > 0u ? cnt : 1u;
}

__device__ __forceinline__ void xcd_barrier(const XcdBarrier& b) {
    asm volatile("s_waitcnt vmcnt(0)" ::: "memory");
    __syncthreads();
    if (threadIdx.x == 0) {
        unsigned* bar = b.bar;
        __builtin_amdgcn_s_waitcnt(0);
        unsigned nloc = b.st[0], nx = b.st[1];
        if (nloc == 0u) { xcd_barrier_complete(bar, b.x, nloc, nx); b.st[0] = nloc; b.st[1] = nx; }
        const unsigned old = xb_add(&bar[XB_XSUB(b.x)], 1u);
        const unsigned gen = old / nloc;
        if (old + 1u == (gen + 1u) * nloc) {
            __builtin_amdgcn_fence(__ATOMIC_RELEASE, "agent");
            asm volatile("s_waitcnt vmcnt(0)" ::: "memory");
            const unsigned og = xb_add(&bar[XB_TOP], 1u);
            const unsigned tg = og / nx;
            if (og + 1u == (tg + 1u) * nx) xb_add(&bar[XB_TOPGEN], 1u);
            else XB_SPIN(xb_ld(&bar[XB_TOPGEN]) == tg, bar);
            __builtin_amdgcn_fence(__ATOMIC_ACQUIRE, "agent");
            xb_add(&bar[XB_XGEN(b.x)], 1u);
            asm volatile("s_waitcnt vmcnt(0)" ::: "memory");
        } else {
            XB_SPIN(xb_ld(&bar[XB_XGEN(b.x)]) == gen, bar);
            __builtin_amdgcn_fence(__ATOMIC_ACQUIRE, "agent");
            asm volatile("s_waitcnt vmcnt(0)" ::: "memory");
        }
    }
    __syncthreads();
}


#ifndef MK_DUP
#define MK_DUP 0u
#endif
#ifndef MK_COOP
#define MK_COOP 1
#endif
constexpr int M_ = 17408, MP_ = 16384, DM = 1024, FF = 2816, NGU = 5632, NIN = 2560, PLE = 256;
constexpr float EPS_ = 1e-6f;
constexpr int LDS_BYTES = 147456;
constexpr int NPHASE = 14;
constexpr size_t WS_WGU1 = 0;
constexpr size_t WS_WD1 = WS_WGU1 + (size_t)NGU * DM * 2;
constexpr size_t WS_WIN = WS_WD1 + (size_t)DM * FF * 2;
constexpr size_t WS_WOUT = WS_WIN + (size_t)NIN * DM * 2;
constexpr size_t WS_WGU2 = WS_WOUT + (size_t)DM * DM * 2;
constexpr size_t WS_WD2 = WS_WGU2 + (size_t)NGU * DM * 2;
constexpr size_t WS_WPG = WS_WD2 + (size_t)DM * FF * 2;
constexpr size_t WS_WPP = WS_WPG + (size_t)DM * DM * 2;
constexpr size_t WS_YC = WS_WPP + (size_t)DM * PLE * 2;
constexpr size_t WS_ACT = WS_YC + (size_t)M_ * DM * 2;
constexpr size_t WS_D = WS_ACT + (size_t)M_ * FF * 2;
constexpr size_t WS_HB = WS_D + (size_t)M_ * DM * 2;
constexpr size_t WS_SLAB2 = WS_HB + (size_t)M_ * DM * 2;
constexpr size_t WS_RS = WS_SLAB2 + (size_t)3 * 1024 * 1024 * 4;
constexpr size_t WS_END = WS_RS + (size_t)M_ * 4;
constexpr size_t WS_BAR = WS_END;
constexpr size_t WS_TOTAL = WS_BAR + (size_t)XCD_BAR_WORDS * 4;
constexpr size_t WS_PROJ = WS_ACT;
constexpr size_t WS_PP = WS_ACT;
constexpr size_t WS_PB = WS_YC + (size_t)16 * 1024 * 1024;
constexpr size_t WS_SLAB4 = WS_ACT + (size_t)M_ * DM * 4 + (size_t)M_ * PLE * 2;
static_assert(WS_SLAB4 + (size_t)4 * 1024 * 1024 * 4 <= WS_D && WS_PB + (size_t)M_ * PLE * 2 <= WS_ACT, "aliases fit");
constexpr size_t OUT_NCP = 17825792, OUT_NCS = 17833984, OUT_CVP = 17965056, OUT_CVS = 18489344;

struct Args { const float* in[28]; float* out; unsigned char* ws; int ph_lo, ph_hi; };

__device__ __forceinline__ float wave_sum(float v) {
#pragma unroll
    for (int o = 1; o < 64; o <<= 1) v += __shfl_xor(v, o);
    return v;
}
__device__ __forceinline__ float bf_lo(unsigned w) { return __uint_as_float(w << 16); }
__device__ __forceinline__ float bf_hi(unsigned w) { return __uint_as_float(w & 0xffff0000u); }
__device__ __forceinline__ float dot4(f32x4 a) { return (a.x * a.x + a.y * a.y) + (a.z * a.z + a.w * a.w); }
#define LDS_WAIT() asm volatile("s_waitcnt lgkmcnt(0)" ::: "memory")

struct TrItem { const float* W; bf16_t* WT; const float* gk; int K, N, k0, n0, drow0; };
__device__ __forceinline__ void tr_load(const TrItem& d, int lane, f32x4 (&v8)[8], float (&g8)[8]) {
#pragma unroll
    for (int i = 0; i < 8; ++i) { const int kk = 8 * i + (lane >> 3); v8[i] = __builtin_nontemporal_load((const f32x4*)(d.W + (size_t)(d.k0 + kk) * d.N + d.n0 + (lane & 7) * 4)); g8[i] = d.gk ? d.gk[d.k0 + kk] : 1.0f; }
}
__device__ __forceinline__ void tr_store(const TrItem& d, LAS float* scr, int lane, const f32x4 (&v8)[8], const float (&g8)[8]) {
#pragma unroll
    for (int i = 0; i < 8; ++i) { const int kk = 8 * i + (lane >> 3); LAS float* q = scr + kk * 33 + (lane & 7) * 4; const f32x4 v = v8[i] * g8[i]; q[0] = v.x; q[1] = v.y; q[2] = v.z; q[3] = v.w; }
    LDS_WAIT();
    const int c = lane & 7;
#pragma unroll
    for (int j = 0; j < 4; ++j) { const int n = (lane >> 3) + 8 * j; const LAS float* t = scr + (8 * c) * 33 + n;
        u32x4 o; o.x = cvt_pk_bf16(t[0 * 33], t[1 * 33]); o.y = cvt_pk_bf16(t[2 * 33], t[3 * 33]); o.z = cvt_pk_bf16(t[4 * 33], t[5 * 33]); o.w = cvt_pk_bf16(t[6 * 33], t[7 * 33]);
        *(u32x4*)(d.WT + (size_t)(d.drow0 + n) * d.K + d.k0 + 8 * c) = o; }
    LDS_WAIT();
}

__device__ __forceinline__ f32x4 bf4(unsigned a, unsigned b) { return (f32x4){bf_lo(a), bf_hi(a), bf_lo(b), bf_hi(b)}; }
template <int MODE>
__device__ __forceinline__ void rp_load_res(int m, const float* __restrict__ resP, const float* __restrict__ resS, const bf16_t* hb, int lane, f32x4 (&h)[4]) {
    if (MODE & 2) { const float* rrow = (m < MP_) ? resP + (size_t)m * DM : resS + (size_t)(m - MP_) * DM;
#pragma unroll
        for (int j = 0; j < 4; ++j) h[j] = __builtin_nontemporal_load((const f32x4*)rrow + lane + 64 * j); }
    else { const u32x2* hr = (const u32x2*)(hb + (size_t)m * DM) + lane;
#pragma unroll
        for (int j = 0; j < 4; ++j) { const u32x2 w = hr[64 * j]; h[j] = bf4(w.x, w.y); } }
}
__device__ __forceinline__ int vzero() { int z; asm volatile("v_mov_b32 %0, 0" : "=v"(z)); return z; }
template <int MODE>
__device__ __forceinline__ void rp_finish(int m, f32x4 (&h)[4], f32x4 (&d)[4], const f32x4 (&gp)[4], float sc, bf16_t* hb, float* rsv, float* __restrict__ outf, int lane, float hin_scale) {
    if (MODE & 32) {
#pragma unroll
        for (int j = 0; j < 4; ++j) h[j] *= hin_scale; }
    if (MODE & 1) {
        float ss = 0.f;
#pragma unroll
        for (int j = 0; j < 4; ++j) ss += dot4(d[j]);
        const float rs = sc * rsqrtf(wave_sum(ss) * (1.0f / DM) + EPS_);
#pragma unroll
        for (int j = 0; j < 4; ++j) h[j] += d[j] * rs * gp[j];
    }
    if (MODE & 4) {
        float s2 = 0.f;
#pragma unroll
        for (int j = 0; j < 4; ++j) s2 += dot4(h[j]);
        const float rs2 = rsqrtf(wave_sum(s2) * (1.0f / DM) + EPS_);
        if (lane == 0) rsv[m] = rs2;
        const float osc = (MODE & 64) ? rs2 : 1.0f;
        const auto hrs = pg8::mk_rsrc(hb); const unsigned ho = (unsigned)m * (DM * 2u) + (unsigned)lane * 8u;
#pragma unroll
        for (int j = 0; j < 4; ++j) { const f32x4 v = h[j] * osc; u32x2 w; w.x = cvt_pk_bf16(v.x, v.y); w.y = cvt_pk_bf16(v.z, v.w); ST8(hrs, ho + 512u * j, w); }
    }
    if (MODE & 8) { f32x4* ho = (f32x4*)(outf + (size_t)m * DM) + lane;
#pragma unroll
        for (int j = 0; j < 4; ++j) __builtin_nontemporal_store(h[j], ho + 64 * j); }
}
template <int MODE, int NSL, int N0>
__device__ __forceinline__ void rowpass(const bf16_t* __restrict__ dbuf, const bf16_t* slab0, const bf16_t* slab1, const bf16_t* __restrict__ pp, const float* __restrict__ resP, const float* __restrict__ resS,
                                        bf16_t* hb, float* rsv, float* __restrict__ outf, const float* __restrict__ gpost, float sc, int gw, int NGW, int lane) {
    f32x4 gp[4]; const int vz = vzero();
#pragma unroll
    for (int j = 0; j < 4; ++j) gp[j] = (MODE & 1) ? ((const f32x4*)gpost)[lane + 64 * j] : (f32x4){0.f, 0.f, 0.f, 0.f};
    constexpr int NR = 4;
    for (int m0 = gw; m0 < MP_; m0 += NR * NGW) {
        f32x4 hh[NR][4], dd[NR][4]; u32x2 ww[NR][4]; float isc[NR];
#pragma unroll
        for (int q = 0; q < NR; ++q) { const int m = m0 + q * NGW; isc[q] = 1.0f; if (m < MP_) { rp_load_res<MODE>(m, resP, resS, hb, lane, hh[q]); if (MODE & 32) isc[q] = rsv[m + vz]; } }
        if (MODE & 1) {
#pragma unroll
            for (int q = 0; q < NR; ++q) { const int m = m0 + q * NGW; if (m < MP_) { const u32x2* dr = (const u32x2*)(dbuf + (size_t)m * DM) + lane;
#pragma unroll
                for (int j = 0; j < 4; ++j) ww[q][j] = dr[64 * j]; } }
#pragma unroll
            for (int q = 0; q < NR; ++q)
#pragma unroll
                for (int j = 0; j < 4; ++j) dd[q][j] = bf4(ww[q][j].x, ww[q][j].y);
        }
#pragma unroll
        for (int q = 0; q < NR; ++q) { const int m = m0 + q * NGW; if (m < MP_) rp_finish<MODE>(m, hh[q], dd[q], gp, sc, hb, rsv, outf, lane, (MODE & 32) ? 1.0f / isc[q] : 1.0f); }
    }
    if (((gw & 1) == 0)) for (int r = (gw >> 3) * 4 + ((gw & 7) >> 1); r < M_ - MP_; r += (NGW >> 3) * 4) {
        const int m = MP_ + r;
        f32x4 h[4], d[4]; float isc1 = 1.0f;
        rp_load_res<MODE>(m, resP, resS, hb, lane, h);
        if (MODE & 32) isc1 = rsv[m + vz];
        if (MODE & 1) {
            u32x2 tq[4][NSL > 0 ? NSL : 1];
#pragma unroll
            for (int j = 0; j < 4; ++j)
#pragma unroll
                for (int s = 0; s < NSL; ++s) tq[j][s] = ((const u32x2*)(((s < N0) ? slab0 + ((size_t)s << 20) : slab1 + ((size_t)(s - N0) << 20)) + (size_t)r * DM))[lane + 64 * j];
#pragma unroll
            for (int j = 0; j < 4; ++j) { f32x4 acc = {0.f, 0.f, 0.f, 0.f};
#pragma unroll
                for (int s = 0; s < NSL; ++s) acc += bf4(tq[j][s].x, tq[j][s].y);
                d[j] = acc; }
            if (MODE & 16) { const u32x2* pr = (const u32x2*)(pp + (size_t)m * DM) + lane;
#pragma unroll
                for (int j = 0; j < 4; ++j) { const u32x2 pw = pr[64 * j]; const f32x4 p = bf4(pw.x, pw.y); d[j].x = pg8::sigmoid_f(d[j].x) * p.x; d[j].y = pg8::sigmoid_f(d[j].y) * p.y; d[j].z = pg8::sigmoid_f(d[j].z) * p.z; d[j].w = pg8::sigmoid_f(d[j].w) * p.w; } }
        }
        rp_finish<MODE>(m, h, d, gp, sc, hb, rsv, outf, lane, (MODE & 32) ? 1.0f / isc1 : 1.0f);
    }
}

#ifdef MK_TM
#define MIX_T(seg) do { const unsigned long long tn_ = __builtin_amdgcn_s_memrealtime(); if ((MK_TM >> (seg)) & 1u) *tqm += tn_ - tpm; tpm = tn_; } while (0)
#else
#define MIX_T(seg) do { } while (0)
#endif
__device__ __forceinline__ void mixer_phase(const Args& a, LAS unsigned char* lds, const bf16_t* __restrict__ PROJ, bf16_t* __restrict__ YC, int wave, int lane, unsigned long long* tqm) {
    unsigned long long tpm = 0ull;
    constexpr int VP = 1056;
    const auto ycrs = pg8::mk_rsrc(YC);
    LAS float* part = (LAS float*)(lds + 128 * VP);
    const int fr = lane & 15, fq = lane >> 4;
    const float* __restrict__ wsm = a.in[15]; const float* __restrict__ bsm = a.in[16];
    float* out = a.out;
    const int G_ = (int)gridDim.x, b_ = (int)blockIdx.x;
    for (int it = 0;; ++it) {
        int u, R0, nrows = 64;
        if (G_ == 256) { if (it == 0) { u = b_; R0 = u * 64; } else if (it == 1 && (b_ & 1) == 0 && b_ < 128) { u = 256; R0 = MP_ + 16 * (b_ >> 1); nrows = 16; } else break; }
        else { u = b_ + it * G_; if (u >= 272) break; R0 = u * 64; }
        const int ntb = nrows >> 4;
        const bool samp = (u >= 256);
#ifdef MK_TM
        tpm = __builtin_amdgcn_s_memrealtime();
#endif
        int s0 = 0, t0 = 0;
        if (!samp) { s0 = (u & 31) * 64; t0 = s0 & 127; }
        const int CB = R0 - t0, kext = t0 + 64;
        if (wave * 8 < nrows)
        {
            const int c0 = lane * 8; const float* cw = a.in[13];
            const f32x4 w0a = *(const f32x4*)(cw + c0), w0b = *(const f32x4*)(cw + c0 + 4), w1a = *(const f32x4*)(cw + 512 + c0), w1b = *(const f32x4*)(cw + 512 + c0 + 4),
                        w2a = *(const f32x4*)(cw + 1024 + c0), w2b = *(const f32x4*)(cw + 1024 + c0 + 4);
            const f32x4 gaa = *(const f32x4*)(a.in[17] + c0), gab = *(const f32x4*)(a.in[17] + c0 + 4);
            f32x4 zp2a = {0.f, 0.f, 0.f, 0.f}, zp2b = zp2a, zp1a = zp2a, zp1b = zp2a;
            const int rb = R0 + wave * 8; const int sb_ = ((R0 - MP_) >> 3) + wave;
            if (samp) { const float* st = a.in[4] + (size_t)sb_ * 1024 + c0; zp2a = *(const f32x4*)st; zp2b = *(const f32x4*)(st + 4); zp1a = *(const f32x4*)(st + 512); zp1b = *(const f32x4*)(st + 516); }
            else if (s0 + wave * 8 > 0) {
                const bf16_t* p2 = PROJ + (size_t)(rb - 2) * NIN + c0; const bf16_t* p1 = p2 + NIN;
                const u32x4 c2 = *(const u32x4*)(p2 + 512), h2 = *(const u32x4*)(p2 + 1024), c1 = *(const u32x4*)(p1 + 512), h1 = *(const u32x4*)(p1 + 1024);
                zp2a = bf4(c2.x, c2.y) * bf4(h2.x, h2.y); zp2b = bf4(c2.z, c2.w) * bf4(h2.z, h2.w); zp1a = bf4(c1.x, c1.y) * bf4(h1.x, h1.y); zp1b = bf4(c1.z, c1.w) * bf4(h1.z, h1.w);
            }
            f32x4 ya[8], yb[8]; float ss[8];
            u32x4 braw8[8], craw8[8], hraw8[8];
#pragma unroll
            for (int i = 0; i < 8; ++i) { const bf16_t* pr = PROJ + (size_t)(rb + i) * NIN + c0; braw8[i] = *(const u32x4*)pr; craw8[i] = *(const u32x4*)(pr + 512); hraw8[i] = *(const u32x4*)(pr + 1024); }
#pragma unroll
            for (int i = 0; i < 8; ++i) {
                const u32x4 braw = braw8[i], craw = craw8[i], hraw = hraw8[i];
                const f32x4 za = bf4(craw.x, craw.y) * bf4(hraw.x, hraw.y), zb = bf4(craw.z, craw.w) * bf4(hraw.z, hraw.w);
                const f32x4 ca = w0a * zp2a + w1a * zp1a + w2a * za, cb = w0b * zp2b + w1b * zp1b + w2b * zb;
                ya[i] = bf4(braw.x, braw.y) * ca; yb[i] = bf4(braw.z, braw.w) * cb;
                ss[i] = wave_sum(dot4(ya[i]) + dot4(yb[i]));
                if (i >= 6) {
                    if (samp) { float* o = out + OUT_NCS + ((size_t)sb_ * 2 + (i - 6)) * 512 + c0; *(f32x4*)o = za; *(f32x4*)(o + 4) = zb; }
                    else if ((u & 31) == 31 && wave == 7) { float* o = out + OUT_NCP + ((size_t)(u >> 5) * 2 + (i - 6)) * 512 + c0; *(f32x4*)o = za; *(f32x4*)(o + 4) = zb; }
                }
                zp2a = zp1a; zp2b = zp1b; zp1a = za; zp1b = zb;
            }
#pragma unroll
            for (int i = 0; i < 8; ++i) {
                const float rs = rsqrtf(ss[i] * (1.0f / 512.0f) + EPS_);
                const f32x4 y0 = ya[i] * rs * gaa, y1 = yb[i] * rs * gab;
                u32x4 w; w.x = cvt_pk_bf16(y0.x, y0.y); w.y = cvt_pk_bf16(y0.z, y0.w); w.z = cvt_pk_bf16(y1.x, y1.y); w.w = cvt_pk_bf16(y1.z, y1.w);
                ST16(ycrs, (unsigned)((rb + i) * DM + c0) * 2u, w);
            }
        }
        const int h = wave; const int nkb = kext >> 5;
        bf16x8 afr[4][4];
#pragma unroll
        for (int kb = 0; kb < 4; ++kb) {
#pragma unroll
            for (int tb = 0; tb < 4; ++tb) {
                f32x4 w0 = {0.f, 0.f, 0.f, 0.f}, w1 = w0; int lim = -1;
                if (kb < nkb) {
                    if (!samp) { const int tt = t0 + tb * 16 + fr, sb = kb * 32 + fq * 8; const float* wp = wsm + (size_t)(h * 128 + tt) * 128 + sb;
                        w0 = *(const f32x4*)wp; w1 = *(const f32x4*)(wp + 4); lim = tt - sb; }
                    else { const int tt = fr & 7; const float* wp = wsm + (size_t)(h * 128 + tt) * 128;
                        w0 = *(const f32x4*)wp; w1 = *(const f32x4*)(wp + 4); lim = ((kb * 4 + fq) == (tb * 2 + (fr >> 3))) ? tt : -1; }
                }
                w0.x = (0 <= lim) ? w0.x : 0.f; w0.y = (1 <= lim) ? w0.y : 0.f; w0.z = (2 <= lim) ? w0.z : 0.f; w0.w = (3 <= lim) ? w0.w : 0.f;
                w1.x = (4 <= lim) ? w1.x : 0.f; w1.y = (5 <= lim) ? w1.y : 0.f; w1.z = (6 <= lim) ? w1.z : 0.f; w1.w = (7 <= lim) ? w1.w : 0.f;
                u32x4 pk; pk.x = cvt_pk_bf16(w0.x, w0.y); pk.y = cvt_pk_bf16(w0.z, w0.w); pk.z = cvt_pk_bf16(w1.x, w1.y); pk.w = cvt_pk_bf16(w1.z, w1.w);
                afr[kb][tb] = __builtin_bit_cast(bf16x8, pk);
            }
        }
        {
            const f32x4 vg0 = *(const f32x4*)(a.in[14] + lane * 8), vg1 = *(const f32x4*)(a.in[14] + lane * 8 + 4);
            for (int sb8 = 0; sb8 < kext; sb8 += 64) {
                u32x4 raw8[8];
#pragma unroll
                for (int i = 0; i < 8; ++i) { int rr = CB + sb8 + i * 8 + wave; rr = rr < M_ ? rr : M_ - 1; raw8[i] = *(const u32x4*)(PROJ + (size_t)rr * NIN + 2048 + lane * 8); }
#pragma unroll
                for (int i = 0; i < 8; ++i) {
                    const int s = sb8 + i * 8 + wave, row = CB + s; const u32x4 raw = raw8[i];
                    f32x4 v0 = bf4(raw.x, raw.y), v1 = bf4(raw.z, raw.w);
                    float ss = dot4(v0) + dot4(v1);
                    ss += __shfl_xor(ss, 1); ss += __shfl_xor(ss, 2); ss += __shfl_xor(ss, 4);
                    const float rs = rsqrtf(ss * (1.0f / 64.0f) + EPS_);
                    v0 = v0 * rs * vg0; v1 = v1 * rs * vg1;
                    u32x4 pk; pk.x = cvt_pk_bf16(v0.x, v0.y); pk.y = cvt_pk_bf16(v0.z, v0.w); pk.z = cvt_pk_bf16(v1.x, v1.y); pk.w = cvt_pk_bf16(v1.z, v1.w);
                    *(LAS u32x4*)(lds + s * VP + lane * 16) = pk;
                    if (s >= t0 && s < t0 + nrows) {
                        if (samp) { float* o = out + OUT_CVS + (size_t)(row - MP_) * 512 + lane * 8; *(f32x4*)o = v0; *(f32x4*)(o + 4) = v1; }
                        else if (s0 - t0 == 1920) { float* o = out + OUT_CVP + (size_t)((u >> 5) * 128 + s) * 512 + lane * 8; *(f32x4*)o = v0; *(f32x4*)(o + 4) = v1; }
                    }
                }
            }
        }
        __syncthreads();
        MIX_T(0);
        f32x4 acc[4][4];
#pragma unroll
        for (int i = 0; i < 4; ++i)
#pragma unroll
            for (int j = 0; j < 4; ++j) acc[i][j] = (f32x4){0.f, 0.f, 0.f, 0.f};
#pragma unroll
        for (int kb = 0; kb < 4; ++kb) if (kb < nkb) {
            u32x2 r0[4], r1[4];
            { const unsigned ta = (unsigned)(uintptr_t)(lds + (kb * 32 + fq * 8 + (fr >> 2)) * VP + (h * 64 + (fr & 3) * 4) * 2);
              asm volatile("ds_read_b64_tr_b16 %0, %8\n\tds_read_b64_tr_b16 %1, %8 offset:4224\n\t"
                           "ds_read_b64_tr_b16 %2, %8 offset:32\n\tds_read_b64_tr_b16 %3, %8 offset:4256\n\t"
                           "ds_read_b64_tr_b16 %4, %8 offset:64\n\tds_read_b64_tr_b16 %5, %8 offset:4288\n\t"
                           "ds_read_b64_tr_b16 %6, %8 offset:96\n\tds_read_b64_tr_b16 %7, %8 offset:4320\n\ts_waitcnt lgkmcnt(0)"
                           : "=&v"(r0[0]), "=&v"(r1[0]), "=&v"(r0[1]), "=&v"(r1[1]), "=&v"(r0[2]), "=&v"(r1[2]), "=&v"(r0[3]), "=&v"(r1[3]) : "v"(ta) : "memory"); }
#pragma unroll
            for (int db = 0; db < 4; ++db) {
                u32x4 bq; bq.x = r0[db].x; bq.y = r0[db].y; bq.z = r1[db].x; bq.w = r1[db].y;
                const bf16x8 bfv = __builtin_bit_cast(bf16x8, bq);
#pragma unroll
                for (int tb = 0; tb < 4; ++tb) if (tb < ntb) acc[tb][db] = __builtin_amdgcn_mfma_f32_16x16x32_bf16(bfv, afr[kb][tb], acc[tb][db], 0, 0, 0);
            }
        }
#pragma unroll
        for (int tb = 0; tb < 4; ++tb) if (tb < ntb) {
            const int t = tb * 16 + fr; const int tt = samp ? (fr & 7) : (t0 + t); const float bias = bsm[h * 128 + tt];
            const bf16_t* up = PROJ + (size_t)(R0 + t) * NIN + 1536 + h * 64 + fq * 4;
            float s = 0.f;
#pragma unroll
            for (int db = 0; db < 4; ++db) { const u32x2 ur = *(const u32x2*)(up + db * 16); const f32x4 uu = bf4(ur.x, ur.y);
                const f32x4 y = uu * (acc[tb][db] + bias); acc[tb][db] = y; s += dot4(y); }
            s += __shfl_xor(s, 16); s += __shfl_xor(s, 32);
            if (fq == 0) part[h * 64 + t] = s;
        }
        __syncthreads();
        MIX_T(1);
#pragma unroll
        for (int tb = 0; tb < 4; ++tb) if (tb < ntb) {
            const int t = tb * 16 + fr; float tot = 0.f;
#pragma unroll
            for (int hh = 0; hh < 8; ++hh) tot += part[hh * 64 + t];
            const float rs = rsqrtf(tot * (1.0f / 512.0f) + EPS_);
            bf16_t* yp = YC + (size_t)(R0 + t) * DM + 512 + h * 64 + fq * 4;
#pragma unroll
            for (int db = 0; db < 4; ++db) { const f32x4 gb = *(const f32x4*)(a.in[18] + h * 64 + db * 16 + fq * 4); const f32x4 y = acc[tb][db] * rs * gb;
                u32x2 w; w.x = cvt_pk_bf16(y.x, y.y); w.y = cvt_pk_bf16(y.z, y.w); ST8(ycrs, (unsigned)((R0 + t) * DM + 512 + h * 64 + fq * 4 + db * 16) * 2u, w); }
        }
        MIX_T(2);
        __syncthreads();
        MIX_T(3);
    }
}

constexpr int TR_I_G = (DM / 64) * (FF / 32), TR_I_D = (FF / 64) * (DM / 32), TR_I_IN = (DM / 64) * (NIN / 32), TR_I_O = (DM / 64) * (DM / 32), TR_I_PP = (PLE / 64) * (DM / 32);
constexpr int TR_A_END = 2 * TR_I_G + TR_I_IN + TR_I_O, TR_B_END = TR_A_END + TR_I_D, TR_C_END = TR_B_END + TR_I_G + TR_I_D + TR_I_O + TR_I_PP, TR_D_END = TR_C_END + TR_I_G;
__device__ __forceinline__ void tr_decode(const Args& a, unsigned char* ws, int it, TrItem& d) {
    int r = it; int mode = 0; d.gk = nullptr;
    if (r < TR_I_G) { d.W = a.in[7]; d.K = DM; d.N = FF; d.WT = (bf16_t*)(ws + WS_WGU1); mode = 1; d.gk = a.in[5]; }
    else if ((r -= TR_I_G) < TR_I_G) { d.W = a.in[8]; d.K = DM; d.N = FF; d.WT = (bf16_t*)(ws + WS_WGU1); mode = 2; d.gk = a.in[5]; }
    else if ((r -= TR_I_G) < TR_I_IN) { d.W = a.in[12]; d.K = DM; d.N = NIN; d.WT = (bf16_t*)(ws + WS_WIN); d.gk = a.in[10]; }
    else if ((r -= TR_I_IN) < TR_I_O) { d.W = a.in[19]; d.K = DM; d.N = DM; d.WT = (bf16_t*)(ws + WS_WOUT); }
    else if ((r -= TR_I_O) < TR_I_D) { d.W = a.in[9]; d.K = FF; d.N = DM; d.WT = (bf16_t*)(ws + WS_WD1); }
    else if ((r -= TR_I_D) < TR_I_G) { d.W = a.in[23]; d.K = DM; d.N = FF; d.WT = (bf16_t*)(ws + WS_WGU2); mode = 2; d.gk = a.in[20]; }
    else if ((r -= TR_I_G) < TR_I_D) { d.W = a.in[24]; d.K = FF; d.N = DM; d.WT = (bf16_t*)(ws + WS_WD2); }
    else if ((r -= TR_I_D) < TR_I_O) { d.W = a.in[25]; d.K = DM; d.N = DM; d.WT = (bf16_t*)(ws + WS_WPG); }
    else if ((r -= TR_I_O) < TR_I_PP) { d.W = a.in[26]; d.K = PLE; d.N = DM; d.WT = (bf16_t*)(ws + WS_WPP); }
    else { r -= TR_I_PP; d.W = a.in[22]; d.K = DM; d.N = FF; d.WT = (bf16_t*)(ws + WS_WGU2); mode = 1; d.gk = a.in[20]; }
    const int nblk = d.N / 32, kb = r / nblk, nb = r % nblk; d.k0 = 64 * kb; d.n0 = 32 * nb;
    d.drow0 = mode ? (d.n0 >> 7) * 256 + (d.n0 & 127) + (mode == 2 ? 128 : 0) : d.n0;
}
__device__ __forceinline__ void do_transposes(const Args& a, unsigned char* ws, LAS unsigned char* lds, int first, int last, int widx, int nwaves, int wave, int lane) {
    LAS float* scr = (LAS float*)(lds + wave * 8448);
    int it = first + widx;
    if (it < last) {
        TrItem d0, d1; f32x4 v0[8], v1[8]; float g0[8], g1[8];
        tr_decode(a, ws, it, d0); tr_load(d0, lane, v0, g0);
        for (;;) {
            const bool m1 = it + nwaves < last;
            if (m1) { tr_decode(a, ws, it + nwaves, d1); tr_load(d1, lane, v1, g1); }
            tr_store(d0, scr, lane, v0, g0);
            if (!m1) break;
            it += nwaves;
            const bool m0 = it + nwaves < last;
            if (m0) { tr_decode(a, ws, it + nwaves, d0); tr_load(d0, lane, v0, g0); }
            tr_store(d1, scr, lane, v1, g1);
            if (!m0) break;
            it += nwaves;
        }
    }
}
__device__ __forceinline__ int fresh_tid() { int t = threadIdx.x; asm volatile("" : "+v"(t)); return t; }
template <bool COOP>
__global__ void __launch_bounds__(512, 2) fwd_kernel(Args a) {
    extern __shared__ __attribute__((aligned(16))) unsigned char lds_raw[];
    LAS unsigned char* lds = (LAS unsigned char*)lds_raw;
    const int tid = threadIdx.x;
    const int G = gridDim.x, NGW = G * 8;
#define LANE_ (fresh_tid() & 63)
#define WAVE_ (__builtin_amdgcn_readfirstlane(fresh_tid() >> 6))
#define GW_ ((int)blockIdx.x * 8 + WAVE_)
    unsigned char* ws = a.ws;
    bf16_t* WGU1 = (bf16_t*)(ws + WS_WGU1); bf16_t* WD1 = (bf16_t*)(ws + WS_WD1); bf16_t* WIN = (bf16_t*)(ws + WS_WIN); bf16_t* WOUT = (bf16_t*)(ws + WS_WOUT);
    bf16_t* WGU2 = (bf16_t*)(ws + WS_WGU2); bf16_t* WD2 = (bf16_t*)(ws + WS_WD2); bf16_t* WPG = (bf16_t*)(ws + WS_WPG); bf16_t* WPP = (bf16_t*)(ws + WS_WPP);
    bf16_t* YC = (bf16_t*)(ws + WS_YC); bf16_t* HB = (bf16_t*)(ws + WS_HB); float* RS = (float*)(ws + WS_RS); bf16_t* ACT = (bf16_t*)(ws + WS_ACT); bf16_t* PROJ = (bf16_t*)(ws + WS_PROJ); bf16_t* PB = (bf16_t*)(ws + WS_PB);
    bf16_t* DB = (bf16_t*)(ws + WS_D); bf16_t* SLAB2 = (bf16_t*)(ws + WS_SLAB2); bf16_t* SLAB4 = (bf16_t*)(ws + WS_SLAB4); bf16_t* PP = (bf16_t*)(ws + WS_PP);
#define IN(k) (a.ph_lo <= (k) && (k) < a.ph_hi)
#define REP(k) for (int rep_ = 0; rep_ < (((MK_DUP >> (k)) & 1u) ? 2 : 1); ++rep_)
    XcdBarrier bar; bar.bar = (unsigned*)(ws + WS_BAR); bar.x = 0; bar.st = nullptr;
    if (COOP) {
        volatile LAS unsigned* st = (volatile LAS unsigned*)(lds + LDS_BYTES - 16);
        if (tid < 4) st[tid] = 0u;
        __syncthreads();
        bar = xcd_barrier_post((unsigned*)(ws + WS_BAR), st);
        if (a.ph_lo < 0) cg::this_grid().sync();
    }
#ifdef MK_TPROBE
#define MIXTQ_ (&tq_)
#else
#define MIXTQ_ nullptr
#endif
#ifdef MK_TPROBE
    unsigned long long tq_ = 0ull, tp_ = __builtin_amdgcn_s_memrealtime();
#define SEAM(k) do { if (COOP && IN(k) && IN((k) + 1)) { const unsigned long long t1_ = __builtin_amdgcn_s_memrealtime(); if ((MK_TW >> (k)) & 1u) tq_ += t1_ - tp_; xcd_barrier(bar); \
        const unsigned long long t2_ = __builtin_amdgcn_s_memrealtime(); if ((MK_TB >> (k)) & 1u) tq_ += t2_ - t1_; tp_ = t2_; } } while (0)
#else
#define SEAM(k) do { if (COOP && IN(k) && IN((k) + 1)) xcd_barrier(bar); } while (0)
#endif

    if (IN(0)) REP(0) {
        const int lane = LANE_, wave = WAVE_, gw = GW_;
        do_transposes(a, ws, lds, 0, TR_A_END, gw, NGW, wave, lane);
        rowpass<2 | 4 | 64, 0, 0>(nullptr, nullptr, nullptr, nullptr, a.in[0], a.in[1], HB, RS, nullptr, nullptr, 0.f, gw, NGW, lane);
    }
    SEAM(0);
    const int bid = (int)blockIdx.x;
#define GEMM_FULL(EPI, Aop, Bop, KK, MM, NN, ...) do { pg8::Gemm g_{Aop, Bop, KK, KK, KK}; pg8::StaticOrder S_; S_.init(MM, NN, G, bid); pg8::EPI E_{__VA_ARGS__}; \
        pg8::gemm_phase<pg8::EPI, pg8::StaticOrder, true, true>(lds, g_, S_, E_); } while (0)
#define GEMM_COMBO(E0T, PERMV, Aop, Bop, KK, NSL, S0, S1, N0, ...) do { typedef pg8::EpiCombo<pg8::E0T, pg8::EpiSlabT<PERMV>> EC_; pg8::Gemm g_{Aop, Bop, KK, KK, 256}; \
        pg8::ComboOrder S_; S_.full.init(MP_, DM, G, bid); S_.sub = pg8::SubOrder{64, 4, 4, NSL, G, bid}; EC_ E_{pg8::E0T{__VA_ARGS__}, pg8::EpiSlabT<PERMV>{S0, S1, N0, 64}}; \
        pg8::gemm_phase<EC_, pg8::ComboOrder, true, true>(lds, g_, S_, E_); } while (0)
    bf16_t* const YCF = YC;
    if (IN(1)) { REP(1) GEMM_FULL(EpiSwiglu, HB, WGU1, DM, M_, NGU, ACT, FF);
        { const int nwg = (M_ / 256) * (NGU / 256), rem = nwg % G, nidle = rem ? G - rem : G, idx = rem ? bid - rem : bid;
          if (idx >= 0) do_transposes(a, ws, lds, TR_A_END, TR_B_END, idx * 8 + WAVE_, nidle * 8, WAVE_, LANE_); } }
    SEAM(1);
    if (IN(2)) REP(2) GEMM_COMBO(EpiBf16, true, ACT, WD1, FF, 11, YCF, SLAB2, 8, DB, DM, nullptr);
    SEAM(2);
    if (IN(3)) rowpass<1 | 4 | 32 | 64, 11, 8>(DB, YCF, SLAB2, nullptr, nullptr, nullptr, HB, RS, nullptr, a.in[6], 0.5f, GW_, NGW, LANE_);
    SEAM(3);
    if (IN(4)) { REP(4) GEMM_FULL(EpiBf16, HB, WIN, DM, M_, NIN, PROJ, NIN, nullptr);
        { const int nwg = (M_ / 256) * (NIN / 256), rem = nwg % G, nidle = rem ? G - rem : G, idx = rem ? bid - rem : bid;
          if (idx >= 0) do_transposes(a, ws, lds, TR_B_END, TR_C_END, idx * 8 + WAVE_, nidle * 8, WAVE_, LANE_); } }
    SEAM(4);
    if (IN(5)) REP(5) mixer_phase(a, lds, PROJ, YC, WAVE_, LANE_, MIXTQ_);
    SEAM(5);
#ifdef MK_XBAR
#pragma nounroll
    for (int xb_ = 0; xb_ < MK_XBAR; ++xb_) xcd_barrier(bar);
#endif
    if (IN(6)) { REP(6) GEMM_COMBO(EpiBf16, true, YC, WOUT, DM, 4, SLAB4, SLAB4, 4, DB, DM, nullptr);
        if (G > 64 && bid >= 64) do_transposes(a, ws, lds, TR_C_END, TR_D_END, (bid - 64) * 8 + WAVE_, (G - 64) * 8, WAVE_, LANE_);
        else if (G <= 64) do_transposes(a, ws, lds, TR_C_END, TR_D_END, bid * 8 + WAVE_, G * 8, WAVE_, LANE_); }
    SEAM(6);
    if (IN(7)) rowpass<1 | 4 | 32 | 64, 4, 4>(DB, SLAB4, SLAB4, nullptr, nullptr, nullptr, HB, RS, nullptr, a.in[11], 1.0f, GW_, NGW, LANE_);
    SEAM(7);
    if (IN(8)) { REP(8) GEMM_FULL(EpiSwiglu, HB, WGU2, DM, M_, NGU, ACT, FF);
        { const int nwg = (M_ / 256) * (NGU / 256), rem = nwg % G, nidle = rem ? G - rem : G, idx = rem ? bid - rem : bid;
          if (idx >= 0) { const int lane = LANE_, w0 = idx * 8 + WAVE_, nw = nidle * 8;
            for (int m0 = w0; m0 < M_; m0 += 8 * nw) {
                f32x4 v[8];
#pragma unroll
                for (int q = 0; q < 8; ++q) { const int m = m0 + q * nw; if (m < M_) { const float* pr = (m < MP_) ? a.in[2] + (size_t)m * PLE : a.in[3] + (size_t)(m - MP_) * PLE; v[q] = ((const f32x4*)pr)[lane]; } }
#pragma unroll
                for (int q = 0; q < 8; ++q) { const int m = m0 + q * nw; if (m < M_) { u32x2 w; w.x = cvt_pk_bf16(v[q].x, v[q].y); w.y = cvt_pk_bf16(v[q].z, v[q].w); ((u32x2*)(PB + (size_t)m * PLE))[lane] = w; } } } } } }
    SEAM(8);
    if (IN(9)) REP(9) GEMM_COMBO(EpiBf16, true, ACT, WD2, FF, 11, YCF, SLAB2, 8, DB, DM, nullptr);
    SEAM(9);
    if (IN(10)) {
        rowpass<1 | 4 | 32, 11, 8>(DB, YCF, SLAB2, nullptr, nullptr, nullptr, HB, RS, nullptr, a.in[21], 0.5f, GW_, NGW, LANE_);
    }
    SEAM(10);
    if (IN(11)) REP(11) { GEMM_FULL(EpiBf16N, PB, WPP, PLE, MP_, DM, PP, DM);
        { pg8::Gemm g_{PB, WPP, PLE, PLE, PLE}; pg8::SubOrder S_{64, 4, 4, 1, G, (bid >= 64 && bid < 80) ? bid - 64 : -1}; pg8::EpiBf16N E_{PP, DM};
          pg8::gemm_phase<pg8::EpiBf16N, pg8::SubOrder, true, true>(lds, g_, S_, E_); } }
    if (IN(12)) REP(12) GEMM_COMBO(EpiPle, false, HB, WPG, DM, 4, SLAB4, SLAB4, 4, DB, PP, DM);
    SEAM(12);
    if (IN(13)) rowpass<1 | 8 | 16, 4, 4>(DB, SLAB4, SLAB4, PP, nullptr, nullptr, HB, nullptr, a.out, a.in[27], 1.0f, GW_, NGW, LANE_);
#ifdef MK_TPROBE
    if (blockIdx.x == 0) { const unsigned long long t1_ = __builtin_amdgcn_s_memrealtime(); if ((MK_TW >> 13) & 1u) tq_ += t1_ - tp_;
        while (__builtin_amdgcn_s_memrealtime() - t1_ < 4ull * tq_) __builtin_amdgcn_s_sleep(8); }
#endif
#undef IN
#undef SEAM
}

extern "C" void kernel_launch(void* const* d_in, const int* in_sizes, int n_in, void* d_out, int out_size, void* d_ws, size_t ws_size, hipStream_t stream) {
    static int grid = 0;
    if (grid == 0) {
        if (n_in != 28 || out_size != 19013632 || ws_size < WS_TOTAL) { fprintf(stderr, "kernel_launch: unexpected shapes: n_in %d out %d ws %zu (need %zu)\n", n_in, out_size, ws_size, (size_t)WS_TOTAL); grid = -1; return; }
        int dev = 0, cus = 0, per_cu = 0;
        if (hipGetDevice(&dev) != hipSuccess || hipDeviceGetAttribute(&cus, hipDeviceAttributeMultiprocessorCount, dev) != hipSuccess) { fprintf(stderr, "kernel_launch: device query failed\n"); grid = -1; return; }
        if (hipFuncSetAttribute((const void*)fwd_kernel<true>, hipFuncAttributeMaxDynamicSharedMemorySize, LDS_BYTES) != hipSuccess) { fprintf(stderr, "kernel_launch: hipFuncSetAttribute failed\n"); grid = -1; return; }
        if (hipOccupancyMaxActiveBlocksPerMultiprocessor(&per_cu, (const void*)fwd_kernel<true>, 512, LDS_BYTES) != hipSuccess || per_cu < 1) { fprintf(stderr, "kernel_launch: occupancy query says %d blocks per CU\n", per_cu); per_cu = 1; }
        (void)hipGetLastError();
        grid = cus * per_cu;
        fprintf(stderr, "kernel_launch: grid %d (cus %d x %d)\n", grid, cus, per_cu);
    }
    if (grid < 0) return;
    Args a{};
    for (int i = 0; i < 28; ++i) a.in[i] = (const float*)d_in[i];
    a.out = (float*)d_out; a.ws = (unsigned char*)d_ws;
#if MK_COOP
    if (hipMemsetAsync((char*)d_ws + WS_BAR, 0, (size_t)XCD_BAR_WORDS * 4, stream) != hipSuccess) { fprintf(stderr, "kernel_launch: memset of the barrier words failed\n"); return; }
    a.ph_lo = 0; a.ph_hi = NPHASE;
    void* args[] = {&a};
    const hipError_t e = hipLaunchCooperativeKernel((const void*)fwd_kernel<true>, dim3(grid), dim3(512), args, LDS_BYTES, stream);
    if (e != hipSuccess) fprintf(stderr, "kernel_launch: cooperative launch failed: %s (grid %d)\n", hipGetErrorString(e), grid);
#endif
}
```

```cpp
#include <hip/hip_runtime.h>
#include <hip/hip_cooperative_groups.h>
#include <cstdio>
#include <cstdint>
namespace cg = cooperative_groups;
#define MK_DUP 0u
namespace pg8 {
#define PG8_LAS __attribute__((address_space(3)))
typedef unsigned short bf16_t;
typedef short bf16x8 __attribute__((ext_vector_type(8)));
typedef float f32x4 __attribute__((ext_vector_type(4)));
typedef unsigned u32x4 __attribute__((ext_vector_type(4)));
constexpr int BM = 256, BK = 64, HALF = 128, HTB = HALF * BK * 2  , STAGE_BYTES = 8 * HTB, NXCD = 8, WGM = 8;

__host__ __device__ __forceinline__ int lds_byte(int r, int c) { const int st = (r >> 4) * 2 + (c >> 5), rr = r & 15, cc = c & 31, ob = rr * 64 + cc * 2; return st * 1024 + (ob ^ (((ob >> 9) & 1) << 5)); }
__host__ __device__ __forceinline__ void stage_rc(int b, int& R, int& C) { const int st = b / 1024, sb = b % 1024, swz = sb ^ (((sb >> 9) & 1) << 5); R = (st >> 1) * 16 + swz / 64; C = (st & 1) * 32 + (swz % 64) / 2; }
__host__ __device__ __forceinline__ int perm32(int rho) { const int n = rho >> 4, i = rho & 15; return 8 * (i >> 2) + 4 * n + (i & 3); }

struct Unit { int pm, pn, ks, kind; };
struct Gemm { const bf16_t* A; const bf16_t* Bt; int ld, K, kslice; };

struct StaticOrder {
    int nM, nN, nwg, G, c;
    __host__ __device__ void init(int M, int N, int G_, int c_) { nM = M / BM; nN = N / BM; nwg = nM * nN; G = G_; c = c_; }
    __host__ __device__ bool next(int i, Unit& u) const {
        const long L = (long)i * G + c; if (L >= nwg) return false;
        int wgid = (int)L; { const int q = nwg / NXCD, r = nwg % NXCD, xcd = wgid % NXCD, off = wgid / NXCD; wgid = (xcd < r ? xcd * (q + 1) : r * (q + 1) + (xcd - r) * q) + off; }
        const int nig = WGM * nN, gid = wgid / nig, fm = gid * WGM, gsz = (nM - fm) < WGM ? (nM - fm) : WGM;
        u.pm = fm + ((wgid % nig) % gsz); u.pn = (wgid % nig) / gsz; u.ks = 0; u.kind = 0; return true;
    }
    __device__ __forceinline__ void a_ready(const Unit&) const {}
    __device__ __forceinline__ void done(const Unit&) const {}
};
struct SubOrder {
    int pm0, npm, nN, nsl, G, c;
    __host__ __device__ bool next(int i, Unit& u) const {
        const int L = i * G + c; if (c < 0 || L >= npm * nN * nsl) return false;
        const int t = L / nsl; u.ks = L - t * nsl; u.pn = t % nN; u.pm = pm0 + t / nN; u.kind = (nsl > 1) ? 1 : 0; return true;
    }
    __device__ __forceinline__ void a_ready(const Unit&) const {}
    __device__ __forceinline__ void done(const Unit&) const {}
};
struct ComboOrder {
    StaticOrder full; SubOrder sub;
    __host__ __device__ bool next(int i, Unit& u) const {
        if (full.next(i, u)) return true;
        const int nf = (full.c < full.nwg) ? (full.nwg - full.c + full.G - 1) / full.G : 0;
        return sub.next(i - nf, u);
    }
    __device__ __forceinline__ void a_ready(const Unit&) const {}
    __device__ __forceinline__ void done(const Unit&) const {}
};
typedef unsigned u32x2 __attribute__((ext_vector_type(2)));

__device__ __forceinline__ unsigned cvt_pk_bf16(float lo, float hi) { unsigned r; asm("v_cvt_pk_bf16_f32 %0, %1, %2" : "=v"(r) : "v"(lo), "v"(hi)); return r; }
__device__ __forceinline__ float sigmoid_f(float x) { return __builtin_amdgcn_rcpf(1.0f + __builtin_amdgcn_exp2f(x * -1.44269504089f)); }

#ifndef MK_WT
#define MK_WT 0
#endif
typedef __attribute__((__vector_size__(4 * sizeof(int)))) int rsrc_t;
constexpr int WT_AUX = MK_WT ? 16 : 0;
__device__ __forceinline__ auto mk_rsrc(const void* base) { return __builtin_amdgcn_make_buffer_rsrc((void*)base, 0, 0x7fffffff, 0x00020000); }
#define ST16(rsrc, byteoff, v) __builtin_amdgcn_raw_buffer_store_b128(__builtin_bit_cast(u32x4, v), rsrc, (int)(byteoff), 0, pg8::WT_AUX)
#define ST8(rsrc, byteoff, v)  __builtin_amdgcn_raw_buffer_store_b64(__builtin_bit_cast(u32x2, v), rsrc, (int)(byteoff), 0, pg8::WT_AUX)

struct EpiF32 {
    static constexpr bool PERM = false, AFTER_DRAIN = false;
    float* C; int ldc;
    __device__ __forceinline__ void operator()(const f32x4 (&acc)[2][2][4][2], const Unit& u, int wr, int wc, int fr_, int fq_) const {
        int tl_ = threadIdx.x; asm volatile("" : "+v"(tl_)); const int fr = tl_ & 15, fq = (tl_ >> 4) & 3;
        const int row0 = u.pm * BM + wr * 64 + fr, col0 = u.pn * BM + wc * 32 + 4 * fq; float* const Cb_ = C;
#pragma unroll
        for (int ai = 0; ai < 2; ++ai)
#pragma unroll
            for (int m = 0; m < 4; ++m) { const unsigned ro = ((unsigned)(row0 + ai * HALF + m * 16) * (unsigned)ldc + (unsigned)col0) * 4u;
#pragma unroll
                for (int bj = 0; bj < 2; ++bj)
#pragma unroll
                    for (int n = 0; n < 2; ++n) *(f32x4*)((char*)Cb_ + ro + (bj * HALF + n * 16) * 4) = acc[ai][bj][m][n]; }
    }
};
struct EpiBf16N {
    static constexpr bool PERM = false, AFTER_DRAIN = false;
    bf16_t* O; int ldc;
    __device__ __forceinline__ void operator()(const f32x4 (&acc)[2][2][4][2], const Unit& u, int wr, int wc, int fr_, int fq_) const {
        int tl_ = threadIdx.x; asm volatile("" : "+v"(tl_)); const int fr = tl_ & 15, fq = (tl_ >> 4) & 3;
        const int row0 = u.pm * BM + wr * 64 + fr, col0 = u.pn * BM + wc * 32 + 4 * fq;
#pragma unroll
        for (int ai = 0; ai < 2; ++ai)
#pragma unroll
            for (int m = 0; m < 4; ++m) { const size_t off = (size_t)(row0 + ai * HALF + m * 16) * ldc + col0;
#pragma unroll
                for (int bj = 0; bj < 2; ++bj)
#pragma unroll
                    for (int n = 0; n < 2; ++n) { const f32x4 a = acc[ai][bj][m][n]; u32x2 w; w.x = cvt_pk_bf16(a.x, a.y); w.y = cvt_pk_bf16(a.z, a.w); *(u32x2*)(O + off + bj * HALF + n * 16) = w; } }
    }
};
struct EpiPle {
    static constexpr bool PERM = false, AFTER_DRAIN = false;
    bf16_t* T; const bf16_t* P; int ldc;
    __device__ __forceinline__ void operator()(const f32x4 (&acc)[2][2][4][2], const Unit& u, int wr, int wc, int fr_, int fq_) const {
        int tl_ = threadIdx.x; asm volatile("" : "+v"(tl_)); const int fr = tl_ & 15, fq = (tl_ >> 4) & 3;
        const int row0 = u.pm * BM + wr * 64 + fr, col0 = u.pn * BM + wc * 32 + 4 * fq;
#pragma unroll
        for (int ai = 0; ai < 2; ++ai)
#pragma unroll
            for (int m = 0; m < 4; ++m) { const size_t off = (size_t)(row0 + ai * HALF + m * 16) * ldc + col0;
#pragma unroll
                for (int bj = 0; bj < 2; ++bj)
#pragma unroll
                    for (int n = 0; n < 2; ++n) { const u32x2 pw = *(const u32x2*)(P + off + bj * HALF + n * 16); const f32x4 a = acc[ai][bj][m][n];
                        const f32x4 p = {__uint_as_float(pw.x << 16), __uint_as_float(pw.x & 0xffff0000u), __uint_as_float(pw.y << 16), __uint_as_float(pw.y & 0xffff0000u)};
                        u32x2 w; w.x = cvt_pk_bf16(sigmoid_f(a.x) * p.x, sigmoid_f(a.y) * p.y); w.y = cvt_pk_bf16(sigmoid_f(a.z) * p.z, sigmoid_f(a.w) * p.w);
                        *(u32x2*)(T + off + bj * HALF + n * 16) = w; } }
    }
};
template <bool PERM_> struct EpiSlabT {
    static constexpr bool PERM = PERM_, AFTER_DRAIN = false;
    bf16_t* base0; bf16_t* base1; int n0; int pm0;
    __device__ __forceinline__ void operator()(const f32x4 (&acc)[2][2][4][2], const Unit& u, int wr, int wc, int fr_, int fq_) const {
        int tl_ = threadIdx.x; asm volatile("" : "+v"(tl_)); const int fr = tl_ & 15, fq = (tl_ >> 4) & 3;
        const int row0 = (u.pm - pm0) * BM + wr * 64 + fr, col0 = u.pn * BM + wc * 32 + (PERM_ ? 8 : 4) * fq;
        bf16_t* const Cb_ = (u.ks < n0) ? base0 + ((size_t)u.ks << 20) : base1 + ((size_t)(u.ks - n0) << 20);
#pragma unroll
        for (int ai = 0; ai < 2; ++ai)
#pragma unroll
            for (int m = 0; m < 4; ++m) { const unsigned ro = ((unsigned)(row0 + ai * HALF + m * 16) * 1024u + (unsigned)col0) * 2u;
#pragma unroll
                for (int bj = 0; bj < 2; ++bj)
#pragma unroll
                    for (int n = 0; n < 2; ++n) { const f32x4 a = acc[ai][bj][m][n]; u32x2 w; w.x = cvt_pk_bf16(a.x, a.y); w.y = cvt_pk_bf16(a.z, a.w);
                        *(u32x2*)((char*)Cb_ + ro + (bj * HALF + n * (PERM_ ? 4 : 16)) * 2) = w; } }
    }
};
struct EpiBf16 {
    static constexpr bool PERM = true, AFTER_DRAIN = false;
    bf16_t* O; int ldc; const float* rs;
    __device__ __forceinline__ void operator()(const f32x4 (&acc)[2][2][4][2], const Unit& u, int wr, int wc, int fr_, int fq_) const {
        int tl_ = threadIdx.x; asm volatile("" : "+v"(tl_)); const int fr = tl_ & 15, fq = (tl_ >> 4) & 3;
        const int row0 = u.pm * BM + wr * 64 + fr, col0 = u.pn * BM + wc * 32 + 8 * fq; const auto rs_ = mk_rsrc(O);
#pragma unroll
        for (int ai = 0; ai < 2; ++ai)
#pragma unroll
            for (int m = 0; m < 4; ++m) { const int row = row0 + ai * HALF + m * 16; const unsigned ro = ((unsigned)row * (unsigned)ldc + (unsigned)col0) * 2u; const float r = rs ? rs[row] : 1.0f;
#pragma unroll
                for (int bj = 0; bj < 2; ++bj) { const f32x4 v0 = acc[ai][bj][m][0] * r, v1 = acc[ai][bj][m][1] * r;
                    u32x4 w; w.x = cvt_pk_bf16(v0[0], v0[1]); w.y = cvt_pk_bf16(v0[2], v0[3]); w.z = cvt_pk_bf16(v1[0], v1[1]); w.w = cvt_pk_bf16(v1[2], v1[3]);
                    ST16(rs_, ro + bj * HALF * 2, w); } }
    }
};
struct EpiSwiglu {
    static constexpr bool PERM = true, AFTER_DRAIN = false;
    bf16_t* O; int ldc;
    static __device__ __forceinline__ f32x4 silu_mul(f32x4 g, f32x4 u) {
        f32x4 t = g * -1.44269504089f;
        t.x = __builtin_fminf(t.x, 60.f); t.y = __builtin_fminf(t.y, 60.f); t.z = __builtin_fminf(t.z, 60.f); t.w = __builtin_fminf(t.w, 60.f);
        f32x4 e; e.x = __builtin_amdgcn_exp2f(t.x); e.y = __builtin_amdgcn_exp2f(t.y); e.z = __builtin_amdgcn_exp2f(t.z); e.w = __builtin_amdgcn_exp2f(t.w);
        const f32x4 d = e + 1.0f;
        const float r01 = __builtin_amdgcn_rcpf(d.x * d.y), r23 = __builtin_amdgcn_rcpf(d.z * d.w);
        const f32x4 sg = {d.y * r01, d.x * r01, d.w * r23, d.z * r23};
        return (g * sg) * u;
    }
    __device__ __forceinline__ void operator()(const f32x4 (&acc)[2][2][4][2], const Unit& u, int wr, int wc, int fr_, int fq_) const {
        int tl_ = threadIdx.x; asm volatile("" : "+v"(tl_)); const int fr = tl_ & 15, fq = (tl_ >> 4) & 3;
        const int row0 = u.pm * BM + wr * 64 + fr, col0 = u.pn * HALF + wc * 32 + 8 * fq; const auto rs_ = mk_rsrc(O);
#pragma unroll
        for (int ai = 0; ai < 2; ++ai)
#pragma unroll
            for (int m = 0; m < 4; ++m) { const unsigned ro = ((unsigned)(row0 + ai * HALF + m * 16) * (unsigned)ldc + (unsigned)col0) * 2u;
                const f32x4 v0 = silu_mul(acc[ai][0][m][0], acc[ai][1][m][0]), v1 = silu_mul(acc[ai][0][m][1], acc[ai][1][m][1]);
                u32x4 w; w.x = cvt_pk_bf16(v0[0], v0[1]); w.y = cvt_pk_bf16(v0[2], v0[3]); w.z = cvt_pk_bf16(v1[0], v1[1]); w.w = cvt_pk_bf16(v1[2], v1[3]);
                ST16(rs_, ro, w); }
    }
};
template <class E0, class E1> struct EpiCombo {
    static_assert(E0::PERM == E1::PERM, "one staging order per phase");
    static constexpr bool PERM = E0::PERM, AFTER_DRAIN = false;
    E0 e0; E1 e1;
    __device__ __forceinline__ void operator()(const f32x4 (&acc)[2][2][4][2], const Unit& u, int wr, int wc, int fr, int fq) const {
        if (u.kind == 0) e0(acc, u, wr, wc, fr, fq); else e1(acc, u, wr, wc, fr, fq);
    }
};

template <class Epi, class Sched, bool ALIGN_EPI = false, bool SP2 = false>
__device__ __forceinline__ void gemm_phase(PG8_LAS unsigned char* lds, const Gemm g, const Sched& S, const Epi& E) {
    int tid_ = threadIdx.x; asm volatile("" : "+v"(tid_));
    const int tid = tid_, wid = __builtin_amdgcn_readfirstlane(tid >> 6), lane = tid & 63, wr = wid >> 2, wc = wid & 3, fr = lane & 15, fq = lane >> 4;
    const int K = g.K, nt = K / BK;
    unsigned voffA[2], voffB[2];
#pragma unroll
    for (int i = 0; i < 2; ++i) { int R, C; stage_rc(tid * 16 + i * 8192, R, C); const int Rb = Epi::PERM ? ((R & ~31) + perm32(R & 31)) : R;
        voffA[i] = (unsigned)(R * g.ld + C) * 2u; voffB[i] = (unsigned)(Rb * g.ld + C) * 2u; }
    const size_t kstep = (size_t)(BK * 2);
    const size_t hstepA = (size_t)HALF * g.ld * 2, hstepB = hstepA;
    const size_t kslice = (size_t)g.kslice * 2;
    const unsigned ldsw = (unsigned)wid * 1024u;
    const int aoff = lds_byte(wr * 64 + fr, fq * 8), boff = lds_byte(wc * 32 + fr, fq * 8);
#define PG8_SA(b, h) (((b) * 2 + (h)) * HTB)
#define PG8_SB(b, h) ((4 + (b) * 2 + (h)) * HTB)
#define PG8_STAGE(bufoff, gbase, voff) do { _Pragma("unroll") for (int _i = 0; _i < 2; ++_i) \
        __builtin_amdgcn_global_load_lds((const unsigned*)((const char*)(gbase) + (voff)[_i]), (PG8_LAS unsigned*)(lds + (bufoff) + ldsw + _i * 8192), 16, 0, 0); } while (0)
#define PG8_LDA(dst, b, h) do { _Pragma("unroll") for (int m = 0; m < 4; ++m) _Pragma("unroll") for (int k = 0; k < 2; ++k) dst[m][k] = *(const PG8_LAS bf16x8*)(lds + PG8_SA(b, h) + aoff + m * 2048 + k * 1024); } while (0)
#define PG8_LDB(dst, b, h) do { _Pragma("unroll") for (int n = 0; n < 2; ++n) _Pragma("unroll") for (int k = 0; k < 2; ++k) dst[n][k] = *(const PG8_LAS bf16x8*)(lds + PG8_SB(b, h) + boff + n * 2048 + k * 1024); } while (0)
#define PG8_MMA(ai, bj, At, Bt) do { __builtin_amdgcn_s_setprio(1); _Pragma("unroll") for (int m = 0; m < 4; ++m) _Pragma("unroll") for (int n = 0; n < 2; ++n) _Pragma("unroll") for (int k = 0; k < 2; ++k) \
        acc[ai][bj][m][n] = __builtin_amdgcn_mfma_f32_16x16x32_bf16(Bt[n][k], At[m][k], acc[ai][bj][m][n], 0, 0, 0); __builtin_amdgcn_s_setprio(0); } while (0)
#define PG8_WAIT_V(n) asm volatile("s_waitcnt vmcnt(" #n ")" ::: "memory")
#define PG8_WAIT_L(n) asm volatile("s_waitcnt lgkmcnt(" #n ")" ::: "memory")
#define PG8_BAR __builtin_amdgcn_s_barrier()
#define PG8_SCHED __builtin_amdgcn_sched_barrier(0)
    Unit cur, nxt; int ui = 0;
    if (!S.next(0, cur)) return;
    f32x4 acc[2][2][4][2];
#pragma unroll
    for (int a = 0; a < 2; ++a)
#pragma unroll
        for (int b = 0; b < 2; ++b)
#pragma unroll
            for (int m = 0; m < 4; ++m)
#pragma unroll
                for (int n = 0; n < 2; ++n) acc[a][b][m][n] = (f32x4){0.f, 0.f, 0.f, 0.f};
    bf16x8 At[4][2], B0[2][2], B1[2][2];
    const char* cA = (const char*)g.A + (size_t)cur.pm * 2 * hstepA + (size_t)cur.ks * kslice; const char* cB = (const char*)g.Bt + (size_t)cur.pn * 2 * hstepB + (size_t)cur.ks * kslice;
    S.a_ready(cur);
    if constexpr (SP2) {
        PG8_STAGE(PG8_SB(0, 0), cB, voffB); PG8_STAGE(PG8_SB(0, 1), cB + hstepB, voffB); PG8_STAGE(PG8_SA(0, 0), cA, voffA); PG8_STAGE(PG8_SA(0, 1), cA + hstepA, voffA);
        if (wr == 1) PG8_BAR;
        PG8_WAIT_V(2); PG8_BAR;
        PG8_STAGE(PG8_SB(1, 0), cB + kstep, voffB); PG8_STAGE(PG8_SA(1, 0), cA + kstep, voffA); PG8_STAGE(PG8_SB(1, 1), cB + hstepB + kstep, voffB);
        PG8_WAIT_V(6); PG8_BAR;
    } else {
        PG8_STAGE(PG8_SB(0, 0), cB, voffB); PG8_STAGE(PG8_SA(0, 0), cA, voffA); PG8_STAGE(PG8_SB(0, 1), cB + hstepB, voffB); PG8_STAGE(PG8_SA(0, 1), cA + hstepA, voffA);
        if (wr == 1) PG8_BAR;
        PG8_WAIT_V(4); PG8_BAR;
        PG8_STAGE(PG8_SB(1, 0), cB + kstep, voffB); PG8_STAGE(PG8_SA(1, 0), cA + kstep, voffA); PG8_STAGE(PG8_SB(1, 1), cB + hstepB + kstep, voffB);
        PG8_WAIT_V(6); PG8_BAR;
    }
    for (;;) {
        const bool has_next = S.next(ui + 1, nxt);
        const char* nA = has_next ? (const char*)g.A + (size_t)nxt.pm * 2 * hstepA + (size_t)nxt.ks * kslice : cA; const char* nB = has_next ? (const char*)g.Bt + (size_t)nxt.pn * 2 * hstepB + (size_t)nxt.ks * kslice : cB;
        const int ntu = (cur.kind != 0) ? g.kslice / BK : nt;
        for (int t = 0; t < ntu; t += 2) {
            const bool last = (t == ntu - 2);
            const char* a1 = cA + (size_t)(t + 1) * kstep;
            const char* a2 = last ? nA : cA + (size_t)(t + 2) * kstep; const char* b2 = last ? nB : cB + (size_t)(t + 2) * kstep;
            const char* a3 = a2 + kstep; const char* b3 = b2 + kstep;
            if (last && has_next) S.a_ready(nxt);
            if constexpr (SP2) {
            PG8_LDB(B0, 0, 0); PG8_LDB(B1, 0, 1); PG8_SCHED; PG8_LDA(At, 0, 0); PG8_STAGE(PG8_SA(1, 1), a1 + hstepA, voffA);
            PG8_WAIT_V(8); PG8_WAIT_L(0); PG8_BAR; PG8_MMA(0, 0, At, B0); PG8_MMA(0, 1, At, B1); PG8_BAR; PG8_SCHED;
            PG8_LDA(At, 0, 1); PG8_STAGE(PG8_SB(0, 0), b2, voffB); PG8_STAGE(PG8_SB(0, 1), b2 + hstepB, voffB); PG8_STAGE(PG8_SA(0, 0), a2, voffA);
            PG8_WAIT_V(8); PG8_WAIT_L(0); PG8_BAR; PG8_MMA(1, 0, At, B0); PG8_MMA(1, 1, At, B1); PG8_BAR; PG8_SCHED;
            PG8_LDB(B0, 1, 0); PG8_LDB(B1, 1, 1); PG8_SCHED; PG8_LDA(At, 1, 0); PG8_STAGE(PG8_SA(0, 1), a2 + hstepA, voffA);
            PG8_WAIT_V(8); PG8_WAIT_L(0); PG8_BAR; PG8_MMA(0, 0, At, B0); PG8_MMA(0, 1, At, B1); PG8_BAR; PG8_SCHED;
            PG8_LDA(At, 1, 1); PG8_STAGE(PG8_SB(1, 0), b3, voffB); PG8_STAGE(PG8_SB(1, 1), b3 + hstepB, voffB); PG8_STAGE(PG8_SA(1, 0), a3, voffA);
            PG8_WAIT_V(8); PG8_WAIT_L(0); PG8_BAR; PG8_MMA(1, 0, At, B0); PG8_MMA(1, 1, At, B1); PG8_BAR; PG8_SCHED;
            } else {
            PG8_LDB(B0, 0, 0); PG8_SCHED; PG8_LDA(At, 0, 0); PG8_STAGE(PG8_SA(1, 1), a1 + hstepA, voffA);
            PG8_WAIT_L(8); PG8_BAR; PG8_WAIT_L(0); PG8_MMA(0, 0, At, B0); PG8_BAR; PG8_SCHED;
            PG8_LDB(B1, 0, 1); PG8_STAGE(PG8_SB(0, 0), b2, voffB);
            PG8_BAR; PG8_WAIT_L(0); PG8_MMA(0, 1, At, B1); PG8_BAR;
            PG8_LDA(At, 0, 1); PG8_STAGE(PG8_SA(0, 0), a2, voffA);
            PG8_BAR; PG8_WAIT_L(0); PG8_MMA(1, 0, At, B0); PG8_BAR; PG8_SCHED;
            PG8_STAGE(PG8_SB(0, 1), b2 + hstepB, voffB);
            PG8_WAIT_V(6); PG8_BAR; PG8_MMA(1, 1, At, B1); PG8_BAR;
            PG8_LDB(B0, 1, 0); PG8_SCHED; PG8_LDA(At, 1, 0); PG8_STAGE(PG8_SA(0, 1), a2 + hstepA, voffA);
            PG8_WAIT_L(8); PG8_BAR; PG8_WAIT_L(0); PG8_MMA(0, 0, At, B0); PG8_BAR; PG8_SCHED;
            PG8_LDB(B1, 1, 1); PG8_STAGE(PG8_SB(1, 0), b3, voffB);
            PG8_BAR; PG8_WAIT_L(0); PG8_MMA(0, 1, At, B1); PG8_BAR;
            PG8_LDA(At, 1, 1); PG8_STAGE(PG8_SA(1, 0), a3, voffA);
            PG8_BAR; PG8_WAIT_L(0); PG8_MMA(1, 0, At, B0); PG8_BAR; PG8_SCHED;
            PG8_STAGE(PG8_SB(1, 1), b3 + hstepB, voffB);
            PG8_WAIT_V(6); PG8_BAR; PG8_MMA(1, 1, At, B1); PG8_BAR;
            }
        }
        if constexpr (ALIGN_EPI) { if (wr == 0) PG8_BAR; }
        if constexpr (!Epi::AFTER_DRAIN) { E(acc, cur, wr, wc, fr, fq); S.done(cur); }
        if (!has_next) break;
#pragma unroll
        for (int a = 0; a < 2; ++a)
#pragma unroll
            for (int b = 0; b < 2; ++b)
#pragma unroll
                for (int m = 0; m < 4; ++m)
#pragma unroll
                    for (int n = 0; n < 2; ++n) acc[a][b][m][n] = (f32x4){0.f, 0.f, 0.f, 0.f};
        cur = nxt; cA = nA; cB = nB; ++ui;
        if constexpr (ALIGN_EPI) { if (wr == 1) PG8_BAR; }
    }
    PG8_WAIT_V(0);
    if constexpr (!ALIGN_EPI) { if (wr == 0) PG8_BAR; }
    PG8_BAR;
    if constexpr (Epi::AFTER_DRAIN) { E.fused(acc, cur, wr, wc, fr, fq, lds, wid, lane); S.done(cur); }
#undef PG8_SA
#undef PG8_SB
#undef PG8_STAGE
#undef PG8_LDA
#undef PG8_LDB
#undef PG8_MMA
#undef PG8_WAIT_V
#undef PG8_WAIT_L
#undef PG8_BAR
#undef PG8_SCHED
}
}

using pg8::bf16_t; using pg8::bf16x8; using pg8::f32x4; using pg8::u32x4; using pg8::u32x2; using pg8::cvt_pk_bf16;
#define LAS __attribute__((address_space(3)))
#define XB_TMO      128
#define XB_XCNT(j)  (256  + 64 * (j))
#define XB_XSUB(j)  (1280 + 64 * (j))
#define XB_XGEN(j)  (2304 + 64 * (j))
#define XB_TOP      3328
#define XB_TOPGEN   3392
#define XCD_BAR_WORDS 3456
#define XB_SPIN_CAP (1u << 18)

__device__ __forceinline__ unsigned xb_ld(unsigned* p)              { return __hip_atomic_load(p, __ATOMIC_RELAXED, __HIP_MEMORY_SCOPE_AGENT); }
__device__ __forceinline__ unsigned xb_add(unsigned* p, unsigned v) { return __hip_atomic_fetch_add(p, v, __ATOMIC_RELAXED, __HIP_MEMORY_SCOPE_AGENT); }
__device__ __forceinline__ unsigned xb_xcc_id() { return (unsigned)__builtin_amdgcn_s_getreg((3 << 11) | 20) & 0xFu; }
#define XB_SPIN(cond, bar) do { unsigned _sp = 0; while (cond) { __builtin_amdgcn_s_sleep(1); \
    if ((++_sp & 255u) == 0u) { if (xb_ld(&(bar)[XB_TMO])) break; if (_sp > XB_SPIN_CAP) { atomicAdd(&(bar)[XB_TMO], 1u); break; } } } } while (0)

struct XcdBarrier {
    unsigned* bar; unsigned x;
    volatile LAS unsigned* st;
};

__device__ __forceinline__ XcdBarrier xcd_barrier_post(unsigned* bar, volatile LAS unsigned* st) {
    XcdBarrier b; b.bar = bar; b.x = xb_xcc_id(); b.st = st;
    if (threadIdx.x == 0) (void)xb_add(&bar[XB_XCNT(b.x)], 1u);
    return b;
}
__device__ __forceinline__ void xcd_barrier_complete(unsigned* bar, unsigned x, unsigned& nloc, unsigned& nx) {
    const unsigned G = gridDim.x * gridDim.y * gridDim.z;
    unsigned sum, cnt, mine, sp = 0u;
    for (;;) {
        sum = 0u; cnt = 0u; mine = 0u;
#pragma unroll
        for (unsigned j = 0; j < 16; ++j) { const unsigned c = xb_ld(&bar[XB_XCNT(j)]); sum += c; cnt += (c > 0u) ? 1u : 0u; mine = (j == x) ? c : mine; }
        if (sum == G) break;
        __builtin_amdgcn_s_sleep(1);
        if ((++sp & 255u) == 0u) { if (xb_ld(&bar[XB_TMO])) break; if (sp > XB_SPIN_CAP) { atomicAdd(&bar[XB_TMO], 1u); break; } }
    }
    nloc = mine > 0u ? mine : 1u; nx = cnt > 0u ? cnt : 1u;
}

__device__ __forceinline__ void xcd_barrier(const XcdBarrier& b) {
    asm volatile("s_waitcnt vmcnt(0)" ::: "memory");
    __syncthreads();
    if (threadIdx.x == 0) {
        unsigned* bar = b.bar;
        __builtin_amdgcn_s_waitcnt(0);
        unsigned nloc = b.st[0], nx = b.st[1];
        if (nloc == 0u) { xcd_barrier_complete(bar, b.x, nloc, nx); b.st[0] = nloc; b.st[1] = nx; }
        const unsigned old = xb_add(&bar[XB_XSUB(b.x)], 1u);
        const unsigned gen = old / nloc;
        if (old + 1u == (gen + 1u) * nloc) {
            __builtin_amdgcn_fence(__ATOMIC_RELEASE, "agent");
            asm volatile("s_waitcnt vmcnt(0)" ::: "memory");
            const unsigned og = xb_add(&bar[XB_TOP], 1u);
            const unsigned tg = og / nx;
            if (og + 1u == (tg + 1u) * nx) xb_add(&bar[XB_TOPGEN], 1u);
            else XB_SPIN(xb_ld(&bar[XB_TOPGEN]) == tg, bar);
            __builtin_amdgcn_fence(__ATOMIC_ACQUIRE, "agent");
            xb_add(&bar[XB_XGEN(b.x)], 1u);
            asm volatile("s_waitcnt vmcnt(0)" ::: "memory");
        } else {
            XB_SPIN(xb_ld(&bar[XB_XGEN(b.x)]) == gen, bar);
            __builtin_amdgcn_fence(__ATOMIC_ACQUIRE, "agent");
            asm volatile("s_waitcnt vmcnt(0)" ::: "memory");
        }
    }
    __syncthreads();
}


#ifndef MK_DUP
#define MK_DUP 0u
#endif
#ifndef MK_COOP
#define MK_COOP 1
#endif
constexpr int M_ = 17408, MP_ = 16384, DM = 1024, FF = 2816, NGU = 5632, NIN = 2560, PLE = 256;
constexpr float EPS_ = 1e-6f;
constexpr int LDS_BYTES = 147456;
constexpr int NPHASE = 14;
constexpr size_t WS_WGU1 = 0;
constexpr size_t WS_WD1 = WS_WGU1 + (size_t)NGU * DM * 2;
constexpr size_t WS_WIN = WS_WD1 + (size_t)DM * FF * 2;
constexpr size_t WS_WOUT = WS_WIN + (size_t)NIN * DM * 2;
constexpr size_t WS_WGU2 = WS_WOUT + (size_t)DM * DM * 2;
constexpr size_t WS_WD2 = WS_WGU2 + (size_t)NGU * DM * 2;
constexpr size_t WS_WPG = WS_WD2 + (size_t)DM * FF * 2;
constexpr size_t WS_WPP = WS_WPG + (size_t)DM * DM * 2;
constexpr size_t WS_YC = WS_WPP + (size_t)DM * PLE * 2;
constexpr size_t WS_ACT = WS_YC + (size_t)M_ * DM * 2;
constexpr size_t WS_D = WS_ACT + (size_t)M_ * FF * 2;
constexpr size_t WS_HB = WS_D + (size_t)M_ * DM * 2;
constexpr size_t WS_SLAB2 = WS_HB + (size_t)M_ * DM * 2;
constexpr size_t WS_RS = WS_SLAB2 + (size_t)3 * 1024 * 1024 * 4;
constexpr size_t WS_END = WS_RS + (size_t)M_ * 4;
constexpr size_t WS_BAR = WS_END;
constexpr size_t WS_TOTAL = WS_BAR + (size_t)XCD_BAR_WORDS * 4;
constexpr size_t WS_PROJ = WS_ACT;
constexpr size_t WS_PP = WS_ACT;
constexpr size_t WS_PB = WS_YC + (size_t)16 * 1024 * 1024;
constexpr size_t WS_SLAB4 = WS_ACT + (size_t)M_ * DM * 4 + (size_t)M_ * PLE * 2;
static_assert(WS_SLAB4 + (size_t)4 * 1024 * 1024 * 4 <= WS_D && WS_PB + (size_t)M_ * PLE * 2 <= WS_ACT, "aliases fit");
constexpr size_t OUT_NCP = 17825792, OUT_NCS = 17833984, OUT_CVP = 17965056, OUT_CVS = 18489344;

struct Args { const float* in[28]; float* out; unsigned char* ws; int ph_lo, ph_hi; };

__device__ __forceinline__ float wave_sum(float v) {
#pragma unroll
    for (int o = 1; o < 64; o <<= 1) v += __shfl_xor(v, o);
    return v;
}
__device__ __forceinline__ float bf_lo(unsigned w) { return __uint_as_float(w << 16); }
__device__ __forceinline__ float bf_hi(unsigned w) { return __uint_as_float(w & 0xffff0000u); }
__device__ __forceinline__ float dot4(f32x4 a) { return (a.x * a.x + a.y * a.y) + (a.z * a.z + a.w * a.w); }
#define LDS_WAIT() asm volatile("s_waitcnt lgkmcnt(0)" ::: "memory")

struct TrItem { const float* W; bf16_t* WT; const float* gk; int K, N, k0, n0, drow0; };
__device__ __forceinline__ void tr_load(const TrItem& d, int lane, f32x4 (&v8)[8], float (&g8)[8]) {
#pragma unroll
    for (int i = 0; i < 8; ++i) { const int kk = 8 * i + (lane >> 3); v8[i] = __builtin_nontemporal_load((const f32x4*)(d.W + (size_t)(d.k0 + kk) * d.N + d.n0 + (lane & 7) * 4)); g8[i] = d.gk ? d.gk[d.k0 + kk] : 1.0f; }
}
__device__ __forceinline__ void tr_store(const TrItem& d, LAS float* scr, int lane, const f32x4 (&v8)[8], const float (&g8)[8]) {
#pragma unroll
    for (int i = 0; i < 8; ++i) { const int kk = 8 * i + (lane >> 3); LAS float* q = scr + kk * 33 + (lane & 7) * 4; const f32x4 v = v8[i] * g8[i]; q[0] = v.x; q[1] = v.y; q[2] = v.z; q[3] = v.w; }
    LDS_WAIT();
    const int c = lane & 7;
#pragma unroll
    for (int j = 0; j < 4; ++j) { const int n = (lane >> 3) + 8 * j; const LAS float* t = scr + (8 * c) * 33 + n;
        u32x4 o; o.x = cvt_pk_bf16(t[0 * 33], t[1 * 33]); o.y = cvt_pk_bf16(t[2 * 33], t[3 * 33]); o.z = cvt_pk_bf16(t[4 * 33], t[5 * 33]); o.w = cvt_pk_bf16(t[6 * 33], t[7 * 33]);
        *(u32x4*)(d.WT + (size_t)(d.drow0 + n) * d.K + d.k0 + 8 * c) = o; }
    LDS_WAIT();
}

__device__ __forceinline__ f32x4 bf4(unsigned a, unsigned b) { return (f32x4){bf_lo(a), bf_hi(a), bf_lo(b), bf_hi(b)}; }
template <int MODE>
__device__ __forceinline__ void rp_load_res(int m, const float* __restrict__ resP, const float* __restrict__ resS, const bf16_t* hb, int lane, f32x4 (&h)[4]) {
    if (MODE & 2) { const float* rrow = (m < MP_) ? resP + (size_t)m * DM : resS + (size_t)(m - MP_) * DM;
#pragma unroll
        for (int j = 0; j < 4; ++j) h[j] = __builtin_nontemporal_load((const f32x4*)rrow + lane + 64 * j); }
    else { const u32x2* hr = (const u32x2*)(hb + (size_t)m * DM) + lane;
#pragma unroll
        for (int j = 0; j < 4; ++j) { const u32x2 w = hr[64 * j]; h[j] = bf4(w.x, w.y); } }
}
__device__ __forceinline__ int vzero() { int z; asm volatile("v_mov_b32 %0, 0" : "=v"(z)); return z; }
template <int MODE>
__device__ __forceinline__ void rp_finish(int m, f32x4 (&h)[4], f32x4 (&d)[4], const f32x4 (&gp)[4], float sc, bf16_t* hb, float* rsv, float* __restrict__ outf, int lane, float hin_scale) {
    if (MODE & 32) {
#pragma unroll
        for (int j = 0; j < 4; ++j) h[j] *= hin_scale; }
    if (MODE & 1) {
        float ss = 0.f;
#pragma unroll
        for (int j = 0; j < 4; ++j) ss += dot4(d[j]);
        const float rs = sc * rsqrtf(wave_sum(ss) * (1.0f / DM) + EPS_);
#pragma unroll
        for (int j = 0; j < 4; ++j) h[j] += d[j] * rs * gp[j];
    }
    if (MODE & 4) {
        float s2 = 0.f;
#pragma unroll
        for (int j = 0; j < 4; ++j) s2 += dot4(h[j]);
        const float rs2 = rsqrtf(wave_sum(s2) * (1.0f / DM) + EPS_);
        if (lane == 0) rsv[m] = rs2;
        const float osc = (MODE & 64) ? rs2 : 1.0f;
        const auto hrs = pg8::mk_rsrc(hb); const unsigned ho = (unsigned)m * (DM * 2u) + (unsigned)lane * 8u;
#pragma unroll
        for (int j = 0; j < 4; ++j) { const f32x4 v = h[j] * osc; u32x2 w; w.x = cvt_pk_bf16(v.x, v.y); w.y = cvt_pk_bf16(v.z, v.w); ST8(hrs, ho + 512u * j, w); }
    }
    if (MODE & 8) { f32x4* ho = (f32x4*)(outf + (size_t)m * DM) + lane;
#pragma unroll
        for (int j = 0; j < 4; ++j) __builtin_nontemporal_store(h[j], ho + 64 * j); }
}
template <int MODE, int NSL, int N0>
__device__ __forceinline__ void rowpass(const bf16_t* __restrict__ dbuf, const bf16_t* slab0, const bf16_t* slab1, const bf16_t* __restrict__ pp, const float* __restrict__ resP, const float* __restrict__ resS,
                                        bf16_t* hb, float* rsv, float* __restrict__ outf, const float* __restrict__ gpost, float sc, int gw, int NGW, int lane) {
    f32x4 gp[4]; const int vz = vzero();
#pragma unroll
    for (int j = 0; j < 4; ++j) gp[j] = (MODE & 1) ? ((const f32x4*)gpost)[lane + 64 * j] : (f32x4){0.f, 0.f, 0.f, 0.f};
    constexpr int NR = 4;
    for (int m0 = gw; m0 < MP_; m0 += NR * NGW) {
        f32x4 hh[NR][4], dd[NR][4]; u32x2 ww[NR][4]; float isc[NR];
#pragma unroll
        for (int q = 0; q < NR; ++q) { const int m = m0 + q * NGW; isc[q] = 1.0f; if (m < MP_) { rp_load_res<MODE>(m, resP, resS, hb, lane, hh[q]); if (MODE & 32) isc[q] = rsv[m + vz]; } }
        if (MODE & 1) {
#pragma unroll
            for (int q = 0; q < NR; ++q) { const int m = m0 + q * NGW; if (m < MP_) { const u32x2* dr = (const u32x2*)(dbuf + (size_t)m * DM) + lane;
#pragma unroll
                for (int j = 0; j < 4; ++j) ww[q][j] = dr[64 * j]; } }
#pragma unroll
            for (int q = 0; q < NR; ++q)
#pragma unroll
                for (int j = 0; j < 4; ++j) dd[q][j] = bf4(ww[q][j].x, ww[q][j].y);
        }
#pragma unroll
        for (int q = 0; q < NR; ++q) { const int m = m0 + q * NGW; if (m < MP_) rp_finish<MODE>(m, hh[q], dd[q], gp, sc, hb, rsv, outf, lane, (MODE & 32) ? 1.0f / isc[q] : 1.0f); }
    }
    if (((gw & 1) == 0)) for (int r = (gw >> 3) * 4 + ((gw & 7) >> 1); r < M_ - MP_; r += (NGW >> 3) * 4) {
        const int m = MP_ + r;
        f32x4 h[4], d[4]; float isc1 = 1.0f;
        rp_load_res<MODE>(m, resP, resS, hb, lane, h);
        if (MODE & 32) isc1 = rsv[m + vz];
        if (MODE & 1) {
            u32x2 tq[4][NSL > 0 ? NSL : 1];
#pragma unroll
            for (int j = 0; j < 4; ++j)
#pragma unroll
                for (int s = 0; s < NSL; ++s) tq[j][s] = ((const u32x2*)(((s < N0) ? slab0 + ((size_t)s << 20) : slab1 + ((size_t)(s - N0) << 20)) + (size_t)r * DM))[lane + 64 * j];
#pragma unroll
            for (int j = 0; j < 4; ++j) { f32x4 acc = {0.f, 0.f, 0.f, 0.f};
#pragma unroll
                for (int s = 0; s < NSL; ++s) acc += bf4(tq[j][s].x, tq[j][s].y);
                d[j] = acc; }
            if (MODE & 16) { const u32x2* pr = (const u32x2*)(pp + (size_t)m * DM) + lane;
#pragma unroll
                for (int j = 0; j < 4; ++j) { const u32x2 pw = pr[64 * j]; const f32x4 p = bf4(pw.x, pw.y); d[j].x = pg8::sigmoid_f(d[j].x) * p.x; d[j].y = pg8::sigmoid_f(d[j].y) * p.y; d[j].z = pg8::sigmoid_f(d[j].z) * p.z; d[j].w = pg8::sigmoid_f(d[j].w) * p.w; } }
        }
        rp_finish<MODE>(m, h, d, gp, sc, hb, rsv, outf, lane, (MODE & 32) ? 1.0f / isc1 : 1.0f);
    }
}

#ifdef MK_TM
#define MIX_T(seg) do { const unsigned long long tn_ = __builtin_amdgcn_s_memrealtime(); if ((MK_TM >> (seg)) & 1u) *tqm += tn_ - tpm; tpm = tn_; } while (0)
#else
#define MIX_T(seg) do { } while (0)
#endif
__device__ __forceinline__ void mixer_phase(const Args& a, LAS unsigned char* lds, const bf16_t* __restrict__ PROJ, bf16_t* __restrict__ YC, int wave, int lane, unsigned long long* tqm) {
    unsigned long long tpm = 0ull;
    constexpr int VP = 1056;
    const auto ycrs = pg8::mk_rsrc(YC);
    LAS float* part = (LAS float*)(lds + 128 * VP);
    const int fr = lane & 15, fq = lane >> 4;
    const float* __restrict__ wsm = a.in[15]; const float* __restrict__ bsm = a.in[16];
    float* out = a.out;
    const int G_ = (int)gridDim.x, b_ = (int)blockIdx.x;
    for (int it = 0;; ++it) {
        int u, R0, nrows = 64;
        if (G_ == 256) { if (it == 0) { u = b_; R0 = u * 64; } else if (it == 1 && (b_ & 1) == 0 && b_ < 128) { u = 256; R0 = MP_ + 16 * (b_ >> 1); nrows = 16; } else break; }
        else { u = b_ + it * G_; if (u >= 272) break; R0 = u * 64; }
        const int ntb = nrows >> 4;
        const bool samp = (u >= 256);
#ifdef MK_TM
        tpm = __builtin_amdgcn_s_memrealtime();
#endif
        int s0 = 0, t0 = 0;
        if (!samp) { s0 = (u & 31) * 64; t0 = s0 & 127; }
        const int CB = R0 - t0, kext = t0 + 64;
        if (wave * 8 < nrows)
        {
            const int c0 = lane * 8; const float* cw = a.in[13];
            const f32x4 w0a = *(const f32x4*)(cw + c0), w0b = *(const f32x4*)(cw + c0 + 4), w1a = *(const f32x4*)(cw + 512 + c0), w1b = *(const f32x4*)(cw + 512 + c0 + 4),
                        w2a = *(const f32x4*)(cw + 1024 + c0), w2b = *(const f32x4*)(cw + 1024 + c0 + 4);
            const f32x4 gaa = *(const f32x4*)(a.in[17] + c0), gab = *(const f32x4*)(a.in[17] + c0 + 4);
            f32x4 zp2a = {0.f, 0.f, 0.f, 0.f}, zp2b = zp2a, zp1a = zp2a, zp1b = zp2a;
            const int rb = R0 + wave * 8; const int sb_ = ((R0 - MP_) >> 3) + wave;
            if (samp) { const float* st = a.in[4] + (size_t)sb_ * 1024 + c0; zp2a = *(const f32x4*)st; zp2b = *(const f32x4*)(st + 4); zp1a = *(const f32x4*)(st + 512); zp1b = *(const f32x4*)(st + 516); }
            else if (s0 + wave * 8 > 0) {
                const bf16_t* p2 = PROJ + (size_t)(rb - 2) * NIN + c0; const bf16_t* p1 = p2 + NIN;
                const u32x4 c2 = *(const u32x4*)(p2 + 512), h2 = *(const u32x4*)(p2 + 1024), c1 = *(const u32x4*)(p1 + 512), h1 = *(const u32x4*)(p1 + 1024);
                zp2a = bf4(c2.x, c2.y) * bf4(h2.x, h2.y); zp2b = bf4(c2.z, c2.w) * bf4(h2.z, h2.w); zp1a = bf4(c1.x, c1.y) * bf4(h1.x, h1.y); zp1b = bf4(c1.z, c1.w) * bf4(h1.z, h1.w);
            }
            f32x4 ya[8], yb[8]; float ss[8];
            u32x4 braw8[8], craw8[8], hraw8[8];
#pragma unroll
            for (int i = 0; i < 8; ++i) { const bf16_t* pr = PROJ + (size_t)(rb + i) * NIN + c0; braw8[i] = *(const u32x4*)pr; craw8[i] = *(const u32x4*)(pr + 512); hraw8[i] = *(const u32x4*)(pr + 1024); }
#pragma unroll
            for (int i = 0; i < 8; ++i) {
                const u32x4 braw = braw8[i], craw = craw8[i], hraw = hraw8[i];
                const f32x4 za = bf4(craw.x, craw.y) * bf4(hraw.x, hraw.y), zb = bf4(craw.z, craw.w) * bf4(hraw.z, hraw.w);
                const f32x4 ca = w0a * zp2a + w1a * zp1a + w2a * za, cb = w0b * zp2b + w1b * zp1b + w2b * zb;
                ya[i] = bf4(braw.x, braw.y) * ca; yb[i] = bf4(braw.z, braw.w) * cb;
                ss[i] = wave_sum(dot4(ya[i]) + dot4(yb[i]));
                if (i >= 6) {
                    if (samp) { float* o = out + OUT_NCS + ((size_t)sb_ * 2 + (i - 6)) * 512 + c0; *(f32x4*)o = za; *(f32x4*)(o + 4) = zb; }
                    else if ((u & 31) == 31 && wave == 7) { float* o = out + OUT_NCP + ((size_t)(u >> 5) * 2 + (i - 6)) * 512 + c0; *(f32x4*)o = za; *(f32x4*)(o + 4) = zb; }
                }
                zp2a = zp1a; zp2b = zp1b; zp1a = za; zp1b = zb;
            }
#pragma unroll
            for (int i = 0; i < 8; ++i) {
                const float rs = rsqrtf(ss[i] * (1.0f / 512.0f) + EPS_);
                const f32x4 y0 = ya[i] * rs * gaa, y1 = yb[i] * rs * gab;
                u32x4 w; w.x = cvt_pk_bf16(y0.x, y0.y); w.y = cvt_pk_bf16(y0.z, y0.w); w.z = cvt_pk_bf16(y1.x, y1.y); w.w = cvt_pk_bf16(y1.z, y1.w);
                ST16(ycrs, (unsigned)((rb + i) * DM + c0) * 2u, w);
            }
        }
        const int h = wave; const int nkb = kext >> 5;
        bf16x8 afr[4][4];
#pragma unroll
        for (int kb = 0; kb < 4; ++kb) {
#pragma unroll
            for (int tb = 0; tb < 4; ++tb) {
                f32x4 w0 = {0.f, 0.f, 0.f, 0.f}, w1 = w0; int lim = -1;
                if (kb < nkb) {
                    if (!samp) { const int tt = t0 + tb * 16 + fr, sb = kb * 32 + fq * 8; const float* wp = wsm + (size_t)(h * 128 + tt) * 128 + sb;
                        w0 = *(const f32x4*)wp; w1 = *(const f32x4*)(wp + 4); lim = tt - sb; }
                    else { const int tt = fr & 7; const float* wp = wsm + (size_t)(h * 128 + tt) * 128;
                        w0 = *(const f32x4*)wp; w1 = *(const f32x4*)(wp + 4); lim = ((kb * 4 + fq) == (tb * 2 + (fr >> 3))) ? tt : -1; }
                }
                w0.x = (0 <= lim) ? w0.x : 0.f; w0.y = (1 <= lim) ? w0.y : 0.f; w0.z = (2 <= lim) ? w0.z : 0.f; w0.w = (3 <= lim) ? w0.w : 0.f;
                w1.x = (4 <= lim) ? w1.x : 0.f; w1.y = (5 <= lim) ? w1.y : 0.f; w1.z = (6 <= lim) ? w1.z : 0.f; w1.w = (7 <= lim) ? w1.w : 0.f;
                u32x4 pk; pk.x = cvt_pk_bf16(w0.x, w0.y); pk.y = cvt_pk_bf16(w0.z, w0.w); pk.z = cvt_pk_bf16(w1.x, w1.y); pk.w = cvt_pk_bf16(w1.z, w1.w);
                afr[kb][tb] = __builtin_bit_cast(bf16x8, pk);
            }
        }
        {
            const f32x4 vg0 = *(const f32x4*)(a.in[14] + lane * 8), vg1 = *(const f32x4*)(a.in[14] + lane * 8 + 4);
            for (int sb8 = 0; sb8 < kext; sb8 += 64) {
                u32x4 raw8[8];
#pragma unroll
                for (int i = 0; i < 8; ++i) { int rr = CB + sb8 + i * 8 + wave; rr = rr < M_ ? rr : M_ - 1; raw8[i] = *(const u32x4*)(PROJ + (size_t)rr * NIN + 2048 + lane * 8); }
#pragma unroll
                for (int i = 0; i < 8; ++i) {
                    const int s = sb8 + i * 8 + wave, row = CB + s; const u32x4 raw = raw8[i];
                    f32x4 v0 = bf4(raw.x, raw.y), v1 = bf4(raw.z, raw.w);
                    float ss = dot4(v0) + dot4(v1);
                    ss += __shfl_xor(ss, 1); ss += __shfl_xor(ss, 2); ss += __shfl_xor(ss, 4);
                    const float rs = rsqrtf(ss * (1.0f / 64.0f) + EPS_);
                    v0 = v0 * rs * vg0; v1 = v1 * rs * vg1;
                    u32x4 pk; pk.x = cvt_pk_bf16(v0.x, v0.y); pk.y = cvt_pk_bf16(v0.z, v0.w); pk.z = cvt_pk_bf16(v1.x, v1.y); pk.w = cvt_pk_bf16(v1.z, v1.w);
                    *(LAS u32x4*)(lds + s * VP + lane * 16) = pk;
                    if (s >= t0 && s < t0 + nrows) {
                        if (samp) { float* o = out + OUT_CVS + (size_t)(row - MP_) * 512 + lane * 8; *(f32x4*)o = v0; *(f32x4*)(o + 4) = v1; }
                        else if (s0 - t0 == 1920) { float* o = out + OUT_CVP + (size_t)((u >> 5) * 128 + s) * 512 + lane * 8; *(f32x4*)o = v0; *(f32x4*)(o + 4) = v1; }
                    }
                }
            }
        }
        __syncthreads();
        MIX_T(0);
        f32x4 acc[4][4];
#pragma unroll
        for (int i = 0; i < 4; ++i)
#pragma unroll
            for (int j = 0; j < 4; ++j) acc[i][j] = (f32x4){0.f, 0.f, 0.f, 0.f};
#pragma unroll
        for (int kb = 0; kb < 4; ++kb) if (kb < nkb) {
            u32x2 r0[4], r1[4];
            { const unsigned ta = (unsigned)(uintptr_t)(lds + (kb * 32 + fq * 8 + (fr >> 2)) * VP + (h * 64 + (fr & 3) * 4) * 2);
              asm volatile("ds_read_b64_tr_b16 %0, %8\n\tds_read_b64_tr_b16 %1, %8 offset:4224\n\t"
                           "ds_read_b64_tr_b16 %2, %8 offset:32\n\tds_read_b64_tr_b16 %3, %8 offset:4256\n\t"
                           "ds_read_b64_tr_b16 %4, %8 offset:64\n\tds_read_b64_tr_b16 %5, %8 offset:4288\n\t"
                           "ds_read_b64_tr_b16 %6, %8 offset:96\n\tds_read_b64_tr_b16 %7, %8 offset:4320\n\ts_waitcnt lgkmcnt(0)"
                           : "=&v"(r0[0]), "=&v"(r1[0]), "=&v"(r0[1]), "=&v"(r1[1]), "=&v"(r0[2]), "=&v"(r1[2]), "=&v"(r0[3]), "=&v"(r1[3]) : "v"(ta) : "memory"); }
#pragma unroll
            for (int db = 0; db < 4; ++db) {
                u32x4 bq; bq.x = r0[db].x; bq.y = r0[db].y; bq.z = r1[db].x; bq.w = r1[db].y;
                const bf16x8 bfv = __builtin_bit_cast(bf16x8, bq);
#pragma unroll
                for (int tb = 0; tb < 4; ++tb) if (tb < ntb) acc[tb][db] = __builtin_amdgcn_mfma_f32_16x16x32_bf16(bfv, afr[kb][tb], acc[tb][db], 0, 0, 0);
            }
        }
#pragma unroll
        for (int tb = 0; tb < 4; ++tb) if (tb < ntb) {
            const int t = tb * 16 + fr; const int tt = samp ? (fr & 7) : (t0 + t); const float bias = bsm[h * 128 + tt];
            const bf16_t* up = PROJ + (size_t)(R0 + t) * NIN + 1536 + h * 64 + fq * 4;
            float s = 0.f;
#pragma unroll
            for (int db = 0; db < 4; ++db) { const u32x2 ur = *(const u32x2*)(up + db * 16); const f32x4 uu = bf4(ur.x, ur.y);
                const f32x4 y = uu * (acc[tb][db] + bias); acc[tb][db] = y; s += dot4(y); }
            s += __shfl_xor(s, 16); s += __shfl_xor(s, 32);
            if (fq == 0) part[h * 64 + t] = s;
        }
        f32x4 gbv[4];
#pragma unroll
        for (int db = 0; db < 4; ++db) gbv[db] = *(const f32x4*)(a.in[18] + h * 64 + db * 16 + fq * 4);
        __syncthreads();
        MIX_T(1);
#pragma unroll
        for (int tb = 0; tb < 4; ++tb) if (tb < ntb) {
            const int t = tb * 16 + fr; float tot = 0.f;
#pragma unroll
            for (int hh = 0; hh < 8; ++hh) tot += part[hh * 64 + t];
            const float rs = rsqrtf(tot * (1.0f / 512.0f) + EPS_);
            bf16_t* yp = YC + (size_t)(R0 + t) * DM + 512 + h * 64 + fq * 4;
#pragma unroll
            for (int db = 0; db < 4; ++db) { const f32x4 gb = gbv[db]; const f32x4 y = acc[tb][db] * rs * gb;
                u32x2 w; w.x = cvt_pk_bf16(y.x, y.y); w.y = cvt_pk_bf16(y.z, y.w); ST8(ycrs, (unsigned)((R0 + t) * DM + 512 + h * 64 + fq * 4 + db * 16) * 2u, w); }
        }
        MIX_T(2);
        __syncthreads();
        MIX_T(3);
    }
}

constexpr int TR_I_G = (DM / 64) * (FF / 32), TR_I_D = (FF / 64) * (DM / 32), TR_I_IN = (DM / 64) * (NIN / 32), TR_I_O = (DM / 64) * (DM / 32), TR_I_PP = (PLE / 64) * (DM / 32);
constexpr int TR_A_END = 2 * TR_I_G + TR_I_IN + TR_I_O, TR_B_END = TR_A_END + TR_I_D, TR_C_END = TR_B_END + TR_I_G + TR_I_D + TR_I_O + TR_I_PP, TR_D_END = TR_C_END + TR_I_G;
__device__ __forceinline__ void tr_decode(const Args& a, unsigned char* ws, int it, TrItem& d) {
    int r = it; int mode = 0; d.gk = nullptr;
    if (r < TR_I_G) { d.W = a.in[7]; d.K = DM; d.N = FF; d.WT = (bf16_t*)(ws + WS_WGU1); mode = 1; d.gk = a.in[5]; }
    else if ((r -= TR_I_G) < TR_I_G) { d.W = a.in[8]; d.K = DM; d.N = FF; d.WT = (bf16_t*)(ws + WS_WGU1); mode = 2; d.gk = a.in[5]; }
    else if ((r -= TR_I_G) < TR_I_IN) { d.W = a.in[12]; d.K = DM; d.N = NIN; d.WT = (bf16_t*)(ws + WS_WIN); d.gk = a.in[10]; }
    else if ((r -= TR_I_IN) < TR_I_O) { d.W = a.in[19]; d.K = DM; d.N = DM; d.WT = (bf16_t*)(ws + WS_WOUT); }
    else if ((r -= TR_I_O) < TR_I_D) { d.W = a.in[9]; d.K = FF; d.N = DM; d.WT = (bf16_t*)(ws + WS_WD1); }
    else if ((r -= TR_I_D) < TR_I_G) { d.W = a.in[23]; d.K = DM; d.N = FF; d.WT = (bf16_t*)(ws + WS_WGU2); mode = 2; d.gk = a.in[20]; }
    else if ((r -= TR_I_G) < TR_I_D) { d.W = a.in[24]; d.K = FF; d.N = DM; d.WT = (bf16_t*)(ws + WS_WD2); }
    else if ((r -= TR_I_D) < TR_I_O) { d.W = a.in[25]; d.K = DM; d.N = DM; d.WT = (bf16_t*)(ws + WS_WPG); }
    else if ((r -= TR_I_O) < TR_I_PP) { d.W = a.in[26]; d.K = PLE; d.N = DM; d.WT = (bf16_t*)(ws + WS_WPP); }
    else { r -= TR_I_PP; d.W = a.in[22]; d.K = DM; d.N = FF; d.WT = (bf16_t*)(ws + WS_WGU2); mode = 1; d.gk = a.in[20]; }
    const int nblk = d.N / 32, kb = r / nblk, nb = r % nblk; d.k0 = 64 * kb; d.n0 = 32 * nb;
    d.drow0 = mode ? (d.n0 >> 7) * 256 + (d.n0 & 127) + (mode == 2 ? 128 : 0) : d.n0;
}
__device__ __forceinline__ void do_transposes(const Args& a, unsigned char* ws, LAS unsigned char* lds, int first, int last, int widx, int nwaves, int wave, int lane) {
    LAS float* scr = (LAS float*)(lds + wave * 8448);
    int it = first + widx;
    if (it < last) {
        TrItem d0, d1; f32x4 v0[8], v1[8]; float g0[8], g1[8];
        tr_decode(a, ws, it, d0); tr_load(d0, lane, v0, g0);
        for (;;) {
            const bool m1 = it + nwaves < last;
            if (m1) { tr_decode(a, ws, it + nwaves, d1); tr_load(d1, lane, v1, g1); }
            tr_store(d0, scr, lane, v0, g0);
            if (!m1) break;
            it += nwaves;
            const bool m0 = it + nwaves < last;
            if (m0) { tr_decode(a, ws, it + nwaves, d0); tr_load(d0, lane, v0, g0); }
            tr_store(d1, scr, lane, v1, g1);
            if (!m0) break;
            it += nwaves;
        }
    }
}
__device__ __forceinline__ int fresh_tid() { int t = threadIdx.x; asm volatile("" : "+v"(t)); return t; }
template <bool COOP>
__global__ void __launch_bounds__(512, 2) fwd_kernel(Args a) {
    extern __shared__ __attribute__((aligned(16))) unsigned char lds_raw[];
    LAS unsigned char* lds = (LAS unsigned char*)lds_raw;
    const int tid = threadIdx.x;
    const int G = gridDim.x, NGW = G * 8;
#define LANE_ (fresh_tid() & 63)
#define WAVE_ (__builtin_amdgcn_readfirstlane(fresh_tid() >> 6))
#define GW_ ((int)blockIdx.x * 8 + WAVE_)
    unsigned char* ws = a.ws;
    bf16_t* WGU1 = (bf16_t*)(ws + WS_WGU1); bf16_t* WD1 = (bf16_t*)(ws + WS_WD1); bf16_t* WIN = (bf16_t*)(ws + WS_WIN); bf16_t* WOUT = (bf16_t*)(ws + WS_WOUT);
    bf16_t* WGU2 = (bf16_t*)(ws + WS_WGU2); bf16_t* WD2 = (bf16_t*)(ws + WS_WD2); bf16_t* WPG = (bf16_t*)(ws + WS_WPG); bf16_t* WPP = (bf16_t*)(ws + WS_WPP);
    bf16_t* YC = (bf16_t*)(ws + WS_YC); bf16_t* HB = (bf16_t*)(ws + WS_HB); float* RS = (float*)(ws + WS_RS); bf16_t* ACT = (bf16_t*)(ws + WS_ACT); bf16_t* PROJ = (bf16_t*)(ws + WS_PROJ); bf16_t* PB = (bf16_t*)(ws + WS_PB);
    bf16_t* DB = (bf16_t*)(ws + WS_D); bf16_t* SLAB2 = (bf16_t*)(ws + WS_SLAB2); bf16_t* SLAB4 = (bf16_t*)(ws + WS_SLAB4); bf16_t* PP = (bf16_t*)(ws + WS_PP);
#define IN(k) (a.ph_lo <= (k) && (k) < a.ph_hi)
#define REP(k) for (int rep_ = 0; rep_ < (((MK_DUP >> (k)) & 1u) ? 2 : 1); ++rep_)
    XcdBarrier bar; bar.bar = (unsigned*)(ws + WS_BAR); bar.x = 0; bar.st = nullptr;
    if (COOP) {
        volatile LAS unsigned* st = (volatile LAS unsigned*)(lds + LDS_BYTES - 16);
        if (tid < 4) st[tid] = 0u;
        __syncthreads();
        bar = xcd_barrier_post((unsigned*)(ws + WS_BAR), st);
        if (a.ph_lo < 0) cg::this_grid().sync();
    }
#ifdef MK_TPROBE
#define MIXTQ_ (&tq_)
#else
#define MIXTQ_ nullptr
#endif
#ifdef MK_TPROBE
    unsigned long long tq_ = 0ull, tp_ = __builtin_amdgcn_s_memrealtime();
#define SEAM(k) do { if (COOP && IN(k) && IN((k) + 1)) { const unsigned long long t1_ = __builtin_amdgcn_s_memrealtime(); if ((MK_TW >> (k)) & 1u) tq_ += t1_ - tp_; xcd_barrier(bar); \
        const unsigned long long t2_ = __builtin_amdgcn_s_memrealtime(); if ((MK_TB >> (k)) & 1u) tq_ += t2_ - t1_; tp_ = t2_; } } while (0)
#else
#define SEAM(k) do { if (COOP && IN(k) && IN((k) + 1)) xcd_barrier(bar); } while (0)
#endif

    if (IN(0)) REP(0) {
        const int lane = LANE_, wave = WAVE_, gw = GW_;
        do_transposes(a, ws, lds, 0, TR_A_END, gw, NGW, wave, lane);
        rowpass<2 | 4 | 64, 0, 0>(nullptr, nullptr, nullptr, nullptr, a.in[0], a.in[1], HB, RS, nullptr, nullptr, 0.f, gw, NGW, lane);
    }
    SEAM(0);
    const int bid = (int)blockIdx.x;
#define GEMM_FULL(EPI, Aop, Bop, KK, MM, NN, ...) do { pg8::Gemm g_{Aop, Bop, KK, KK, KK}; pg8::StaticOrder S_; S_.init(MM, NN, G, bid); pg8::EPI E_{__VA_ARGS__}; \
        pg8::gemm_phase<pg8::EPI, pg8::StaticOrder, true, true>(lds, g_, S_, E_); } while (0)
#define GEMM_COMBO(E0T, PERMV, Aop, Bop, KK, NSL, S0, S1, N0, ...) do { typedef pg8::EpiCombo<pg8::E0T, pg8::EpiSlabT<PERMV>> EC_; pg8::Gemm g_{Aop, Bop, KK, KK, 256}; \
        pg8::ComboOrder S_; S_.full.init(MP_, DM, G, bid); S_.sub = pg8::SubOrder{64, 4, 4, NSL, G, bid}; EC_ E_{pg8::E0T{__VA_ARGS__}, pg8::EpiSlabT<PERMV>{S0, S1, N0, 64}}; \
        pg8::gemm_phase<EC_, pg8::ComboOrder, true, true>(lds, g_, S_, E_); } while (0)
    bf16_t* const YCF = YC;
    if (IN(1)) { REP(1) GEMM_FULL(EpiSwiglu, HB, WGU1, DM, M_, NGU, ACT, FF);
        { const int nwg = (M_ / 256) * (NGU / 256), rem = nwg % G, nidle = rem ? G - rem : G, idx = rem ? bid - rem : bid;
          if (idx >= 0) do_transposes(a, ws, lds, TR_A_END, TR_B_END, idx * 8 + WAVE_, nidle * 8, WAVE_, LANE_); } }
    SEAM(1);
    if (IN(2)) REP(2) GEMM_COMBO(EpiBf16, true, ACT, WD1, FF, 11, YCF, SLAB2, 8, DB, DM, nullptr);
    SEAM(2);
    if (IN(3)) rowpass<1 | 4 | 32 | 64, 11, 8>(DB, YCF, SLAB2, nullptr, nullptr, nullptr, HB, RS, nullptr, a.in[6], 0.5f, GW_, NGW, LANE_);
    SEAM(3);
    if (IN(4)) { REP(4) GEMM_FULL(EpiBf16, HB, WIN, DM, M_, NIN, PROJ, NIN, nullptr);
        { const int nwg = (M_ / 256) * (NIN / 256), rem = nwg % G, nidle = rem ? G - rem : G, idx = rem ? bid - rem : bid;
          if (idx >= 0) do_transposes(a, ws, lds, TR_B_END, TR_C_END, idx * 8 + WAVE_, nidle * 8, WAVE_, LANE_); } }
    SEAM(4);
    if (IN(5)) REP(5) mixer_phase(a, lds, PROJ, YC, WAVE_, LANE_, MIXTQ_);
    SEAM(5);
#ifdef MK_XBAR
#pragma nounroll
    for (int xb_ = 0; xb_ < MK_XBAR; ++xb_) xcd_barrier(bar);
#endif
    if (IN(6)) { REP(6) GEMM_COMBO(EpiBf16, true, YC, WOUT, DM, 4, SLAB4, SLAB4, 4, DB, DM, nullptr);
        if (G > 64 && bid >= 64) do_transposes(a, ws, lds, TR_C_END, TR_D_END, (bid - 64) * 8 + WAVE_, (G - 64) * 8, WAVE_, LANE_);
        else if (G <= 64) do_transposes(a, ws, lds, TR_C_END, TR_D_END, bid * 8 + WAVE_, G * 8, WAVE_, LANE_); }
    SEAM(6);
    if (IN(7)) rowpass<1 | 4 | 32 | 64, 4, 4>(DB, SLAB4, SLAB4, nullptr, nullptr, nullptr, HB, RS, nullptr, a.in[11], 1.0f, GW_, NGW, LANE_);
    SEAM(7);
    if (IN(8)) { REP(8) GEMM_FULL(EpiSwiglu, HB, WGU2, DM, M_, NGU, ACT, FF);
        { const int nwg = (M_ / 256) * (NGU / 256), rem = nwg % G, nidle = rem ? G - rem : G, idx = rem ? bid - rem : bid;
          if (idx >= 0) { const int lane = LANE_, w0 = idx * 8 + WAVE_, nw = nidle * 8;
            for (int m0 = w0; m0 < M_; m0 += 8 * nw) {
                f32x4 v[8];
#pragma unroll
                for (int q = 0; q < 8; ++q) { const int m = m0 + q * nw; if (m < M_) { const float* pr = (m < MP_) ? a.in[2] + (size_t)m * PLE : a.in[3] + (size_t)(m - MP_) * PLE; v[q] = ((const f32x4*)pr)[lane]; } }
#pragma unroll
                for (int q = 0; q < 8; ++q) { const int m = m0 + q * nw; if (m < M_) { u32x2 w; w.x = cvt_pk_bf16(v[q].x, v[q].y); w.y = cvt_pk_bf16(v[q].z, v[q].w); ((u32x2*)(PB + (size_t)m * PLE))[lane] = w; } } } } } }
    SEAM(8);
    if (IN(9)) REP(9) GEMM_COMBO(EpiBf16, true, ACT, WD2, FF, 11, YCF, SLAB2, 8, DB, DM, nullptr);
    SEAM(9);
    if (IN(10)) {
        rowpass<1 | 4 | 32, 11, 8>(DB, YCF, SLAB2, nullptr, nullptr, nullptr, HB, RS, nullptr, a.in[21], 0.5f, GW_, NGW, LANE_);
    }
    SEAM(10);
    if (IN(11)) REP(11) { GEMM_FULL(EpiBf16N, PB, WPP, PLE, MP_, DM, PP, DM);
        { pg8::Gemm g_{PB, WPP, PLE, PLE, PLE}; pg8::SubOrder S_{64, 4, 4, 1, G, (bid >= 64 && bid < 80) ? bid - 64 : -1}; pg8::EpiBf16N E_{PP, DM};
          pg8::gemm_phase<pg8::EpiBf16N, pg8::SubOrder, true, true>(lds, g_, S_, E_); } }
    if (IN(12)) REP(12) GEMM_COMBO(EpiPle, false, HB, WPG, DM, 4, SLAB4, SLAB4, 4, DB, PP, DM);
    SEAM(12);
    if (IN(13)) rowpass<1 | 8 | 16, 4, 4>(DB, SLAB4, SLAB4, PP, nullptr, nullptr, HB, nullptr, a.out, a.in[27], 1.0f, GW_, NGW, LANE_);
#ifdef MK_TPROBE
    if (blockIdx.x == 0) { const unsigned long long t1_ = __builtin_amdgcn_s_memrealtime(); if ((MK_TW >> 13) & 1u) tq_ += t1_ - tp_;
        while (__builtin_amdgcn_s_memrealtime() - t1_ < 4ull * tq_) __builtin_amdgcn_s_sleep(8); }
#endif
#undef IN
#undef SEAM
}

extern "C" void kernel_launch(void* const* d_in, const int* in_sizes, int n_in, void* d_out, int out_size, void* d_ws, size_t ws_size, hipStream_t stream) {
    static int grid = 0;
    if (grid == 0) {
        if (n_in != 28 || out_size != 19013632 || ws_size < WS_TOTAL) { fprintf(stderr, "kernel_launch: unexpected shapes: n_in %d out %d ws %zu (need %zu)\n", n_in, out_size, ws_size, (size_t)WS_TOTAL); grid = -1; return; }
        int dev = 0, cus = 0, per_cu = 0;
        if (hipGetDevice(&dev) != hipSuccess || hipDeviceGetAttribute(&cus, hipDeviceAttributeMultiprocessorCount, dev) != hipSuccess) { fprintf(stderr, "kernel_launch: device query failed\n"); grid = -1; return; }
        if (hipFuncSetAttribute((const void*)fwd_kernel<true>, hipFuncAttributeMaxDynamicSharedMemorySize, LDS_BYTES) != hipSuccess) { fprintf(stderr, "kernel_launch: hipFuncSetAttribute failed\n"); grid = -1; return; }
        if (hipOccupancyMaxActiveBlocksPerMultiprocessor(&per_cu, (const void*)fwd_kernel<true>, 512, LDS_BYTES) != hipSuccess || per_cu < 1) { fprintf(stderr, "kernel_launch: occupancy query says %d blocks per CU\n", per_cu); per_cu = 1; }
        (void)hipGetLastError();
        grid = cus * per_cu;
        fprintf(stderr, "kernel_launch: grid %d (cus %d x %d)\n", grid, cus, per_cu);
    }
    if (grid < 0) return;
    Args a{};
    for (int i = 0; i < 28; ++i) a.in[i] = (const float*)d_in[i];
    a.out = (float*)d_out; a.ws = (unsigned char*)d_ws;
#if MK_COOP
    if (hipMemsetAsync((char*)d_ws + WS_BAR, 0, (size_t)XCD_BAR_WORDS * 4, stream) != hipSuccess) { fprintf(stderr, "kernel_launch: memset of the barrier words failed\n"); return; }
    a.ph_lo = 0; a.ph_hi = NPHASE;
    void* args[] = {&a};
    const hipError_t e = hipLaunchCooperativeKernel((const void*)fwd_kernel<true>, dim3(grid), dim3(512), args, LDS_BYTES, stream);
    if (e != hipSuccess) fprintf(stderr, "kernel_launch: cooperative launch failed: %s (grid %d)\n", hipGetErrorString(e), grid);
#endif
}
```
